# Optimizing an MI355X kernel written in HIP

```python
import jax, jax.numpy as jnp
from jax import lax
import numpy as np

D_MODEL = 1024
BATCH = 8
SEQ = 4096
DEPTH = 4

ROPE_THETA = 10000.0
EPS = 1e-6
BLOCK = 128

FOX_HEADS = 8
FOX_DIM = D_MODEL // 16
GLA_HEADS = 4
GLA_DK = D_MODEL // 16
GLA_DV = D_MODEL // 8
GLA_RANK = 16
GLA_TAU = 16.0
GLA_CHUNK = 64
RET_HEADS = 4
RET_DK = D_MODEL // 16
RET_DV = D_MODEL // 8
RET_CHUNK = 128
DIL_HEADS = 8
DIL_DIM = D_MODEL // 16
DIL_PATTERNS = ((128, 1), (512, 4), (2048, 16))

FOX_W = FOX_HEADS * FOX_DIM
GLA_KW = GLA_HEADS * GLA_DK
GLA_VW = GLA_HEADS * GLA_DV
EVEN_MIX = FOX_W + GLA_VW
EVEN_SIZES = (FOX_W, FOX_W, FOX_W, FOX_HEADS, GLA_KW, GLA_KW, GLA_VW, GLA_RANK, EVEN_MIX)
EVEN_IN = sum(EVEN_SIZES)

RET_KW = RET_HEADS * RET_DK
RET_VW = RET_HEADS * RET_DV
DIL_W = DIL_HEADS * DIL_DIM
ODD_MIX = RET_VW + DIL_W
ODD_SIZES = (RET_KW, RET_KW, RET_VW, DIL_W, DIL_W, DIL_W, ODD_MIX)
ODD_IN = sum(ODD_SIZES)

kernel_name = "hybrid_fox_gla_retnet_dilated"

F32 = jnp.float32


def _offsets(sizes):
    return np.cumsum(np.array(sizes))[:-1].tolist()


def rmsnorm(x, g):
    xf = x.astype(F32)
    y = xf * lax.rsqrt(jnp.mean(xf * xf, axis=-1, keepdims=True) + EPS)
    return (y * g.astype(F32)).astype(x.dtype)


def split_heads(t, h):
    B, S, _ = t.shape
    return t.reshape(B, S, h, -1).transpose(0, 2, 1, 3)


def merge_heads(t):
    B, H, S, d = t.shape
    return t.transpose(0, 2, 1, 3).reshape(B, S, H * d)


def rope(x):
    S, dh = x.shape[-2], x.shape[-1]
    inv = jnp.power(ROPE_THETA, -jnp.arange(0, dh, 2, dtype=F32) / dh)
    ang = jnp.arange(S, dtype=F32)[:, None] * inv[None, :]
    cos, sin = jnp.cos(ang), jnp.sin(ang)
    xf = x.astype(F32)
    x1, x2 = xf[..., : dh // 2], xf[..., dh // 2:]
    return jnp.concatenate([x1 * cos - x2 * sin, x2 * cos + x1 * sin], axis=-1).astype(x.dtype)


def head_norm(o, center):
    of = o.astype(F32)
    if center:
        of = of - jnp.mean(of, axis=-1, keepdims=True)
    return of * lax.rsqrt(jnp.mean(of * of, axis=-1, keepdims=True) + EPS)


def forgetting_attention(q, k, v, logf):
    B, H, S, dh = q.shape
    c = jnp.cumsum(logf, axis=-1)
    nb = S // BLOCK
    qb = q.reshape(B, H, nb, BLOCK, dh).transpose(2, 0, 1, 3, 4)
    cb = c.reshape(B, H, nb, BLOCK).transpose(2, 0, 1, 3)
    kpos = jnp.arange(S)
    scale = dh ** -0.5

    def one_block(args):
        i, qi, ci = args
        s = jnp.einsum('bhqd,bhkd->bhqk', qi, k, preferred_element_type=F32) * scale
        s = s + ci[..., :, None] - c[..., None, :]
        qpos = i * BLOCK + jnp.arange(BLOCK)
        s = jnp.where(kpos[None, :] <= qpos[:, None], s, -jnp.inf)
        p = jax.nn.softmax(s, axis=-1)
        return jnp.einsum('bhqk,bhkd->bhqd', p.astype(v.dtype), v)

    o = lax.map(one_block, (jnp.arange(nb), qb, cb))
    return o.transpose(1, 2, 0, 3, 4).reshape(B, H, S, dh)


def gla_chunked(q, k, v, g):
    B, H, S, dk = q.shape
    dv = v.shape[-1]
    C = GLA_CHUNK
    n = S // C
    r = lambda t: t.astype(F32).reshape(B, H, n, C, t.shape[-1])
    qf, kf, vf, gf = r(q) * dk ** -0.5, r(k), r(v), r(g)
    b = jnp.cumsum(gf, axis=3)
    b_last = b[:, :, :, -1:, :]
    q_t = qf * jnp.exp(b)
    k_t = kf * jnp.exp(-b)
    mask = jnp.tril(jnp.ones((C, C), dtype=bool))
    att = jnp.where(mask, jnp.einsum('bhnqd,bhnkd->bhnqk', q_t, k_t), 0.0)
    o_intra = jnp.einsum('bhnqk,bhnkv->bhnqv', att, vf)
    kv = jnp.einsum('bhnkd,bhnkv->bhndv', kf * jnp.exp(b_last - b), vf)
    decay = jnp.exp(b_last[:, :, :, 0, :])

    def step(state, inp):
        kv_n, dec_n = inp
        return state * dec_n[..., None] + kv_n, state

    _, prev = lax.scan(step, jnp.zeros((B, H, dk, dv), F32),
                       (kv.transpose(2, 0, 1, 3, 4), decay.transpose(2, 0, 1, 3)))
    prev = prev.transpose(1, 2, 0, 3, 4)
    o_inter = jnp.einsum('bhnqd,bhndv->bhnqv', q_t, prev)
    return (o_intra + o_inter).reshape(B, H, S, dv).astype(v.dtype)


def retention_chunked(q, k, v):
    B, H, S, dk = q.shape
    dv = v.shape[-1]
    C = RET_CHUNK
    n = S // C
    log_g = jnp.log(1.0 - jnp.power(2.0, -5.0 - jnp.arange(H, dtype=F32)))
    idx = jnp.arange(C, dtype=F32)
    diff = idx[:, None] - idx[None, :]
    dmat = jnp.where(diff >= 0, jnp.exp(jnp.maximum(diff, 0.0)[None] * log_g[:, None, None]), 0.0)
    xi = jnp.exp((idx + 1.0)[None, :] * log_g[:, None])
    zeta = jnp.exp((C - 1.0 - idx)[None, :] * log_g[:, None])
    gC = jnp.exp(C * log_g)
    r = lambda t: t.astype(F32).reshape(B, H, n, C, t.shape[-1])
    qf, kf, vf = r(q) * dk ** -0.5, r(k), r(v)
    att = jnp.einsum('bhnqd,bhnkd->bhnqk', qf, kf) * dmat[None, :, None]
    o_intra = jnp.einsum('bhnqk,bhnkv->bhnqv', att, vf)
    kv = jnp.einsum('bhnkd,bhnkv->bhndv', kf * zeta[None, :, None, :, None], vf)

    def step(state, kv_n):
        return state * gC[None, :, None, None] + kv_n, state

    _, prev = lax.scan(step, jnp.zeros((B, H, dk, dv), F32), kv.transpose(2, 0, 1, 3, 4))
    prev = prev.transpose(1, 2, 0, 3, 4)
    o_inter = jnp.einsum('bhnqd,bhndv->bhnqv', qf * xi[None, :, None, :, None], prev)
    return (o_intra + o_inter).reshape(B, H, S, dv).astype(v.dtype)


def _dilated_branch(q, k, v, window, dil):
    B, H, S, dh = q.shape
    span = window // dil
    unit = dil * BLOCK
    Sp = -(-S // unit) * unit
    m = Sp // dil
    nb = m // BLOCK

    def to_strided(t):
        t = jnp.pad(t, ((0, 0), (0, 0), (0, Sp - S), (0, 0)))
        return t.reshape(B, H, m, dil, dh).transpose(0, 1, 3, 2, 4).reshape(B, H, dil, nb, BLOCK, dh)

    def with_prev(t):
        prev = jnp.pad(t, ((0, 0), (0, 0), (0, 0), (1, 0), (0, 0), (0, 0)))[:, :, :, :-1]
        return jnp.concatenate([prev, t], axis=4)

    qs = to_strided(q)
    kb = with_prev(to_strided(k))
    vb = with_prev(to_strided(v))
    s = jnp.einsum('bhrnqd,bhrnkd->bhrnqk', qs, kb, preferred_element_type=F32) * dh ** -0.5
    qi = jnp.arange(BLOCK)
    ki = jnp.arange(2 * BLOCK) - BLOCK
    rel = qi[:, None] - ki[None, :]
    valid = (rel >= 0) & (rel <= span) & ((jnp.arange(nb)[:, None, None] * BLOCK + ki[None, None, :]) >= 0)
    s = jnp.where(valid, s, -jnp.inf)
    mx = jnp.max(s, axis=-1, keepdims=True)
    p = jnp.exp(s - mx)
    den = jnp.sum(p, axis=-1, keepdims=True)
    o = jnp.einsum('bhrnqk,bhrnkd->bhrnqd', p, vb.astype(F32)) / den
    lse = (mx + jnp.log(den))[..., 0]

    def from_strided(t):
        tail = t.shape[5:]
        t = t.reshape((B, H, dil, m) + tail)
        t = jnp.moveaxis(t, 2, 3).reshape((B, H, Sp) + tail)
        return t[:, :, :S]

    return from_strided(o), from_strided(lse)


def dilated_attention(q, k, v):
    outs, lses = [], []
    for window, dil in DIL_PATTERNS:
        o, lse = _dilated_branch(q, k, v, window, dil)
        outs.append(o)
        lses.append(lse)
    w = jax.nn.softmax(jnp.stack(lses, axis=0), axis=0)
    o = jnp.sum(w[..., None] * jnp.stack(outs, axis=0), axis=0)
    return o.astype(v.dtype)


def even_layer(h, norm_g, w_in, b_f, w_lr, b_lr, gla_g, w_out):
    u = rmsnorm(h, norm_g)
    z = u @ w_in
    fq, fk, fv, ff, gq, gk, gv, glr, gate = jnp.split(z, _offsets(EVEN_SIZES), axis=-1)
    logf = jax.nn.log_sigmoid((ff + b_f).astype(F32)).transpose(0, 2, 1)
    o_a = forgetting_attention(split_heads(fq, FOX_HEADS), split_heads(fk, FOX_HEADS),
                               split_heads(fv, FOX_HEADS), logf)
    glog = jax.nn.log_sigmoid((glr @ w_lr + b_lr).astype(F32)) / GLA_TAU
    o_b = gla_chunked(split_heads(gq, GLA_HEADS), split_heads(gk, GLA_HEADS),
                      split_heads(gv, GLA_HEADS), split_heads(glog, GLA_HEADS))
    o_b = merge_heads(head_norm(o_b, center=False)) * gla_g.astype(F32)
    mix = jnp.concatenate([merge_heads(o_a).astype(F32), o_b], axis=-1).astype(h.dtype)
    return h + (mix * jax.nn.silu(gate)) @ w_out


def odd_layer(h, norm_g, w_in, gn_w, gn_b, w_out):
    u = rmsnorm(h, norm_g)
    z = u @ w_in
    rq, rk, rv, dq, dk, dv, gate = jnp.split(z, _offsets(ODD_SIZES), axis=-1)
    o_c = retention_chunked(rope(split_heads(rq, RET_HEADS)), rope(split_heads(rk, RET_HEADS)),
                            split_heads(rv, RET_HEADS))
    o_c = merge_heads(head_norm(o_c, center=True)) * gn_w.astype(F32) + gn_b.astype(F32)
    o_d = dilated_attention(rope(split_heads(dq, DIL_HEADS)), rope(split_heads(dk, DIL_HEADS)),
                            split_heads(dv, DIL_HEADS))
    mix = jnp.concatenate([o_c, merge_heads(o_d).astype(F32)], axis=-1).astype(h.dtype)
    return h + (mix * jax.nn.silu(gate)) @ w_out


def setup_inputs(seed: int = 0) -> dict:
    key = jax.random.key(seed)
    ks = jax.random.split(key, 16)
    NE = (DEPTH + 1) // 2
    NO = DEPTH // 2
    nrm = lambda k, shape: jax.random.normal(k, shape, F32)
    return {
        "x": nrm(ks[0], (BATCH, SEQ, D_MODEL)),
        "norm_even": 1.0 + 0.02 * nrm(ks[1], (NE, D_MODEL)),
        "w_in_even": nrm(ks[2], (NE, D_MODEL, EVEN_IN)) * D_MODEL ** -0.5,
        "b_f_even": 3.0 + 0.5 * nrm(ks[3], (NE, FOX_HEADS)),
        "w_lr_even": nrm(ks[4], (NE, GLA_RANK, GLA_KW)) * GLA_RANK ** -0.5,
        "b_lr_even": 0.02 * nrm(ks[5], (NE, GLA_KW)),
        "gla_norm_even": 1.0 + 0.02 * nrm(ks[6], (NE, GLA_VW)),
        "w_out_even": nrm(ks[7], (NE, EVEN_MIX, D_MODEL)) * EVEN_MIX ** -0.5,
        "norm_odd": 1.0 + 0.02 * nrm(ks[8], (NO, D_MODEL)),
        "w_in_odd": nrm(ks[9], (NO, D_MODEL, ODD_IN)) * D_MODEL ** -0.5,
        "ret_gn_w_odd": 1.0 + 0.02 * nrm(ks[10], (NO, RET_VW)),
        "ret_gn_b_odd": 0.02 * nrm(ks[11], (NO, RET_VW)),
        "w_out_odd": nrm(ks[12], (NO, ODD_MIX, D_MODEL)) * ODD_MIX ** -0.5,
        "final_norm": 1.0 + 0.02 * nrm(ks[13], (D_MODEL,)),
    }


def reference(x, norm_even, w_in_even, b_f_even, w_lr_even, b_lr_even, gla_norm_even, w_out_even,
              norm_odd, w_in_odd, ret_gn_w_odd, ret_gn_b_odd, w_out_odd, final_norm):
    h = x
    for i in range(DEPTH):
        j = i // 2
        if i % 2 == 0:
            h = even_layer(h, norm_even[j], w_in_even[j], b_f_even[j], w_lr_even[j],
                           b_lr_even[j], gla_norm_even[j], w_out_even[j])
        else:
            h = odd_layer(h, norm_odd[j], w_in_odd[j], ret_gn_w_odd[j], ret_gn_b_odd[j],
                          w_out_odd[j])
    return rmsnorm(h, final_norm)
```

```cpp
#include <hip/hip_runtime.h>
#include <hip/hip_bf16.h>
#include <cstdio>
#include <cstdint>
#include <cmath>

namespace pg8 {
#define PG8_LAS __attribute__((address_space(3)))
typedef unsigned short bf16_t;
typedef short bf16x8 __attribute__((ext_vector_type(8)));
typedef float f32x4 __attribute__((ext_vector_type(4)));
typedef unsigned u32x4 __attribute__((ext_vector_type(4)));
constexpr int BM = 256, BK = 64, HALF = 128, HTB = HALF * BK * 2  , STAGE_BYTES = 8 * HTB, NXCD = 8, WGM = 8;

__host__ __device__ __forceinline__ int lds_byte(int r, int c) { const int st = (r >> 4) * 2 + (c >> 5), rr = r & 15, cc = c & 31, ob = rr * 64 + cc * 2; return st * 1024 + (ob ^ (((ob >> 9) & 1) << 5)); }
__host__ __device__ __forceinline__ void stage_rc(int b, int& R, int& C) { const int st = b / 1024, sb = b % 1024, swz = sb ^ (((sb >> 9) & 1) << 5); R = (st >> 1) * 16 + swz / 64; C = (st & 1) * 32 + (swz % 64) / 2; }
__host__ __device__ __forceinline__ int perm32(int rho) { const int n = rho >> 4, i = rho & 15; return 8 * (i >> 2) + 4 * n + (i & 3); }

struct Unit { int pm, pn; };
struct Gemm { const bf16_t* A; const bf16_t* Bt; int M, N, K; };

struct StaticOrder {
    int nM, nN, nwg, G, c;
    __host__ __device__ void init(int M, int N, int G_, int c_) { nM = M / BM; nN = N / BM; nwg = nM * nN; G = G_; c = c_; }
    __host__ __device__ bool next(int i, Unit& u) const {
        const long L = (long)i * G + c; if (L >= nwg) return false;
        int wgid = (int)L; { const int q = nwg / NXCD, r = nwg % NXCD, xcd = wgid % NXCD, off = wgid / NXCD; wgid = (xcd < r ? xcd * (q + 1) : r * (q + 1) + (xcd - r) * q) + off; }
        const int nig = WGM * nN, gid = wgid / nig, fm = gid * WGM, gsz = (nM - fm) < WGM ? (nM - fm) : WGM;
        u.pm = fm + ((wgid % nig) % gsz); u.pn = (wgid % nig) / gsz; return true;
    }
    __device__ __forceinline__ void a_ready(const Unit&) const {}
    __device__ __forceinline__ void done(const Unit&) const {}
};

__device__ __forceinline__ unsigned cvt_pk_bf16(float lo, float hi) { unsigned r; asm volatile("v_cvt_pk_bf16_f32 %0, %1, %2" : "=v"(r) : "v"(lo), "v"(hi)); return r; }

struct EpiIn {
    static constexpr bool PERM = true, AFTER_DRAIN = false;
    bf16_t* Z; int ldz; const float* ss; const float* rope; int odd; float qscale, ascale;
    __device__ __forceinline__ void operator()(const f32x4 (&acc)[2][2][4][2], const Unit& u, int wr, int wc, int fr, int fq) const {
        const int row0 = u.pm * BM + wr * 64 + fr; const int pn = u.pn;
        const float cs = (pn == 0) ? qscale : ((pn == 4 || pn == 5) ? ascale : 1.0f);
        const bool do_rope = odd && (pn <= 1 || (pn >= 4 && pn <= 7));
        const bool do_silu = pn >= 10;
        const int col0 = pn * BM + wc * 32 + 8 * fq;
#pragma unroll
        for (int ai = 0; ai < 2; ++ai)
#pragma unroll
            for (int m = 0; m < 4; ++m) {
                const int row = row0 + ai * HALF + m * 16;
                const f32x4* sp = (const f32x4*)(ss + (size_t)row * 16);
                const f32x4 s0 = sp[0], s1 = sp[1], s2 = sp[2], s3 = sp[3];
                const float tot = ((s0[0] + s0[1]) + (s0[2] + s0[3])) + ((s1[0] + s1[1]) + (s1[2] + s1[3])) + ((s2[0] + s2[1]) + (s2[2] + s2[3])) + ((s3[0] + s3[1]) + (s3[2] + s3[3]));
                const float sc = cs / sqrtf(tot * (1.0f / 1024.0f) + 1e-6f);
                bf16_t* rowp = Z + (size_t)row * ldz + col0;
#pragma unroll
                for (int bj = 0; bj < 2; ++bj) {
                    f32x4 v0 = acc[ai][bj][m][0] * sc, v1 = acc[ai][bj][m][1] * sc;
                    if (do_rope) {
                        const int t = row & 4095; const int j0 = ((bj * HALF + wc * 32 + 8 * fq) & 63) >> 1;
                        const f32x4* rp = (const f32x4*)(rope + ((size_t)t * 32 + j0) * 2);
                        const f32x4 c01 = rp[0], c23 = rp[1];
                        f32x4 w0, w1;
                        w0[0] = v0[0] * c01[0] - v0[1] * c01[1]; w0[1] = v0[1] * c01[0] + v0[0] * c01[1];
                        w0[2] = v0[2] * c01[2] - v0[3] * c01[3]; w0[3] = v0[3] * c01[2] + v0[2] * c01[3];
                        w1[0] = v1[0] * c23[0] - v1[1] * c23[1]; w1[1] = v1[1] * c23[0] + v1[0] * c23[1];
                        w1[2] = v1[2] * c23[2] - v1[3] * c23[3]; w1[3] = v1[3] * c23[2] + v1[2] * c23[3];
                        v0 = w0; v1 = w1;
                    }
                    if (do_silu) {
#pragma unroll
                        for (int e = 0; e < 4; ++e) { v0[e] = v0[e] / (1.0f + __expf(-v0[e])); v1[e] = v1[e] / (1.0f + __expf(-v1[e])); }
                    }
                    u32x4 w; w.x = cvt_pk_bf16(v0[0], v0[1]); w.y = cvt_pk_bf16(v0[2], v0[3]); w.z = cvt_pk_bf16(v1[0], v1[1]); w.w = cvt_pk_bf16(v1[2], v1[3]);
                    *(u32x4*)(rowp + bj * HALF) = w;
                }
            }
    }
};

struct EpiOut {
    static constexpr bool PERM = true, AFTER_DRAIN = false;
    const float* hin; float* hout; bf16_t* hb; float* ss;
    __device__ __forceinline__ void operator()(const f32x4 (&acc)[2][2][4][2], const Unit& u, int wr, int wc, int fr, int fq) const {
        const int row0 = u.pm * BM + wr * 64 + fr; const int col0 = u.pn * BM + wc * 32 + 8 * fq;
#pragma unroll
        for (int ai = 0; ai < 2; ++ai)
#pragma unroll
            for (int m = 0; m < 4; ++m) {
                const int row = row0 + ai * HALF + m * 16; const size_t off = (size_t)row * 1024 + col0; float q = 0.f;
#pragma unroll
                for (int bj = 0; bj < 2; ++bj) {
                    const f32x4 b0 = *(const f32x4*)(hin + off + bj * HALF), b1 = *(const f32x4*)(hin + off + bj * HALF + 4);
                    const f32x4 v0 = acc[ai][bj][m][0] + b0, v1 = acc[ai][bj][m][1] + b1;
                    *(f32x4*)(hout + off + bj * HALF) = v0; *(f32x4*)(hout + off + bj * HALF + 4) = v1;
                    q += (v0[0] * v0[0] + v0[1] * v0[1]) + (v0[2] * v0[2] + v0[3] * v0[3]) + (v1[0] * v1[0] + v1[1] * v1[1]) + (v1[2] * v1[2] + v1[3] * v1[3]);
                    u32x4 w; w.x = cvt_pk_bf16(v0[0], v0[1]); w.y = cvt_pk_bf16(v0[2], v0[3]); w.z = cvt_pk_bf16(v1[0], v1[1]); w.w = cvt_pk_bf16(v1[2], v1[3]);
                    *(u32x4*)(hb + off + bj * HALF) = w;
                }
                q += __shfl_xor(q, 16); q += __shfl_xor(q, 32);
                if (fq == 0) ss[(size_t)row * 16 + u.pn * 4 + wc] = q;
            }
    }
};

template <class Epi, class Sched, bool ALIGN_EPI = false, bool SP2 = false>
__device__ __forceinline__ void gemm_phase(PG8_LAS unsigned char* lds, const Gemm g, const Sched& S, const Epi& E) {
    int tid_ = threadIdx.x; asm volatile("" : "+v"(tid_));
    const int tid = tid_, wid = __builtin_amdgcn_readfirstlane(tid >> 6), lane = tid & 63, wr = wid >> 2, wc = wid & 3, fr = lane & 15, fq = lane >> 4;
    const int K = g.K, nt = K / BK;
    unsigned voffA[2], voffB[2];
#pragma unroll
    for (int i = 0; i < 2; ++i) { int R, C; stage_rc(tid * 16 + i * 8192, R, C); const int Rb = Epi::PERM ? ((R & ~31) + perm32(R & 31)) : R;
        voffA[i] = (unsigned)(R * K + C) * 2u; voffB[i] = (unsigned)(Rb * K + C) * 2u; }
    const size_t kstep = (size_t)(BK * 2);
    const size_t hstep = (size_t)HALF * K * 2;
    const size_t tstep = 2 * hstep;
    const unsigned ldsw = (unsigned)wid * 1024u;
    const int aoff = lds_byte(wr * 64 + fr, fq * 8), boff = lds_byte(wc * 32 + fr, fq * 8);
#define PG8_SA(b, h) (((b) * 2 + (h)) * HTB)
#define PG8_SB(b, h) ((4 + (b) * 2 + (h)) * HTB)
#define PG8_STAGE(bufoff, gbase, voff) do { _Pragma("unroll") for (int _i = 0; _i < 2; ++_i) \
        __builtin_amdgcn_global_load_lds((const unsigned*)((const char*)(gbase) + (voff)[_i]), (PG8_LAS unsigned*)(lds + (bufoff) + ldsw + _i * 8192), 16, 0, 0); } while (0)
#define PG8_LDA(dst, b, h) do { _Pragma("unroll") for (int m = 0; m < 4; ++m) _Pragma("unroll") for (int k = 0; k < 2; ++k) dst[m][k] = *(const PG8_LAS bf16x8*)(lds + PG8_SA(b, h) + aoff + m * 2048 + k * 1024); } while (0)
#define PG8_LDB(dst, b, h) do { _Pragma("unroll") for (int n = 0; n < 2; ++n) _Pragma("unroll") for (int k = 0; k < 2; ++k) dst[n][k] = *(const PG8_LAS bf16x8*)(lds + PG8_SB(b, h) + boff + n * 2048 + k * 1024); } while (0)
#define PG8_MMA(ai, bj, At, Bt) do { __builtin_amdgcn_s_setprio(1); _Pragma("unroll") for (int m = 0; m < 4; ++m) _Pragma("unroll") for (int n = 0; n < 2; ++n) _Pragma("unroll") for (int k = 0; k < 2; ++k) \
        acc[ai][bj][m][n] = __builtin_amdgcn_mfma_f32_16x16x32_bf16(Bt[n][k], At[m][k], acc[ai][bj][m][n], 0, 0, 0); __builtin_amdgcn_s_setprio(0); } while (0)
#define PG8_WAIT_V(n) asm volatile("s_waitcnt vmcnt(" #n ")" ::: "memory")
#define PG8_WAIT_L(n) asm volatile("s_waitcnt lgkmcnt(" #n ")" ::: "memory")
#define PG8_BAR __builtin_amdgcn_s_barrier()
#define PG8_SCHED __builtin_amdgcn_sched_barrier(0)
    Unit cur, nxt; int ui = 0;
    if (!S.next(0, cur)) return;
    f32x4 acc[2][2][4][2];
#pragma unroll
    for (int a = 0; a < 2; ++a)
#pragma unroll
        for (int b = 0; b < 2; ++b)
#pragma unroll
            for (int m = 0; m < 4; ++m)
#pragma unroll
                for (int n = 0; n < 2; ++n) acc[a][b][m][n] = (f32x4){0.f, 0.f, 0.f, 0.f};
    bf16x8 At[4][2], B0[2][2], B1[2][2];
    const char* cA = (const char*)g.A + (size_t)cur.pm * tstep; const char* cB = (const char*)g.Bt + (size_t)cur.pn * tstep;
    S.a_ready(cur);
    if constexpr (SP2) {
        PG8_STAGE(PG8_SB(0, 0), cB, voffB); PG8_STAGE(PG8_SB(0, 1), cB + hstep, voffB); PG8_STAGE(PG8_SA(0, 0), cA, voffA); PG8_STAGE(PG8_SA(0, 1), cA + hstep, voffA);
        if (wr == 1) PG8_BAR;
        PG8_WAIT_V(2); PG8_BAR;
        PG8_STAGE(PG8_SB(1, 0), cB + kstep, voffB); PG8_STAGE(PG8_SA(1, 0), cA + kstep, voffA); PG8_STAGE(PG8_SB(1, 1), cB + hstep + kstep, voffB);
        PG8_WAIT_V(6); PG8_BAR;
    } else {
        PG8_STAGE(PG8_SB(0, 0), cB, voffB); PG8_STAGE(PG8_SA(0, 0), cA, voffA); PG8_STAGE(PG8_SB(0, 1), cB + hstep, voffB); PG8_STAGE(PG8_SA(0, 1), cA + hstep, voffA);
        if (wr == 1) PG8_BAR;
        PG8_WAIT_V(4); PG8_BAR;
        PG8_STAGE(PG8_SB(1, 0), cB + kstep, voffB); PG8_STAGE(PG8_SA(1, 0), cA + kstep, voffA); PG8_STAGE(PG8_SB(1, 1), cB + hstep + kstep, voffB);
        PG8_WAIT_V(6); PG8_BAR;
    }
    for (;;) {
        const bool has_next = S.next(ui + 1, nxt);
        const char* nA = has_next ? (const char*)g.A + (size_t)nxt.pm * tstep : cA; const char* nB = has_next ? (const char*)g.Bt + (size_t)nxt.pn * tstep : cB;
        for (int t = 0; t < nt; t += 2) {
            const bool last = (t == nt - 2);
            const char* a1 = cA + (size_t)(t + 1) * kstep;
            const char* a2 = last ? nA : cA + (size_t)(t + 2) * kstep; const char* b2 = last ? nB : cB + (size_t)(t + 2) * kstep;
            const char* a3 = a2 + kstep; const char* b3 = b2 + kstep;
            if (last && has_next) S.a_ready(nxt);
            if constexpr (SP2) {
            PG8_LDB(B0, 0, 0); PG8_LDB(B1, 0, 1); PG8_SCHED; PG8_LDA(At, 0, 0); PG8_STAGE(PG8_SA(1, 1), a1 + hstep, voffA);
            PG8_WAIT_V(8); PG8_WAIT_L(0); PG8_BAR; PG8_MMA(0, 0, At, B0); PG8_MMA(0, 1, At, B1); PG8_BAR; PG8_SCHED;
            PG8_LDA(At, 0, 1); PG8_STAGE(PG8_SB(0, 0), b2, voffB); PG8_STAGE(PG8_SB(0, 1), b2 + hstep, voffB); PG8_STAGE(PG8_SA(0, 0), a2, voffA);
            PG8_WAIT_V(8); PG8_WAIT_L(0); PG8_BAR; PG8_MMA(1, 0, At, B0); PG8_MMA(1, 1, At, B1); PG8_BAR; PG8_SCHED;
            PG8_LDB(B0, 1, 0); PG8_LDB(B1, 1, 1); PG8_SCHED; PG8_LDA(At, 1, 0); PG8_STAGE(PG8_SA(0, 1), a2 + hstep, voffA);
            PG8_WAIT_V(8); PG8_WAIT_L(0); PG8_BAR; PG8_MMA(0, 0, At, B0); PG8_MMA(0, 1, At, B1); PG8_BAR; PG8_SCHED;
            PG8_LDA(At, 1, 1); PG8_STAGE(PG8_SB(1, 0), b3, voffB); PG8_STAGE(PG8_SB(1, 1), b3 + hstep, voffB); PG8_STAGE(PG8_SA(1, 0), a3, voffA);
            PG8_WAIT_V(8); PG8_WAIT_L(0); PG8_BAR; PG8_MMA(1, 0, At, B0); PG8_MMA(1, 1, At, B1); PG8_BAR; PG8_SCHED;
            } else {
            PG8_LDB(B0, 0, 0); PG8_SCHED; PG8_LDA(At, 0, 0); PG8_STAGE(PG8_SA(1, 1), a1 + hstep, voffA);
            PG8_WAIT_L(8); PG8_BAR; PG8_WAIT_L(0); PG8_MMA(0, 0, At, B0); PG8_BAR; PG8_SCHED;
            PG8_LDB(B1, 0, 1); PG8_STAGE(PG8_SB(0, 0), b2, voffB);
            PG8_BAR; PG8_WAIT_L(0); PG8_MMA(0, 1, At, B1); PG8_BAR;
            PG8_LDA(At, 0, 1); PG8_STAGE(PG8_SA(0, 0), a2, voffA);
            PG8_BAR; PG8_WAIT_L(0); PG8_MMA(1, 0, At, B0); PG8_BAR; PG8_SCHED;
            PG8_STAGE(PG8_SB(0, 1), b2 + hstep, voffB);
            PG8_WAIT_V(6); PG8_BAR; PG8_MMA(1, 1, At, B1); PG8_BAR;
            PG8_LDB(B0, 1, 0); PG8_SCHED; PG8_LDA(At, 1, 0); PG8_STAGE(PG8_SA(0, 1), a2 + hstep, voffA);
            PG8_WAIT_L(8); PG8_BAR; PG8_WAIT_L(0); PG8_MMA(0, 0, At, B0); PG8_BAR; PG8_SCHED;
            PG8_LDB(B1, 1, 1); PG8_STAGE(PG8_SB(1, 0), b3, voffB);
            PG8_BAR; PG8_WAIT_L(0); PG8_MMA(0, 1, At, B1); PG8_BAR;
            PG8_LDA(At, 1, 1); PG8_STAGE(PG8_SA(1, 0), a3, voffA);
            PG8_BAR; PG8_WAIT_L(0); PG8_MMA(1, 0, At, B0); PG8_BAR; PG8_SCHED;
            PG8_STAGE(PG8_SB(1, 1), b3 + hstep, voffB);
            PG8_WAIT_V(6); PG8_BAR; PG8_MMA(1, 1, At, B1); PG8_BAR;
            }
        }
        if constexpr (ALIGN_EPI) { if (wr == 0) PG8_BAR; }
        if constexpr (!Epi::AFTER_DRAIN) { E(acc, cur, wr, wc, fr, fq); S.done(cur); }
        if (!has_next) break;
#pragma unroll
        for (int a = 0; a < 2; ++a)
#pragma unroll
            for (int b = 0; b < 2; ++b)
#pragma unroll
                for (int m = 0; m < 4; ++m)
#pragma unroll
                    for (int n = 0; n < 2; ++n) acc[a][b][m][n] = (f32x4){0.f, 0.f, 0.f, 0.f};
        cur = nxt; cA = nA; cB = nB; ++ui;
        if constexpr (ALIGN_EPI) { if (wr == 1) PG8_BAR; }
    }
    PG8_WAIT_V(0);
    if constexpr (!ALIGN_EPI) { if (wr == 0) PG8_BAR; }
    PG8_BAR;
#undef PG8_SA
#undef PG8_SB
#undef PG8_STAGE
#undef PG8_LDA
#undef PG8_LDB
#undef PG8_MMA
#undef PG8_WAIT_V
#undef PG8_WAIT_L
#undef PG8_BAR
#undef PG8_SCHED
}
}
namespace attn_body {
using bf16=__hip_bfloat16;
using bf16x8=__attribute__((ext_vector_type(8)))short;
using s16x4=__attribute__((ext_vector_type(4)))short;
using f32x16=__attribute__((ext_vector_type(16)))float;
using u32x4=__attribute__((ext_vector_type(4)))unsigned;
constexpr int BATCH=8,NHEAD=8,SEQ=4096,D=64,DM=3584,OP=1024;
constexpr int NW=8,QBLK=32,QB=QBLK*NW,KVBLK=64,NQB=SEQ/QB;
constexpr int ATTN_PITCH=DM, ATTN_UNIT_ROWS=QB;
__device__ __forceinline__ int crow(int r,int hi){return (r&3)+8*(r>>2)+4*hi;}
#define SBAR() __builtin_amdgcn_sched_barrier(0)
__device__ __forceinline__ void cmask(f32x16&p0,f32x16&p1,int jb,int qrel,int hi){
  const float NEG=-INFINITY; int kb=64*jb+4*hi;
  #pragma unroll
  for(int r=0;r<16;++r){int kv=kb+(r&3)+8*(r>>2); if(kv>qrel)p0[r]=NEG; if(kv+32>qrel)p1[r]=NEG;}
}

constexpr int NSLOT=3, SLOTB=8192;
constexpr int LDS_K=0, LDS_V=NSLOT*SLOTB, LDS_WS=2*NSLOT*SLOTB, LDS_OST=LDS_WS+NW*64*4, LDS_BIAS=LDS_OST+NW*4096, LDS_BYTES=LDS_BIAS+SEQ*4;
constexpr float C2=0.125f*1.4426950408889634f;
__device__ __forceinline__ void glds16(const void*gsrc,unsigned lds_dst){unsigned keep;
  asm volatile("s_mov_b32 %0, m0\n\ts_mov_b32 m0, %2\n\ts_nop 0\n\tglobal_load_lds_dwordx4 %1, off\n\ts_mov_b32 m0, %0":"=&s"(keep):"v"(gsrc),"s"(lds_dst):"memory");}
__device__ __forceinline__ float max3f(float a,float b,float c){float r;asm("v_max3_f32 %0, %1, %2, %3":"=v"(r):"v"(a),"v"(b),"v"(c));return r;}
__device__ __forceinline__ float max2f(float a,float b){float r;asm("v_max_f32_e32 %0, %1, %2":"=v"(r):"v"(a),"v"(b));return r;}
__device__ __forceinline__ float fadd_s(float a,float b){float r;asm("v_add_f32_e32 %0, %1, %2":"=v"(r):"v"(a),"v"(b));return r;}
__device__ __forceinline__ float fsub_s(float a,float b){float r;asm("v_sub_f32_e32 %0, %1, %2":"=v"(r):"v"(a),"v"(b));return r;}
typedef float f32x4v __attribute__((ext_vector_type(4))); typedef float f32x2_t __attribute__((ext_vector_type(2))); typedef __bf16 bf16x2_t __attribute__((ext_vector_type(2)));
__device__ __forceinline__ unsigned cvtpk_s(float lo,float hi){f32x2_t v={lo,hi};bf16x2_t b=__builtin_convertvector(v,bf16x2_t);return __builtin_bit_cast(unsigned,b);}
#define WAIT_BAR(N) asm volatile("s_waitcnt vmcnt(" #N ") lgkmcnt(0)\n\ts_barrier":::"memory")

__device__ __forceinline__ void qkt(f32x16&p0,f32x16&p1,const char*Kslot,const bf16x8*qr,const f32x16&negm,int r32,int hi){
  const char*kb=Kslot+hi*1024+r32*16;
  #pragma unroll
  for(int d0=0;d0<4;++d0){
    const bf16x8 b0=*reinterpret_cast<const bf16x8*>(kb+d0*2048);
    const bf16x8 b1=*reinterpret_cast<const bf16x8*>(kb+d0*2048+512);
    if(d0==0){p0=__builtin_amdgcn_mfma_f32_32x32x16_bf16(b0,qr[0],negm,0,0,0);p1=__builtin_amdgcn_mfma_f32_32x32x16_bf16(b1,qr[0],negm,0,0,0);}
    else{p0=__builtin_amdgcn_mfma_f32_32x32x16_bf16(b0,qr[d0],p0,0,0,0);p1=__builtin_amdgcn_mfma_f32_32x32x16_bf16(b1,qr[d0],p1,0,0,0);}}
}
typedef __attribute__((address_space(3))) const char* lds_cptr;
typedef short v4i16_t __attribute__((ext_vector_type(4)));
__device__ __forceinline__ void kload8(bf16x8*kf,lds_cptr kp){
  kf[0]=*(const __attribute__((address_space(3))) bf16x8*)(kp);      kf[1]=*(const __attribute__((address_space(3))) bf16x8*)(kp+512);
  kf[2]=*(const __attribute__((address_space(3))) bf16x8*)(kp+2048); kf[3]=*(const __attribute__((address_space(3))) bf16x8*)(kp+2560);
  kf[4]=*(const __attribute__((address_space(3))) bf16x8*)(kp+4096); kf[5]=*(const __attribute__((address_space(3))) bf16x8*)(kp+4608);
  kf[6]=*(const __attribute__((address_space(3))) bf16x8*)(kp+6144); kf[7]=*(const __attribute__((address_space(3))) bf16x8*)(kp+6656);
}
__device__ __forceinline__ void kload2(bf16x8*kf,lds_cptr kp,int j){ kf[2*j]=*(const __attribute__((address_space(3))) bf16x8*)(kp+j*2048); kf[2*j+1]=*(const __attribute__((address_space(3))) bf16x8*)(kp+j*2048+512); }
__device__ __forceinline__ s16x4 vtr(lds_cptr p){ return __builtin_bit_cast(s16x4,__builtin_amdgcn_ds_read_tr16_b64_v4i16((__attribute__((address_space(3))) v4i16_t*)p)); }
__device__ __forceinline__ float rowmax(const f32x16&p0,const f32x16&p1){
  float a=max3f(p0[0],p0[1],p1[0]),b=max3f(p0[2],p0[3],p1[1]);a=max3f(a,p1[2],p1[3]);
  #pragma unroll
  for(int r=4;r<16;r+=4){a=max3f(a,p0[r],p0[r+1]);b=max3f(b,p0[r+2],p0[r+3]);a=max3f(a,p1[r],p1[r+1]);b=max3f(b,p1[r+2],p1[r+3]);}
  const float m=max2f(a,b);
  auto rr=__builtin_amdgcn_permlane32_swap(__float_as_uint(m),__float_as_uint(m),false,false);
  return max2f(__uint_as_float(rr[0]),__uint_as_float(rr[1]));
}
__device__ __forceinline__ void pv(f32x16*o,int vb,bf16x8 pa0,bf16x8 pa1,bf16x8 pa2,bf16x8 pa3){
  #pragma unroll
  for(int d0=0;d0<2;++d0){s16x4 lo[4],hi[4];
    #pragma unroll
    for(int ks=0;ks<4;++ks){
      asm volatile("ds_read_b64_tr_b16 %0,%1 offset:%c2":"=&v"(lo[ks]):"v"(vb),"i"(d0*4096+ks*1024):"memory");
      asm volatile("ds_read_b64_tr_b16 %0,%1 offset:%c2":"=&v"(hi[ks]):"v"(vb),"i"(d0*4096+ks*1024+512):"memory");}
    asm volatile("s_waitcnt lgkmcnt(0)":::"memory");SBAR();
    #define PK(k) (bf16x8){lo[k][0],lo[k][1],lo[k][2],lo[k][3],hi[k][0],hi[k][1],hi[k][2],hi[k][3]}
    o[d0]=__builtin_amdgcn_mfma_f32_32x32x16_bf16(pa0,PK(0),o[d0],0,0,0);
    o[d0]=__builtin_amdgcn_mfma_f32_32x32x16_bf16(pa1,PK(1),o[d0],0,0,0);
    o[d0]=__builtin_amdgcn_mfma_f32_32x32x16_bf16(pa2,PK(2),o[d0],0,0,0);
    o[d0]=__builtin_amdgcn_mfma_f32_32x32x16_bf16(pa3,PK(3),o[d0],0,0,0);
    #undef PK
  }
}

#ifndef ATTN_STORE16
#define ATTN_STORE16(p,v) (*(u32x4*)(p)=(v))
#endif
template<int THRL> __device__ __forceinline__ void attn_unit(int b,int h,int qb,const bf16*Q,const bf16*__restrict__ K,const bf16*__restrict__ V,const bf16*__restrict__ GT,const float*__restrict__ CB,bf16*O,char*shm){
  int tid_=threadIdx.x; asm volatile("":"+v"(tid_)); const int tid=tid_,lane=tid&63,r32=lane&31,hi=lane>>5; const int wid=__builtin_amdgcn_readfirstlane(tid>>6);
  const long rowbase=(long)b*SEQ; const int q0=qb*QB;
  const bf16*Qw=Q+(rowbase+q0+wid*QBLK)*DM+h*D;
  const bf16*Kh=K+rowbase*DM+h*D,*Vh=V+rowbase*DM+h*D;
  const unsigned lds0=(unsigned)(uintptr_t)shm;
  float*wsf=(float*)(shm+LDS_WS)+wid*64;
  const bf16*ksrc=Kh+(long)lane*DM+wid*8;
  const bf16*vsrc=Vh+(long)(16*(wid&3)+(lane>>2))*DM+(wid>>2)*32+(lane&3)*8;
  const unsigned kdst=lds0+LDS_K+wid*1024, vdst=lds0+LDS_V+wid*1024;
  #define DMA_K(t,slot) glds16(ksrc+(long)(t)*KVBLK*DM,(unsigned)__builtin_amdgcn_readfirstlane(kdst+(slot)))
  #define DMA_V(t,slot) glds16(vsrc+(long)(t)*KVBLK*DM,(unsigned)__builtin_amdgcn_readfirstlane(vdst+(slot)))
  const int vb0=(int)(lds0+LDS_V)+((lane>>4)&1)*32+(lane&3)*8+(4*hi+((lane&15)>>2))*64;
  const char*Kbase=shm+LDS_K; bf16x8 kf[8];
  const lds_cptr shm3=(lds_cptr)shm; const lds_cptr kp0=shm3+LDS_K+hi*1024+r32*16; const lds_cptr vp0=shm3+LDS_V+((lane>>4)&1)*32+(lane&3)*8+(4*hi+((lane&15)>>2))*64;
  const int NT=(q0+QB)/KVBLK;
  { const float*cbh=CB+(long)(b*NHEAD+h)*SEQ; const float cref=cbh[q0]; float*bl=(float*)(shm+LDS_BIAS); const int nk=q0+QB;
    for(int i=tid;i<nk;i+=NW*64) bl[i]=(cref-cbh[i])*1.4426950408889634f; }
  const __attribute__((address_space(3))) float* biasp=(const __attribute__((address_space(3))) float*)((lds_cptr)shm+LDS_BIAS)+4*hi;
  #define BIASADD(P0,P1,t) do{ const __attribute__((address_space(3))) float* bp_=biasp+64*(t); \
    _Pragma("unroll") for(int g_=0;g_<4;++g_){ f32x4v x0_=*(const __attribute__((address_space(3))) f32x4v*)(bp_+8*g_); f32x4v x1_=*(const __attribute__((address_space(3))) f32x4v*)(bp_+32+8*g_); \
      x0_=x0_-mhat; x1_=x1_-mhat; \
      P0[4*g_]+=x0_[0];P0[4*g_+1]+=x0_[1];P0[4*g_+2]+=x0_[2];P0[4*g_+3]+=x0_[3]; P1[4*g_]+=x1_[0];P1[4*g_+1]+=x1_[1];P1[4*g_+2]+=x1_[2];P1[4*g_+3]+=x1_[3]; } }while(0)
  DMA_K(0,0);DMA_V(0,0);DMA_K(1,SLOTB);
  bf16x8 qr[4];
  #pragma unroll
  for(int d0=0;d0<4;++d0)qr[d0]=*reinterpret_cast<const bf16x8*>(&Qw[(long)r32*DM+d0*16+hi*8]);
  float mhat=0.f,l_reg=0.f;f32x16 o[2];o[0]=f32x16{};o[1]=f32x16{};const f32x16 negm=f32x16{};
  const int qrel=wid*QBLK+r32;
  #define CMASK(P0,P1,t) do{int jb_=(t)-(NT-4); if(jb_>=0)cmask(P0,P1,jb_,qrel,hi);}while(0)
  bool resc=false;
  #define START(P0,P1) do{ const float rm=rowmax(P0,P1); resc=false; \
    { const float dl=rm; mhat=fadd_s(mhat,dl); \
      _Pragma("unroll") for(int r=0;r<16;++r){P0[r]=fsub_s(P0[r],dl);P1[r]=fsub_s(P1[r],dl);} \
      } \
    _Pragma("unroll") for(int r=0;r<16;++r)P0[r]=__builtin_amdgcn_exp2f(P0[r]); }while(0)
  #define RESC() do{ if(resc){ asm volatile("s_waitcnt lgkmcnt(0)":::"memory"); \
      _Pragma("unroll") for(int d_=0;d_<2;++d_) _Pragma("unroll") for(int r=0;r<16;++r)o[d_][r]*=wsf[crow(r,hi)]; } }while(0)
  f32x16 pA0,pA1,pB0,pB1;
  int sl_prev=0,sl_cur=0,sl_next=SLOTB;
  #define ROT() do{sl_prev=sl_cur;sl_cur=sl_next;sl_next=(sl_next==(NSLOT-1)*SLOTB)?0:sl_next+SLOTB;}while(0)
  DMA_K(2,2*SLOTB);
  WAIT_BAR(3);
  qkt(pA0,pA1,Kbase,qr,negm,r32,hi);asm volatile("s_nop 15\n\ts_nop 7":"+v"(pA0),"+v"(pA1));BIASADD(pA0,pA1,0);CMASK(pA0,pA1,0);
  START(pA0,pA1);
  _Pragma("unroll") for(int r=0;r<16;++r)pA1[r]=__builtin_amdgcn_exp2f(pA1[r]);
  WAIT_BAR(0);
  DMA_K(3,0);DMA_V(1,SLOTB);
  ROT();
  kload8(kf,kp0+sl_cur);
  WAIT_BAR(2);
  s16x4 vlo[8],vhi[8]; u32x4 pw0,pw1,pw2,pw3;
  #define PKW(P,B) cvtpk_s(P[B],P[B+1])
  #define PAF(k) __builtin_bit_cast(bf16x8,pw##k)
  #define VFR(i) (bf16x8){vlo[i][0],vlo[i][1],vlo[i][2],vlo[i][3],vhi[i][0],vhi[i][1],vhi[i][2],vhi[i][3]}
  #define PIN(x) asm volatile("":"+v"(x))
  #define MX3(a,b,c) __builtin_fmaxf(__builtin_fmaxf((a),(b)),(c))
  #define GAPA(MF,A0,A1,A2,A3,W0,W1,PW) do{ MF; sacc+=A0; sacc+=A1; sacc+=A2; sacc+=A3; PIN(sacc); W0; W1; PIN(PW); SBAR(); }while(0)
  #define EX(v) __builtin_amdgcn_exp2f(v)
  #define GAPB(MF,X,B) do{ MF; X[B]=EX(X[B]); X[B+1]=EX(X[B+1]); X[B+2]=EX(X[B+2]); X[B+3]=EX(X[B+3]); PIN(X); SBAR(); }while(0)
  #define VRD(i) do{ vlo[i]=vtr(vp_+(((i)>>2)*4096+((i)&3)*1024)); vhi[i]=vtr(vp_+(((i)>>2)*4096+((i)&3)*1024+512)); }while(0)
  #define KRD(G,j) do{ if(G){ kload2(kf,kp0+sl_next,j); SBAR(); } }while(0)
  #define STEP(C0,C1,P0,P1,t,GK,GV,GL) do{ SBAR(); \
    const lds_cptr vp_=vp0+sl_prev; \
    VRD(0); SBAR(); float sacc=(P0[0]+P0[1]); \
    GAPA(C0=__builtin_amdgcn_mfma_f32_32x32x16_bf16(kf[0],qr[0],negm,0,0,0), P0[2],P0[3],P0[4],P0[5],     pw0[0]=PKW(P0,0), pw0[1]=PKW(P0,2), pw0); \
    VRD(4); SBAR(); GAPA(C1=__builtin_amdgcn_mfma_f32_32x32x16_bf16(kf[1],qr[0],negm,0,0,0), P0[6],P0[7],P0[8],P0[9],     pw0[2]=PKW(P0,4), pw0[3]=PKW(P0,6), pw0); \
    VRD(1); SBAR(); GAPA(C0=__builtin_amdgcn_mfma_f32_32x32x16_bf16(kf[2],qr[1],C0,0,0,0),   P0[10],P0[11],P0[12],P0[13], pw1[0]=PKW(P0,8), pw1[1]=PKW(P0,10), pw1); \
    VRD(5); SBAR(); GAPA(C1=__builtin_amdgcn_mfma_f32_32x32x16_bf16(kf[3],qr[1],C1,0,0,0),   P0[14],P0[15],P1[0],P1[1],   pw1[2]=PKW(P0,12),pw1[3]=PKW(P0,14), pw1); \
    VRD(2); SBAR(); GAPA(C0=__builtin_amdgcn_mfma_f32_32x32x16_bf16(kf[4],qr[2],C0,0,0,0),   P1[2],P1[3],P1[4],P1[5],     pw2[0]=PKW(P1,0), pw2[1]=PKW(P1,2), pw2); \
    VRD(6); SBAR(); GAPA(C1=__builtin_amdgcn_mfma_f32_32x32x16_bf16(kf[5],qr[2],C1,0,0,0),   P1[6],P1[7],P1[8],P1[9],     pw2[2]=PKW(P1,4), pw2[3]=PKW(P1,6), pw2); \
    VRD(3); SBAR(); GAPA(C0=__builtin_amdgcn_mfma_f32_32x32x16_bf16(kf[6],qr[3],C0,0,0,0),   P1[10],P1[11],P1[12],P1[13], pw3[0]=PKW(P1,8), pw3[1]=PKW(P1,10), pw3); \
    VRD(7); SBAR(); GAPA(C1=__builtin_amdgcn_mfma_f32_32x32x16_bf16(kf[7],qr[3],C1,0,0,0),   P1[14],P1[15],0.f,0.f,       pw3[2]=PKW(P1,12),pw3[3]=PKW(P1,14), pw3); \
    l_reg+=sacc; \
    if(GK){DMA_K((t)+3,sl_cur);} if(GV){DMA_V((t)+1,sl_next);} \
    BIASADD(C0,C1,t); CMASK(C0,C1,t); \
    { float a=MX3(C0[0],C0[1],C1[0]),b=MX3(C0[2],C0[3],C1[1]); a=MX3(a,C1[2],C1[3]); \
      _Pragma("unroll") for(int r=4;r<16;r+=4){a=MX3(a,C0[r],C0[r+1]);b=MX3(b,C0[r+2],C0[r+3]);a=MX3(a,C1[r],C1[r+1]);b=MX3(b,C1[r+2],C1[r+3]);} \
      float rm=__builtin_fmaxf(a,b); { auto rr=__builtin_amdgcn_permlane32_swap(__float_as_uint(rm),__float_as_uint(rm),false,false); rm=__builtin_fmaxf(__uint_as_float(rr[0]),__uint_as_float(rr[1])); } \
      resc=false; \
      if(__builtin_expect(__any(rm>(float)THRL),0)){ const float dl=__builtin_fmaxf(rm,0.f); mhat+=dl; \
        _Pragma("unroll") for(int r=0;r<16;++r){C0[r]-=dl;C1[r]-=dl;} \
        const float f=__builtin_amdgcn_exp2f(-dl); l_reg*=f; if(hi==0)wsf[r32]=f; resc=true; } } \
    SBAR(); \
    GAPB(o[0]=__builtin_amdgcn_mfma_f32_32x32x16_bf16(PAF(0),VFR(0),o[0],0,0,0), C0,0); \
    GAPB(o[1]=__builtin_amdgcn_mfma_f32_32x32x16_bf16(PAF(0),VFR(4),o[1],0,0,0), C0,4); \
    KRD(GL,0); GAPB(o[0]=__builtin_amdgcn_mfma_f32_32x32x16_bf16(PAF(1),VFR(1),o[0],0,0,0), C0,8); \
    KRD(GL,1); GAPB(o[1]=__builtin_amdgcn_mfma_f32_32x32x16_bf16(PAF(1),VFR(5),o[1],0,0,0), C0,12); \
    KRD(GL,2); GAPB(o[0]=__builtin_amdgcn_mfma_f32_32x32x16_bf16(PAF(2),VFR(2),o[0],0,0,0), C1,0); \
    KRD(GL,3); GAPB(o[1]=__builtin_amdgcn_mfma_f32_32x32x16_bf16(PAF(2),VFR(6),o[1],0,0,0), C1,4); \
    GAPB(o[0]=__builtin_amdgcn_mfma_f32_32x32x16_bf16(PAF(3),VFR(3),o[0],0,0,0), C1,8); \
    GAPB(o[1]=__builtin_amdgcn_mfma_f32_32x32x16_bf16(PAF(3),VFR(7),o[1],0,0,0), C1,12); \
    }while(0)
  int t=1;
  #undef CMASK
  #define CMASK(P0,P1,t) do{}while(0)
  for(;t+5<NT;t+=2){
    STEP(pB0,pB1,pA0,pA1,t,true,true,true);     WAIT_BAR(2); RESC(); ROT();
    STEP(pA0,pA1,pB0,pB1,t+1,true,true,true);   WAIT_BAR(2); RESC(); ROT();
  }
  #undef CMASK
  #define CMASK(P0,P1,t) do{int jb_=(t)-(NT-4); if(jb_>=0)cmask(P0,P1,jb_,qrel,hi);}while(0)
  #define ENDW(tt) do{ if((tt)+3<NT){WAIT_BAR(2);} else if((tt)+2<NT){WAIT_BAR(1);} else {WAIT_BAR(0);} }while(0)
  for(;t+1<NT;t+=2){
    STEP(pB0,pB1,pA0,pA1,t,(t+3<NT),(t+1<NT),(t+1<NT));       ENDW(t);   RESC(); ROT();
    STEP(pA0,pA1,pB0,pB1,t+1,(t+4<NT),(t+2<NT),(t+2<NT));     ENDW(t+1); RESC(); ROT();
  }
  STEP(pB0,pB1,pA0,pA1,NT-1,false,false,false); RESC();
  { float sacc=pB0[0]+pB0[1]; _Pragma("unroll") for(int r=2;r<16;++r)sacc+=pB0[r]; _Pragma("unroll") for(int r=0;r<16;++r)sacc+=pB1[r]; l_reg+=sacc;
    pw0=(u32x4){PKW(pB0,0),PKW(pB0,2),PKW(pB0,4),PKW(pB0,6)};pw1=(u32x4){PKW(pB0,8),PKW(pB0,10),PKW(pB0,12),PKW(pB0,14)};pw2=(u32x4){PKW(pB1,0),PKW(pB1,2),PKW(pB1,4),PKW(pB1,6)};pw3=(u32x4){PKW(pB1,8),PKW(pB1,10),PKW(pB1,12),PKW(pB1,14)};
    SBAR(); pv(o,vb0+sl_cur,PAF(0),PAF(1),PAF(2),PAF(3)); }
  #undef PKW
  #undef PAF
  #undef VFR
  #undef PIN
  #undef MX3
  #undef GAPA
  #undef GAPB
  #undef EX
  #undef VRD
  #undef KRD
  #undef STEP
  #undef ENDW
  {auto rr=__builtin_amdgcn_permlane32_swap(__float_as_uint(l_reg),__float_as_uint(l_reg),false,false);l_reg=__uint_as_float(rr[0])+__uint_as_float(rr[1]);}
  if(hi==0)wsf[32+r32]=l_reg;asm volatile("s_waitcnt lgkmcnt(0)":::"memory");
  float rli[16];
  #pragma unroll
  for(int r=0;r<16;++r)rli[r]=__builtin_amdgcn_rcpf(wsf[32+crow(r,hi)]);
  bf16*Ow=O+(rowbase+q0+wid*QBLK)*OP+h*D; const bf16*Gw=GT+(rowbase+q0+wid*QBLK)*DM+h*D;
  { bf16*stg=(bf16*)(shm+LDS_OST)+wid*2048;
    #pragma unroll
    for(int r=0;r<16;++r){const int orow=crow(r,hi);
      #pragma unroll
      for(int d0=0;d0<2;++d0)stg[orow*64+d0*32+r32]=__float2bfloat16(o[d0][r]*rli[r]);}
    asm volatile("s_waitcnt lgkmcnt(0)":::"memory");
    #pragma unroll
    for(int i=0;i<4;++i){const int row=i*8+(lane>>3),ch=lane&7; const u32x4 v=*(const u32x4*)(stg+row*64+ch*8); const u32x4 g=*(const u32x4*)(Gw+(long)row*DM+ch*8); u32x4 w;
      _Pragma("unroll") for(int e=0;e<4;++e){ const float a0=__uint_as_float(v[e]<<16)*__uint_as_float(g[e]<<16), a1=__uint_as_float(v[e]&0xffff0000u)*__uint_as_float(g[e]&0xffff0000u); w[e]=cvtpk_s(a0,a1); }
      ATTN_STORE16(Ow+(long)row*OP+ch*8,w);} }
  asm volatile("s_waitcnt lgkmcnt(0)\n\ts_barrier":::"memory");
  #undef BIASADD
  #undef DMA_K
  #undef DMA_V
  #undef CMASK
  #undef START
  #undef RESC
  #undef ROT
}
constexpr int ATTN_LDS_BYTES=LDS_BYTES;
struct AttnTensors { const bf16* Q; const bf16* K; const bf16* V; const bf16* GT; const float* CB; bf16* O; };
struct AttnUnit { int bh; int qb; };
struct StaticOrder {
  int vcu,G;
  __device__ __forceinline__ explicit StaticOrder(int grid,int block):vcu((grid%8==0)?(block%8)*(grid/8)+block/8:block),G(grid){}
  __device__ __forceinline__ bool next(int i,AttnUnit&u)const{
    if(G==256){ if(i>=4)return false; const int s=vcu&3; u.bh=vcu>>2; u.qb=(i==0)?s:(i==1)?7-s:(i==2)?8+s:15-s; return true; }
    const int idx=i*G+vcu; if(idx>=BATCH*NHEAD*NQB)return false; u.bh=idx/NQB; u.qb=NQB-1-idx%NQB; return true; }
  __device__ __forceinline__ void a_ready(const AttnUnit&)const{}
  __device__ __forceinline__ void done(const AttnUnit&)const{}
};
template<class Sched,int THRL=8> __device__ __forceinline__ void attn_phase(char*lds,const AttnTensors&T,const Sched&S){
  AttnUnit u;
  for(int i=0;S.next(i,u);++i){ S.a_ready(u); attn_unit<THRL>(u.bh/NHEAD,u.bh%NHEAD,u.qb,T.Q,T.K,T.V,T.GT,T.CB,T.O,lds); S.done(u); }
}
#undef SBAR
#undef WAIT_BAR
}
constexpr int NWAVES = 8;
constexpr int BATCH = 8, SEQ = 4096, DMODEL = 1024, M = BATCH * SEQ;
constexpr int NZ = 3584;
constexpr int ZC_LQ = 0, ZC_LK = 256, ZC_LV = 512, ZC_AQ = 1024, ZC_AK = 1536, ZC_AV = 2048, ZC_GATE = 2560;
constexpr int EVEN_IN = 3608, ODD_IN = 3584;
constexpr float RMS_EPS = 1e-6f;
constexpr float LOG2E = 1.4426950408889634f;
constexpr float C2 = 0.125f * LOG2E;

constexpr size_t MiB = 1u << 20;
constexpr size_t WS_CTL = 0, CTL_ZERO_BYTES = 1 * MiB;
constexpr size_t WS_ROPE = 1 * MiB;
constexpr size_t WS_SS = 2 * MiB;
constexpr size_t WS_FF = 4 * MiB;
constexpr size_t WS_GLR = 5 * MiB;
constexpr size_t WS_CB = 7 * MiB;
constexpr size_t WS_LSE = 8 * MiB;
constexpr size_t WS_DECAY = 9 * MiB;
constexpr size_t WS_WSK = 10 * MiB;
constexpr size_t WS_W = 11 * MiB;
constexpr size_t WS_Z = 48 * MiB;
constexpr size_t WS_Y = 272 * MiB;
constexpr size_t WS_HB = 336 * MiB;
constexpr size_t WS_KV = 400 * MiB;
constexpr size_t WS_PREV = 464 * MiB;
constexpr size_t WS_END = 496 * MiB;
constexpr int CW_TMO = 0, CW_CODE = 1;
constexpr int CW_BAR = 4096;

constexpr int RING_OFF = 0, RING_BYTES = 131072;
constexpr int LDSCTL_OFF = RING_BYTES, MISC_OFF = LDSCTL_OFF + 320;
constexpr int LDS_BYTES = 147456;
static_assert(MISC_OFF + 128 <= LDS_BYTES, "LDS map");

#define GAS __attribute__((address_space(1)))
#define LAS __attribute__((address_space(3)))
typedef unsigned short bf16;
typedef unsigned v4u __attribute__((ext_vector_type(4)));
typedef float f32x4 __attribute__((ext_vector_type(4)));
typedef short bf16x8 __attribute__((ext_vector_type(8)));
typedef GAS unsigned gu32;
#define RLX_AGENT __ATOMIC_RELAXED, __HIP_MEMORY_SCOPE_AGENT
#define LDS_WAIT() asm volatile("s_waitcnt lgkmcnt(0)" ::: "memory")
#define VM_WAIT() asm volatile("s_waitcnt vmcnt(0)" ::: "memory")
__device__ __forceinline__ unsigned f2bf(float f) { unsigned u = __builtin_bit_cast(unsigned, f); return (u + 0x7fffu + ((u >> 16) & 1u)) >> 16; }
__device__ __forceinline__ unsigned pk2(float lo, float hi) { return f2bf(lo) | (f2bf(hi) << 16); }
__device__ __forceinline__ float bflo(unsigned w) { return __uint_as_float(w << 16); }
__device__ __forceinline__ float bfhi(unsigned w) { return __uint_as_float(w & 0xffff0000u); }
__device__ __forceinline__ float bf1(bf16 h) { return __uint_as_float((unsigned)h << 16); }
__device__ __forceinline__ float logsigmoidf(float x) { return x < 0.f ? x - log1pf(__expf(x)) : -log1pf(__expf(-x)); }

#define XB_TMO      128
#define XB_XCNT(j)  (256  + 64 * (j))
#define XB_XSUB(j)  (1280 + 64 * (j))
#define XB_XGEN(j)  (2304 + 64 * (j))
#define XB_TOP      3328
#define XB_TOPGEN   3392
#define XCD_BAR_WORDS 3456
#define XB_SPIN_CAP (1u << 18)

__device__ __forceinline__ unsigned xb_ld(unsigned* p)              { return __hip_atomic_load(p, __ATOMIC_RELAXED, __HIP_MEMORY_SCOPE_AGENT); }
__device__ __forceinline__ unsigned xb_add(unsigned* p, unsigned v) { return __hip_atomic_fetch_add(p, v, __ATOMIC_RELAXED, __HIP_MEMORY_SCOPE_AGENT); }
__device__ __forceinline__ unsigned xb_xcc_id() { return (unsigned)__builtin_amdgcn_s_getreg((3 << 11) | 20) & 0xFu; }
#define XB_SPIN(cond, bar) do { unsigned _sp = 0; while (cond) { __builtin_amdgcn_s_sleep(1); \
    if ((++_sp & 255u) == 0u) { if (xb_ld(&(bar)[XB_TMO])) break; if (_sp > XB_SPIN_CAP) { atomicAdd(&(bar)[XB_TMO], 1u); break; } } } } while (0)

struct XcdBarrier { unsigned* bar; unsigned x; volatile LAS unsigned* st; };

__device__ __forceinline__ XcdBarrier xcd_barrier_post(unsigned* bar, volatile LAS unsigned* st) {
    XcdBarrier b; b.bar = bar; b.x = xb_xcc_id(); b.st = st;
    if (threadIdx.x == 0) (void)xb_add(&bar[XB_XCNT(b.x)], 1u);
    return b;
}
__device__ __forceinline__ void xcd_barrier_complete(unsigned* bar, unsigned x, unsigned& nloc, unsigned& nx) {
    const unsigned G = gridDim.x * gridDim.y * gridDim.z;
    unsigned sum, cnt, mine, sp = 0u;
    for (;;) {
        sum = 0u; cnt = 0u; mine = 0u;
#pragma unroll
        for (unsigned j = 0; j < 16; ++j) { const unsigned c = xb_ld(&bar[XB_XCNT(j)]); sum += c; cnt += (c > 0u) ? 1u : 0u; mine = (j == x) ? c : mine; }
        if (sum == G) break;
        __builtin_amdgcn_s_sleep(1);
        if ((++sp & 255u) == 0u) { if (xb_ld(&bar[XB_TMO])) break; if (sp > XB_SPIN_CAP) { atomicAdd(&bar[XB_TMO], 1u); break; } }
    }
    nloc = mine > 0u ? mine : 1u; nx = cnt > 0u ? cnt : 1u;
}
__device__ __forceinline__ void xcd_barrier(const XcdBarrier& b) {
    asm volatile("s_waitcnt vmcnt(0)" ::: "memory");
    __syncthreads();
    if (threadIdx.x == 0) {
        unsigned* bar = b.bar;
        __builtin_amdgcn_s_waitcnt(0);
        unsigned nloc = b.st[0], nx = b.st[1];
        if (nloc == 0u) { xcd_barrier_complete(bar, b.x, nloc, nx); b.st[0] = nloc; b.st[1] = nx; }
        const unsigned old = xb_add(&bar[XB_XSUB(b.x)], 1u);
        const unsigned gen = old / nloc;
        if (old + 1u == (gen + 1u) * nloc) {
            __builtin_amdgcn_fence(__ATOMIC_RELEASE, "agent");
            asm volatile("s_waitcnt vmcnt(0)" ::: "memory");
            const unsigned og = xb_add(&bar[XB_TOP], 1u);
            const unsigned tg = og / nx;
            if (og + 1u == (tg + 1u) * nx) xb_add(&bar[XB_TOPGEN], 1u);
            else XB_SPIN(xb_ld(&bar[XB_TOPGEN]) == tg, bar);
            __builtin_amdgcn_fence(__ATOMIC_ACQUIRE, "agent");
            xb_add(&bar[XB_XGEN(b.x)], 1u);
            asm volatile("s_waitcnt vmcnt(0)" ::: "memory");
        } else {
            XB_SPIN(xb_ld(&bar[XB_XGEN(b.x)]) == gen, bar);
            __builtin_amdgcn_fence(__ATOMIC_ACQUIRE, "agent");
            asm volatile("s_waitcnt vmcnt(0)" ::: "memory");
        }
    }
    __syncthreads();
}

struct Frame {
    LAS unsigned char* lds;
    volatile LAS unsigned* MISC;
    gu32* ctl;
    int tid, lane, wave;
    int vcu, G;
    unsigned char* ws;
};

__device__ __forceinline__ float wave_sum(float v) {
#pragma unroll
    for (int o = 1; o < 64; o <<= 1) v += __shfl_xor(v, o);
    return v;
}

__device__ __forceinline__ int wsrc_col(int kind, int n) {
    if (kind == 0) {
        if (n < 256) return 1544 + n;
        if (n < 512) return 1800 + (n - 256);
        if (n < 1024) return 2056 + (n - 512);
        if (n < 1536) return n - 1024;
        if (n < 2048) return 512 + (n - 1536);
        if (n < 2560) return 1024 + (n - 2048);
        return 2584 + (n - 2560);
    } else if (kind == 1) {
        const bool il = (n < 512) || (n >= 1024 && n < 2048);
        if (!il) return n;
        const int p = n & 63; return (n & ~63) + (p >> 1) + 32 * (p & 1);
    } else if (kind == 2) {
        return n;
    } else {
        if (n < 8) return 1536 + n;
        if (n < 24) return 2568 + (n - 8);
        return -1;
    }
}
__device__ __forceinline__ void p0_transpose_item(const float* W, int Nsrc, int kind, const float* gain, bf16* WT, int nblk, LAS float* scr, int item, int lane) {
    const int K = DMODEL; const int kb = item / nblk, nb = item % nblk, k0 = 64 * kb, n0 = 32 * nb;
    const int sc = wsrc_col(kind, n0 + (lane & 31));
#pragma unroll 8
    for (int i = 0; i < 32; ++i) { const int kk = 2 * i + (lane >> 5); const float g = gain ? gain[k0 + kk] : 1.0f;
        scr[kk * 33 + (lane & 31)] = (sc >= 0) ? W[(size_t)(k0 + kk) * Nsrc + sc] * g : 0.f; }
    LDS_WAIT(); asm volatile("" ::: "memory");
    const int c = lane & 7;
#pragma unroll
    for (int j = 0; j < 4; ++j) { const int n = (lane >> 3) + 8 * j; const LAS float* s = scr + (8 * c) * 33 + n;
        v4u o; o.x = pk2(s[0 * 33], s[1 * 33]); o.y = pk2(s[2 * 33], s[3 * 33]); o.z = pk2(s[4 * 33], s[5 * 33]); o.w = pk2(s[6 * 33], s[7 * 33]);
        *(GAS v4u*)(WT + (size_t)(n0 + n) * K + k0 + 8 * c) = o; }
    LDS_WAIT(); asm volatile("" ::: "memory");
}
struct Args { const float* in[14]; float* out; unsigned char* ws; int ph_lo, ph_hi, li, pad; };

constexpr size_t W_LAYER_BYTES = 9 * MiB;
__device__ __forceinline__ bf16* w_in_ptr(unsigned char* ws, int L) { return (bf16*)(ws + WS_W + (size_t)L * W_LAYER_BYTES); }
__device__ __forceinline__ bf16* w_out_ptr(unsigned char* ws, int L) { return (bf16*)(ws + WS_W + (size_t)L * W_LAYER_BYTES + 7 * MiB); }

__device__ __forceinline__ void p0_prologue(Frame& F, const Args& a) {
    LAS float* scr = (LAS float*)(F.lds + RING_OFF + F.wave * 16384);
    const int gw = F.vcu * NWAVES + F.wave, NGW = F.G * NWAVES;
    constexpr int I_IN = 16 * 112, I_OUT = 16 * 32, I_SK = 16, PER_LAYER = I_IN + I_OUT, NITEMS = 4 * PER_LAYER + 2 * I_SK;
    for (int it = gw; it < NITEMS; it += NGW) {
        if (it < 4 * PER_LAYER) {
            const int L = it / PER_LAYER; int r = it % PER_LAYER; const int j = L >> 1, odd = L & 1;
            if (r < I_IN) {
                const float* W = odd ? a.in[9] + (size_t)j * DMODEL * ODD_IN : a.in[2] + (size_t)j * DMODEL * EVEN_IN;
                const float* gain = (odd ? a.in[8] : a.in[1]) + j * DMODEL;
                p0_transpose_item(W, odd ? ODD_IN : EVEN_IN, odd ? 1 : 0, gain, w_in_ptr(a.ws, L), 112, scr, r, F.lane);
            } else {
                r -= I_IN;
                const float* W = (odd ? a.in[12] : a.in[7]) + (size_t)j * DMODEL * DMODEL;
                p0_transpose_item(W, DMODEL, 2, nullptr, w_out_ptr(a.ws, L), 32, scr, r, F.lane);
            }
        } else {
            const int r = it - 4 * PER_LAYER; const int j = r / I_SK;
            p0_transpose_item(a.in[2] + (size_t)j * DMODEL * EVEN_IN, EVEN_IN, 3, a.in[1] + j * DMODEL, (bf16*)(a.ws + WS_WSK) + (size_t)j * 32 * DMODEL, 1, scr, r % I_SK, F.lane);
        }
    }
    {
        bf16* HB = (bf16*)(a.ws + WS_HB); float* SS = (float*)(a.ws + WS_SS);
        for (int m = gw; m < M; m += NGW) {
            const GAS f32x4* xr = (const GAS f32x4*)(a.in[0] + (size_t)m * DMODEL) + F.lane;
            GAS unsigned long long* o8 = (GAS unsigned long long*)(HB + (size_t)m * DMODEL) + F.lane;
            float s = 0.f;
#pragma unroll
            for (int j = 0; j < 4; ++j) { const f32x4 v = xr[64 * j]; s += (v.x * v.x + v.y * v.y) + (v.z * v.z + v.w * v.w);
                o8[64 * j] = (unsigned long long)pk2(v.x, v.y) | ((unsigned long long)pk2(v.z, v.w) << 32); }
            s = wave_sum(s);
            if (F.lane < 16) SS[(size_t)m * 16 + F.lane] = (F.lane == 0) ? s : 0.f;
        }
    }
    {
        float* RP = (float*)(a.ws + WS_ROPE);
        for (int e = F.vcu * 512 + F.tid; e < SEQ * 32; e += F.G * 512) {
            const int t = e >> 5, j = e & 31;
            const float inv = (float)exp(-(double)j * (9.210340371976184 / 32.0));
            const float ang = (float)t * inv;
            double sn, cs; sincos((double)ang, &sn, &cs);
            RP[2 * e] = (float)cs; RP[2 * e + 1] = (float)sn;
        }
    }
}

__device__ __forceinline__ void skinny_phase(Frame& F, const bf16* HB, const bf16* WSK, const float* SS, const float* b_f, float* FFo, float* GLRo) {
    typedef float f32x4_t __attribute__((ext_vector_type(4)));
    const int lr = F.lane & 15, kq = F.lane >> 4;
    for (int rb = blockIdx.x; rb < M / 128; rb += F.G) {
        const int r0 = rb * 128 + F.wave * 16;
        f32x4_t acc0 = {0.f, 0.f, 0.f, 0.f}, acc1 = {0.f, 0.f, 0.f, 0.f};
        const bf16* ap = HB + (size_t)(r0 + lr) * DMODEL + 8 * kq;
        const bf16* bp0 = WSK + (size_t)lr * DMODEL + 8 * kq;
        const bf16* bp1 = WSK + (size_t)(16 + lr) * DMODEL + 8 * kq;
#pragma unroll 8
        for (int k0 = 0; k0 < DMODEL; k0 += 32) {
            const bf16x8 av = *(const bf16x8*)(ap + k0), b0 = *(const bf16x8*)(bp0 + k0), b1 = *(const bf16x8*)(bp1 + k0);
            acc0 = __builtin_amdgcn_mfma_f32_16x16x32_bf16(av, b0, acc0, 0, 0, 0);
            acc1 = __builtin_amdgcn_mfma_f32_16x16x32_bf16(av, b1, acc1, 0, 0, 0);
        }
#pragma unroll
        for (int reg = 0; reg < 4; ++reg) {
            const int row = r0 + 4 * kq + reg;
            const f32x4* sp = (const f32x4*)(SS + (size_t)row * 16);
            const f32x4 s0 = sp[0], s1 = sp[1], s2 = sp[2], s3 = sp[3];
            const float tot = ((s0[0] + s0[1]) + (s0[2] + s0[3])) + ((s1[0] + s1[1]) + (s1[2] + s1[3])) + ((s2[0] + s2[1]) + (s2[2] + s2[3])) + ((s3[0] + s3[1]) + (s3[2] + s3[3]));
            const float rinv = 1.0f / sqrtf(tot * (1.0f / 1024.0f) + RMS_EPS);
            const float v0 = acc0[reg] * rinv, v1 = acc1[reg] * rinv;
            if (lr < 8) { FFo[(size_t)row * 8 + lr] = logsigmoidf(v0 + b_f[lr]); GLRo[(size_t)row * 16 + 8 + lr] = v1; }
            else GLRo[(size_t)row * 16 + (lr - 8)] = v0;
        }
    }
}

__device__ __forceinline__ void cumsum_unit(Frame& F, int bh, const float* FFp, float* CB) {
    LAS float* wsum = (LAS float*)(F.lds + RING_OFF);
    const int b = bh >> 3, h = bh & 7;
    float v[8]; float run = 0.f;
#pragma unroll
    for (int i = 0; i < 8; ++i) { run += FFp[((size_t)b * SEQ + F.tid * 8 + i) * 8 + h]; v[i] = run; }
    float x = run;
#pragma unroll
    for (int o = 1; o < 64; o <<= 1) { const float y = __shfl_up(x, o); if (F.lane >= o) x += y; }
    if (F.lane == 63) wsum[F.wave] = x;
    __syncthreads();
    float off = x - run;
    for (int w = 0; w < F.wave; ++w) off += wsum[w];
#pragma unroll
    for (int i = 0; i < 8; ++i) CB[(size_t)bh * SEQ + F.tid * 8 + i] = v[i] + off;
    __syncthreads();
}

__device__ __forceinline__ void lin_naive_unit(Frame& F, int b, bool odd, const bf16* Z, const float* GLRp, const float* w_lr, const float* b_lr, const float* g1, const float* g2, bf16* Y) {
    float* qs = (float*)(F.lds + RING_OFF);
    float* ks = qs + 4096;
    float* al = ks + 4096;
    float* vs = al + 4096;
    float* os = vs + 8192;
    const int tid = F.tid, hd = tid >> 7;
    float S[64];
#pragma unroll
    for (int d = 0; d < 64; ++d) S[d] = 0.f;
    for (int t0 = 0; t0 < SEQ; t0 += 16) {
        for (int i = 0; i < 8; ++i) {
            const int e = tid + 512 * i, tok = e >> 8, c = e & 255; const size_t row = (size_t)b * SEQ + t0 + tok;
            qs[e] = bf1(Z[row * NZ + ZC_LQ + c]); ks[e] = bf1(Z[row * NZ + ZC_LK + c]);
            float a;
            if (odd) a = 1.0f - exp2f(-5.0f - (float)(c >> 6));
            else { float x = b_lr[c];
#pragma unroll
                for (int r = 0; r < 16; ++r) x += GLRp[row * 16 + r] * w_lr[r * 256 + c];
                a = __expf(logsigmoidf(x) * (1.0f / 16.0f)); }
            al[e] = a;
        }
        for (int i = 0; i < 16; ++i) vs[i * 512 + tid] = bf1(Z[((size_t)b * SEQ + t0 + i) * NZ + ZC_LV + tid]);
        __syncthreads();
        for (int tok = 0; tok < 16; ++tok) {
            const f32x4* q4 = (const f32x4*)(qs + tok * 256 + hd * 64); const f32x4* k4 = (const f32x4*)(ks + tok * 256 + hd * 64); const f32x4* a4 = (const f32x4*)(al + tok * 256 + hd * 64);
            const float vv = vs[tok * 512 + tid]; float o = 0.f;
#pragma unroll
            for (int d4 = 0; d4 < 16; ++d4) { const f32x4 qq = q4[d4], kk = k4[d4], aa = a4[d4];
#pragma unroll
                for (int e = 0; e < 4; ++e) { S[4 * d4 + e] = aa[e] * S[4 * d4 + e] + kk[e] * vv; o += qq[e] * S[4 * d4 + e]; } }
            os[tok * 512 + tid] = o;
        }
        __syncthreads();
        for (int i = 0; i < 8; ++i) {
            const int p = F.wave * 8 + i, tok = p >> 2, hh = p & 3; const size_t row = (size_t)b * SEQ + t0 + tok;
            float x0 = os[tok * 512 + hh * 128 + F.lane], x1 = os[tok * 512 + hh * 128 + 64 + F.lane];
            if (odd) { const float mu = wave_sum(x0 + x1) * (1.0f / 128.0f); x0 -= mu; x1 -= mu; }
            const float var = wave_sum(x0 * x0 + x1 * x1) * (1.0f / 128.0f); const float rs = 1.0f / sqrtf(var + RMS_EPS);
            const int c0 = hh * 128 + F.lane, c1 = c0 + 64;
            float y0 = x0 * rs * g1[c0], y1 = x1 * rs * g1[c1];
            if (odd) { y0 += g2[c0]; y1 += g2[c1]; }
            const int yb = odd ? 0 : 512;
            y0 *= bf1(Z[row * NZ + ZC_GATE + yb + c0]); y1 *= bf1(Z[row * NZ + ZC_GATE + yb + c1]);
            Y[row * DMODEL + yb + c0] = (bf16)f2bf(y0); Y[row * DMODEL + yb + c1] = (bf16)f2bf(y1);
        }
        __syncthreads();
    }
}

__device__ __forceinline__ void dil_naive_unit(Frame& F, int u, const bf16* Z, bf16* Y) {
    const int bh = u >> 3, tb = u & 7, b = bh >> 3, h = bh & 7, t = tb * 512 + F.tid;
    const bf16* zb = Z + (size_t)b * SEQ * NZ;
    float q[64], acc[64];
    { const v4u* qp = (const v4u*)(zb + (size_t)t * NZ + ZC_AQ + h * 64);
#pragma unroll
      for (int c = 0; c < 8; ++c) { const v4u w = qp[c];
#pragma unroll
          for (int e = 0; e < 4; ++e) { q[8 * c + 2 * e] = bflo(w[e]); q[8 * c + 2 * e + 1] = bfhi(w[e]); } } }
#pragma unroll
    for (int d = 0; d < 64; ++d) acc[d] = 0.f;
    float mx = -INFINITY, l = 0.f;
    for (int p = 0; p < 3; ++p) {
        const int dil = (p == 0) ? 1 : (p == 1) ? 4 : 16;
        for (int j = 0; j <= 128; ++j) {
            const int pos = t - j * dil; if (pos < 0) break;
            const v4u* kp = (const v4u*)(zb + (size_t)pos * NZ + ZC_AK + h * 64);
            float s = 0.f;
#pragma unroll
            for (int c = 0; c < 8; ++c) { const v4u w = kp[c];
#pragma unroll
                for (int e = 0; e < 4; ++e) { s += q[8 * c + 2 * e] * bflo(w[e]); s += q[8 * c + 2 * e + 1] * bfhi(w[e]); } }
            if (s > mx) { const float sc = exp2f(mx - s); l *= sc;
#pragma unroll
                for (int d = 0; d < 64; ++d) acc[d] *= sc;
                mx = s; }
            const float pr = exp2f(s - mx); l += pr;
            const v4u* vp = (const v4u*)(zb + (size_t)pos * NZ + ZC_AV + h * 64);
#pragma unroll
            for (int c = 0; c < 8; ++c) { const v4u w = vp[c];
#pragma unroll
                for (int e = 0; e < 4; ++e) { acc[8 * c + 2 * e] += pr * bflo(w[e]); acc[8 * c + 2 * e + 1] += pr * bfhi(w[e]); } }
        }
    }
    const float inv = 1.0f / l; const size_t row = (size_t)b * SEQ + t;
    const v4u* gp = (const v4u*)(Z + row * NZ + ZC_GATE + 512 + h * 64); v4u* yp = (v4u*)(Y + row * DMODEL + 512 + h * 64);
#pragma unroll
    for (int c = 0; c < 8; ++c) { const v4u g = gp[c]; v4u o;
#pragma unroll
        for (int e = 0; e < 4; ++e) o[e] = pk2(acc[8 * c + 2 * e] * inv * bflo(g[e]), acc[8 * c + 2 * e + 1] * inv * bfhi(g[e]));
        yp[c] = o; }
}

__device__ __forceinline__ void final_norm_phase(Frame& F, float* out, const float* g) {
    const int gw = F.vcu * NWAVES + F.wave, NGW = F.G * NWAVES;
    f32x4 gv[4];
#pragma unroll
    for (int j = 0; j < 4; ++j) gv[j] = ((const f32x4*)g)[F.lane + 64 * j];
    for (int m = gw; m < M; m += NGW) {
        GAS f32x4* xr = (GAS f32x4*)(out + (size_t)m * DMODEL) + F.lane;
        f32x4 v[4]; float s = 0.f;
#pragma unroll
        for (int j = 0; j < 4; ++j) { v[j] = xr[64 * j]; s += (v[j].x * v[j].x + v[j].y * v[j].y) + (v[j].z * v[j].z + v[j].w * v[j].w); }
        const float r = 1.0f / sqrtf(wave_sum(s) * (1.0f / 1024.0f) + RMS_EPS);
#pragma unroll
        for (int j = 0; j < 4; ++j) xr[64 * j] = v[j] * r * gv[j];
    }
}

constexpr int PH_PER_LAYER = 4, N_PHASES = 2 + 4 * PH_PER_LAYER;
#ifndef MK_N_LAUNCHES
#define MK_N_LAUNCHES 1
#endif

#define IN(k) (lo <= (k) && (k) < hi)
#define SEAM(k) do { if (IN(k) && IN((k) + 1)) xcd_barrier(bar); } while (0)
__device__ __forceinline__ unsigned char* launder_ptr(unsigned char* p) { asm volatile("" : "+s"(p)); return p; }
__device__ __forceinline__ void refresh(Frame& F) { int t = threadIdx.x; asm volatile("" : "+v"(t)); F.tid = t; F.lane = t & 63; F.wave = __builtin_amdgcn_readfirstlane(t >> 6); }
template <int L> __device__ __forceinline__ void run_layer(Frame& F, const Args& args, const XcdBarrier& bar, const int lo, const int hi, unsigned char* lds) {
    constexpr int pb = 1 + PH_PER_LAYER * L; constexpr int j = L >> 1; constexpr bool odd = (L & 1) != 0;
    if (IN(pb)) {
        unsigned char* ws = launder_ptr(args.ws); refresh(F);
        bf16* Z = (bf16*)(ws + WS_Z); bf16* HB = (bf16*)(ws + WS_HB); float* SS = (float*)(ws + WS_SS);
        pg8::Gemm g{HB, w_in_ptr(ws, L), M, NZ, DMODEL}; pg8::StaticOrder S; S.init(M, NZ, F.G, (int)blockIdx.x);
        pg8::EpiIn E{Z, NZ, SS, (const float*)(ws + WS_ROPE), odd ? 1 : 0, 0.125f, C2};
        pg8::gemm_phase<pg8::EpiIn, pg8::StaticOrder, true, true>(F.lds + RING_OFF, g, S, E);
        if (!odd) skinny_phase(F, HB, (const bf16*)(ws + WS_WSK) + (size_t)j * 32 * DMODEL, SS, args.in[3] + j * 8, (float*)(ws + WS_FF), (float*)(ws + WS_GLR));
    }
    SEAM(pb);
    if (IN(pb + 1)) {
        unsigned char* ws = launder_ptr(args.ws); refresh(F);
        bf16* Z = (bf16*)(ws + WS_Z); bf16* Y = (bf16*)(ws + WS_Y);
        if (!odd) {
            for (int u = blockIdx.x; u < 72; u += F.G) {
                if (u < 8) lin_naive_unit(F, u, false, Z, (const float*)(ws + WS_GLR), args.in[4] + (size_t)j * 16 * 256, args.in[5] + j * 256, args.in[6] + j * 512, nullptr, Y);
                else cumsum_unit(F, u - 8, (const float*)(ws + WS_FF), (float*)(ws + WS_CB));
            }
        } else {
            for (int u = blockIdx.x; u < 520; u += F.G) {
                if (u < 8) lin_naive_unit(F, u, true, Z, nullptr, nullptr, nullptr, args.in[10] + j * 512, args.in[11] + j * 512, Y);
                else dil_naive_unit(F, u - 8, Z, Y);
            }
        }
    }
    SEAM(pb + 1);
    if (IN(pb + 2)) {
        if (!odd) {
            unsigned char* ws = launder_ptr(args.ws);
            bf16* Z = (bf16*)(ws + WS_Z);
            const attn_body::AttnTensors AT{(const attn_body::bf16*)(Z + ZC_AQ), (const attn_body::bf16*)(Z + ZC_AK), (const attn_body::bf16*)(Z + ZC_AV), (const attn_body::bf16*)(Z + ZC_GATE), (const float*)(ws + WS_CB), (attn_body::bf16*)(ws + WS_Y)};
            const attn_body::StaticOrder S((int)F.G, (int)blockIdx.x);
            attn_body::attn_phase<attn_body::StaticOrder>((char*)lds + RING_OFF, AT, S);
        }
    }
    SEAM(pb + 2);
    if (IN(pb + 3)) {
        unsigned char* ws = launder_ptr(args.ws); refresh(F);
        pg8::Gemm g{(bf16*)(ws + WS_Y), w_out_ptr(ws, L), M, DMODEL, DMODEL}; pg8::StaticOrder S; S.init(M, DMODEL, F.G, (int)blockIdx.x);
        pg8::EpiOut E{L == 0 ? args.in[0] : args.out, args.out, (bf16*)(ws + WS_HB), (float*)(ws + WS_SS)};
        pg8::gemm_phase<pg8::EpiOut, pg8::StaticOrder, true, true>(F.lds + RING_OFF, g, S, E);
    }
    SEAM(pb + 3);
}
#undef IN
#undef SEAM

__global__ void __launch_bounds__(NWAVES * 64, 2) trunk_fwd(Args args) {
    extern __shared__ __attribute__((aligned(16))) unsigned char lds[];
    Frame F;
    F.lds = (LAS unsigned char*)lds;
    F.MISC = (volatile LAS unsigned*)(F.lds + MISC_OFF);
    F.tid = threadIdx.x; F.lane = F.tid & 63; F.wave = __builtin_amdgcn_readfirstlane(F.tid >> 6);
    F.G = gridDim.x; { const int bx = blockIdx.x; F.vcu = (F.G % 8 == 0) ? (bx % 8) * (F.G / 8) + bx / 8 : bx; }
    F.ws = args.ws; F.ctl = (gu32*)(args.ws + WS_CTL);
    for (int u = F.tid; u < (LDS_BYTES - LDSCTL_OFF) / 4; u += NWAVES * 64) ((LAS unsigned*)(F.lds + LDSCTL_OFF))[u] = 0u;
    __syncthreads();
    XcdBarrier bar = xcd_barrier_post((unsigned*)(F.ctl + CW_BAR) + args.li * XCD_BAR_WORDS, F.MISC + 8);
    const int lo = args.ph_lo, hi = args.ph_hi;
#define IN(k) (lo <= (k) && (k) < hi)
#define SEAM(k) do { if (IN(k) && IN((k) + 1)) xcd_barrier(bar); } while (0)

    if (IN(0)) p0_prologue(F, args);
    SEAM(0);

    run_layer<0>(F, args, bar, lo, hi, lds); run_layer<1>(F, args, bar, lo, hi, lds); run_layer<2>(F, args, bar, lo, hi, lds); run_layer<3>(F, args, bar, lo, hi, lds);
    if (IN(N_PHASES - 1)) { refresh(F); final_norm_phase(F, args.out, args.in[13]); }
#undef IN
#undef SEAM
}

extern "C" void kernel_launch(void* const* d_in, const int* in_sizes, int n_in, void* d_out, int out_size, void* d_ws, size_t ws_size, hipStream_t stream) {
    static int grid = 0;
    if (grid == 0) {
        if (n_in != 14 || in_sizes[0] != M * DMODEL || out_size != M * DMODEL || ws_size < WS_END) { fprintf(stderr, "kernel_launch: unexpected shapes: n_in %d in0 %d out %d ws %zu (need %zu)\n", n_in, n_in > 0 ? in_sizes[0] : -1, out_size, ws_size, (size_t)WS_END); grid = -1; return; }
        int dev = 0, cus = 0, per_cu = 0;
        if (hipGetDevice(&dev) != hipSuccess || hipDeviceGetAttribute(&cus, hipDeviceAttributeMultiprocessorCount, dev) != hipSuccess) { fprintf(stderr, "kernel_launch: device query failed\n"); grid = -1; return; }
        if (hipFuncSetAttribute((const void*)trunk_fwd, hipFuncAttributeMaxDynamicSharedMemorySize, LDS_BYTES) != hipSuccess) { fprintf(stderr, "kernel_launch: hipFuncSetAttribute failed\n"); grid = -1; return; }
        if (hipOccupancyMaxActiveBlocksPerMultiprocessor(&per_cu, (const void*)trunk_fwd, NWAVES * 64, LDS_BYTES) != hipSuccess || per_cu < 1) fprintf(stderr, "kernel_launch: note: occupancy query reports %d blocks per CU\n", per_cu);
        (void)hipGetLastError();
        grid = cus;
    }
    if (grid < 0) return;
    if (hipMemsetAsync((char*)d_ws + WS_CTL, 0, CTL_ZERO_BYTES, stream) != hipSuccess) { fprintf(stderr, "kernel_launch: memset failed\n"); return; }
    Args a{};
    for (int i = 0; i < 14; ++i) a.in[i] = (const float*)d_in[i];
    a.out = (float*)d_out; a.ws = (unsigned char*)d_ws;
    constexpr int NL = MK_N_LAUNCHES;
    for (int li = 0; li < NL; ++li) {
        a.ph_lo = (NL == 1) ? 0 : li; a.ph_hi = (NL == 1) ? N_PHASES : li + 1; a.li = li;
        hipLaunchKernelGGL(trunk_fwd, dim3(grid), dim3(NWAVES * 64), LDS_BYTES, stream, a);
        const hipError_t le = hipPeekAtLastError();
        if (le != hipSuccess) { fprintf(stderr, "kernel_launch: launch %d failed: %s\n", li, hipGetErrorName(le)); break; }
    }
}
```

```cpp
#include <hip/hip_runtime.h>
#include <hip/hip_bf16.h>
#include <cstdio>
#include <cstdint>
#include <cmath>

namespace pg8 {
#define PG8_LAS __attribute__((address_space(3)))
typedef unsigned short bf16_t;
typedef short bf16x8 __attribute__((ext_vector_type(8)));
typedef float f32x4 __attribute__((ext_vector_type(4)));
typedef unsigned u32x4 __attribute__((ext_vector_type(4)));
constexpr int BM = 256, BK = 64, HALF = 128, HTB = HALF * BK * 2  , STAGE_BYTES = 8 * HTB, NXCD = 8, WGM = 8;

__host__ __device__ __forceinline__ int lds_byte(int r, int c) { const int st = (r >> 4) * 2 + (c >> 5), rr = r & 15, cc = c & 31, ob = rr * 64 + cc * 2; return st * 1024 + (ob ^ (((ob >> 9) & 1) << 5)); }
__host__ __device__ __forceinline__ void stage_rc(int b, int& R, int& C) { const int st = b / 1024, sb = b % 1024, swz = sb ^ (((sb >> 9) & 1) << 5); R = (st >> 1) * 16 + swz / 64; C = (st & 1) * 32 + (swz % 64) / 2; }
__host__ __device__ __forceinline__ int perm32(int rho) { const int n = rho >> 4, i = rho & 15; return 8 * (i >> 2) + 4 * n + (i & 3); }

struct Unit { int pm, pn; };
struct Gemm { const bf16_t* A; const bf16_t* Bt; int M, N, K; };

struct StaticOrder {
    int nM, nN, nwg, G, c;
    __host__ __device__ void init(int M, int N, int G_, int c_) { nM = M / BM; nN = N / BM; nwg = nM * nN; G = G_; c = c_; }
    __host__ __device__ bool next(int i, Unit& u) const {
        const long L = (long)i * G + c; if (L >= nwg) return false;
        int wgid = (int)L; { const int q = nwg / NXCD, r = nwg % NXCD, xcd = wgid % NXCD, off = wgid / NXCD; wgid = (xcd < r ? xcd * (q + 1) : r * (q + 1) + (xcd - r) * q) + off; }
        const int nig = WGM * nN, gid = wgid / nig, fm = gid * WGM, gsz = (nM - fm) < WGM ? (nM - fm) : WGM;
        u.pm = fm + ((wgid % nig) % gsz); u.pn = (wgid % nig) / gsz; return true;
    }
    __device__ __forceinline__ void a_ready(const Unit&) const {}
    __device__ __forceinline__ void done(const Unit&) const {}
};

__device__ __forceinline__ unsigned cvt_pk_bf16(float lo, float hi) { unsigned r; asm volatile("v_cvt_pk_bf16_f32 %0, %1, %2" : "=v"(r) : "v"(lo), "v"(hi)); return r; }

struct EpiIn {
    static constexpr bool PERM = true, AFTER_DRAIN = false;
    bf16_t* Z; int ldz; const float* ss; const float* rope; int odd; float qscale, ascale;
    __device__ __forceinline__ void operator()(const f32x4 (&acc)[2][2][4][2], const Unit& u, int wr, int wc, int fr, int fq) const {
        const int row0 = u.pm * BM + wr * 64 + fr; const int pn = u.pn;
        const float cs = (pn == 0) ? qscale : ((pn == 4 || pn == 5) ? ascale : 1.0f);
        const bool do_rope = odd && (pn <= 1 || (pn >= 4 && pn <= 7));
        const bool do_silu = pn >= 10;
        const int col0 = pn * BM + wc * 32 + 8 * fq;
#pragma unroll
        for (int ai = 0; ai < 2; ++ai)
#pragma unroll
            for (int m = 0; m < 4; ++m) {
                const int row = row0 + ai * HALF + m * 16;
                const f32x4* sp = (const f32x4*)(ss + (size_t)row * 16);
                const f32x4 s0 = sp[0], s1 = sp[1], s2 = sp[2], s3 = sp[3];
                const float tot = ((s0[0] + s0[1]) + (s0[2] + s0[3])) + ((s1[0] + s1[1]) + (s1[2] + s1[3])) + ((s2[0] + s2[1]) + (s2[2] + s2[3])) + ((s3[0] + s3[1]) + (s3[2] + s3[3]));
                const float sc = cs / sqrtf(tot * (1.0f / 1024.0f) + 1e-6f);
                bf16_t* rowp = Z + (size_t)row * ldz + col0;
#pragma unroll
                for (int bj = 0; bj < 2; ++bj) {
                    f32x4 v0 = acc[ai][bj][m][0] * sc, v1 = acc[ai][bj][m][1] * sc;
                    if (do_rope) {
                        const int t = row & 4095; const int j0 = ((bj * HALF + wc * 32 + 8 * fq) & 63) >> 1;
                        const f32x4* rp = (const f32x4*)(rope + ((size_t)t * 32 + j0) * 2);
                        const f32x4 c01 = rp[0], c23 = rp[1];
                        f32x4 w0, w1;
                        w0[0] = v0[0] * c01[0] - v0[1] * c01[1]; w0[1] = v0[1] * c01[0] + v0[0] * c01[1];
                        w0[2] = v0[2] * c01[2] - v0[3] * c01[3]; w0[3] = v0[3] * c01[2] + v0[2] * c01[3];
                        w1[0] = v1[0] * c23[0] - v1[1] * c23[1]; w1[1] = v1[1] * c23[0] + v1[0] * c23[1];
                        w1[2] = v1[2] * c23[2] - v1[3] * c23[3]; w1[3] = v1[3] * c23[2] + v1[2] * c23[3];
                        v0 = w0; v1 = w1;
                    }
                    if (do_silu) {
#pragma unroll
                        for (int e = 0; e < 4; ++e) { v0[e] = v0[e] / (1.0f + __expf(-v0[e])); v1[e] = v1[e] / (1.0f + __expf(-v1[e])); }
                    }
                    u32x4 w; w.x = cvt_pk_bf16(v0[0], v0[1]); w.y = cvt_pk_bf16(v0[2], v0[3]); w.z = cvt_pk_bf16(v1[0], v1[1]); w.w = cvt_pk_bf16(v1[2], v1[3]);
                    *(u32x4*)(rowp + bj * HALF) = w;
                }
            }
    }
};

struct EpiOut {
    static constexpr bool PERM = true, AFTER_DRAIN = false;
    const float* hin; float* hout; bf16_t* hb; float* ss;
    __device__ __forceinline__ void operator()(const f32x4 (&acc)[2][2][4][2], const Unit& u, int wr, int wc, int fr, int fq) const {
        const int row0 = u.pm * BM + wr * 64 + fr; const int col0 = u.pn * BM + wc * 32 + 8 * fq;
#pragma unroll
        for (int ai = 0; ai < 2; ++ai)
#pragma unroll
            for (int m = 0; m < 4; ++m) {
                const int row = row0 + ai * HALF + m * 16; const size_t off = (size_t)row * 1024 + col0; float q = 0.f;
#pragma unroll
                for (int bj = 0; bj < 2; ++bj) {
                    const f32x4 b0 = *(const f32x4*)(hin + off + bj * HALF), b1 = *(const f32x4*)(hin + off + bj * HALF + 4);
                    const f32x4 v0 = acc[ai][bj][m][0] + b0, v1 = acc[ai][bj][m][1] + b1;
                    *(f32x4*)(hout + off + bj * HALF) = v0; *(f32x4*)(hout + off + bj * HALF + 4) = v1;
                    q += (v0[0] * v0[0] + v0[1] * v0[1]) + (v0[2] * v0[2] + v0[3] * v0[3]) + (v1[0] * v1[0] + v1[1] * v1[1]) + (v1[2] * v1[2] + v1[3] * v1[3]);
                    u32x4 w; w.x = cvt_pk_bf16(v0[0], v0[1]); w.y = cvt_pk_bf16(v0[2], v0[3]); w.z = cvt_pk_bf16(v1[0], v1[1]); w.w = cvt_pk_bf16(v1[2], v1[3]);
                    *(u32x4*)(hb + off + bj * HALF) = w;
                }
                q += __shfl_xor(q, 16); q += __shfl_xor(q, 32);
                if (fq == 0) ss[(size_t)row * 16 + u.pn * 4 + wc] = q;
            }
    }
};

template <class Epi, class Sched, bool ALIGN_EPI = false, bool SP2 = false>
__device__ __forceinline__ void gemm_phase(PG8_LAS unsigned char* lds, const Gemm g, const Sched& S, const Epi& E) {
    int tid_ = threadIdx.x; asm volatile("" : "+v"(tid_));
    const int tid = tid_, wid = __builtin_amdgcn_readfirstlane(tid >> 6), lane = tid & 63, wr = wid >> 2, wc = wid & 3, fr = lane & 15, fq = lane >> 4;
    const int K = g.K, nt = K / BK;
    unsigned voffA[2], voffB[2];
#pragma unroll
    for (int i = 0; i < 2; ++i) { int R, C; stage_rc(tid * 16 + i * 8192, R, C); const int Rb = Epi::PERM ? ((R & ~31) + perm32(R & 31)) : R;
        voffA[i] = (unsigned)(R * K + C) * 2u; voffB[i] = (unsigned)(Rb * K + C) * 2u; }
    const size_t kstep = (size_t)(BK * 2);
    const size_t hstep = (size_t)HALF * K * 2;
    const size_t tstep = 2 * hstep;
    const unsigned ldsw = (unsigned)wid * 1024u;
    const int aoff = lds_byte(wr * 64 + fr, fq * 8), boff = lds_byte(wc * 32 + fr, fq * 8);
#define PG8_SA(b, h) (((b) * 2 + (h)) * HTB)
#define PG8_SB(b, h) ((4 + (b) * 2 + (h)) * HTB)
#define PG8_STAGE(bufoff, gbase, voff) do { _Pragma("unroll") for (int _i = 0; _i < 2; ++_i) \
        __builtin_amdgcn_global_load_lds((const unsigned*)((const char*)(gbase) + (voff)[_i]), (PG8_LAS unsigned*)(lds + (bufoff) + ldsw + _i * 8192), 16, 0, 0); } while (0)
#define PG8_LDA(dst, b, h) do { _Pragma("unroll") for (int m = 0; m < 4; ++m) _Pragma("unroll") for (int k = 0; k < 2; ++k) dst[m][k] = *(const PG8_LAS bf16x8*)(lds + PG8_SA(b, h) + aoff + m * 2048 + k * 1024); } while (0)
#define PG8_LDB(dst, b, h) do { _Pragma("unroll") for (int n = 0; n < 2; ++n) _Pragma("unroll") for (int k = 0; k < 2; ++k) dst[n][k] = *(const PG8_LAS bf16x8*)(lds + PG8_SB(b, h) + boff + n * 2048 + k * 1024); } while (0)
#define PG8_MMA(ai, bj, At, Bt) do { __builtin_amdgcn_s_setprio(1); _Pragma("unroll") for (int m = 0; m < 4; ++m) _Pragma("unroll") for (int n = 0; n < 2; ++n) _Pragma("unroll") for (int k = 0; k < 2; ++k) \
        acc[ai][bj][m][n] = __builtin_amdgcn_mfma_f32_16x16x32_bf16(Bt[n][k], At[m][k], acc[ai][bj][m][n], 0, 0, 0); __builtin_amdgcn_s_setprio(0); } while (0)
#define PG8_WAIT_V(n) asm volatile("s_waitcnt vmcnt(" #n ")" ::: "memory")
#define PG8_WAIT_L(n) asm volatile("s_waitcnt lgkmcnt(" #n ")" ::: "memory")
#define PG8_BAR __builtin_amdgcn_s_barrier()
#define PG8_SCHED __builtin_amdgcn_sched_barrier(0)
    Unit cur, nxt; int ui = 0;
    if (!S.next(0, cur)) return;
    f32x4 acc[2][2][4][2];
#pragma unroll
    for (int a = 0; a < 2; ++a)
#pragma unroll
        for (int b = 0; b < 2; ++b)
#pragma unroll
            for (int m = 0; m < 4; ++m)
#pragma unroll
                for (int n = 0; n < 2; ++n) acc[a][b][m][n] = (f32x4){0.f, 0.f, 0.f, 0.f};
    bf16x8 At[4][2], B0[2][2], B1[2][2];
    const char* cA = (const char*)g.A + (size_t)cur.pm * tstep; const char* cB = (const char*)g.Bt + (size_t)cur.pn * tstep;
    S.a_ready(cur);
    if constexpr (SP2) {
        PG8_STAGE(PG8_SB(0, 0), cB, voffB); PG8_STAGE(PG8_SB(0, 1), cB + hstep, voffB); PG8_STAGE(PG8_SA(0, 0), cA, voffA); PG8_STAGE(PG8_SA(0, 1), cA + hstep, voffA);
        if (wr == 1) PG8_BAR;
        PG8_WAIT_V(2); PG8_BAR;
        PG8_STAGE(PG8_SB(1, 0), cB + kstep, voffB); PG8_STAGE(PG8_SA(1, 0), cA + kstep, voffA); PG8_STAGE(PG8_SB(1, 1), cB + hstep + kstep, voffB);
        PG8_WAIT_V(6); PG8_BAR;
    } else {
        PG8_STAGE(PG8_SB(0, 0), cB, voffB); PG8_STAGE(PG8_SA(0, 0), cA, voffA); PG8_STAGE(PG8_SB(0, 1), cB + hstep, voffB); PG8_STAGE(PG8_SA(0, 1), cA + hstep, voffA);
        if (wr == 1) PG8_BAR;
        PG8_WAIT_V(4); PG8_BAR;
        PG8_STAGE(PG8_SB(1, 0), cB + kstep, voffB); PG8_STAGE(PG8_SA(1, 0), cA + kstep, voffA); PG8_STAGE(PG8_SB(1, 1), cB + hstep + kstep, voffB);
        PG8_WAIT_V(6); PG8_BAR;
    }
    for (;;) {
        const bool has_next = S.next(ui + 1, nxt);
        const char* nA = has_next ? (const char*)g.A + (size_t)nxt.pm * tstep : cA; const char* nB = has_next ? (const char*)g.Bt + (size_t)nxt.pn * tstep : cB;
        for (int t = 0; t < nt; t += 2) {
            const bool last = (t == nt - 2);
            const char* a1 = cA + (size_t)(t + 1) * kstep;
            const char* a2 = last ? nA : cA + (size_t)(t + 2) * kstep; const char* b2 = last ? nB : cB + (size_t)(t + 2) * kstep;
            const char* a3 = a2 + kstep; const char* b3 = b2 + kstep;
            if (last && has_next) S.a_ready(nxt);
            if constexpr (SP2) {
            PG8_LDB(B0, 0, 0); PG8_LDB(B1, 0, 1); PG8_SCHED; PG8_LDA(At, 0, 0); PG8_STAGE(PG8_SA(1, 1), a1 + hstep, voffA);
            PG8_WAIT_V(8); PG8_WAIT_L(0); PG8_BAR; PG8_MMA(0, 0, At, B0); PG8_MMA(0, 1, At, B1); PG8_BAR; PG8_SCHED;
            PG8_LDA(At, 0, 1); PG8_STAGE(PG8_SB(0, 0), b2, voffB); PG8_STAGE(PG8_SB(0, 1), b2 + hstep, voffB); PG8_STAGE(PG8_SA(0, 0), a2, voffA);
            PG8_WAIT_V(8); PG8_WAIT_L(0); PG8_BAR; PG8_MMA(1, 0, At, B0); PG8_MMA(1, 1, At, B1); PG8_BAR; PG8_SCHED;
            PG8_LDB(B0, 1, 0); PG8_LDB(B1, 1, 1); PG8_SCHED; PG8_LDA(At, 1, 0); PG8_STAGE(PG8_SA(0, 1), a2 + hstep, voffA);
            PG8_WAIT_V(8); PG8_WAIT_L(0); PG8_BAR; PG8_MMA(0, 0, At, B0); PG8_MMA(0, 1, At, B1); PG8_BAR; PG8_SCHED;
            PG8_LDA(At, 1, 1); PG8_STAGE(PG8_SB(1, 0), b3, voffB); PG8_STAGE(PG8_SB(1, 1), b3 + hstep, voffB); PG8_STAGE(PG8_SA(1, 0), a3, voffA);
            PG8_WAIT_V(8); PG8_WAIT_L(0); PG8_BAR; PG8_MMA(1, 0, At, B0); PG8_MMA(1, 1, At, B1); PG8_BAR; PG8_SCHED;
            } else {
            PG8_LDB(B0, 0, 0); PG8_SCHED; PG8_LDA(At, 0, 0); PG8_STAGE(PG8_SA(1, 1), a1 + hstep, voffA);
            PG8_WAIT_L(8); PG8_BAR; PG8_WAIT_L(0); PG8_MMA(0, 0, At, B0); PG8_BAR; PG8_SCHED;
            PG8_LDB(B1, 0, 1); PG8_STAGE(PG8_SB(0, 0), b2, voffB);
            PG8_BAR; PG8_WAIT_L(0); PG8_MMA(0, 1, At, B1); PG8_BAR;
            PG8_LDA(At, 0, 1); PG8_STAGE(PG8_SA(0, 0), a2, voffA);
            PG8_BAR; PG8_WAIT_L(0); PG8_MMA(1, 0, At, B0); PG8_BAR; PG8_SCHED;
            PG8_STAGE(PG8_SB(0, 1), b2 + hstep, voffB);
            PG8_WAIT_V(6); PG8_BAR; PG8_MMA(1, 1, At, B1); PG8_BAR;
            PG8_LDB(B0, 1, 0); PG8_SCHED; PG8_LDA(At, 1, 0); PG8_STAGE(PG8_SA(0, 1), a2 + hstep, voffA);
            PG8_WAIT_L(8); PG8_BAR; PG8_WAIT_L(0); PG8_MMA(0, 0, At, B0); PG8_BAR; PG8_SCHED;
            PG8_LDB(B1, 1, 1); PG8_STAGE(PG8_SB(1, 0), b3, voffB);
            PG8_BAR; PG8_WAIT_L(0); PG8_MMA(0, 1, At, B1); PG8_BAR;
            PG8_LDA(At, 1, 1); PG8_STAGE(PG8_SA(1, 0), a3, voffA);
            PG8_BAR; PG8_WAIT_L(0); PG8_MMA(1, 0, At, B0); PG8_BAR; PG8_SCHED;
            PG8_STAGE(PG8_SB(1, 1), b3 + hstep, voffB);
            PG8_WAIT_V(6); PG8_BAR; PG8_MMA(1, 1, At, B1); PG8_BAR;
            }
        }
        if constexpr (ALIGN_EPI) { if (wr == 0) PG8_BAR; }
        if constexpr (!Epi::AFTER_DRAIN) { E(acc, cur, wr, wc, fr, fq); S.done(cur); }
        if (!has_next) break;
#pragma unroll
        for (int a = 0; a < 2; ++a)
#pragma unroll
            for (int b = 0; b < 2; ++b)
#pragma unroll
                for (int m = 0; m < 4; ++m)
#pragma unroll
                    for (int n = 0; n < 2; ++n) acc[a][b][m][n] = (f32x4){0.f, 0.f, 0.f, 0.f};
        cur = nxt; cA = nA; cB = nB; ++ui;
        if constexpr (ALIGN_EPI) { if (wr == 1) PG8_BAR; }
    }
    PG8_WAIT_V(0);
    if constexpr (!ALIGN_EPI) { if (wr == 0) PG8_BAR; }
    PG8_BAR;
#undef PG8_SA
#undef PG8_SB
#undef PG8_STAGE
#undef PG8_LDA
#undef PG8_LDB
#undef PG8_MMA
#undef PG8_WAIT_V
#undef PG8_WAIT_L
#undef PG8_BAR
#undef PG8_SCHED
}
}
namespace attn_body {
using bf16=__hip_bfloat16;
using bf16x8=__attribute__((ext_vector_type(8)))short;
using s16x4=__attribute__((ext_vector_type(4)))short;
using f32x16=__attribute__((ext_vector_type(16)))float;
using u32x4=__attribute__((ext_vector_type(4)))unsigned;
constexpr int BATCH=8,NHEAD=8,SEQ=4096,D=64,DM=3584,OP=1024;
constexpr int NW=8,QBLK=32,QB=QBLK*NW,KVBLK=64,NQB=SEQ/QB;
constexpr int ATTN_PITCH=DM, ATTN_UNIT_ROWS=QB;
__device__ __forceinline__ int crow(int r,int hi){return (r&3)+8*(r>>2)+4*hi;}
#define SBAR() __builtin_amdgcn_sched_barrier(0)
__device__ __forceinline__ void cmask(f32x16&p0,f32x16&p1,int jb,int qrel,int hi){
  const float NEG=-INFINITY; int kb=64*jb+4*hi;
  #pragma unroll
  for(int r=0;r<16;++r){int kv=kb+(r&3)+8*(r>>2); if(kv>qrel)p0[r]=NEG; if(kv+32>qrel)p1[r]=NEG;}
}

constexpr int NSLOT=3, SLOTB=8192;
constexpr int LDS_K=0, LDS_V=NSLOT*SLOTB, LDS_WS=2*NSLOT*SLOTB, LDS_OST=LDS_WS+NW*64*4, LDS_BIAS=LDS_OST+NW*4096, LDS_BYTES=LDS_BIAS+SEQ*4;
constexpr float C2=0.125f*1.4426950408889634f;
__device__ __forceinline__ void glds16(const void*gsrc,unsigned lds_dst){unsigned keep;
  asm volatile("s_mov_b32 %0, m0\n\ts_mov_b32 m0, %2\n\ts_nop 0\n\tglobal_load_lds_dwordx4 %1, off\n\ts_mov_b32 m0, %0":"=&s"(keep):"v"(gsrc),"s"(lds_dst):"memory");}
__device__ __forceinline__ float max3f(float a,float b,float c){float r;asm("v_max3_f32 %0, %1, %2, %3":"=v"(r):"v"(a),"v"(b),"v"(c));return r;}
__device__ __forceinline__ float max2f(float a,float b){float r;asm("v_max_f32_e32 %0, %1, %2":"=v"(r):"v"(a),"v"(b));return r;}
__device__ __forceinline__ float fadd_s(float a,float b){float r;asm("v_add_f32_e32 %0, %1, %2":"=v"(r):"v"(a),"v"(b));return r;}
__device__ __forceinline__ float fsub_s(float a,float b){float r;asm("v_sub_f32_e32 %0, %1, %2":"=v"(r):"v"(a),"v"(b));return r;}
typedef float f32x4v __attribute__((ext_vector_type(4))); typedef float f32x2_t __attribute__((ext_vector_type(2))); typedef __bf16 bf16x2_t __attribute__((ext_vector_type(2)));
__device__ __forceinline__ unsigned cvtpk_s(float lo,float hi){f32x2_t v={lo,hi};bf16x2_t b=__builtin_convertvector(v,bf16x2_t);return __builtin_bit_cast(unsigned,b);}
#define WAIT_BAR(N) asm volatile("s_waitcnt vmcnt(" #N ") lgkmcnt(0)\n\ts_barrier":::"memory")

__device__ __forceinline__ void qkt(f32x16&p0,f32x16&p1,const char*Kslot,const bf16x8*qr,const f32x16&negm,int r32,int hi){
  const char*kb=Kslot+hi*1024+r32*16;
  #pragma unroll
  for(int d0=0;d0<4;++d0){
    const bf16x8 b0=*reinterpret_cast<const bf16x8*>(kb+d0*2048);
    const bf16x8 b1=*reinterpret_cast<const bf16x8*>(kb+d0*2048+512);
    if(d0==0){p0=__builtin_amdgcn_mfma_f32_32x32x16_bf16(b0,qr[0],negm,0,0,0);p1=__builtin_amdgcn_mfma_f32_32x32x16_bf16(b1,qr[0],negm,0,0,0);}
    else{p0=__builtin_amdgcn_mfma_f32_32x32x16_bf16(b0,qr[d0],p0,0,0,0);p1=__builtin_amdgcn_mfma_f32_32x32x16_bf16(b1,qr[d0],p1,0,0,0);}}
}
typedef __attribute__((address_space(3))) const char* lds_cptr;
typedef short v4i16_t __attribute__((ext_vector_type(4)));
__device__ __forceinline__ void kload8(bf16x8*kf,lds_cptr kp){
  kf[0]=*(const __attribute__((address_space(3))) bf16x8*)(kp);      kf[1]=*(const __attribute__((address_space(3))) bf16x8*)(kp+512);
  kf[2]=*(const __attribute__((address_space(3))) bf16x8*)(kp+2048); kf[3]=*(const __attribute__((address_space(3))) bf16x8*)(kp+2560);
  kf[4]=*(const __attribute__((address_space(3))) bf16x8*)(kp+4096); kf[5]=*(const __attribute__((address_space(3))) bf16x8*)(kp+4608);
  kf[6]=*(const __attribute__((address_space(3))) bf16x8*)(kp+6144); kf[7]=*(const __attribute__((address_space(3))) bf16x8*)(kp+6656);
}
__device__ __forceinline__ void kload2(bf16x8*kf,lds_cptr kp,int j){ kf[2*j]=*(const __attribute__((address_space(3))) bf16x8*)(kp+j*2048); kf[2*j+1]=*(const __attribute__((address_space(3))) bf16x8*)(kp+j*2048+512); }
__device__ __forceinline__ s16x4 vtr(lds_cptr p){ return __builtin_bit_cast(s16x4,__builtin_amdgcn_ds_read_tr16_b64_v4i16((__attribute__((address_space(3))) v4i16_t*)p)); }
__device__ __forceinline__ float rowmax(const f32x16&p0,const f32x16&p1){
  float a=max3f(p0[0],p0[1],p1[0]),b=max3f(p0[2],p0[3],p1[1]);a=max3f(a,p1[2],p1[3]);
  #pragma unroll
  for(int r=4;r<16;r+=4){a=max3f(a,p0[r],p0[r+1]);b=max3f(b,p0[r+2],p0[r+3]);a=max3f(a,p1[r],p1[r+1]);b=max3f(b,p1[r+2],p1[r+3]);}
  const float m=max2f(a,b);
  auto rr=__builtin_amdgcn_permlane32_swap(__float_as_uint(m),__float_as_uint(m),false,false);
  return max2f(__uint_as_float(rr[0]),__uint_as_float(rr[1]));
}
__device__ __forceinline__ void pv(f32x16*o,int vb,bf16x8 pa0,bf16x8 pa1,bf16x8 pa2,bf16x8 pa3){
  #pragma unroll
  for(int d0=0;d0<2;++d0){s16x4 lo[4],hi[4];
    #pragma unroll
    for(int ks=0;ks<4;++ks){
      asm volatile("ds_read_b64_tr_b16 %0,%1 offset:%c2":"=&v"(lo[ks]):"v"(vb),"i"(d0*4096+ks*1024):"memory");
      asm volatile("ds_read_b64_tr_b16 %0,%1 offset:%c2":"=&v"(hi[ks]):"v"(vb),"i"(d0*4096+ks*1024+512):"memory");}
    asm volatile("s_waitcnt lgkmcnt(0)":::"memory");SBAR();
    #define PK(k) (bf16x8){lo[k][0],lo[k][1],lo[k][2],lo[k][3],hi[k][0],hi[k][1],hi[k][2],hi[k][3]}
    o[d0]=__builtin_amdgcn_mfma_f32_32x32x16_bf16(pa0,PK(0),o[d0],0,0,0);
    o[d0]=__builtin_amdgcn_mfma_f32_32x32x16_bf16(pa1,PK(1),o[d0],0,0,0);
    o[d0]=__builtin_amdgcn_mfma_f32_32x32x16_bf16(pa2,PK(2),o[d0],0,0,0);
    o[d0]=__builtin_amdgcn_mfma_f32_32x32x16_bf16(pa3,PK(3),o[d0],0,0,0);
    #undef PK
  }
}

#ifndef ATTN_STORE16
#define ATTN_STORE16(p,v) (*(u32x4*)(p)=(v))
#endif
template<int THRL> __device__ __forceinline__ void attn_unit(int b,int h,int qb,const bf16*Q,const bf16*__restrict__ K,const bf16*__restrict__ V,const bf16*__restrict__ GT,const float*__restrict__ CB,bf16*O,char*shm){
  int tid_=threadIdx.x; asm volatile("":"+v"(tid_)); const int tid=tid_,lane=tid&63,r32=lane&31,hi=lane>>5; const int wid=__builtin_amdgcn_readfirstlane(tid>>6);
  const long rowbase=(long)b*SEQ; const int q0=qb*QB;
  const bf16*Qw=Q+(rowbase+q0+wid*QBLK)*DM+h*D;
  const bf16*Kh=K+rowbase*DM+h*D,*Vh=V+rowbase*DM+h*D;
  const unsigned lds0=(unsigned)(uintptr_t)shm;
  float*wsf=(float*)(shm+LDS_WS)+wid*64;
  const bf16*ksrc=Kh+(long)lane*DM+wid*8;
  const bf16*vsrc=Vh+(long)(16*(wid&3)+(lane>>2))*DM+(wid>>2)*32+(lane&3)*8;
  const unsigned kdst=lds0+LDS_K+wid*1024, vdst=lds0+LDS_V+wid*1024;
  #define DMA_K(t,slot) glds16(ksrc+(long)(t)*KVBLK*DM,(unsigned)__builtin_amdgcn_readfirstlane(kdst+(slot)))
  #define DMA_V(t,slot) glds16(vsrc+(long)(t)*KVBLK*DM,(unsigned)__builtin_amdgcn_readfirstlane(vdst+(slot)))
  const int vb0=(int)(lds0+LDS_V)+((lane>>4)&1)*32+(lane&3)*8+(4*hi+((lane&15)>>2))*64;
  const char*Kbase=shm+LDS_K; bf16x8 kf[8];
  const lds_cptr shm3=(lds_cptr)shm; const lds_cptr kp0=shm3+LDS_K+hi*1024+r32*16; const lds_cptr vp0=shm3+LDS_V+((lane>>4)&1)*32+(lane&3)*8+(4*hi+((lane&15)>>2))*64;
  const int NT=(q0+QB)/KVBLK;
  { const float*cbh=CB+(long)(b*NHEAD+h)*SEQ; const float cref=cbh[q0]; float*bl=(float*)(shm+LDS_BIAS); const int nk=q0+QB;
    for(int i=tid;i<nk;i+=NW*64) bl[i]=(cref-cbh[i])*1.4426950408889634f; }
  const __attribute__((address_space(3))) float* biasp=(const __attribute__((address_space(3))) float*)((lds_cptr)shm+LDS_BIAS)+4*hi;
  #define BIASADD(P0,P1,t) do{ const __attribute__((address_space(3))) float* bp_=biasp+64*(t); \
    _Pragma("unroll") for(int g_=0;g_<4;++g_){ f32x4v x0_=*(const __attribute__((address_space(3))) f32x4v*)(bp_+8*g_); f32x4v x1_=*(const __attribute__((address_space(3))) f32x4v*)(bp_+32+8*g_); \
      x0_=x0_-mhat; x1_=x1_-mhat; \
      P0[4*g_]+=x0_[0];P0[4*g_+1]+=x0_[1];P0[4*g_+2]+=x0_[2];P0[4*g_+3]+=x0_[3]; P1[4*g_]+=x1_[0];P1[4*g_+1]+=x1_[1];P1[4*g_+2]+=x1_[2];P1[4*g_+3]+=x1_[3]; } }while(0)
  DMA_K(0,0);DMA_V(0,0);DMA_K(1,SLOTB);
  bf16x8 qr[4];
  #pragma unroll
  for(int d0=0;d0<4;++d0)qr[d0]=*reinterpret_cast<const bf16x8*>(&Qw[(long)r32*DM+d0*16+hi*8]);
  float mhat=0.f,l_reg=0.f;f32x16 o[2];o[0]=f32x16{};o[1]=f32x16{};const f32x16 negm=f32x16{};
  const int qrel=wid*QBLK+r32;
  #define CMASK(P0,P1,t) do{int jb_=(t)-(NT-4); if(jb_>=0)cmask(P0,P1,jb_,qrel,hi);}while(0)
  bool resc=false;
  #define START(P0,P1) do{ const float rm=rowmax(P0,P1); resc=false; \
    { const float dl=rm; mhat=fadd_s(mhat,dl); \
      _Pragma("unroll") for(int r=0;r<16;++r){P0[r]=fsub_s(P0[r],dl);P1[r]=fsub_s(P1[r],dl);} \
      } \
    _Pragma("unroll") for(int r=0;r<16;++r)P0[r]=__builtin_amdgcn_exp2f(P0[r]); }while(0)
  #define RESC() do{ if(resc){ asm volatile("s_waitcnt lgkmcnt(0)":::"memory"); \
      _Pragma("unroll") for(int d_=0;d_<2;++d_) _Pragma("unroll") for(int r=0;r<16;++r)o[d_][r]*=wsf[crow(r,hi)]; } }while(0)
  f32x16 pA0,pA1,pB0,pB1;
  int sl_prev=0,sl_cur=0,sl_next=SLOTB;
  #define ROT() do{sl_prev=sl_cur;sl_cur=sl_next;sl_next=(sl_next==(NSLOT-1)*SLOTB)?0:sl_next+SLOTB;}while(0)
  DMA_K(2,2*SLOTB);
  WAIT_BAR(3);
  qkt(pA0,pA1,Kbase,qr,negm,r32,hi);asm volatile("s_nop 15\n\ts_nop 7":"+v"(pA0),"+v"(pA1));BIASADD(pA0,pA1,0);CMASK(pA0,pA1,0);
  START(pA0,pA1);
  _Pragma("unroll") for(int r=0;r<16;++r)pA1[r]=__builtin_amdgcn_exp2f(pA1[r]);
  WAIT_BAR(0);
  DMA_K(3,0);DMA_V(1,SLOTB);
  ROT();
  kload8(kf,kp0+sl_cur);
  WAIT_BAR(2);
  s16x4 vlo[8],vhi[8]; u32x4 pw0,pw1,pw2,pw3;
  #define PKW(P,B) cvtpk_s(P[B],P[B+1])
  #define PAF(k) __builtin_bit_cast(bf16x8,pw##k)
  #define VFR(i) (bf16x8){vlo[i][0],vlo[i][1],vlo[i][2],vlo[i][3],vhi[i][0],vhi[i][1],vhi[i][2],vhi[i][3]}
  #define PIN(x) asm volatile("":"+v"(x))
  #define MX3(a,b,c) __builtin_fmaxf(__builtin_fmaxf((a),(b)),(c))
  #define GAPA(MF,A0,A1,A2,A3,W0,W1,PW) do{ MF; sacc+=A0; sacc+=A1; sacc+=A2; sacc+=A3; PIN(sacc); W0; W1; PIN(PW); SBAR(); }while(0)
  #define EX(v) __builtin_amdgcn_exp2f(v)
  #define GAPB(MF,X,B) do{ MF; X[B]=EX(X[B]); X[B+1]=EX(X[B+1]); X[B+2]=EX(X[B+2]); X[B+3]=EX(X[B+3]); PIN(X); SBAR(); }while(0)
  #define VRD(i) do{ vlo[i]=vtr(vp_+(((i)>>2)*4096+((i)&3)*1024)); vhi[i]=vtr(vp_+(((i)>>2)*4096+((i)&3)*1024+512)); }while(0)
  #define KRD(G,j) do{ if(G){ kload2(kf,kp0+sl_next,j); SBAR(); } }while(0)
  #define STEP(C0,C1,P0,P1,t,GK,GV,GL) do{ SBAR(); \
    const lds_cptr vp_=vp0+sl_prev; \
    VRD(0); SBAR(); float sacc=(P0[0]+P0[1]); \
    GAPA(C0=__builtin_amdgcn_mfma_f32_32x32x16_bf16(kf[0],qr[0],negm,0,0,0), P0[2],P0[3],P0[4],P0[5],     pw0[0]=PKW(P0,0), pw0[1]=PKW(P0,2), pw0); \
    VRD(4); SBAR(); GAPA(C1=__builtin_amdgcn_mfma_f32_32x32x16_bf16(kf[1],qr[0],negm,0,0,0), P0[6],P0[7],P0[8],P0[9],     pw0[2]=PKW(P0,4), pw0[3]=PKW(P0,6), pw0); \
    VRD(1); SBAR(); GAPA(C0=__builtin_amdgcn_mfma_f32_32x32x16_bf16(kf[2],qr[1],C0,0,0,0),   P0[10],P0[11],P0[12],P0[13], pw1[0]=PKW(P0,8), pw1[1]=PKW(P0,10), pw1); \
    VRD(5); SBAR(); GAPA(C1=__builtin_amdgcn_mfma_f32_32x32x16_bf16(kf[3],qr[1],C1,0,0,0),   P0[14],P0[15],P1[0],P1[1],   pw1[2]=PKW(P0,12),pw1[3]=PKW(P0,14), pw1); \
    VRD(2); SBAR(); GAPA(C0=__builtin_amdgcn_mfma_f32_32x32x16_bf16(kf[4],qr[2],C0,0,0,0),   P1[2],P1[3],P1[4],P1[5],     pw2[0]=PKW(P1,0), pw2[1]=PKW(P1,2), pw2); \
    VRD(6); SBAR(); GAPA(C1=__builtin_amdgcn_mfma_f32_32x32x16_bf16(kf[5],qr[2],C1,0,0,0),   P1[6],P1[7],P1[8],P1[9],     pw2[2]=PKW(P1,4), pw2[3]=PKW(P1,6), pw2); \
    VRD(3); SBAR(); GAPA(C0=__builtin_amdgcn_mfma_f32_32x32x16_bf16(kf[6],qr[3],C0,0,0,0),   P1[10],P1[11],P1[12],P1[13], pw3[0]=PKW(P1,8), pw3[1]=PKW(P1,10), pw3); \
    VRD(7); SBAR(); GAPA(C1=__builtin_amdgcn_mfma_f32_32x32x16_bf16(kf[7],qr[3],C1,0,0,0),   P1[14],P1[15],0.f,0.f,       pw3[2]=PKW(P1,12),pw3[3]=PKW(P1,14), pw3); \
    l_reg+=sacc; \
    if(GK){DMA_K((t)+3,sl_cur);} if(GV){DMA_V((t)+1,sl_next);} \
    BIASADD(C0,C1,t); CMASK(C0,C1,t); \
    { float a=MX3(C0[0],C0[1],C1[0]),b=MX3(C0[2],C0[3],C1[1]); a=MX3(a,C1[2],C1[3]); \
      _Pragma("unroll") for(int r=4;r<16;r+=4){a=MX3(a,C0[r],C0[r+1]);b=MX3(b,C0[r+2],C0[r+3]);a=MX3(a,C1[r],C1[r+1]);b=MX3(b,C1[r+2],C1[r+3]);} \
      float rm=__builtin_fmaxf(a,b); { auto rr=__builtin_amdgcn_permlane32_swap(__float_as_uint(rm),__float_as_uint(rm),false,false); rm=__builtin_fmaxf(__uint_as_float(rr[0]),__uint_as_float(rr[1])); } \
      resc=false; \
      if(__builtin_expect(__any(rm>(float)THRL),0)){ const float dl=__builtin_fmaxf(rm,0.f); mhat+=dl; \
        _Pragma("unroll") for(int r=0;r<16;++r){C0[r]-=dl;C1[r]-=dl;} \
        const float f=__builtin_amdgcn_exp2f(-dl); l_reg*=f; if(hi==0)wsf[r32]=f; resc=true; } } \
    SBAR(); \
    GAPB(o[0]=__builtin_amdgcn_mfma_f32_32x32x16_bf16(PAF(0),VFR(0),o[0],0,0,0), C0,0); \
    GAPB(o[1]=__builtin_amdgcn_mfma_f32_32x32x16_bf16(PAF(0),VFR(4),o[1],0,0,0), C0,4); \
    KRD(GL,0); GAPB(o[0]=__builtin_amdgcn_mfma_f32_32x32x16_bf16(PAF(1),VFR(1),o[0],0,0,0), C0,8); \
    KRD(GL,1); GAPB(o[1]=__builtin_amdgcn_mfma_f32_32x32x16_bf16(PAF(1),VFR(5),o[1],0,0,0), C0,12); \
    KRD(GL,2); GAPB(o[0]=__builtin_amdgcn_mfma_f32_32x32x16_bf16(PAF(2),VFR(2),o[0],0,0,0), C1,0); \
    KRD(GL,3); GAPB(o[1]=__builtin_amdgcn_mfma_f32_32x32x16_bf16(PAF(2),VFR(6),o[1],0,0,0), C1,4); \
    GAPB(o[0]=__builtin_amdgcn_mfma_f32_32x32x16_bf16(PAF(3),VFR(3),o[0],0,0,0), C1,8); \
    GAPB(o[1]=__builtin_amdgcn_mfma_f32_32x32x16_bf16(PAF(3),VFR(7),o[1],0,0,0), C1,12); \
    }while(0)
  int t=1;
  #undef CMASK
  #define CMASK(P0,P1,t) do{}while(0)
  for(;t+5<NT;t+=2){
    STEP(pB0,pB1,pA0,pA1,t,true,true,true);     WAIT_BAR(2); RESC(); ROT();
    STEP(pA0,pA1,pB0,pB1,t+1,true,true,true);   WAIT_BAR(2); RESC(); ROT();
  }
  #undef CMASK
  #define CMASK(P0,P1,t) do{int jb_=(t)-(NT-4); if(jb_>=0)cmask(P0,P1,jb_,qrel,hi);}while(0)
  #define ENDW(tt) do{ if((tt)+3<NT){WAIT_BAR(2);} else if((tt)+2<NT){WAIT_BAR(1);} else {WAIT_BAR(0);} }while(0)
  for(;t+1<NT;t+=2){
    STEP(pB0,pB1,pA0,pA1,t,(t+3<NT),(t+1<NT),(t+1<NT));       ENDW(t);   RESC(); ROT();
    STEP(pA0,pA1,pB0,pB1,t+1,(t+4<NT),(t+2<NT),(t+2<NT));     ENDW(t+1); RESC(); ROT();
  }
  STEP(pB0,pB1,pA0,pA1,NT-1,false,false,false); RESC();
  { float sacc=pB0[0]+pB0[1]; _Pragma("unroll") for(int r=2;r<16;++r)sacc+=pB0[r]; _Pragma("unroll") for(int r=0;r<16;++r)sacc+=pB1[r]; l_reg+=sacc;
    pw0=(u32x4){PKW(pB0,0),PKW(pB0,2),PKW(pB0,4),PKW(pB0,6)};pw1=(u32x4){PKW(pB0,8),PKW(pB0,10),PKW(pB0,12),PKW(pB0,14)};pw2=(u32x4){PKW(pB1,0),PKW(pB1,2),PKW(pB1,4),PKW(pB1,6)};pw3=(u32x4){PKW(pB1,8),PKW(pB1,10),PKW(pB1,12),PKW(pB1,14)};
    SBAR(); pv(o,vb0+sl_cur,PAF(0),PAF(1),PAF(2),PAF(3)); }
  #undef PKW
  #undef PAF
  #undef VFR
  #undef PIN
  #undef MX3
  #undef GAPA
  #undef GAPB
  #undef EX
  #undef VRD
  #undef KRD
  #undef STEP
  #undef ENDW
  {auto rr=__builtin_amdgcn_permlane32_swap(__float_as_uint(l_reg),__float_as_uint(l_reg),false,false);l_reg=__uint_as_float(rr[0])+__uint_as_float(rr[1]);}
  if(hi==0)wsf[32+r32]=l_reg;asm volatile("s_waitcnt lgkmcnt(0)":::"memory");
  float rli[16];
  #pragma unroll
  for(int r=0;r<16;++r)rli[r]=__builtin_amdgcn_rcpf(wsf[32+crow(r,hi)]);
  bf16*Ow=O+(rowbase+q0+wid*QBLK)*OP+h*D; const bf16*Gw=GT+(rowbase+q0+wid*QBLK)*DM+h*D;
  { bf16*stg=(bf16*)(shm+LDS_OST)+wid*2048;
    #pragma unroll
    for(int r=0;r<16;++r){const int orow=crow(r,hi);
      #pragma unroll
      for(int d0=0;d0<2;++d0)stg[orow*64+d0*32+r32]=__float2bfloat16(o[d0][r]*rli[r]);}
    asm volatile("s_waitcnt lgkmcnt(0)":::"memory");
    #pragma unroll
    for(int i=0;i<4;++i){const int row=i*8+(lane>>3),ch=lane&7; const u32x4 v=*(const u32x4*)(stg+row*64+ch*8); const u32x4 g=*(const u32x4*)(Gw+(long)row*DM+ch*8); u32x4 w;
      _Pragma("unroll") for(int e=0;e<4;++e){ const float a0=__uint_as_float(v[e]<<16)*__uint_as_float(g[e]<<16), a1=__uint_as_float(v[e]&0xffff0000u)*__uint_as_float(g[e]&0xffff0000u); w[e]=cvtpk_s(a0,a1); }
      ATTN_STORE16(Ow+(long)row*OP+ch*8,w);} }
  asm volatile("s_waitcnt lgkmcnt(0)\n\ts_barrier":::"memory");
  #undef BIASADD
  #undef DMA_K
  #undef DMA_V
  #undef CMASK
  #undef START
  #undef RESC
  #undef ROT
}
constexpr int ATTN_LDS_BYTES=LDS_BYTES;
struct AttnTensors { const bf16* Q; const bf16* K; const bf16* V; const bf16* GT; const float* CB; bf16* O; };
struct AttnUnit { int bh; int qb; };
struct StaticOrder {
  int vcu,G,half;
  __device__ __forceinline__ explicit StaticOrder(int grid,int block,int half_):vcu((grid%8==0)?(block%8)*(grid/8)+block/8:block),G(grid),half(half_){}
  __device__ __forceinline__ bool next(int i,AttnUnit&u)const{
    if(G==256){ if(i>=2)return false; const int s=vcu&3; u.bh=vcu>>2; u.qb=(half==0)?((i==0)?s:15-s):((i==0)?7-s:8+s); return true; }
    const int idx=i*G+vcu; if(idx>=BATCH*NHEAD*NQB/2)return false; const int k=idx&7; u.bh=idx>>3; u.qb=(half==0)?((k<4)?k:8+k):4+k; return true; }
  __device__ __forceinline__ void a_ready(const AttnUnit&)const{}
  __device__ __forceinline__ void done(const AttnUnit&)const{}
};
template<class Sched,int THRL=8> __device__ __forceinline__ void attn_phase(char*lds,const AttnTensors&T,const Sched&S){
  AttnUnit u;
  for(int i=0;S.next(i,u);++i){ S.a_ready(u); attn_unit<THRL>(u.bh/NHEAD,u.bh%NHEAD,u.qb,T.Q,T.K,T.V,T.GT,T.CB,T.O,lds); S.done(u); }
}
#undef SBAR
#undef WAIT_BAR
}
constexpr int NWAVES = 8;
constexpr int BATCH = 8, SEQ = 4096, DMODEL = 1024, M = BATCH * SEQ;
constexpr int NZ = 3584;
constexpr int ZC_LQ = 0, ZC_LK = 256, ZC_LV = 512, ZC_AQ = 1024, ZC_AK = 1536, ZC_AV = 2048, ZC_GATE = 2560;
constexpr int EVEN_IN = 3608, ODD_IN = 3584;
constexpr float RMS_EPS = 1e-6f;
constexpr float LOG2E = 1.4426950408889634f;
constexpr float C2 = 0.125f * LOG2E;

constexpr size_t MiB = 1u << 20;
constexpr size_t WS_CTL = 0, CTL_ZERO_BYTES = 1 * MiB;
constexpr size_t WS_ROPE = 1 * MiB;
constexpr size_t WS_SS = 2 * MiB;
constexpr size_t WS_FF = 4 * MiB;
constexpr size_t WS_GLR = 5 * MiB;
constexpr size_t WS_CB = 7 * MiB;
constexpr size_t WS_LSE = 8 * MiB;
constexpr size_t WS_DECAY = 9 * MiB;
constexpr size_t WS_WSK = 10 * MiB;
constexpr size_t WS_W = 11 * MiB;
constexpr size_t WS_Z = 48 * MiB;
constexpr size_t WS_Y = 272 * MiB;
constexpr size_t WS_HB = 336 * MiB;
constexpr size_t WS_KV = 400 * MiB;
constexpr size_t WS_PREV = 464 * MiB;
constexpr size_t WS_END = 496 * MiB;
constexpr int CW_TMO = 0, CW_CODE = 1;
constexpr int CW_BAR = 4096;

constexpr int RING_OFF = 0, RING_BYTES = 131072;
constexpr int LDSCTL_OFF = RING_BYTES, MISC_OFF = LDSCTL_OFF + 320;
constexpr int LDS_BYTES = 147456;
static_assert(MISC_OFF + 128 <= LDS_BYTES, "LDS map");

#define GAS __attribute__((address_space(1)))
#define LAS __attribute__((address_space(3)))
typedef unsigned short bf16;
typedef unsigned v4u __attribute__((ext_vector_type(4)));
typedef float f32x4 __attribute__((ext_vector_type(4)));
typedef short bf16x8 __attribute__((ext_vector_type(8)));
typedef GAS unsigned gu32;
#define RLX_AGENT __ATOMIC_RELAXED, __HIP_MEMORY_SCOPE_AGENT
#define LDS_WAIT() asm volatile("s_waitcnt lgkmcnt(0)" ::: "memory")
#define VM_WAIT() asm volatile("s_waitcnt vmcnt(0)" ::: "memory")
__device__ __forceinline__ unsigned f2bf(float f) { unsigned u = __builtin_bit_cast(unsigned, f); return (u + 0x7fffu + ((u >> 16) & 1u)) >> 16; }
__device__ __forceinline__ unsigned pk2(float lo, float hi) { return f2bf(lo) | (f2bf(hi) << 16); }
__device__ __forceinline__ float bflo(unsigned w) { return __uint_as_float(w << 16); }
__device__ __forceinline__ float bfhi(unsigned w) { return __uint_as_float(w & 0xffff0000u); }
__device__ __forceinline__ float bf1(bf16 h) { return __uint_as_float((unsigned)h << 16); }
__device__ __forceinline__ float logsigmoidf(float x) { return x < 0.f ? x - log1pf(__expf(x)) : -log1pf(__expf(-x)); }

#define XB_TMO      128
#define XB_XCNT(j)  (256  + 64 * (j))
#define XB_XSUB(j)  (1280 + 64 * (j))
#define XB_XGEN(j)  (2304 + 64 * (j))
#define XB_TOP      3328
#define XB_TOPGEN   3392
#define XCD_BAR_WORDS 3456
#define XB_SPIN_CAP (1u << 18)

__device__ __forceinline__ unsigned xb_ld(unsigned* p)              { return __hip_atomic_load(p, __ATOMIC_RELAXED, __HIP_MEMORY_SCOPE_AGENT); }
__device__ __forceinline__ unsigned xb_add(unsigned* p, unsigned v) { return __hip_atomic_fetch_add(p, v, __ATOMIC_RELAXED, __HIP_MEMORY_SCOPE_AGENT); }
__device__ __forceinline__ unsigned xb_xcc_id() { return (unsigned)__builtin_amdgcn_s_getreg((3 << 11) | 20) & 0xFu; }
#define XB_SPIN(cond, bar) do { unsigned _sp = 0; while (cond) { __builtin_amdgcn_s_sleep(1); \
    if ((++_sp & 255u) == 0u) { if (xb_ld(&(bar)[XB_TMO])) break; if (_sp > XB_SPIN_CAP) { atomicAdd(&(bar)[XB_TMO], 1u); break; } } } } while (0)

struct XcdBarrier { unsigned* bar; unsigned x; volatile LAS unsigned* st; };

__device__ __forceinline__ XcdBarrier xcd_barrier_post(unsigned* bar, volatile LAS unsigned* st) {
    XcdBarrier b; b.bar = bar; b.x = xb_xcc_id(); b.st = st;
    if (threadIdx.x == 0) (void)xb_add(&bar[XB_XCNT(b.x)], 1u);
    return b;
}
__device__ __forceinline__ void xcd_barrier_complete(unsigned* bar, unsigned x, unsigned& nloc, unsigned& nx) {
    const unsigned G = gridDim.x * gridDim.y * gridDim.z;
    unsigned sum, cnt, mine, sp = 0u;
    for (;;) {
        sum = 0u; cnt = 0u; mine = 0u;
#pragma unroll
        for (unsigned j = 0; j < 16; ++j) { const unsigned c = xb_ld(&bar[XB_XCNT(j)]); sum += c; cnt += (c > 0u) ? 1u : 0u; mine = (j == x) ? c : mine; }
        if (sum == G) break;
        __builtin_amdgcn_s_sleep(1);
        if ((++sp & 255u) == 0u) { if (xb_ld(&bar[XB_TMO])) break; if (sp > XB_SPIN_CAP) { atomicAdd(&bar[XB_TMO], 1u); break; } }
    }
    nloc = mine > 0u ? mine : 1u; nx = cnt > 0u ? cnt : 1u;
}
__device__ __forceinline__ void xcd_barrier(const XcdBarrier& b) {
    asm volatile("s_waitcnt vmcnt(0)" ::: "memory");
    __syncthreads();
    if (threadIdx.x == 0) {
        unsigned* bar = b.bar;
        __builtin_amdgcn_s_waitcnt(0);
        unsigned nloc = b.st[0], nx = b.st[1];
        if (nloc == 0u) { xcd_barrier_complete(bar, b.x, nloc, nx); b.st[0] = nloc; b.st[1] = nx; }
        const unsigned old = xb_add(&bar[XB_XSUB(b.x)], 1u);
        const unsigned gen = old / nloc;
        if (old + 1u == (gen + 1u) * nloc) {
            __builtin_amdgcn_fence(__ATOMIC_RELEASE, "agent");
            asm volatile("s_waitcnt vmcnt(0)" ::: "memory");
            const unsigned og = xb_add(&bar[XB_TOP], 1u);
            const unsigned tg = og / nx;
            if (og + 1u == (tg + 1u) * nx) xb_add(&bar[XB_TOPGEN], 1u);
            else XB_SPIN(xb_ld(&bar[XB_TOPGEN]) == tg, bar);
            __builtin_amdgcn_fence(__ATOMIC_ACQUIRE, "agent");
            xb_add(&bar[XB_XGEN(b.x)], 1u);
            asm volatile("s_waitcnt vmcnt(0)" ::: "memory");
        } else {
            XB_SPIN(xb_ld(&bar[XB_XGEN(b.x)]) == gen, bar);
            __builtin_amdgcn_fence(__ATOMIC_ACQUIRE, "agent");
            asm volatile("s_waitcnt vmcnt(0)" ::: "memory");
        }
    }
    __syncthreads();
}

struct Frame {
    LAS unsigned char* lds;
    volatile LAS unsigned* MISC;
    gu32* ctl;
    int tid, lane, wave;
    int vcu, G;
    unsigned char* ws;
};

__device__ __forceinline__ float wave_sum(float v) {
#pragma unroll
    for (int o = 1; o < 64; o <<= 1) v += __shfl_xor(v, o);
    return v;
}

__device__ __forceinline__ int wsrc_col(int kind, int n) {
    if (kind == 0) {
        if (n < 256) return 1544 + n;
        if (n < 512) return 1800 + (n - 256);
        if (n < 1024) return 2056 + (n - 512);
        if (n < 1536) return n - 1024;
        if (n < 2048) return 512 + (n - 1536);
        if (n < 2560) return 1024 + (n - 2048);
        return 2584 + (n - 2560);
    } else if (kind == 1) {
        const bool il = (n < 512) || (n >= 1024 && n < 2048);
        if (!il) return n;
        const int p = n & 63; return (n & ~63) + (p >> 1) + 32 * (p & 1);
    } else if (kind == 2) {
        return n;
    } else {
        if (n < 8) return 1536 + n;
        if (n < 24) return 2568 + (n - 8);
        return -1;
    }
}
__device__ __forceinline__ void p0_transpose_item(const float* W, int Nsrc, int kind, const float* gain, bf16* WT, int nblk, LAS float* scr, int item, int lane) {
    const int K = DMODEL; const int kb = item / nblk, nb = item % nblk, k0 = 64 * kb, n0 = 32 * nb;
    const int sc = wsrc_col(kind, n0 + (lane & 31));
#pragma unroll 8
    for (int i = 0; i < 32; ++i) { const int kk = 2 * i + (lane >> 5); const float g = gain ? gain[k0 + kk] : 1.0f;
        scr[kk * 33 + (lane & 31)] = (sc >= 0) ? W[(size_t)(k0 + kk) * Nsrc + sc] * g : 0.f; }
    LDS_WAIT(); asm volatile("" ::: "memory");
    const int c = lane & 7;
#pragma unroll
    for (int j = 0; j < 4; ++j) { const int n = (lane >> 3) + 8 * j; const LAS float* s = scr + (8 * c) * 33 + n;
        v4u o; o.x = pk2(s[0 * 33], s[1 * 33]); o.y = pk2(s[2 * 33], s[3 * 33]); o.z = pk2(s[4 * 33], s[5 * 33]); o.w = pk2(s[6 * 33], s[7 * 33]);
        *(GAS v4u*)(WT + (size_t)(n0 + n) * K + k0 + 8 * c) = o; }
    LDS_WAIT(); asm volatile("" ::: "memory");
}
typedef float f32x16 __attribute__((ext_vector_type(16)));
typedef float f32x2 __attribute__((ext_vector_type(2)));
typedef unsigned v2u __attribute__((ext_vector_type(2)));
typedef __bf16 bf16x2_t __attribute__((ext_vector_type(2)));
__device__ __forceinline__ unsigned cvtpk(float lo, float hi) { f32x2 v = {lo, hi}; bf16x2_t b = __builtin_convertvector(v, bf16x2_t); return __builtin_bit_cast(unsigned, b); }
__device__ __forceinline__ int crow16(int r, int hi) { return (r & 3) + 8 * (r >> 2) + 4 * hi; }
__device__ __forceinline__ f32x16 mfma32(bf16x8 a, bf16x8 b, f32x16 c) { return __builtin_amdgcn_mfma_f32_32x32x16_bf16(a, b, c, 0, 0, 0); }
__device__ __forceinline__ bf16x8 pack8(const f32x16& p, int s2) {
    v4u w; w.x = cvtpk(p[8 * s2 + 0], p[8 * s2 + 1]); w.y = cvtpk(p[8 * s2 + 2], p[8 * s2 + 3]); w.z = cvtpk(p[8 * s2 + 4], p[8 * s2 + 5]); w.w = cvtpk(p[8 * s2 + 6], p[8 * s2 + 7]);
    return __builtin_bit_cast(bf16x8, w);
}
__device__ __forceinline__ bf16x8 ld_perm8(const LAS bf16* p) {
    const v2u a = *(const LAS v2u*)p, b = *(const LAS v2u*)(p + 8);
    v4u w; w.x = a.x; w.y = a.y; w.z = b.x; w.w = b.y; return __builtin_bit_cast(bf16x8, w);
}

constexpr int LC = 64;
constexpr int LLD = 72;
constexpr int LA_SEG = 0;
constexpr int LA_A = 2048;
constexpr int LA_B = LA_A + 64 * LLD * 2;
constexpr int LA_VT = LA_B + 64 * LLD * 2;
constexpr int LA_P = LA_VT + 128 * LLD * 2;
constexpr int LA_O = LA_P + 128 * LLD * 2;
constexpr int LA_END = LA_O + 64 * 132 * 4;
static_assert(LA_END <= RING_BYTES, "linear-attention LDS map");

struct LinArgs {
    const bf16* Z; const float* GLR; const float* w_lr; const float* b_lr;
    const float* g1; const float* g2;
    float* KV; float* DEC; bf16* PREV; bf16* Y;
};

template <bool ODD> __device__ __forceinline__ float lin_cumdecay(Frame& F, const LinArgs& A, int b, int h, int t0, float (&bv)[8]) {
    LAS float* seg = (LAS float*)(F.lds + RING_OFF + LA_SEG);
    const int d = F.lane;
    float run = 0.f;
    if (ODD) {
        const float lg = __logf(1.0f - exp2f(-5.0f - (float)h));
#pragma unroll
        for (int i = 0; i < 8; ++i) { run += lg; bv[i] = run; }
    } else {
        float w[16];
#pragma unroll
        for (int r = 0; r < 16; ++r) w[r] = A.w_lr[r * 256 + h * 64 + d];
        const float bias = A.b_lr[h * 64 + d];
#pragma unroll
        for (int i = 0; i < 8; ++i) {
            const f32x4* gp = (const f32x4*)(A.GLR + ((size_t)b * SEQ + t0 + 8 * F.wave + i) * 16);
            const f32x4 g0 = gp[0], g1 = gp[1], g2 = gp[2], g3 = gp[3];
            float x = bias;
            x += g0[0] * w[0] + g0[1] * w[1] + g0[2] * w[2] + g0[3] * w[3];
            x += g1[0] * w[4] + g1[1] * w[5] + g1[2] * w[6] + g1[3] * w[7];
            x += g2[0] * w[8] + g2[1] * w[9] + g2[2] * w[10] + g2[3] * w[11];
            x += g3[0] * w[12] + g3[1] * w[13] + g3[2] * w[14] + g3[3] * w[15];
            run += logsigmoidf(x) * (1.0f / 16.0f); bv[i] = run;
        }
    }
    __syncthreads();
    seg[F.wave * 64 + d] = run;
    __syncthreads();
    float off = 0.f, tot = 0.f;
#pragma unroll
    for (int w8 = 0; w8 < 8; ++w8) { const float s = seg[w8 * 64 + d]; tot += s; if (w8 < F.wave) off += s; }
#pragma unroll
    for (int i = 0; i < 8; ++i) bv[i] += off;
    return tot;
}

__device__ __forceinline__ void lin_stage_vt(Frame& F, const bf16* Z, int b, int h, int t0) {
    LAS bf16* VT = (LAS bf16*)(F.lds + RING_OFF + LA_VT);
    const int tok = F.tid >> 3, c = F.tid & 7;
    const v4u* src = (const v4u*)(Z + ((size_t)b * SEQ + t0 + tok) * NZ + ZC_LV + h * 128 + 16 * c);
    const v4u x0 = src[0], x1 = src[1];
#pragma unroll
    for (int e = 0; e < 4; ++e) {
        VT[(16 * c + 2 * e) * LLD + tok] = (bf16)(x0[e] & 0xffffu); VT[(16 * c + 2 * e + 1) * LLD + tok] = (bf16)(x0[e] >> 16);
        VT[(16 * c + 8 + 2 * e) * LLD + tok] = (bf16)(x1[e] & 0xffffu); VT[(16 * c + 8 + 2 * e + 1) * LLD + tok] = (bf16)(x1[e] >> 16);
    }
}

template <bool ODD> __device__ __forceinline__ void lin_kv_unit(Frame& F, const LinArgs& A, int u) {
    const int bh = u >> 6, n = u & 63, b = bh >> 2, h = bh & 3, t0 = n * LC;
    LAS bf16* KzT = (LAS bf16*)(F.lds + RING_OFF + LA_A); LAS bf16* VT = (LAS bf16*)(F.lds + RING_OFF + LA_VT);
    const int d = F.lane, r32 = F.lane & 31, hi = F.lane >> 5;
    float bv[8];
    const float blast = lin_cumdecay<ODD>(F, A, b, h, t0, bv);
#pragma unroll
    for (int i = 0; i < 8; ++i) {
        const int tok = 8 * F.wave + i;
        const float kk = bf1(A.Z[((size_t)b * SEQ + t0 + tok) * NZ + ZC_LK + h * 64 + d]);
        KzT[d * LLD + tok] = (bf16)f2bf(kk * __expf(blast - bv[i]));
    }
    lin_stage_vt(F, A.Z, b, h, t0);
    if (F.wave == 0) A.DEC[((size_t)bh * 64 + n) * 64 + d] = __expf(blast);
    __syncthreads();
    const int vb = F.wave >> 1, db = F.wave & 1;
    f32x16 acc = {};
#pragma unroll
    for (int s = 0; s < 4; ++s) {
        const bf16x8 a = *(const LAS bf16x8*)(VT + (vb * 32 + r32) * LLD + 16 * s + 8 * hi);
        const bf16x8 bb = *(const LAS bf16x8*)(KzT + (db * 32 + r32) * LLD + 16 * s + 8 * hi);
        acc = mfma32(a, bb, acc);
    }
    float* dst = A.KV + ((size_t)bh * 64 + n) * (128 * 64) + db * 32 + r32;
#pragma unroll
    for (int r = 0; r < 16; ++r) dst[(size_t)(vb * 32 + crow16(r, hi)) * 64] = acc[r];
}

__device__ __forceinline__ void lin_scan_phase(Frame& F, const LinArgs& A) {
    const int gt = F.vcu * 512 + F.tid;
    for (int e = gt; e < 32 * 128 * 32; e += F.G * 512) {
        const int bh = e >> 12, rem = e & 4095;
        const f32x2* kvp = (const f32x2*)(A.KV + (size_t)bh * 64 * (128 * 64) + rem * 2);
        const f32x2* dcp = (const f32x2*)(A.DEC + (size_t)bh * 64 * 64 + (rem & 31) * 2);
        unsigned* pp = (unsigned*)(A.PREV + (size_t)bh * 64 * (128 * 64) + rem * 2);
        f32x2 st = {0.f, 0.f};
        for (int n0 = 0; n0 < 64; n0 += 8) {
            f32x2 kv[8], dc[8];
#pragma unroll
            for (int i = 0; i < 8; ++i) { kv[i] = kvp[(size_t)(n0 + i) * 4096]; dc[i] = dcp[(n0 + i) * 32]; }
#pragma unroll
            for (int i = 0; i < 8; ++i) { pp[(size_t)(n0 + i) * 4096] = cvtpk(st.x, st.y); st = st * dc[i] + kv[i]; }
        }
    }
}

template <bool ODD> __device__ __forceinline__ void lin_out_unit(Frame& F, const LinArgs& A, int u) {
    const int bh = u >> 6, n = u & 63, b = bh >> 2, h = bh & 3, t0 = n * LC;
    LAS bf16* QtL = (LAS bf16*)(F.lds + RING_OFF + LA_A); LAS bf16* KtL = (LAS bf16*)(F.lds + RING_OFF + LA_B);
    LAS bf16* VT = (LAS bf16*)(F.lds + RING_OFF + LA_VT); LAS bf16* PL = (LAS bf16*)(F.lds + RING_OFF + LA_P);
    LAS float* OL = (LAS float*)(F.lds + RING_OFF + LA_O);
    const int d = F.lane, r32 = F.lane & 31, hi = F.lane >> 5;
    float bv[8];
    (void)lin_cumdecay<ODD>(F, A, b, h, t0, bv);
#pragma unroll
    for (int i = 0; i < 8; ++i) {
        const int tok = 8 * F.wave + i; const size_t row = (size_t)b * SEQ + t0 + tok;
        const float qq = bf1(A.Z[row * NZ + ZC_LQ + h * 64 + d]), kk = bf1(A.Z[row * NZ + ZC_LK + h * 64 + d]);
        QtL[tok * LLD + d] = (bf16)f2bf(qq * __expf(bv[i])); KtL[tok * LLD + d] = (bf16)f2bf(kk * __expf(-bv[i]));
    }
    lin_stage_vt(F, A.Z, b, h, t0);
    { const v4u* src = (const v4u*)(A.PREV + ((size_t)bh * 64 + n) * (128 * 64));
#pragma unroll
      for (int e = 0; e < 2; ++e) { const int pi = F.tid + 512 * e; *(LAS v4u*)(PL + (pi >> 3) * LLD + (pi & 7) * 8) = src[pi]; } }
    __syncthreads();
    const int qi = F.wave >> 2, vj = F.wave & 3;
    f32x16 st0 = {}, st1 = {};
#pragma unroll
    for (int s = 0; s < 4; ++s) {
        const bf16x8 qf = *(const LAS bf16x8*)(QtL + (qi * 32 + r32) * LLD + 16 * s + 8 * hi);
        const bf16x8 k0 = *(const LAS bf16x8*)(KtL + r32 * LLD + 16 * s + 8 * hi);
        st0 = mfma32(k0, qf, st0);
        if (qi == 1) { const bf16x8 k1 = *(const LAS bf16x8*)(KtL + (32 + r32) * LLD + 16 * s + 8 * hi); st1 = mfma32(k1, qf, st1); }
    }
#pragma unroll
    for (int r = 0; r < 16; ++r) { const int kl = crow16(r, hi); if (qi == 0) { if (kl > r32) st0[r] = 0.f; } else { if (kl > r32) st1[r] = 0.f; } }
    f32x16 o = {};
    const LAS bf16* vrow = VT + (vj * 32 + r32) * LLD + 4 * hi;
#pragma unroll
    for (int s2 = 0; s2 < 2; ++s2) o = mfma32(pack8(st0, s2), ld_perm8(vrow + 16 * s2), o);
    if (qi == 1) {
#pragma unroll
        for (int s2 = 0; s2 < 2; ++s2) o = mfma32(pack8(st1, s2), ld_perm8(vrow + 32 + 16 * s2), o);
    }
#pragma unroll
    for (int s = 0; s < 4; ++s) {
        const bf16x8 qf = *(const LAS bf16x8*)(QtL + (qi * 32 + r32) * LLD + 16 * s + 8 * hi);
        const bf16x8 pf = *(const LAS bf16x8*)(PL + (vj * 32 + r32) * LLD + 16 * s + 8 * hi);
        o = mfma32(qf, pf, o);
    }
#pragma unroll
    for (int r = 0; r < 16; ++r) OL[(qi * 32 + crow16(r, hi)) * 132 + vj * 32 + r32] = o[r];
    __syncthreads();
    {
        const int q = F.tid >> 3, part = F.tid & 7; const size_t row = (size_t)b * SEQ + t0 + q;
        f32x4 x[4];
#pragma unroll
        for (int e = 0; e < 4; ++e) x[e] = *(const LAS f32x4*)(OL + q * 132 + part * 16 + 4 * e);
        if (ODD) {
            float s = 0.f;
#pragma unroll
            for (int e = 0; e < 4; ++e) s += (x[e][0] + x[e][1]) + (x[e][2] + x[e][3]);
            s += __shfl_xor(s, 1); s += __shfl_xor(s, 2); s += __shfl_xor(s, 4);
            const float mu = s * (1.0f / 128.0f);
#pragma unroll
            for (int e = 0; e < 4; ++e) x[e] = x[e] - mu;
        }
        float s2 = 0.f;
#pragma unroll
        for (int e = 0; e < 4; ++e) s2 += (x[e][0] * x[e][0] + x[e][1] * x[e][1]) + (x[e][2] * x[e][2] + x[e][3] * x[e][3]);
        s2 += __shfl_xor(s2, 1); s2 += __shfl_xor(s2, 2); s2 += __shfl_xor(s2, 4);
        const float rs = 1.0f / sqrtf(s2 * (1.0f / 128.0f) + RMS_EPS);
        const int c0 = h * 128 + part * 16, yb = ODD ? 0 : 512;
        const v4u* gp = (const v4u*)(A.Z + row * NZ + ZC_GATE + yb + c0); v4u* yp = (v4u*)(A.Y + row * DMODEL + yb + c0);
#pragma unroll
        for (int e2 = 0; e2 < 2; ++e2) {
            const v4u gt = gp[e2]; v4u ov;
#pragma unroll
            for (int e = 0; e < 4; ++e) {
                const int c = c0 + 8 * e2 + 2 * e; const f32x4 xv = x[2 * e2 + (e >> 1)]; const float xa = xv[(2 * e) & 3], xb = xv[(2 * e + 1) & 3];
                float ya = xa * rs * A.g1[c], yb2 = xb * rs * A.g1[c + 1];
                if (ODD) { ya += A.g2[c]; yb2 += A.g2[c + 1]; }
                ov[e] = cvtpk(ya * bflo(gt[e]), yb2 * bfhi(gt[e]));
            }
            yp[e2] = ov;
        }
    }
}

constexpr int DK_LD = 72;
constexpr int DV_LD = 392;
constexpr int DA_K = 0, DA_VT = DA_K + 384 * DK_LD * 2, DA_WS = DA_VT + 64 * DV_LD * 2, DA_END = DA_WS + 8 * 128 * 4;
static_assert(DA_END <= RING_BYTES, "dilated-attention LDS map");

template <int PAT> __device__ __forceinline__ void dil_unit(Frame& F, const bf16* Z, bf16* Y, float* LSE, int u) {
    constexpr int DIL = (PAT == 0) ? 1 : (PAT == 1) ? 4 : 16;
    const int bh = u >> 4, rem = u & 15, b = bh >> 3, h = bh & 7, r = rem % DIL, blk = rem / DIL, i0 = 256 * blk;
    LAS bf16* KL = (LAS bf16*)(F.lds + RING_OFF + DA_K); LAS bf16* VT = (LAS bf16*)(F.lds + RING_OFF + DA_VT);
    LAS float* wsc = (LAS float*)(F.lds + RING_OFF + DA_WS) + F.wave * 128;
    const int r32 = F.lane & 31, hi = F.lane >> 5;
    const bf16* zb = Z + (size_t)b * SEQ * NZ + h * 64;
    __syncthreads();
#pragma unroll
    for (int e = 0; e < 6; ++e) {
        const int pi = F.tid + 512 * e, row = pi >> 3, c = pi & 7, idx = i0 - 128 + row;
        v4u kx = {0u, 0u, 0u, 0u}, vx = {0u, 0u, 0u, 0u};
        if (idx >= 0) { const bf16* tp = zb + (size_t)(idx * DIL + r) * NZ; kx = *(const v4u*)(tp + ZC_AK + 8 * c); vx = *(const v4u*)(tp + ZC_AV + 8 * c); }
        *(LAS v4u*)(KL + row * DK_LD + 8 * c) = kx;
#pragma unroll
        for (int q = 0; q < 4; ++q) { VT[(8 * c + 2 * q) * DV_LD + row] = (bf16)(vx[q] & 0xffffu); VT[(8 * c + 2 * q + 1) * DV_LD + row] = (bf16)(vx[q] >> 16); }
    }
    const int qidx = i0 + 32 * F.wave + r32; const size_t qrow = (size_t)b * SEQ + (size_t)qidx * DIL + r;
    bf16x8 qf[4];
#pragma unroll
    for (int s = 0; s < 4; ++s) qf[s] = *(const bf16x8*)(Z + qrow * NZ + ZC_AQ + h * 64 + 16 * s + 8 * hi);
    __syncthreads();
    const int kb_lo = (i0 + 32 * F.wave - 128 < 0) ? (128 - i0 - 32 * F.wave) / 32 : 0;
    f32x16 st[5];
#pragma unroll
    for (int kb = 0; kb < 5; ++kb) {
        st[kb] = (f32x16){};
        if (kb >= kb_lo) {
#pragma unroll
            for (int s = 0; s < 4; ++s) { const bf16x8 kf = *(const LAS bf16x8*)(KL + (32 * F.wave + 32 * kb + r32) * DK_LD + 16 * s + 8 * hi); st[kb] = mfma32(kf, qf[s], st[kb]); }
        }
    }
    float mx = -INFINITY;
#pragma unroll
    for (int kb = 0; kb < 5; ++kb)
#pragma unroll
        for (int rr = 0; rr < 16; ++rr) {
            const int kl = crow16(rr, hi); bool ok = kb >= kb_lo;
            if (kb == 0) ok = ok && (kl >= r32);
            if (kb == 4) ok = ok && (kl <= r32);
            const float sv = ok ? st[kb][rr] : -INFINITY; st[kb][rr] = sv; mx = fmaxf(mx, sv);
        }
    mx = fmaxf(mx, __shfl_xor(mx, 32));
    float l = 0.f;
#pragma unroll
    for (int kb = 0; kb < 5; ++kb)
#pragma unroll
        for (int rr = 0; rr < 16; ++rr) { const float p = exp2f(st[kb][rr] - mx); st[kb][rr] = p; l += p; }
    l += __shfl_xor(l, 32);
    f32x16 o0 = {}, o1 = {};
#pragma unroll
    for (int kb = 0; kb < 5; ++kb) {
        if (kb >= kb_lo) {
#pragma unroll
            for (int s2 = 0; s2 < 2; ++s2) {
                const bf16x8 pa = pack8(st[kb], s2);
                const int base = 32 * F.wave + 32 * kb + 16 * s2 + 4 * hi;
                o0 = mfma32(pa, ld_perm8(VT + r32 * DV_LD + base), o0);
                o1 = mfma32(pa, ld_perm8(VT + (32 + r32) * DV_LD + base), o1);
            }
        }
    }
    const float lse_cur = mx + __log2f(l);
    float w_old = 0.f, w_cur = 1.0f / l;
    if (PAT > 0) {
        const float lse_old = LSE[qrow * 8 + h];
        const float m2 = fmaxf(lse_old, lse_cur), lse_new = m2 + __log2f(exp2f(lse_old - m2) + exp2f(lse_cur - m2));
        w_old = exp2f(lse_old - lse_new); w_cur = exp2f(lse_cur - lse_new) / l;
        if (PAT < 2 && hi == 0) LSE[qrow * 8 + h] = lse_new;
    } else { if (hi == 0) LSE[qrow * 8 + h] = lse_cur; }
    if (hi == 0) { wsc[r32] = w_old; wsc[32 + r32] = w_cur; }
    __builtin_amdgcn_fence(__ATOMIC_RELEASE, "workgroup"); __builtin_amdgcn_wave_barrier(); __builtin_amdgcn_fence(__ATOMIC_ACQUIRE, "workgroup");
#pragma unroll
    for (int rr = 0; rr < 16; ++rr) {
        const int ql = crow16(rr, hi); const float wo = wsc[ql], wc = wsc[32 + ql];
        const size_t row = (size_t)b * SEQ + (size_t)(i0 + 32 * F.wave + ql) * DIL + r;
        bf16* yp = Y + row * DMODEL + 512 + h * 64 + r32;
        float a0 = o0[rr] * wc, a1 = o1[rr] * wc;
        if (PAT > 0) { a0 += wo * bf1(yp[0]); a1 += wo * bf1(yp[32]); }
        if (PAT == 2) { const bf16* gp = Z + row * NZ + ZC_GATE + 512 + h * 64 + r32; a0 *= bf1(gp[0]); a1 *= bf1(gp[32]); }
        yp[0] = (bf16)f2bf(a0); yp[32] = (bf16)f2bf(a1);
    }
}
struct Args { const float* in[14]; float* out; unsigned char* ws; int ph_lo, ph_hi, li, pad; };

constexpr size_t W_LAYER_BYTES = 9 * MiB;
__device__ __forceinline__ bf16* w_in_ptr(unsigned char* ws, int L) { return (bf16*)(ws + WS_W + (size_t)L * W_LAYER_BYTES); }
__device__ __forceinline__ bf16* w_out_ptr(unsigned char* ws, int L) { return (bf16*)(ws + WS_W + (size_t)L * W_LAYER_BYTES + 7 * MiB); }

__device__ __forceinline__ void p0_prologue(Frame& F, const Args& a) {
    LAS float* scr = (LAS float*)(F.lds + RING_OFF + F.wave * 16384);
    const int gw = F.vcu * NWAVES + F.wave, NGW = F.G * NWAVES;
    constexpr int I_IN = 16 * 112, I_OUT = 16 * 32, I_SK = 16, PER_LAYER = I_IN + I_OUT, NITEMS = 4 * PER_LAYER + 2 * I_SK;
    for (int it = gw; it < NITEMS; it += NGW) {
        if (it < 4 * PER_LAYER) {
            const int L = it / PER_LAYER; int r = it % PER_LAYER; const int j = L >> 1, odd = L & 1;
            if (r < I_IN) {
                const float* W = odd ? a.in[9] + (size_t)j * DMODEL * ODD_IN : a.in[2] + (size_t)j * DMODEL * EVEN_IN;
                const float* gain = (odd ? a.in[8] : a.in[1]) + j * DMODEL;
                p0_transpose_item(W, odd ? ODD_IN : EVEN_IN, odd ? 1 : 0, gain, w_in_ptr(a.ws, L), 112, scr, r, F.lane);
            } else {
                r -= I_IN;
                const float* W = (odd ? a.in[12] : a.in[7]) + (size_t)j * DMODEL * DMODEL;
                p0_transpose_item(W, DMODEL, 2, nullptr, w_out_ptr(a.ws, L), 32, scr, r, F.lane);
            }
        } else {
            const int r = it - 4 * PER_LAYER; const int j = r / I_SK;
            p0_transpose_item(a.in[2] + (size_t)j * DMODEL * EVEN_IN, EVEN_IN, 3, a.in[1] + j * DMODEL, (bf16*)(a.ws + WS_WSK) + (size_t)j * 32 * DMODEL, 1, scr, r % I_SK, F.lane);
        }
    }
    {
        bf16* HB = (bf16*)(a.ws + WS_HB); float* SS = (float*)(a.ws + WS_SS);
        for (int m = gw; m < M; m += NGW) {
            const GAS f32x4* xr = (const GAS f32x4*)(a.in[0] + (size_t)m * DMODEL) + F.lane;
            GAS unsigned long long* o8 = (GAS unsigned long long*)(HB + (size_t)m * DMODEL) + F.lane;
            float s = 0.f;
#pragma unroll
            for (int j = 0; j < 4; ++j) { const f32x4 v = xr[64 * j]; s += (v.x * v.x + v.y * v.y) + (v.z * v.z + v.w * v.w);
                o8[64 * j] = (unsigned long long)pk2(v.x, v.y) | ((unsigned long long)pk2(v.z, v.w) << 32); }
            s = wave_sum(s);
            if (F.lane < 16) SS[(size_t)m * 16 + F.lane] = (F.lane == 0) ? s : 0.f;
        }
    }
    {
        float* RP = (float*)(a.ws + WS_ROPE);
        for (int e = F.vcu * 512 + F.tid; e < SEQ * 32; e += F.G * 512) {
            const int t = e >> 5, j = e & 31;
            const float inv = (float)exp(-(double)j * (9.210340371976184 / 32.0));
            const float ang = (float)t * inv;
            double sn, cs; sincos((double)ang, &sn, &cs);
            RP[2 * e] = (float)cs; RP[2 * e + 1] = (float)sn;
        }
    }
}

__device__ __forceinline__ void skinny_phase(Frame& F, const bf16* HB, const bf16* WSK, const float* SS, const float* b_f, float* FFo, float* GLRo) {
    typedef float f32x4_t __attribute__((ext_vector_type(4)));
    const int lr = F.lane & 15, kq = F.lane >> 4;
    for (int rb = blockIdx.x; rb < M / 128; rb += F.G) {
        const int r0 = rb * 128 + F.wave * 16;
        f32x4_t acc0 = {0.f, 0.f, 0.f, 0.f}, acc1 = {0.f, 0.f, 0.f, 0.f};
        const bf16* ap = HB + (size_t)(r0 + lr) * DMODEL + 8 * kq;
        const bf16* bp0 = WSK + (size_t)lr * DMODEL + 8 * kq;
        const bf16* bp1 = WSK + (size_t)(16 + lr) * DMODEL + 8 * kq;
#pragma unroll 8
        for (int k0 = 0; k0 < DMODEL; k0 += 32) {
            const bf16x8 av = *(const bf16x8*)(ap + k0), b0 = *(const bf16x8*)(bp0 + k0), b1 = *(const bf16x8*)(bp1 + k0);
            acc0 = __builtin_amdgcn_mfma_f32_16x16x32_bf16(av, b0, acc0, 0, 0, 0);
            acc1 = __builtin_amdgcn_mfma_f32_16x16x32_bf16(av, b1, acc1, 0, 0, 0);
        }
#pragma unroll
        for (int reg = 0; reg < 4; ++reg) {
            const int row = r0 + 4 * kq + reg;
            const f32x4* sp = (const f32x4*)(SS + (size_t)row * 16);
            const f32x4 s0 = sp[0], s1 = sp[1], s2 = sp[2], s3 = sp[3];
            const float tot = ((s0[0] + s0[1]) + (s0[2] + s0[3])) + ((s1[0] + s1[1]) + (s1[2] + s1[3])) + ((s2[0] + s2[1]) + (s2[2] + s2[3])) + ((s3[0] + s3[1]) + (s3[2] + s3[3]));
            const float rinv = 1.0f / sqrtf(tot * (1.0f / 1024.0f) + RMS_EPS);
            const float v0 = acc0[reg] * rinv, v1 = acc1[reg] * rinv;
            if (lr < 8) { FFo[(size_t)row * 8 + lr] = logsigmoidf(v0 + b_f[lr]); GLRo[(size_t)row * 16 + 8 + lr] = v1; }
            else GLRo[(size_t)row * 16 + (lr - 8)] = v0;
        }
    }
}

__device__ __forceinline__ void cumsum_unit(Frame& F, int bh, const float* FFp, float* CB) {
    LAS float* wsum = (LAS float*)(F.lds + RING_OFF);
    const int b = bh >> 3, h = bh & 7;
    float v[8]; float run = 0.f;
#pragma unroll
    for (int i = 0; i < 8; ++i) { run += FFp[((size_t)b * SEQ + F.tid * 8 + i) * 8 + h]; v[i] = run; }
    float x = run;
#pragma unroll
    for (int o = 1; o < 64; o <<= 1) { const float y = __shfl_up(x, o); if (F.lane >= o) x += y; }
    if (F.lane == 63) wsum[F.wave] = x;
    __syncthreads();
    float off = x - run;
    for (int w = 0; w < F.wave; ++w) off += wsum[w];
#pragma unroll
    for (int i = 0; i < 8; ++i) CB[(size_t)bh * SEQ + F.tid * 8 + i] = v[i] + off;
    __syncthreads();
}

__device__ __forceinline__ void lin_naive_unit(Frame& F, int b, bool odd, const bf16* Z, const float* GLRp, const float* w_lr, const float* b_lr, const float* g1, const float* g2, bf16* Y) {
    float* qs = (float*)(F.lds + RING_OFF);
    float* ks = qs + 4096;
    float* al = ks + 4096;
    float* vs = al + 4096;
    float* os = vs + 8192;
    const int tid = F.tid, hd = tid >> 7;
    float S[64];
#pragma unroll
    for (int d = 0; d < 64; ++d) S[d] = 0.f;
    for (int t0 = 0; t0 < SEQ; t0 += 16) {
        for (int i = 0; i < 8; ++i) {
            const int e = tid + 512 * i, tok = e >> 8, c = e & 255; const size_t row = (size_t)b * SEQ + t0 + tok;
            qs[e] = bf1(Z[row * NZ + ZC_LQ + c]); ks[e] = bf1(Z[row * NZ + ZC_LK + c]);
            float a;
            if (odd) a = 1.0f - exp2f(-5.0f - (float)(c >> 6));
            else { float x = b_lr[c];
#pragma unroll
                for (int r = 0; r < 16; ++r) x += GLRp[row * 16 + r] * w_lr[r * 256 + c];
                a = __expf(logsigmoidf(x) * (1.0f / 16.0f)); }
            al[e] = a;
        }
        for (int i = 0; i < 16; ++i) vs[i * 512 + tid] = bf1(Z[((size_t)b * SEQ + t0 + i) * NZ + ZC_LV + tid]);
        __syncthreads();
        for (int tok = 0; tok < 16; ++tok) {
            const f32x4* q4 = (const f32x4*)(qs + tok * 256 + hd * 64); const f32x4* k4 = (const f32x4*)(ks + tok * 256 + hd * 64); const f32x4* a4 = (const f32x4*)(al + tok * 256 + hd * 64);
            const float vv = vs[tok * 512 + tid]; float o = 0.f;
#pragma unroll
            for (int d4 = 0; d4 < 16; ++d4) { const f32x4 qq = q4[d4], kk = k4[d4], aa = a4[d4];
#pragma unroll
                for (int e = 0; e < 4; ++e) { S[4 * d4 + e] = aa[e] * S[4 * d4 + e] + kk[e] * vv; o += qq[e] * S[4 * d4 + e]; } }
            os[tok * 512 + tid] = o;
        }
        __syncthreads();
        for (int i = 0; i < 8; ++i) {
            const int p = F.wave * 8 + i, tok = p >> 2, hh = p & 3; const size_t row = (size_t)b * SEQ + t0 + tok;
            float x0 = os[tok * 512 + hh * 128 + F.lane], x1 = os[tok * 512 + hh * 128 + 64 + F.lane];
            if (odd) { const float mu = wave_sum(x0 + x1) * (1.0f / 128.0f); x0 -= mu; x1 -= mu; }
            const float var = wave_sum(x0 * x0 + x1 * x1) * (1.0f / 128.0f); const float rs = 1.0f / sqrtf(var + RMS_EPS);
            const int c0 = hh * 128 + F.lane, c1 = c0 + 64;
            float y0 = x0 * rs * g1[c0], y1 = x1 * rs * g1[c1];
            if (odd) { y0 += g2[c0]; y1 += g2[c1]; }
            const int yb = odd ? 0 : 512;
            y0 *= bf1(Z[row * NZ + ZC_GATE + yb + c0]); y1 *= bf1(Z[row * NZ + ZC_GATE + yb + c1]);
            Y[row * DMODEL + yb + c0] = (bf16)f2bf(y0); Y[row * DMODEL + yb + c1] = (bf16)f2bf(y1);
        }
        __syncthreads();
    }
}

__device__ __forceinline__ void dil_naive_unit(Frame& F, int u, const bf16* Z, bf16* Y) {
    const int bh = u >> 3, tb = u & 7, b = bh >> 3, h = bh & 7, t = tb * 512 + F.tid;
    const bf16* zb = Z + (size_t)b * SEQ * NZ;
    float q[64], acc[64];
    { const v4u* qp = (const v4u*)(zb + (size_t)t * NZ + ZC_AQ + h * 64);
#pragma unroll
      for (int c = 0; c < 8; ++c) { const v4u w = qp[c];
#pragma unroll
          for (int e = 0; e < 4; ++e) { q[8 * c + 2 * e] = bflo(w[e]); q[8 * c + 2 * e + 1] = bfhi(w[e]); } } }
#pragma unroll
    for (int d = 0; d < 64; ++d) acc[d] = 0.f;
    float mx = -INFINITY, l = 0.f;
    for (int p = 0; p < 3; ++p) {
        const int dil = (p == 0) ? 1 : (p == 1) ? 4 : 16;
        for (int j = 0; j <= 128; ++j) {
            const int pos = t - j * dil; if (pos < 0) break;
            const v4u* kp = (const v4u*)(zb + (size_t)pos * NZ + ZC_AK + h * 64);
            float s = 0.f;
#pragma unroll
            for (int c = 0; c < 8; ++c) { const v4u w = kp[c];
#pragma unroll
                for (int e = 0; e < 4; ++e) { s += q[8 * c + 2 * e] * bflo(w[e]); s += q[8 * c + 2 * e + 1] * bfhi(w[e]); } }
            if (s > mx) { const float sc = exp2f(mx - s); l *= sc;
#pragma unroll
                for (int d = 0; d < 64; ++d) acc[d] *= sc;
                mx = s; }
            const float pr = exp2f(s - mx); l += pr;
            const v4u* vp = (const v4u*)(zb + (size_t)pos * NZ + ZC_AV + h * 64);
#pragma unroll
            for (int c = 0; c < 8; ++c) { const v4u w = vp[c];
#pragma unroll
                for (int e = 0; e < 4; ++e) { acc[8 * c + 2 * e] += pr * bflo(w[e]); acc[8 * c + 2 * e + 1] += pr * bfhi(w[e]); } }
        }
    }
    const float inv = 1.0f / l; const size_t row = (size_t)b * SEQ + t;
    const v4u* gp = (const v4u*)(Z + row * NZ + ZC_GATE + 512 + h * 64); v4u* yp = (v4u*)(Y + row * DMODEL + 512 + h * 64);
#pragma unroll
    for (int c = 0; c < 8; ++c) { const v4u g = gp[c]; v4u o;
#pragma unroll
        for (int e = 0; e < 4; ++e) o[e] = pk2(acc[8 * c + 2 * e] * inv * bflo(g[e]), acc[8 * c + 2 * e + 1] * inv * bfhi(g[e]));
        yp[c] = o; }
}

__device__ __forceinline__ void final_norm_phase(Frame& F, float* out, const float* g) {
    const int gw = F.vcu * NWAVES + F.wave, NGW = F.G * NWAVES;
    f32x4 gv[4];
#pragma unroll
    for (int j = 0; j < 4; ++j) gv[j] = ((const f32x4*)g)[F.lane + 64 * j];
    for (int m = gw; m < M; m += NGW) {
        GAS f32x4* xr = (GAS f32x4*)(out + (size_t)m * DMODEL) + F.lane;
        f32x4 v[4]; float s = 0.f;
#pragma unroll
        for (int j = 0; j < 4; ++j) { v[j] = xr[64 * j]; s += (v[j].x * v[j].x + v[j].y * v[j].y) + (v[j].z * v[j].z + v[j].w * v[j].w); }
        const float r = 1.0f / sqrtf(wave_sum(s) * (1.0f / 1024.0f) + RMS_EPS);
#pragma unroll
        for (int j = 0; j < 4; ++j) xr[64 * j] = v[j] * r * gv[j];
    }
}

constexpr int PH_PER_LAYER = 5, N_PHASES = 2 + 4 * PH_PER_LAYER;
#ifndef MK_N_LAUNCHES
#define MK_N_LAUNCHES 1
#endif

#define IN(k) (lo <= (k) && (k) < hi)
#define SEAM(k) do { if (IN(k) && IN((k) + 1)) xcd_barrier(bar); } while (0)
__device__ __forceinline__ unsigned char* launder_ptr(unsigned char* p) { asm volatile("" : "+s"(p)); return p; }
__device__ __forceinline__ void refresh(Frame& F) { int t = threadIdx.x; asm volatile("" : "+v"(t)); F.tid = t; F.lane = t & 63; F.wave = __builtin_amdgcn_readfirstlane(t >> 6); }
#ifndef LIN_MFMA
#define LIN_MFMA 1
#endif
#ifndef DIL_MFMA
#define DIL_MFMA 1
#endif
template <int L> __device__ __forceinline__ LinArgs make_lin_args(unsigned char* ws, const Args& args) {
    constexpr int j = L >> 1; constexpr bool odd = (L & 1) != 0;
    LinArgs A;
    A.Z = (const bf16*)(ws + WS_Z); A.GLR = (const float*)(ws + WS_GLR); A.w_lr = args.in[4] + (size_t)j * 16 * 256; A.b_lr = args.in[5] + j * 256;
    A.g1 = odd ? args.in[10] + j * 512 : args.in[6] + j * 512; A.g2 = odd ? args.in[11] + j * 512 : nullptr;
    A.KV = (float*)(ws + WS_KV); A.DEC = (float*)(ws + WS_DECAY); A.PREV = (bf16*)(ws + WS_PREV); A.Y = (bf16*)(ws + WS_Y);
    return A;
}
template <int L> __device__ __forceinline__ void run_layer(Frame& F, const Args& args, const XcdBarrier& bar, const int lo, const int hi, unsigned char* lds) {
    constexpr int pb = 1 + PH_PER_LAYER * L; constexpr int j = L >> 1; constexpr bool odd = (L & 1) != 0;
    if (IN(pb)) {
        unsigned char* ws = launder_ptr(args.ws); refresh(F);
        bf16* Z = (bf16*)(ws + WS_Z); bf16* HB = (bf16*)(ws + WS_HB); float* SS = (float*)(ws + WS_SS);
        pg8::Gemm g{HB, w_in_ptr(ws, L), M, NZ, DMODEL}; pg8::StaticOrder S; S.init(M, NZ, F.G, (int)blockIdx.x);
        pg8::EpiIn E{Z, NZ, SS, (const float*)(ws + WS_ROPE), odd ? 1 : 0, 0.125f, C2};
        pg8::gemm_phase<pg8::EpiIn, pg8::StaticOrder, true, true>(F.lds + RING_OFF, g, S, E);
        if (!odd) skinny_phase(F, HB, (const bf16*)(ws + WS_WSK) + (size_t)j * 32 * DMODEL, SS, args.in[3] + j * 8, (float*)(ws + WS_FF), (float*)(ws + WS_GLR));
    }
    SEAM(pb);
    if (IN(pb + 1)) {
        unsigned char* ws = launder_ptr(args.ws); refresh(F);
        bf16* Z = (bf16*)(ws + WS_Z); bf16* Y = (bf16*)(ws + WS_Y);
#if LIN_MFMA
        { const LinArgs A = make_lin_args<L>(ws, args); for (int u = F.vcu; u < 2048; u += F.G) lin_kv_unit<odd>(F, A, u); }
#else
        for (int u = blockIdx.x; u < 8; u += F.G) lin_naive_unit(F, u, odd, Z, (const float*)(ws + WS_GLR), args.in[4] + (size_t)j * 16 * 256, args.in[5] + j * 256, odd ? args.in[10] + j * 512 : args.in[6] + j * 512, odd ? args.in[11] + j * 512 : nullptr, Y);
#endif
        if (!odd) { for (int u = F.vcu; u < 64; u += F.G) cumsum_unit(F, u, (const float*)(ws + WS_FF), (float*)(ws + WS_CB)); }
        else {
#if DIL_MFMA
            for (int u = F.vcu; u < 1024; u += F.G) dil_unit<0>(F, Z, Y, (float*)(ws + WS_LSE), u);
#else
            for (int u = blockIdx.x; u < 512; u += F.G) dil_naive_unit(F, u, Z, Y);
#endif
        }
    }
    SEAM(pb + 1);
    if (IN(pb + 2)) {
        unsigned char* ws = launder_ptr(args.ws); refresh(F);
#if LIN_MFMA
        { const LinArgs A = make_lin_args<L>(ws, args); lin_scan_phase(F, A); }
#endif
        if (!odd) {
            bf16* Z = (bf16*)(ws + WS_Z);
            const attn_body::AttnTensors AT{(const attn_body::bf16*)(Z + ZC_AQ), (const attn_body::bf16*)(Z + ZC_AK), (const attn_body::bf16*)(Z + ZC_AV), (const attn_body::bf16*)(Z + ZC_GATE), (const float*)(ws + WS_CB), (attn_body::bf16*)(ws + WS_Y)};
            const attn_body::StaticOrder S((int)F.G, (int)blockIdx.x, 0);
            attn_body::attn_phase<attn_body::StaticOrder>((char*)lds + RING_OFF, AT, S);
        } else {
#if DIL_MFMA
            for (int u = F.vcu; u < 1024; u += F.G) dil_unit<1>(F, (const bf16*)(ws + WS_Z), (bf16*)(ws + WS_Y), (float*)(ws + WS_LSE), u);
#endif
        }
    }
    SEAM(pb + 2);
    if (IN(pb + 3)) {
        unsigned char* ws = launder_ptr(args.ws); refresh(F);
#if LIN_MFMA
        { const LinArgs A = make_lin_args<L>(ws, args); for (int u = F.vcu; u < 2048; u += F.G) lin_out_unit<odd>(F, A, u); }
#endif
        if (!odd) {
            bf16* Z = (bf16*)(ws + WS_Z);
            const attn_body::AttnTensors AT{(const attn_body::bf16*)(Z + ZC_AQ), (const attn_body::bf16*)(Z + ZC_AK), (const attn_body::bf16*)(Z + ZC_AV), (const attn_body::bf16*)(Z + ZC_GATE), (const float*)(ws + WS_CB), (attn_body::bf16*)(ws + WS_Y)};
            const attn_body::StaticOrder S((int)F.G, (int)blockIdx.x, 1);
            __syncthreads();
            attn_body::attn_phase<attn_body::StaticOrder>((char*)lds + RING_OFF, AT, S);
        } else {
#if DIL_MFMA
            for (int u = F.vcu; u < 1024; u += F.G) dil_unit<2>(F, (const bf16*)(ws + WS_Z), (bf16*)(ws + WS_Y), (float*)(ws + WS_LSE), u);
#endif
        }
    }
    SEAM(pb + 3);
    if (IN(pb + 4)) {
        unsigned char* ws = launder_ptr(args.ws); refresh(F);
        pg8::Gemm g{(bf16*)(ws + WS_Y), w_out_ptr(ws, L), M, DMODEL, DMODEL}; pg8::StaticOrder S; S.init(M, DMODEL, F.G, (int)blockIdx.x);
        pg8::EpiOut E{L == 0 ? args.in[0] : args.out, args.out, (bf16*)(ws + WS_HB), (float*)(ws + WS_SS)};
        pg8::gemm_phase<pg8::EpiOut, pg8::StaticOrder, true, true>(F.lds + RING_OFF, g, S, E);
    }
    SEAM(pb + 4);
}
#undef IN
#undef SEAM

__global__ void __launch_bounds__(NWAVES * 64, 2) trunk_fwd(Args args) {
    extern __shared__ __attribute__((aligned(16))) unsigned char lds[];
    Frame F;
    F.lds = (LAS unsigned char*)lds;
    F.MISC = (volatile LAS unsigned*)(F.lds + MISC_OFF);
    F.tid = threadIdx.x; F.lane = F.tid & 63; F.wave = __builtin_amdgcn_readfirstlane(F.tid >> 6);
    F.G = gridDim.x; { const int bx = blockIdx.x; F.vcu = (F.G % 8 == 0) ? (bx % 8) * (F.G / 8) + bx / 8 : bx; }
    F.ws = args.ws; F.ctl = (gu32*)(args.ws + WS_CTL);
    for (int u = F.tid; u < (LDS_BYTES - LDSCTL_OFF) / 4; u += NWAVES * 64) ((LAS unsigned*)(F.lds + LDSCTL_OFF))[u] = 0u;
    __syncthreads();
    XcdBarrier bar = xcd_barrier_post((unsigned*)(F.ctl + CW_BAR) + args.li * XCD_BAR_WORDS, F.MISC + 8);
    const int lo = args.ph_lo, hi = args.ph_hi;
#define IN(k) (lo <= (k) && (k) < hi)
#define SEAM(k) do { if (IN(k) && IN((k) + 1)) xcd_barrier(bar); } while (0)

    if (IN(0)) p0_prologue(F, args);
    SEAM(0);

    run_layer<0>(F, args, bar, lo, hi, lds); run_layer<1>(F, args, bar, lo, hi, lds); run_layer<2>(F, args, bar, lo, hi, lds); run_layer<3>(F, args, bar, lo, hi, lds);
    if (IN(N_PHASES - 1)) { refresh(F); final_norm_phase(F, args.out, args.in[13]); }
#undef IN
#undef SEAM
}

extern "C" void kernel_launch(void* const* d_in, const int* in_sizes, int n_in, void* d_out, int out_size, void* d_ws, size_t ws_size, hipStream_t stream) {
    static int grid = 0;
    if (grid == 0) {
        if (n_in != 14 || in_sizes[0] != M * DMODEL || out_size != M * DMODEL || ws_size < WS_END) { fprintf(stderr, "kernel_launch: unexpected shapes: n_in %d in0 %d out %d ws %zu (need %zu)\n", n_in, n_in > 0 ? in_sizes[0] : -1, out_size, ws_size, (size_t)WS_END); grid = -1; return; }
        int dev = 0, cus = 0, per_cu = 0;
        if (hipGetDevice(&dev) != hipSuccess || hipDeviceGetAttribute(&cus, hipDeviceAttributeMultiprocessorCount, dev) != hipSuccess) { fprintf(stderr, "kernel_launch: device query failed\n"); grid = -1; return; }
        if (hipFuncSetAttribute((const void*)trunk_fwd, hipFuncAttributeMaxDynamicSharedMemorySize, LDS_BYTES) != hipSuccess) { fprintf(stderr, "kernel_launch: hipFuncSetAttribute failed\n"); grid = -1; return; }
        if (hipOccupancyMaxActiveBlocksPerMultiprocessor(&per_cu, (const void*)trunk_fwd, NWAVES * 64, LDS_BYTES) != hipSuccess || per_cu < 1) fprintf(stderr, "kernel_launch: note: occupancy query reports %d blocks per CU\n", per_cu);
        (void)hipGetLastError();
        grid = cus;
    }
    if (grid < 0) return;
    if (hipMemsetAsync((char*)d_ws + WS_CTL, 0, CTL_ZERO_BYTES, stream) != hipSuccess) { fprintf(stderr, "kernel_launch: memset failed\n"); return; }
    Args a{};
    for (int i = 0; i < 14; ++i) a.in[i] = (const float*)d_in[i];
    a.out = (float*)d_out; a.ws = (unsigned char*)d_ws;
    constexpr int NL = MK_N_LAUNCHES;
    for (int li = 0; li < NL; ++li) {
        a.ph_lo = (NL == 1) ? 0 : li; a.ph_hi = (NL == 1) ? N_PHASES : li + 1; a.li = li;
        hipLaunchKernelGGL(trunk_fwd, dim3(grid), dim3(NWAVES * 64), LDS_BYTES, stream, a);
        const hipError_t le = hipPeekAtLastError();
        if (le != hipSuccess) { fprintf(stderr, "kernel_launch: launch %d failed: %s\n", li, hipGetErrorName(le)); break; }
    }
}
```

```cpp
#include <hip/hip_runtime.h>
#include <hip/hip_bf16.h>
#include <cstdio>
#include <cstdint>
#include <cmath>

namespace pg8 {
#define PG8_LAS __attribute__((address_space(3)))
typedef unsigned short bf16_t;
typedef short bf16x8 __attribute__((ext_vector_type(8)));
typedef float f32x4 __attribute__((ext_vector_type(4)));
typedef unsigned u32x4 __attribute__((ext_vector_type(4)));
constexpr int BM = 256, BK = 64, HALF = 128, HTB = HALF * BK * 2  , STAGE_BYTES = 8 * HTB, NXCD = 8, WGM = 8;

__host__ __device__ __forceinline__ int lds_byte(int r, int c) { const int st = (r >> 4) * 2 + (c >> 5), rr = r & 15, cc = c & 31, ob = rr * 64 + cc * 2; return st * 1024 + (ob ^ (((ob >> 9) & 1) << 5)); }
__host__ __device__ __forceinline__ void stage_rc(int b, int& R, int& C) { const int st = b / 1024, sb = b % 1024, swz = sb ^ (((sb >> 9) & 1) << 5); R = (st >> 1) * 16 + swz / 64; C = (st & 1) * 32 + (swz % 64) / 2; }
__host__ __device__ __forceinline__ int perm32(int rho) { const int n = rho >> 4, i = rho & 15; return 8 * (i >> 2) + 4 * n + (i & 3); }

struct Unit { int pm, pn; };
struct Gemm { const bf16_t* A; const bf16_t* Bt; int M, N, K; };

struct StaticOrder {
    int nM, nN, nwg, G, c;
    __host__ __device__ void init(int M, int N, int G_, int c_) { nM = M / BM; nN = N / BM; nwg = nM * nN; G = G_; c = c_; }
    __host__ __device__ bool next(int i, Unit& u) const {
        const long L = (long)i * G + c; if (L >= nwg) return false;
        int wgid = (int)L; { const int q = nwg / NXCD, r = nwg % NXCD, xcd = wgid % NXCD, off = wgid / NXCD; wgid = (xcd < r ? xcd * (q + 1) : r * (q + 1) + (xcd - r) * q) + off; }
        const int nig = WGM * nN, gid = wgid / nig, fm = gid * WGM, gsz = (nM - fm) < WGM ? (nM - fm) : WGM;
        u.pm = fm + ((wgid % nig) % gsz); u.pn = (wgid % nig) / gsz; return true;
    }
    __device__ __forceinline__ void a_ready(const Unit&) const {}
    __device__ __forceinline__ void done(const Unit&) const {}
};

__device__ __forceinline__ unsigned cvt_pk_bf16(float lo, float hi) { unsigned r; asm volatile("v_cvt_pk_bf16_f32 %0, %1, %2" : "=v"(r) : "v"(lo), "v"(hi)); return r; }

struct EpiIn {
    static constexpr bool PERM = true, AFTER_DRAIN = false;
    bf16_t* Z; int ldz; const float* ss; const float* rope; int odd; float qscale, ascale;
    __device__ __forceinline__ void operator()(const f32x4 (&acc)[2][2][4][2], const Unit& u, int wr, int wc, int fr, int fq) const {
        const int row0 = u.pm * BM + wr * 64 + fr; const int pn = u.pn;
        const float cs = (pn == 0) ? qscale : ((pn == 4 || pn == 5) ? ascale : 1.0f);
        const bool do_rope = odd && (pn <= 1 || (pn >= 4 && pn <= 7));
        const bool do_silu = pn >= 10;
        const int col0 = pn * BM + wc * 32 + 8 * fq;
#pragma unroll
        for (int ai = 0; ai < 2; ++ai)
#pragma unroll
            for (int m = 0; m < 4; ++m) {
                const int row = row0 + ai * HALF + m * 16;
                const f32x4* sp = (const f32x4*)(ss + (size_t)row * 16);
                const f32x4 s0 = sp[0], s1 = sp[1], s2 = sp[2], s3 = sp[3];
                const float tot = ((s0[0] + s0[1]) + (s0[2] + s0[3])) + ((s1[0] + s1[1]) + (s1[2] + s1[3])) + ((s2[0] + s2[1]) + (s2[2] + s2[3])) + ((s3[0] + s3[1]) + (s3[2] + s3[3]));
                const float sc = cs / sqrtf(tot * (1.0f / 1024.0f) + 1e-6f);
                bf16_t* rowp = Z + (size_t)row * ldz + col0;
#pragma unroll
                for (int bj = 0; bj < 2; ++bj) {
                    f32x4 v0 = acc[ai][bj][m][0] * sc, v1 = acc[ai][bj][m][1] * sc;
                    if (do_rope) {
                        const int t = row & 4095; const int j0 = ((bj * HALF + wc * 32 + 8 * fq) & 63) >> 1;
                        const f32x4* rp = (const f32x4*)(rope + ((size_t)t * 32 + j0) * 2);
                        const f32x4 c01 = rp[0], c23 = rp[1];
                        f32x4 w0, w1;
                        w0[0] = v0[0] * c01[0] - v0[1] * c01[1]; w0[1] = v0[1] * c01[0] + v0[0] * c01[1];
                        w0[2] = v0[2] * c01[2] - v0[3] * c01[3]; w0[3] = v0[3] * c01[2] + v0[2] * c01[3];
                        w1[0] = v1[0] * c23[0] - v1[1] * c23[1]; w1[1] = v1[1] * c23[0] + v1[0] * c23[1];
                        w1[2] = v1[2] * c23[2] - v1[3] * c23[3]; w1[3] = v1[3] * c23[2] + v1[2] * c23[3];
                        v0 = w0; v1 = w1;
                    }
                    if (do_silu) {
#pragma unroll
                        for (int e = 0; e < 4; ++e) { v0[e] = v0[e] / (1.0f + __expf(-v0[e])); v1[e] = v1[e] / (1.0f + __expf(-v1[e])); }
                    }
                    u32x4 w; w.x = cvt_pk_bf16(v0[0], v0[1]); w.y = cvt_pk_bf16(v0[2], v0[3]); w.z = cvt_pk_bf16(v1[0], v1[1]); w.w = cvt_pk_bf16(v1[2], v1[3]);
                    *(u32x4*)(rowp + bj * HALF) = w;
                }
            }
    }
};

struct EpiOut {
    static constexpr bool PERM = true, AFTER_DRAIN = false;
    bf16_t* hb; float* ss;
    __device__ __forceinline__ void operator()(const f32x4 (&acc)[2][2][4][2], const Unit& u, int wr, int wc, int fr, int fq) const {
        const int row0 = u.pm * BM + wr * 64 + fr; const int col0 = u.pn * BM + wc * 32 + 8 * fq;
#pragma unroll
        for (int ai = 0; ai < 2; ++ai)
#pragma unroll
            for (int m = 0; m < 4; ++m) {
                const int row = row0 + ai * HALF + m * 16; const size_t off = (size_t)row * 1024 + col0; float q = 0.f;
#pragma unroll
                for (int bj = 0; bj < 2; ++bj) {
                    const u32x4 old = *(const u32x4*)(hb + off + bj * HALF);
                    f32x4 v0 = acc[ai][bj][m][0], v1 = acc[ai][bj][m][1];
                    v0[0] += __uint_as_float(old.x << 16); v0[1] += __uint_as_float(old.x & 0xffff0000u); v0[2] += __uint_as_float(old.y << 16); v0[3] += __uint_as_float(old.y & 0xffff0000u);
                    v1[0] += __uint_as_float(old.z << 16); v1[1] += __uint_as_float(old.z & 0xffff0000u); v1[2] += __uint_as_float(old.w << 16); v1[3] += __uint_as_float(old.w & 0xffff0000u);
                    q += (v0[0] * v0[0] + v0[1] * v0[1]) + (v0[2] * v0[2] + v0[3] * v0[3]) + (v1[0] * v1[0] + v1[1] * v1[1]) + (v1[2] * v1[2] + v1[3] * v1[3]);
                    u32x4 w; w.x = cvt_pk_bf16(v0[0], v0[1]); w.y = cvt_pk_bf16(v0[2], v0[3]); w.z = cvt_pk_bf16(v1[0], v1[1]); w.w = cvt_pk_bf16(v1[2], v1[3]);
                    *(u32x4*)(hb + off + bj * HALF) = w;
                }
                q += __shfl_xor(q, 16); q += __shfl_xor(q, 32);
                if (fq == 0) ss[(size_t)row * 16 + u.pn * 4 + wc] = q;
            }
    }
};

template <class Epi, class Sched, bool ALIGN_EPI = false, bool SP2 = false>
__device__ __forceinline__ void gemm_phase(PG8_LAS unsigned char* lds, const Gemm g, const Sched& S, const Epi& E) {
    int tid_ = threadIdx.x; asm volatile("" : "+v"(tid_));
    const int tid = tid_, wid = __builtin_amdgcn_readfirstlane(tid >> 6), lane = tid & 63, wr = wid >> 2, wc = wid & 3, fr = lane & 15, fq = lane >> 4;
    const int K = g.K, nt = K / BK;
    unsigned voffA[2], voffB[2];
#pragma unroll
    for (int i = 0; i < 2; ++i) { int R, C; stage_rc(tid * 16 + i * 8192, R, C); const int Rb = Epi::PERM ? ((R & ~31) + perm32(R & 31)) : R;
        voffA[i] = (unsigned)(R * K + C) * 2u; voffB[i] = (unsigned)(Rb * K + C) * 2u; }
    const size_t kstep = (size_t)(BK * 2);
    const size_t hstep = (size_t)HALF * K * 2;
    const size_t tstep = 2 * hstep;
    const unsigned ldsw = (unsigned)wid * 1024u;
    const int aoff = lds_byte(wr * 64 + fr, fq * 8), boff = lds_byte(wc * 32 + fr, fq * 8);
#define PG8_SA(b, h) (((b) * 2 + (h)) * HTB)
#define PG8_SB(b, h) ((4 + (b) * 2 + (h)) * HTB)
#define PG8_STAGE(bufoff, gbase, voff) do { _Pragma("unroll") for (int _i = 0; _i < 2; ++_i) \
        __builtin_amdgcn_global_load_lds((const unsigned*)((const char*)(gbase) + (voff)[_i]), (PG8_LAS unsigned*)(lds + (bufoff) + ldsw + _i * 8192), 16, 0, 0); } while (0)
#define PG8_LDA(dst, b, h) do { _Pragma("unroll") for (int m = 0; m < 4; ++m) _Pragma("unroll") for (int k = 0; k < 2; ++k) dst[m][k] = *(const PG8_LAS bf16x8*)(lds + PG8_SA(b, h) + aoff + m * 2048 + k * 1024); } while (0)
#define PG8_LDB(dst, b, h) do { _Pragma("unroll") for (int n = 0; n < 2; ++n) _Pragma("unroll") for (int k = 0; k < 2; ++k) dst[n][k] = *(const PG8_LAS bf16x8*)(lds + PG8_SB(b, h) + boff + n * 2048 + k * 1024); } while (0)
#define PG8_MMA(ai, bj, At, Bt) do { __builtin_amdgcn_s_setprio(1); _Pragma("unroll") for (int m = 0; m < 4; ++m) _Pragma("unroll") for (int n = 0; n < 2; ++n) _Pragma("unroll") for (int k = 0; k < 2; ++k) \
        acc[ai][bj][m][n] = __builtin_amdgcn_mfma_f32_16x16x32_bf16(Bt[n][k], At[m][k], acc[ai][bj][m][n], 0, 0, 0); __builtin_amdgcn_s_setprio(0); } while (0)
#define PG8_WAIT_V(n) asm volatile("s_waitcnt vmcnt(" #n ")" ::: "memory")
#define PG8_WAIT_L(n) asm volatile("s_waitcnt lgkmcnt(" #n ")" ::: "memory")
#define PG8_BAR __builtin_amdgcn_s_barrier()
#define PG8_SCHED __builtin_amdgcn_sched_barrier(0)
    Unit cur, nxt; int ui = 0;
    if (!S.next(0, cur)) return;
    f32x4 acc[2][2][4][2];
#pragma unroll
    for (int a = 0; a < 2; ++a)
#pragma unroll
        for (int b = 0; b < 2; ++b)
#pragma unroll
            for (int m = 0; m < 4; ++m)
#pragma unroll
                for (int n = 0; n < 2; ++n) acc[a][b][m][n] = (f32x4){0.f, 0.f, 0.f, 0.f};
    bf16x8 At[4][2], B0[2][2], B1[2][2];
    const char* cA = (const char*)g.A + (size_t)cur.pm * tstep; const char* cB = (const char*)g.Bt + (size_t)cur.pn * tstep;
    S.a_ready(cur);
    if constexpr (SP2) {
        PG8_STAGE(PG8_SB(0, 0), cB, voffB); PG8_STAGE(PG8_SB(0, 1), cB + hstep, voffB); PG8_STAGE(PG8_SA(0, 0), cA, voffA); PG8_STAGE(PG8_SA(0, 1), cA + hstep, voffA);
        if (wr == 1) PG8_BAR;
        PG8_WAIT_V(2); PG8_BAR;
        PG8_STAGE(PG8_SB(1, 0), cB + kstep, voffB); PG8_STAGE(PG8_SA(1, 0), cA + kstep, voffA); PG8_STAGE(PG8_SB(1, 1), cB + hstep + kstep, voffB);
        PG8_WAIT_V(6); PG8_BAR;
    } else {
        PG8_STAGE(PG8_SB(0, 0), cB, voffB); PG8_STAGE(PG8_SA(0, 0), cA, voffA); PG8_STAGE(PG8_SB(0, 1), cB + hstep, voffB); PG8_STAGE(PG8_SA(0, 1), cA + hstep, voffA);
        if (wr == 1) PG8_BAR;
        PG8_WAIT_V(4); PG8_BAR;
        PG8_STAGE(PG8_SB(1, 0), cB + kstep, voffB); PG8_STAGE(PG8_SA(1, 0), cA + kstep, voffA); PG8_STAGE(PG8_SB(1, 1), cB + hstep + kstep, voffB);
        PG8_WAIT_V(6); PG8_BAR;
    }
    for (;;) {
        const bool has_next = S.next(ui + 1, nxt);
        const char* nA = has_next ? (const char*)g.A + (size_t)nxt.pm * tstep : cA; const char* nB = has_next ? (const char*)g.Bt + (size_t)nxt.pn * tstep : cB;
        for (int t = 0; t < nt; t += 2) {
            const bool last = (t == nt - 2);
            const char* a1 = cA + (size_t)(t + 1) * kstep;
            const char* a2 = last ? nA : cA + (size_t)(t + 2) * kstep; const char* b2 = last ? nB : cB + (size_t)(t + 2) * kstep;
            const char* a3 = a2 + kstep; const char* b3 = b2 + kstep;
            if (last && has_next) S.a_ready(nxt);
            if constexpr (SP2) {
            PG8_LDB(B0, 0, 0); PG8_LDB(B1, 0, 1); PG8_SCHED; PG8_LDA(At, 0, 0); PG8_STAGE(PG8_SA(1, 1), a1 + hstep, voffA);
            PG8_WAIT_V(8); PG8_WAIT_L(0); PG8_BAR; PG8_MMA(0, 0, At, B0); PG8_MMA(0, 1, At, B1); PG8_BAR; PG8_SCHED;
            PG8_LDA(At, 0, 1); PG8_STAGE(PG8_SB(0, 0), b2, voffB); PG8_STAGE(PG8_SB(0, 1), b2 + hstep, voffB); PG8_STAGE(PG8_SA(0, 0), a2, voffA);
            PG8_WAIT_V(8); PG8_WAIT_L(0); PG8_BAR; PG8_MMA(1, 0, At, B0); PG8_MMA(1, 1, At, B1); PG8_BAR; PG8_SCHED;
            PG8_LDB(B0, 1, 0); PG8_LDB(B1, 1, 1); PG8_SCHED; PG8_LDA(At, 1, 0); PG8_STAGE(PG8_SA(0, 1), a2 + hstep, voffA);
            PG8_WAIT_V(8); PG8_WAIT_L(0); PG8_BAR; PG8_MMA(0, 0, At, B0); PG8_MMA(0, 1, At, B1); PG8_BAR; PG8_SCHED;
            PG8_LDA(At, 1, 1); PG8_STAGE(PG8_SB(1, 0), b3, voffB); PG8_STAGE(PG8_SB(1, 1), b3 + hstep, voffB); PG8_STAGE(PG8_SA(1, 0), a3, voffA);
            PG8_WAIT_V(8); PG8_WAIT_L(0); PG8_BAR; PG8_MMA(1, 0, At, B0); PG8_MMA(1, 1, At, B1); PG8_BAR; PG8_SCHED;
            } else {
            PG8_LDB(B0, 0, 0); PG8_SCHED; PG8_LDA(At, 0, 0); PG8_STAGE(PG8_SA(1, 1), a1 + hstep, voffA);
            PG8_WAIT_L(8); PG8_BAR; PG8_WAIT_L(0); PG8_MMA(0, 0, At, B0); PG8_BAR; PG8_SCHED;
            PG8_LDB(B1, 0, 1); PG8_STAGE(PG8_SB(0, 0), b2, voffB);
            PG8_BAR; PG8_WAIT_L(0); PG8_MMA(0, 1, At, B1); PG8_BAR;
            PG8_LDA(At, 0, 1); PG8_STAGE(PG8_SA(0, 0), a2, voffA);
            PG8_BAR; PG8_WAIT_L(0); PG8_MMA(1, 0, At, B0); PG8_BAR; PG8_SCHED;
            PG8_STAGE(PG8_SB(0, 1), b2 + hstep, voffB);
            PG8_WAIT_V(6); PG8_BAR; PG8_MMA(1, 1, At, B1); PG8_BAR;
            PG8_LDB(B0, 1, 0); PG8_SCHED; PG8_LDA(At, 1, 0); PG8_STAGE(PG8_SA(0, 1), a2 + hstep, voffA);
            PG8_WAIT_L(8); PG8_BAR; PG8_WAIT_L(0); PG8_MMA(0, 0, At, B0); PG8_BAR; PG8_SCHED;
            PG8_LDB(B1, 1, 1); PG8_STAGE(PG8_SB(1, 0), b3, voffB);
            PG8_BAR; PG8_WAIT_L(0); PG8_MMA(0, 1, At, B1); PG8_BAR;
            PG8_LDA(At, 1, 1); PG8_STAGE(PG8_SA(1, 0), a3, voffA);
            PG8_BAR; PG8_WAIT_L(0); PG8_MMA(1, 0, At, B0); PG8_BAR; PG8_SCHED;
            PG8_STAGE(PG8_SB(1, 1), b3 + hstep, voffB);
            PG8_WAIT_V(6); PG8_BAR; PG8_MMA(1, 1, At, B1); PG8_BAR;
            }
        }
        if constexpr (ALIGN_EPI) { if (wr == 0) PG8_BAR; }
        if constexpr (!Epi::AFTER_DRAIN) { E(acc, cur, wr, wc, fr, fq); S.done(cur); }
        if (!has_next) break;
#pragma unroll
        for (int a = 0; a < 2; ++a)
#pragma unroll
            for (int b = 0; b < 2; ++b)
#pragma unroll
                for (int m = 0; m < 4; ++m)
#pragma unroll
                    for (int n = 0; n < 2; ++n) acc[a][b][m][n] = (f32x4){0.f, 0.f, 0.f, 0.f};
        cur = nxt; cA = nA; cB = nB; ++ui;
        if constexpr (ALIGN_EPI) { if (wr == 1) PG8_BAR; }
    }
    PG8_WAIT_V(0);
    if constexpr (!ALIGN_EPI) { if (wr == 0) PG8_BAR; }
    PG8_BAR;
#undef PG8_SA
#undef PG8_SB
#undef PG8_STAGE
#undef PG8_LDA
#undef PG8_LDB
#undef PG8_MMA
#undef PG8_WAIT_V
#undef PG8_WAIT_L
#undef PG8_BAR
#undef PG8_SCHED
}
}
namespace attn_body {
using bf16=__hip_bfloat16;
using bf16x8=__attribute__((ext_vector_type(8)))short;
using s16x4=__attribute__((ext_vector_type(4)))short;
using f32x16=__attribute__((ext_vector_type(16)))float;
using u32x4=__attribute__((ext_vector_type(4)))unsigned;
constexpr int BATCH=8,NHEAD=8,SEQ=4096,D=64,DM=3584,OP=1024;
constexpr int NW=8,QBLK=32,QB=QBLK*NW,KVBLK=64,NQB=SEQ/QB;
constexpr int ATTN_PITCH=DM, ATTN_UNIT_ROWS=QB;
__device__ __forceinline__ int crow(int r,int hi){return (r&3)+8*(r>>2)+4*hi;}
#define SBAR() __builtin_amdgcn_sched_barrier(0)
__device__ __forceinline__ void cmask(f32x16&p0,f32x16&p1,int jb,int qrel,int hi){
  const float NEG=-INFINITY; int kb=64*jb+4*hi;
  #pragma unroll
  for(int r=0;r<16;++r){int kv=kb+(r&3)+8*(r>>2); if(kv>qrel)p0[r]=NEG; if(kv+32>qrel)p1[r]=NEG;}
}

constexpr int NSLOT=3, SLOTB=8192;
constexpr int LDS_K=0, LDS_V=NSLOT*SLOTB, LDS_WS=2*NSLOT*SLOTB, LDS_OST=LDS_WS+NW*64*4, LDS_BIAS=LDS_OST+NW*4096, LDS_BYTES=LDS_BIAS+SEQ*4;
constexpr float C2=0.125f*1.4426950408889634f;
__device__ __forceinline__ void glds16(const void*gsrc,unsigned lds_dst){unsigned keep;
  asm volatile("s_mov_b32 %0, m0\n\ts_mov_b32 m0, %2\n\ts_nop 0\n\tglobal_load_lds_dwordx4 %1, off\n\ts_mov_b32 m0, %0":"=&s"(keep):"v"(gsrc),"s"(lds_dst):"memory");}
__device__ __forceinline__ float max3f(float a,float b,float c){float r;asm("v_max3_f32 %0, %1, %2, %3":"=v"(r):"v"(a),"v"(b),"v"(c));return r;}
__device__ __forceinline__ float max2f(float a,float b){float r;asm("v_max_f32_e32 %0, %1, %2":"=v"(r):"v"(a),"v"(b));return r;}
__device__ __forceinline__ float fadd_s(float a,float b){float r;asm("v_add_f32_e32 %0, %1, %2":"=v"(r):"v"(a),"v"(b));return r;}
__device__ __forceinline__ float fsub_s(float a,float b){float r;asm("v_sub_f32_e32 %0, %1, %2":"=v"(r):"v"(a),"v"(b));return r;}
typedef float f32x4v __attribute__((ext_vector_type(4))); typedef float f32x2_t __attribute__((ext_vector_type(2))); typedef __bf16 bf16x2_t __attribute__((ext_vector_type(2)));
__device__ __forceinline__ unsigned cvtpk_s(float lo,float hi){f32x2_t v={lo,hi};bf16x2_t b=__builtin_convertvector(v,bf16x2_t);return __builtin_bit_cast(unsigned,b);}
#define WAIT_BAR(N) asm volatile("s_waitcnt vmcnt(" #N ") lgkmcnt(0)\n\ts_barrier":::"memory")

__device__ __forceinline__ void qkt(f32x16&p0,f32x16&p1,const char*Kslot,const bf16x8*qr,const f32x16&negm,int r32,int hi){
  const char*kb=Kslot+hi*1024+r32*16;
  #pragma unroll
  for(int d0=0;d0<4;++d0){
    const bf16x8 b0=*reinterpret_cast<const bf16x8*>(kb+d0*2048);
    const bf16x8 b1=*reinterpret_cast<const bf16x8*>(kb+d0*2048+512);
    if(d0==0){p0=__builtin_amdgcn_mfma_f32_32x32x16_bf16(b0,qr[0],negm,0,0,0);p1=__builtin_amdgcn_mfma_f32_32x32x16_bf16(b1,qr[0],negm,0,0,0);}
    else{p0=__builtin_amdgcn_mfma_f32_32x32x16_bf16(b0,qr[d0],p0,0,0,0);p1=__builtin_amdgcn_mfma_f32_32x32x16_bf16(b1,qr[d0],p1,0,0,0);}}
}
typedef __attribute__((address_space(3))) const char* lds_cptr;
typedef short v4i16_t __attribute__((ext_vector_type(4)));
__device__ __forceinline__ void kload8(bf16x8*kf,lds_cptr kp){
  kf[0]=*(const __attribute__((address_space(3))) bf16x8*)(kp);      kf[1]=*(const __attribute__((address_space(3))) bf16x8*)(kp+512);
  kf[2]=*(const __attribute__((address_space(3))) bf16x8*)(kp+2048); kf[3]=*(const __attribute__((address_space(3))) bf16x8*)(kp+2560);
  kf[4]=*(const __attribute__((address_space(3))) bf16x8*)(kp+4096); kf[5]=*(const __attribute__((address_space(3))) bf16x8*)(kp+4608);
  kf[6]=*(const __attribute__((address_space(3))) bf16x8*)(kp+6144); kf[7]=*(const __attribute__((address_space(3))) bf16x8*)(kp+6656);
}
__device__ __forceinline__ void kload2(bf16x8*kf,lds_cptr kp,int j){ kf[2*j]=*(const __attribute__((address_space(3))) bf16x8*)(kp+j*2048); kf[2*j+1]=*(const __attribute__((address_space(3))) bf16x8*)(kp+j*2048+512); }
__device__ __forceinline__ s16x4 vtr(lds_cptr p){ return __builtin_bit_cast(s16x4,__builtin_amdgcn_ds_read_tr16_b64_v4i16((__attribute__((address_space(3))) v4i16_t*)p)); }
__device__ __forceinline__ float rowmax(const f32x16&p0,const f32x16&p1){
  float a=max3f(p0[0],p0[1],p1[0]),b=max3f(p0[2],p0[3],p1[1]);a=max3f(a,p1[2],p1[3]);
  #pragma unroll
  for(int r=4;r<16;r+=4){a=max3f(a,p0[r],p0[r+1]);b=max3f(b,p0[r+2],p0[r+3]);a=max3f(a,p1[r],p1[r+1]);b=max3f(b,p1[r+2],p1[r+3]);}
  const float m=max2f(a,b);
  auto rr=__builtin_amdgcn_permlane32_swap(__float_as_uint(m),__float_as_uint(m),false,false);
  return max2f(__uint_as_float(rr[0]),__uint_as_float(rr[1]));
}
__device__ __forceinline__ void pv(f32x16*o,int vb,bf16x8 pa0,bf16x8 pa1,bf16x8 pa2,bf16x8 pa3){
  #pragma unroll
  for(int d0=0;d0<2;++d0){s16x4 lo[4],hi[4];
    #pragma unroll
    for(int ks=0;ks<4;++ks){
      asm volatile("ds_read_b64_tr_b16 %0,%1 offset:%c2":"=&v"(lo[ks]):"v"(vb),"i"(d0*4096+ks*1024):"memory");
      asm volatile("ds_read_b64_tr_b16 %0,%1 offset:%c2":"=&v"(hi[ks]):"v"(vb),"i"(d0*4096+ks*1024+512):"memory");}
    asm volatile("s_waitcnt lgkmcnt(0)":::"memory");SBAR();
    #define PK(k) (bf16x8){lo[k][0],lo[k][1],lo[k][2],lo[k][3],hi[k][0],hi[k][1],hi[k][2],hi[k][3]}
    o[d0]=__builtin_amdgcn_mfma_f32_32x32x16_bf16(pa0,PK(0),o[d0],0,0,0);
    o[d0]=__builtin_amdgcn_mfma_f32_32x32x16_bf16(pa1,PK(1),o[d0],0,0,0);
    o[d0]=__builtin_amdgcn_mfma_f32_32x32x16_bf16(pa2,PK(2),o[d0],0,0,0);
    o[d0]=__builtin_amdgcn_mfma_f32_32x32x16_bf16(pa3,PK(3),o[d0],0,0,0);
    #undef PK
  }
}

#ifndef ATTN_STORE16
#define ATTN_STORE16(p,v) (*(u32x4*)(p)=(v))
#endif
template<int THRL> __device__ __forceinline__ void attn_unit(int b,int h,int qb,const bf16*Q,const bf16*__restrict__ K,const bf16*__restrict__ V,const bf16*__restrict__ GT,const float*__restrict__ CB,bf16*O,char*shm){
  int tid_=threadIdx.x; asm volatile("":"+v"(tid_)); const int tid=tid_,lane=tid&63,r32=lane&31,hi=lane>>5; const int wid=__builtin_amdgcn_readfirstlane(tid>>6);
  const long rowbase=(long)b*SEQ; const int q0=qb*QB;
  const bf16*Qw=Q+(rowbase+q0+wid*QBLK)*DM+h*D;
  const bf16*Kh=K+rowbase*DM+h*D,*Vh=V+rowbase*DM+h*D;
  const unsigned lds0=(unsigned)(uintptr_t)shm;
  float*wsf=(float*)(shm+LDS_WS)+wid*64;
  const bf16*ksrc=Kh+(long)lane*DM+wid*8;
  const bf16*vsrc=Vh+(long)(16*(wid&3)+(lane>>2))*DM+(wid>>2)*32+(lane&3)*8;
  const unsigned kdst=lds0+LDS_K+wid*1024, vdst=lds0+LDS_V+wid*1024;
  #define DMA_K(t,slot) glds16(ksrc+(long)(t)*KVBLK*DM,(unsigned)__builtin_amdgcn_readfirstlane(kdst+(slot)))
  #define DMA_V(t,slot) glds16(vsrc+(long)(t)*KVBLK*DM,(unsigned)__builtin_amdgcn_readfirstlane(vdst+(slot)))
  const int vb0=(int)(lds0+LDS_V)+((lane>>4)&1)*32+(lane&3)*8+(4*hi+((lane&15)>>2))*64;
  const char*Kbase=shm+LDS_K; bf16x8 kf[8];
  const lds_cptr shm3=(lds_cptr)shm; const lds_cptr kp0=shm3+LDS_K+hi*1024+r32*16; const lds_cptr vp0=shm3+LDS_V+((lane>>4)&1)*32+(lane&3)*8+(4*hi+((lane&15)>>2))*64;
  const int NT=(q0+QB)/KVBLK;
  { const float*cbh=CB+(long)(b*NHEAD+h)*SEQ; const float cref=cbh[q0]; float*bl=(float*)(shm+LDS_BIAS); const int nk=q0+QB;
    for(int i=tid;i<nk;i+=NW*64) bl[i]=(cref-cbh[i])*1.4426950408889634f; }
  const __attribute__((address_space(3))) float* biasp=(const __attribute__((address_space(3))) float*)((lds_cptr)shm+LDS_BIAS)+4*hi;
  #define BIASADD(P0,P1,t) do{ const __attribute__((address_space(3))) float* bp_=biasp+64*(t); \
    _Pragma("unroll") for(int g_=0;g_<4;++g_){ f32x4v x0_=*(const __attribute__((address_space(3))) f32x4v*)(bp_+8*g_); f32x4v x1_=*(const __attribute__((address_space(3))) f32x4v*)(bp_+32+8*g_); \
      x0_=x0_-mhat; x1_=x1_-mhat; \
      P0[4*g_]+=x0_[0];P0[4*g_+1]+=x0_[1];P0[4*g_+2]+=x0_[2];P0[4*g_+3]+=x0_[3]; P1[4*g_]+=x1_[0];P1[4*g_+1]+=x1_[1];P1[4*g_+2]+=x1_[2];P1[4*g_+3]+=x1_[3]; } }while(0)
  DMA_K(0,0);DMA_V(0,0);DMA_K(1,SLOTB);
  bf16x8 qr[4];
  #pragma unroll
  for(int d0=0;d0<4;++d0)qr[d0]=*reinterpret_cast<const bf16x8*>(&Qw[(long)r32*DM+d0*16+hi*8]);
  float mhat=0.f,l_reg=0.f;f32x16 o[2];o[0]=f32x16{};o[1]=f32x16{};const f32x16 negm=f32x16{};
  const int qrel=wid*QBLK+r32;
  #define CMASK(P0,P1,t) do{int jb_=(t)-(NT-4); if(jb_>=0)cmask(P0,P1,jb_,qrel,hi);}while(0)
  bool resc=false;
  #define START(P0,P1) do{ const float rm=rowmax(P0,P1); resc=false; \
    { const float dl=rm; mhat=fadd_s(mhat,dl); \
      _Pragma("unroll") for(int r=0;r<16;++r){P0[r]=fsub_s(P0[r],dl);P1[r]=fsub_s(P1[r],dl);} \
      } \
    _Pragma("unroll") for(int r=0;r<16;++r)P0[r]=__builtin_amdgcn_exp2f(P0[r]); }while(0)
  #define RESC() do{ if(resc){ asm volatile("s_waitcnt lgkmcnt(0)":::"memory"); \
      _Pragma("unroll") for(int d_=0;d_<2;++d_) _Pragma("unroll") for(int r=0;r<16;++r)o[d_][r]*=wsf[crow(r,hi)]; } }while(0)
  f32x16 pA0,pA1,pB0,pB1;
  int sl_prev=0,sl_cur=0,sl_next=SLOTB;
  #define ROT() do{sl_prev=sl_cur;sl_cur=sl_next;sl_next=(sl_next==(NSLOT-1)*SLOTB)?0:sl_next+SLOTB;}while(0)
  DMA_K(2,2*SLOTB);
  WAIT_BAR(3);
  qkt(pA0,pA1,Kbase,qr,negm,r32,hi);asm volatile("s_nop 15\n\ts_nop 7":"+v"(pA0),"+v"(pA1));BIASADD(pA0,pA1,0);CMASK(pA0,pA1,0);
  START(pA0,pA1);
  _Pragma("unroll") for(int r=0;r<16;++r)pA1[r]=__builtin_amdgcn_exp2f(pA1[r]);
  WAIT_BAR(0);
  DMA_K(3,0);DMA_V(1,SLOTB);
  ROT();
  kload8(kf,kp0+sl_cur);
  WAIT_BAR(2);
  s16x4 vlo[8],vhi[8]; u32x4 pw0,pw1,pw2,pw3;
  #define PKW(P,B) cvtpk_s(P[B],P[B+1])
  #define PAF(k) __builtin_bit_cast(bf16x8,pw##k)
  #define VFR(i) (bf16x8){vlo[i][0],vlo[i][1],vlo[i][2],vlo[i][3],vhi[i][0],vhi[i][1],vhi[i][2],vhi[i][3]}
  #define PIN(x) asm volatile("":"+v"(x))
  #define MX3(a,b,c) __builtin_fmaxf(__builtin_fmaxf((a),(b)),(c))
  #define GAPA(MF,A0,A1,A2,A3,W0,W1,PW) do{ MF; sacc+=A0; sacc+=A1; sacc+=A2; sacc+=A3; PIN(sacc); W0; W1; PIN(PW); SBAR(); }while(0)
  #define EX(v) __builtin_amdgcn_exp2f(v)
  #define GAPB(MF,X,B) do{ MF; X[B]=EX(X[B]); X[B+1]=EX(X[B+1]); X[B+2]=EX(X[B+2]); X[B+3]=EX(X[B+3]); PIN(X); SBAR(); }while(0)
  #define VRD(i) do{ vlo[i]=vtr(vp_+(((i)>>2)*4096+((i)&3)*1024)); vhi[i]=vtr(vp_+(((i)>>2)*4096+((i)&3)*1024+512)); }while(0)
  #define KRD(G,j) do{ if(G){ kload2(kf,kp0+sl_next,j); SBAR(); } }while(0)
  #define STEP(C0,C1,P0,P1,t,GK,GV,GL) do{ SBAR(); \
    const lds_cptr vp_=vp0+sl_prev; \
    VRD(0); SBAR(); float sacc=(P0[0]+P0[1]); \
    GAPA(C0=__builtin_amdgcn_mfma_f32_32x32x16_bf16(kf[0],qr[0],negm,0,0,0), P0[2],P0[3],P0[4],P0[5],     pw0[0]=PKW(P0,0), pw0[1]=PKW(P0,2), pw0); \
    VRD(4); SBAR(); GAPA(C1=__builtin_amdgcn_mfma_f32_32x32x16_bf16(kf[1],qr[0],negm,0,0,0), P0[6],P0[7],P0[8],P0[9],     pw0[2]=PKW(P0,4), pw0[3]=PKW(P0,6), pw0); \
    VRD(1); SBAR(); GAPA(C0=__builtin_amdgcn_mfma_f32_32x32x16_bf16(kf[2],qr[1],C0,0,0,0),   P0[10],P0[11],P0[12],P0[13], pw1[0]=PKW(P0,8), pw1[1]=PKW(P0,10), pw1); \
    VRD(5); SBAR(); GAPA(C1=__builtin_amdgcn_mfma_f32_32x32x16_bf16(kf[3],qr[1],C1,0,0,0),   P0[14],P0[15],P1[0],P1[1],   pw1[2]=PKW(P0,12),pw1[3]=PKW(P0,14), pw1); \
    VRD(2); SBAR(); GAPA(C0=__builtin_amdgcn_mfma_f32_32x32x16_bf16(kf[4],qr[2],C0,0,0,0),   P1[2],P1[3],P1[4],P1[5],     pw2[0]=PKW(P1,0), pw2[1]=PKW(P1,2), pw2); \
    VRD(6); SBAR(); GAPA(C1=__builtin_amdgcn_mfma_f32_32x32x16_bf16(kf[5],qr[2],C1,0,0,0),   P1[6],P1[7],P1[8],P1[9],     pw2[2]=PKW(P1,4), pw2[3]=PKW(P1,6), pw2); \
    VRD(3); SBAR(); GAPA(C0=__builtin_amdgcn_mfma_f32_32x32x16_bf16(kf[6],qr[3],C0,0,0,0),   P1[10],P1[11],P1[12],P1[13], pw3[0]=PKW(P1,8), pw3[1]=PKW(P1,10), pw3); \
    VRD(7); SBAR(); GAPA(C1=__builtin_amdgcn_mfma_f32_32x32x16_bf16(kf[7],qr[3],C1,0,0,0),   P1[14],P1[15],0.f,0.f,       pw3[2]=PKW(P1,12),pw3[3]=PKW(P1,14), pw3); \
    l_reg+=sacc; \
    if(GK){DMA_K((t)+3,sl_cur);} if(GV){DMA_V((t)+1,sl_next);} \
    BIASADD(C0,C1,t); CMASK(C0,C1,t); \
    { float a=MX3(C0[0],C0[1],C1[0]),b=MX3(C0[2],C0[3],C1[1]); a=MX3(a,C1[2],C1[3]); \
      _Pragma("unroll") for(int r=4;r<16;r+=4){a=MX3(a,C0[r],C0[r+1]);b=MX3(b,C0[r+2],C0[r+3]);a=MX3(a,C1[r],C1[r+1]);b=MX3(b,C1[r+2],C1[r+3]);} \
      float rm=__builtin_fmaxf(a,b); { auto rr=__builtin_amdgcn_permlane32_swap(__float_as_uint(rm),__float_as_uint(rm),false,false); rm=__builtin_fmaxf(__uint_as_float(rr[0]),__uint_as_float(rr[1])); } \
      resc=false; \
      if(__builtin_expect(__any(rm>(float)THRL),0)){ const float dl=__builtin_fmaxf(rm,0.f); mhat+=dl; \
        _Pragma("unroll") for(int r=0;r<16;++r){C0[r]-=dl;C1[r]-=dl;} \
        const float f=__builtin_amdgcn_exp2f(-dl); l_reg*=f; if(hi==0)wsf[r32]=f; resc=true; } } \
    SBAR(); \
    GAPB(o[0]=__builtin_amdgcn_mfma_f32_32x32x16_bf16(PAF(0),VFR(0),o[0],0,0,0), C0,0); \
    GAPB(o[1]=__builtin_amdgcn_mfma_f32_32x32x16_bf16(PAF(0),VFR(4),o[1],0,0,0), C0,4); \
    KRD(GL,0); GAPB(o[0]=__builtin_amdgcn_mfma_f32_32x32x16_bf16(PAF(1),VFR(1),o[0],0,0,0), C0,8); \
    KRD(GL,1); GAPB(o[1]=__builtin_amdgcn_mfma_f32_32x32x16_bf16(PAF(1),VFR(5),o[1],0,0,0), C0,12); \
    KRD(GL,2); GAPB(o[0]=__builtin_amdgcn_mfma_f32_32x32x16_bf16(PAF(2),VFR(2),o[0],0,0,0), C1,0); \
    KRD(GL,3); GAPB(o[1]=__builtin_amdgcn_mfma_f32_32x32x16_bf16(PAF(2),VFR(6),o[1],0,0,0), C1,4); \
    GAPB(o[0]=__builtin_amdgcn_mfma_f32_32x32x16_bf16(PAF(3),VFR(3),o[0],0,0,0), C1,8); \
    GAPB(o[1]=__builtin_amdgcn_mfma_f32_32x32x16_bf16(PAF(3),VFR(7),o[1],0,0,0), C1,12); \
    }while(0)
  int t=1;
  #undef CMASK
  #define CMASK(P0,P1,t) do{}while(0)
  for(;t+5<NT;t+=2){
    STEP(pB0,pB1,pA0,pA1,t,true,true,true);     WAIT_BAR(2); RESC(); ROT();
    STEP(pA0,pA1,pB0,pB1,t+1,true,true,true);   WAIT_BAR(2); RESC(); ROT();
  }
  #undef CMASK
  #define CMASK(P0,P1,t) do{int jb_=(t)-(NT-4); if(jb_>=0)cmask(P0,P1,jb_,qrel,hi);}while(0)
  #define ENDW(tt) do{ if((tt)+3<NT){WAIT_BAR(2);} else if((tt)+2<NT){WAIT_BAR(1);} else {WAIT_BAR(0);} }while(0)
  for(;t+1<NT;t+=2){
    STEP(pB0,pB1,pA0,pA1,t,(t+3<NT),(t+1<NT),(t+1<NT));       ENDW(t);   RESC(); ROT();
    STEP(pA0,pA1,pB0,pB1,t+1,(t+4<NT),(t+2<NT),(t+2<NT));     ENDW(t+1); RESC(); ROT();
  }
  STEP(pB0,pB1,pA0,pA1,NT-1,false,false,false); RESC();
  { float sacc=pB0[0]+pB0[1]; _Pragma("unroll") for(int r=2;r<16;++r)sacc+=pB0[r]; _Pragma("unroll") for(int r=0;r<16;++r)sacc+=pB1[r]; l_reg+=sacc;
    pw0=(u32x4){PKW(pB0,0),PKW(pB0,2),PKW(pB0,4),PKW(pB0,6)};pw1=(u32x4){PKW(pB0,8),PKW(pB0,10),PKW(pB0,12),PKW(pB0,14)};pw2=(u32x4){PKW(pB1,0),PKW(pB1,2),PKW(pB1,4),PKW(pB1,6)};pw3=(u32x4){PKW(pB1,8),PKW(pB1,10),PKW(pB1,12),PKW(pB1,14)};
    SBAR(); pv(o,vb0+sl_cur,PAF(0),PAF(1),PAF(2),PAF(3)); }
  #undef PKW
  #undef PAF
  #undef VFR
  #undef PIN
  #undef MX3
  #undef GAPA
  #undef GAPB
  #undef EX
  #undef VRD
  #undef KRD
  #undef STEP
  #undef ENDW
  {auto rr=__builtin_amdgcn_permlane32_swap(__float_as_uint(l_reg),__float_as_uint(l_reg),false,false);l_reg=__uint_as_float(rr[0])+__uint_as_float(rr[1]);}
  if(hi==0)wsf[32+r32]=l_reg;asm volatile("s_waitcnt lgkmcnt(0)":::"memory");
  float rli[16];
  #pragma unroll
  for(int r=0;r<16;++r)rli[r]=__builtin_amdgcn_rcpf(wsf[32+crow(r,hi)]);
  bf16*Ow=O+(rowbase+q0+wid*QBLK)*OP+h*D; const bf16*Gw=GT+(rowbase+q0+wid*QBLK)*DM+h*D;
  { bf16*stg=(bf16*)(shm+LDS_OST)+wid*2048;
    #pragma unroll
    for(int r=0;r<16;++r){const int orow=crow(r,hi);
      #pragma unroll
      for(int d0=0;d0<2;++d0)stg[orow*64+d0*32+r32]=__float2bfloat16(o[d0][r]*rli[r]);}
    asm volatile("s_waitcnt lgkmcnt(0)":::"memory");
    #pragma unroll
    for(int i=0;i<4;++i){const int row=i*8+(lane>>3),ch=lane&7; const u32x4 v=*(const u32x4*)(stg+row*64+ch*8); const u32x4 g=*(const u32x4*)(Gw+(long)row*DM+ch*8); u32x4 w;
      _Pragma("unroll") for(int e=0;e<4;++e){ const float a0=__uint_as_float(v[e]<<16)*__uint_as_float(g[e]<<16), a1=__uint_as_float(v[e]&0xffff0000u)*__uint_as_float(g[e]&0xffff0000u); w[e]=cvtpk_s(a0,a1); }
      ATTN_STORE16(Ow+(long)row*OP+ch*8,w);} }
  asm volatile("s_waitcnt lgkmcnt(0)\n\ts_barrier":::"memory");
  #undef BIASADD
  #undef DMA_K
  #undef DMA_V
  #undef CMASK
  #undef START
  #undef RESC
  #undef ROT
}
constexpr int ATTN_LDS_BYTES=LDS_BYTES;
struct AttnTensors { const bf16* Q; const bf16* K; const bf16* V; const bf16* GT; const float* CB; bf16* O; };
struct AttnUnit { int bh; int qb; };
struct StaticOrder {
  int vcu,G,half;
  __device__ __forceinline__ explicit StaticOrder(int grid,int block,int half_):vcu((grid%8==0)?(block%8)*(grid/8)+block/8:block),G(grid),half(half_){}
  __device__ __forceinline__ bool next(int i,AttnUnit&u)const{
    if(G==256){ if(i>=2)return false; const int s=vcu&3; u.bh=vcu>>2; u.qb=(half==0)?((i==0)?s:15-s):((i==0)?7-s:8+s); return true; }
    const int idx=i*G+vcu; if(idx>=BATCH*NHEAD*NQB/2)return false; const int k=idx&7; u.bh=idx>>3; u.qb=(half==0)?((k<4)?k:8+k):4+k; return true; }
  __device__ __forceinline__ void a_ready(const AttnUnit&)const{}
  __device__ __forceinline__ void done(const AttnUnit&)const{}
};
template<class Sched,int THRL=8> __device__ __forceinline__ void attn_phase(char*lds,const AttnTensors&T,const Sched&S){
  AttnUnit u;
  for(int i=0;S.next(i,u);++i){ S.a_ready(u); attn_unit<THRL>(u.bh/NHEAD,u.bh%NHEAD,u.qb,T.Q,T.K,T.V,T.GT,T.CB,T.O,lds); S.done(u); }
}
#undef SBAR
#undef WAIT_BAR
}
constexpr int NWAVES = 8;
constexpr int BATCH = 8, SEQ = 4096, DMODEL = 1024, M = BATCH * SEQ;
constexpr int NZ = 3584;
constexpr int ZC_LQ = 0, ZC_LK = 256, ZC_LV = 512, ZC_AQ = 1024, ZC_AK = 1536, ZC_AV = 2048, ZC_GATE = 2560;
constexpr int EVEN_IN = 3608, ODD_IN = 3584;
constexpr float RMS_EPS = 1e-6f;
constexpr float LOG2E = 1.4426950408889634f;
constexpr float C2 = 0.125f * LOG2E;

constexpr size_t MiB = 1u << 20;
constexpr size_t WS_CTL = 0, CTL_ZERO_BYTES = 1 * MiB;
constexpr size_t WS_ROPE = 1 * MiB;
constexpr size_t WS_SS = 2 * MiB;
constexpr size_t WS_FF = 4 * MiB;
constexpr size_t WS_GLR = 5 * MiB;
constexpr size_t WS_CB = 7 * MiB;
constexpr size_t WS_LSE = 8 * MiB;
constexpr size_t WS_DECAY = 9 * MiB;
constexpr size_t WS_WSK = 10 * MiB;
constexpr size_t WS_W = 11 * MiB;
constexpr size_t WS_Z = 48 * MiB;
constexpr size_t WS_Y = 272 * MiB;
constexpr size_t WS_HB = 336 * MiB;
constexpr size_t WS_KV = 400 * MiB;
constexpr size_t WS_PREV = 464 * MiB;
constexpr size_t WS_END = 496 * MiB;
constexpr int CW_TMO = 0, CW_CODE = 1;
constexpr int CW_BAR = 4096;

constexpr int RING_OFF = 0, RING_BYTES = 131072;
constexpr int LDSCTL_OFF = RING_BYTES, MISC_OFF = LDSCTL_OFF + 320;
constexpr int LDS_BYTES = 147456;
static_assert(MISC_OFF + 128 <= LDS_BYTES, "LDS map");

#define GAS __attribute__((address_space(1)))
#define LAS __attribute__((address_space(3)))
typedef unsigned short bf16;
typedef unsigned v4u __attribute__((ext_vector_type(4)));
typedef float f32x4 __attribute__((ext_vector_type(4)));
typedef short bf16x8 __attribute__((ext_vector_type(8)));
typedef GAS unsigned gu32;
#define RLX_AGENT __ATOMIC_RELAXED, __HIP_MEMORY_SCOPE_AGENT
#define LDS_WAIT() asm volatile("s_waitcnt lgkmcnt(0)" ::: "memory")
#define VM_WAIT() asm volatile("s_waitcnt vmcnt(0)" ::: "memory")
__device__ __forceinline__ unsigned f2bf(float f) { unsigned u = __builtin_bit_cast(unsigned, f); return (u + 0x7fffu + ((u >> 16) & 1u)) >> 16; }
__device__ __forceinline__ unsigned pk2(float lo, float hi) { return f2bf(lo) | (f2bf(hi) << 16); }
__device__ __forceinline__ float bflo(unsigned w) { return __uint_as_float(w << 16); }
__device__ __forceinline__ float bfhi(unsigned w) { return __uint_as_float(w & 0xffff0000u); }
__device__ __forceinline__ float bf1(bf16 h) { return __uint_as_float((unsigned)h << 16); }
__device__ __forceinline__ float logsigmoidf(float x) { return x < 0.f ? x - log1pf(__expf(x)) : -log1pf(__expf(-x)); }

#define XB_TMO      128
#define XB_XCNT(j)  (256  + 64 * (j))
#define XB_XSUB(j)  (1280 + 64 * (j))
#define XB_XGEN(j)  (2304 + 64 * (j))
#define XB_TOP      3328
#define XB_TOPGEN   3392
#define XCD_BAR_WORDS 3456
#define XB_SPIN_CAP (1u << 18)

__device__ __forceinline__ unsigned xb_ld(unsigned* p)              { return __hip_atomic_load(p, __ATOMIC_RELAXED, __HIP_MEMORY_SCOPE_AGENT); }
__device__ __forceinline__ unsigned xb_add(unsigned* p, unsigned v) { return __hip_atomic_fetch_add(p, v, __ATOMIC_RELAXED, __HIP_MEMORY_SCOPE_AGENT); }
__device__ __forceinline__ unsigned xb_xcc_id() { return (unsigned)__builtin_amdgcn_s_getreg((3 << 11) | 20) & 0xFu; }
#define XB_SPIN(cond, bar) do { unsigned _sp = 0; while (cond) { __builtin_amdgcn_s_sleep(1); \
    if ((++_sp & 255u) == 0u) { if (xb_ld(&(bar)[XB_TMO])) break; if (_sp > XB_SPIN_CAP) { atomicAdd(&(bar)[XB_TMO], 1u); break; } } } } while (0)

struct XcdBarrier { unsigned* bar; unsigned x; volatile LAS unsigned* st; };

__device__ __forceinline__ XcdBarrier xcd_barrier_post(unsigned* bar, volatile LAS unsigned* st) {
    XcdBarrier b; b.bar = bar; b.x = xb_xcc_id(); b.st = st;
    if (threadIdx.x == 0) (void)xb_add(&bar[XB_XCNT(b.x)], 1u);
    return b;
}
__device__ __forceinline__ void xcd_barrier_complete(unsigned* bar, unsigned x, unsigned& nloc, unsigned& nx) {
    const unsigned G = gridDim.x * gridDim.y * gridDim.z;
    unsigned sum, cnt, mine, sp = 0u;
    for (;;) {
        sum = 0u; cnt = 0u; mine = 0u;
#pragma unroll
        for (unsigned j = 0; j < 16; ++j) { const unsigned c = xb_ld(&bar[XB_XCNT(j)]); sum += c; cnt += (c > 0u) ? 1u : 0u; mine = (j == x) ? c : mine; }
        if (sum == G) break;
        __builtin_amdgcn_s_sleep(1);
        if ((++sp & 255u) == 0u) { if (xb_ld(&bar[XB_TMO])) break; if (sp > XB_SPIN_CAP) { atomicAdd(&bar[XB_TMO], 1u); break; } }
    }
    nloc = mine > 0u ? mine : 1u; nx = cnt > 0u ? cnt : 1u;
}
__device__ __forceinline__ void xcd_barrier(const XcdBarrier& b) {
    asm volatile("s_waitcnt vmcnt(0)" ::: "memory");
    __syncthreads();
    if (threadIdx.x == 0) {
        unsigned* bar = b.bar;
        __builtin_amdgcn_s_waitcnt(0);
        unsigned nloc = b.st[0], nx = b.st[1];
        if (nloc == 0u) { xcd_barrier_complete(bar, b.x, nloc, nx); b.st[0] = nloc; b.st[1] = nx; }
        const unsigned old = xb_add(&bar[XB_XSUB(b.x)], 1u);
        const unsigned gen = old / nloc;
        if (old + 1u == (gen + 1u) * nloc) {
            __builtin_amdgcn_fence(__ATOMIC_RELEASE, "agent");
            asm volatile("s_waitcnt vmcnt(0)" ::: "memory");
            const unsigned og = xb_add(&bar[XB_TOP], 1u);
            const unsigned tg = og / nx;
            if (og + 1u == (tg + 1u) * nx) xb_add(&bar[XB_TOPGEN], 1u);
            else XB_SPIN(xb_ld(&bar[XB_TOPGEN]) == tg, bar);
            __builtin_amdgcn_fence(__ATOMIC_ACQUIRE, "agent");
            xb_add(&bar[XB_XGEN(b.x)], 1u);
            asm volatile("s_waitcnt vmcnt(0)" ::: "memory");
        } else {
            XB_SPIN(xb_ld(&bar[XB_XGEN(b.x)]) == gen, bar);
            __builtin_amdgcn_fence(__ATOMIC_ACQUIRE, "agent");
            asm volatile("s_waitcnt vmcnt(0)" ::: "memory");
        }
    }
    __syncthreads();
}

struct Frame {
    LAS unsigned char* lds;
    volatile LAS unsigned* MISC;
    gu32* ctl;
    int tid, lane, wave;
    int vcu, G;
    unsigned char* ws;
};

__device__ __forceinline__ float wave_sum(float v) {
#pragma unroll
    for (int o = 1; o < 64; o <<= 1) v += __shfl_xor(v, o);
    return v;
}

__device__ __forceinline__ int wsrc_col(int kind, int n) {
    if (kind == 0) {
        if (n < 256) return 1544 + n;
        if (n < 512) return 1800 + (n - 256);
        if (n < 1024) return 2056 + (n - 512);
        if (n < 1536) return n - 1024;
        if (n < 2048) return 512 + (n - 1536);
        if (n < 2560) return 1024 + (n - 2048);
        return 2584 + (n - 2560);
    } else if (kind == 1) {
        const bool il = (n < 512) || (n >= 1024 && n < 2048);
        if (!il) return n;
        const int p = n & 63; return (n & ~63) + (p >> 1) + 32 * (p & 1);
    } else if (kind == 2) {
        return n;
    } else {
        if (n < 8) return 1536 + n;
        if (n < 24) return 2568 + (n - 8);
        return -1;
    }
}
__device__ __forceinline__ void p0_transpose_item(const float* W, int Nsrc, int kind, const float* gain, bf16* WT, int nblk, LAS float* scr, int item, int lane) {
    const int K = DMODEL; const int kb = item / nblk, nb = item % nblk, k0 = 64 * kb, n0 = 32 * nb;
    const int sc = wsrc_col(kind, n0 + (lane & 31));
#pragma unroll 8
    for (int i = 0; i < 32; ++i) { const int kk = 2 * i + (lane >> 5); const float g = gain ? gain[k0 + kk] : 1.0f;
        scr[kk * 33 + (lane & 31)] = (sc >= 0) ? W[(size_t)(k0 + kk) * Nsrc + sc] * g : 0.f; }
    LDS_WAIT(); asm volatile("" ::: "memory");
    const int c = lane & 7;
#pragma unroll
    for (int j = 0; j < 4; ++j) { const int n = (lane >> 3) + 8 * j; const LAS float* s = scr + (8 * c) * 33 + n;
        v4u o; o.x = pk2(s[0 * 33], s[1 * 33]); o.y = pk2(s[2 * 33], s[3 * 33]); o.z = pk2(s[4 * 33], s[5 * 33]); o.w = pk2(s[6 * 33], s[7 * 33]);
        *(GAS v4u*)(WT + (size_t)(n0 + n) * K + k0 + 8 * c) = o; }
    LDS_WAIT(); asm volatile("" ::: "memory");
}
typedef float f32x16 __attribute__((ext_vector_type(16)));
typedef float f32x2 __attribute__((ext_vector_type(2)));
typedef unsigned v2u __attribute__((ext_vector_type(2)));
typedef __bf16 bf16x2_t __attribute__((ext_vector_type(2)));
__device__ __forceinline__ unsigned cvtpk(float lo, float hi) { f32x2 v = {lo, hi}; bf16x2_t b = __builtin_convertvector(v, bf16x2_t); return __builtin_bit_cast(unsigned, b); }
__device__ __forceinline__ int crow16(int r, int hi) { return (r & 3) + 8 * (r >> 2) + 4 * hi; }
__device__ __forceinline__ f32x16 mfma32(bf16x8 a, bf16x8 b, f32x16 c) { return __builtin_amdgcn_mfma_f32_32x32x16_bf16(a, b, c, 0, 0, 0); }
__device__ __forceinline__ bf16x8 pack8(const f32x16& p, int s2) {
    v4u w; w.x = cvtpk(p[8 * s2 + 0], p[8 * s2 + 1]); w.y = cvtpk(p[8 * s2 + 2], p[8 * s2 + 3]); w.z = cvtpk(p[8 * s2 + 4], p[8 * s2 + 5]); w.w = cvtpk(p[8 * s2 + 6], p[8 * s2 + 7]);
    return __builtin_bit_cast(bf16x8, w);
}
__device__ __forceinline__ bf16x8 ld_perm8(const LAS bf16* p) {
    const v2u a = *(const LAS v2u*)p, b = *(const LAS v2u*)(p + 8);
    v4u w; w.x = a.x; w.y = a.y; w.z = b.x; w.w = b.y; return __builtin_bit_cast(bf16x8, w);
}

constexpr int LC = 64;
constexpr int LLD = 72;
constexpr int LA_SEG = 0;
constexpr int LA_A = 2048;
constexpr int LA_B = LA_A + 64 * LLD * 2;
constexpr int LA_VT = LA_B + 64 * LLD * 2;
constexpr int LA_P = LA_VT + 128 * LLD * 2;
constexpr int LA_O = LA_P + 128 * LLD * 2;
constexpr int LA_END = LA_O + 64 * 132 * 4;
static_assert(LA_END <= RING_BYTES, "linear-attention LDS map");

struct LinArgs {
    const bf16* Z; const float* GLR; const float* w_lr; const float* b_lr;
    const float* g1; const float* g2;
    float* KV; float* DEC; bf16* PREV; bf16* Y;
};

template <bool ODD> __device__ __forceinline__ float lin_cumdecay(Frame& F, const LinArgs& A, int b, int h, int t0, float (&bv)[8]) {
    LAS float* seg = (LAS float*)(F.lds + RING_OFF + LA_SEG);
    const int d = F.lane;
    float run = 0.f;
    if (ODD) {
        const float lg = __logf(1.0f - exp2f(-5.0f - (float)h));
#pragma unroll
        for (int i = 0; i < 8; ++i) { run += lg; bv[i] = run; }
    } else {
        float w[16];
#pragma unroll
        for (int r = 0; r < 16; ++r) w[r] = A.w_lr[r * 256 + h * 64 + d];
        const float bias = A.b_lr[h * 64 + d];
#pragma unroll
        for (int i = 0; i < 8; ++i) {
            const f32x4* gp = (const f32x4*)(A.GLR + ((size_t)b * SEQ + t0 + 8 * F.wave + i) * 16);
            const f32x4 g0 = gp[0], g1 = gp[1], g2 = gp[2], g3 = gp[3];
            float x = bias;
            x += g0[0] * w[0] + g0[1] * w[1] + g0[2] * w[2] + g0[3] * w[3];
            x += g1[0] * w[4] + g1[1] * w[5] + g1[2] * w[6] + g1[3] * w[7];
            x += g2[0] * w[8] + g2[1] * w[9] + g2[2] * w[10] + g2[3] * w[11];
            x += g3[0] * w[12] + g3[1] * w[13] + g3[2] * w[14] + g3[3] * w[15];
            run += logsigmoidf(x) * (1.0f / 16.0f); bv[i] = run;
        }
    }
    __syncthreads();
    seg[F.wave * 64 + d] = run;
    __syncthreads();
    float off = 0.f, tot = 0.f;
#pragma unroll
    for (int w8 = 0; w8 < 8; ++w8) { const float s = seg[w8 * 64 + d]; tot += s; if (w8 < F.wave) off += s; }
#pragma unroll
    for (int i = 0; i < 8; ++i) bv[i] += off;
    return tot;
}

__device__ __forceinline__ void lin_stage_vt(Frame& F, const bf16* Z, int b, int h, int t0) {
    LAS bf16* VT = (LAS bf16*)(F.lds + RING_OFF + LA_VT);
    const int tok = F.tid >> 3, c = F.tid & 7;
    const v4u* src = (const v4u*)(Z + ((size_t)b * SEQ + t0 + tok) * NZ + ZC_LV + h * 128 + 16 * c);
    const v4u x0 = src[0], x1 = src[1];
#pragma unroll
    for (int e = 0; e < 4; ++e) {
        VT[(16 * c + 2 * e) * LLD + tok] = (bf16)(x0[e] & 0xffffu); VT[(16 * c + 2 * e + 1) * LLD + tok] = (bf16)(x0[e] >> 16);
        VT[(16 * c + 8 + 2 * e) * LLD + tok] = (bf16)(x1[e] & 0xffffu); VT[(16 * c + 8 + 2 * e + 1) * LLD + tok] = (bf16)(x1[e] >> 16);
    }
}

template <bool ODD> __device__ __forceinline__ void lin_kv_unit(Frame& F, const LinArgs& A, int u) {
    const int bh = u >> 6, n = u & 63, b = bh >> 2, h = bh & 3, t0 = n * LC;
    LAS bf16* KzT = (LAS bf16*)(F.lds + RING_OFF + LA_A); LAS bf16* VT = (LAS bf16*)(F.lds + RING_OFF + LA_VT);
    const int d = F.lane, r32 = F.lane & 31, hi = F.lane >> 5;
    float bv[8];
    const float blast = lin_cumdecay<ODD>(F, A, b, h, t0, bv);
#pragma unroll
    for (int i = 0; i < 8; ++i) {
        const int tok = 8 * F.wave + i;
        const float kk = bf1(A.Z[((size_t)b * SEQ + t0 + tok) * NZ + ZC_LK + h * 64 + d]);
        KzT[d * LLD + tok] = (bf16)f2bf(kk * __expf(blast - bv[i]));
    }
    lin_stage_vt(F, A.Z, b, h, t0);
    if (F.wave == 0) A.DEC[((size_t)bh * 64 + n) * 64 + d] = __expf(blast);
    __syncthreads();
    const int vb = F.wave >> 1, db = F.wave & 1;
    f32x16 acc = {};
#pragma unroll
    for (int s = 0; s < 4; ++s) {
        const bf16x8 a = *(const LAS bf16x8*)(VT + (vb * 32 + r32) * LLD + 16 * s + 8 * hi);
        const bf16x8 bb = *(const LAS bf16x8*)(KzT + (db * 32 + r32) * LLD + 16 * s + 8 * hi);
        acc = mfma32(a, bb, acc);
    }
    float* dst = A.KV + ((size_t)bh * 64 + n) * (128 * 64) + db * 32 + r32;
#pragma unroll
    for (int r = 0; r < 16; ++r) dst[(size_t)(vb * 32 + crow16(r, hi)) * 64] = acc[r];
}

__device__ __forceinline__ void lin_scan_phase(Frame& F, const LinArgs& A) {
    const int gt = F.vcu * 512 + F.tid;
    for (int e = gt; e < 32 * 128 * 32; e += F.G * 512) {
        const int bh = e >> 12, rem = e & 4095;
        const f32x2* kvp = (const f32x2*)(A.KV + (size_t)bh * 64 * (128 * 64) + rem * 2);
        const f32x2* dcp = (const f32x2*)(A.DEC + (size_t)bh * 64 * 64 + (rem & 31) * 2);
        unsigned* pp = (unsigned*)(A.PREV + (size_t)bh * 64 * (128 * 64) + rem * 2);
        f32x2 st = {0.f, 0.f};
        for (int n0 = 0; n0 < 64; n0 += 8) {
            f32x2 kv[8], dc[8];
#pragma unroll
            for (int i = 0; i < 8; ++i) { kv[i] = kvp[(size_t)(n0 + i) * 4096]; dc[i] = dcp[(n0 + i) * 32]; }
#pragma unroll
            for (int i = 0; i < 8; ++i) { pp[(size_t)(n0 + i) * 4096] = cvtpk(st.x, st.y); st = st * dc[i] + kv[i]; }
        }
    }
}

template <bool ODD> __device__ __forceinline__ void lin_out_unit(Frame& F, const LinArgs& A, int u) {
    const int bh = u >> 6, n = u & 63, b = bh >> 2, h = bh & 3, t0 = n * LC;
    LAS bf16* QtL = (LAS bf16*)(F.lds + RING_OFF + LA_A); LAS bf16* KtL = (LAS bf16*)(F.lds + RING_OFF + LA_B);
    LAS bf16* VT = (LAS bf16*)(F.lds + RING_OFF + LA_VT); LAS bf16* PL = (LAS bf16*)(F.lds + RING_OFF + LA_P);
    LAS float* OL = (LAS float*)(F.lds + RING_OFF + LA_O);
    const int d = F.lane, r32 = F.lane & 31, hi = F.lane >> 5;
    float bv[8];
    (void)lin_cumdecay<ODD>(F, A, b, h, t0, bv);
#pragma unroll
    for (int i = 0; i < 8; ++i) {
        const int tok = 8 * F.wave + i; const size_t row = (size_t)b * SEQ + t0 + tok;
        const float qq = bf1(A.Z[row * NZ + ZC_LQ + h * 64 + d]), kk = bf1(A.Z[row * NZ + ZC_LK + h * 64 + d]);
        QtL[tok * LLD + d] = (bf16)f2bf(qq * __expf(bv[i])); KtL[tok * LLD + d] = (bf16)f2bf(kk * __expf(-bv[i]));
    }
    lin_stage_vt(F, A.Z, b, h, t0);
    { const v4u* src = (const v4u*)(A.PREV + ((size_t)bh * 64 + n) * (128 * 64));
#pragma unroll
      for (int e = 0; e < 2; ++e) { const int pi = F.tid + 512 * e; *(LAS v4u*)(PL + (pi >> 3) * LLD + (pi & 7) * 8) = src[pi]; } }
    __syncthreads();
    const int qi = F.wave >> 2, vj = F.wave & 3;
    f32x16 st0 = {}, st1 = {};
#pragma unroll
    for (int s = 0; s < 4; ++s) {
        const bf16x8 qf = *(const LAS bf16x8*)(QtL + (qi * 32 + r32) * LLD + 16 * s + 8 * hi);
        const bf16x8 k0 = *(const LAS bf16x8*)(KtL + r32 * LLD + 16 * s + 8 * hi);
        st0 = mfma32(k0, qf, st0);
        if (qi == 1) { const bf16x8 k1 = *(const LAS bf16x8*)(KtL + (32 + r32) * LLD + 16 * s + 8 * hi); st1 = mfma32(k1, qf, st1); }
    }
#pragma unroll
    for (int r = 0; r < 16; ++r) { const int kl = crow16(r, hi); if (qi == 0) { if (kl > r32) st0[r] = 0.f; } else { if (kl > r32) st1[r] = 0.f; } }
    f32x16 o = {};
    const LAS bf16* vrow = VT + (vj * 32 + r32) * LLD + 4 * hi;
#pragma unroll
    for (int s2 = 0; s2 < 2; ++s2) o = mfma32(pack8(st0, s2), ld_perm8(vrow + 16 * s2), o);
    if (qi == 1) {
#pragma unroll
        for (int s2 = 0; s2 < 2; ++s2) o = mfma32(pack8(st1, s2), ld_perm8(vrow + 32 + 16 * s2), o);
    }
#pragma unroll
    for (int s = 0; s < 4; ++s) {
        const bf16x8 qf = *(const LAS bf16x8*)(QtL + (qi * 32 + r32) * LLD + 16 * s + 8 * hi);
        const bf16x8 pf = *(const LAS bf16x8*)(PL + (vj * 32 + r32) * LLD + 16 * s + 8 * hi);
        o = mfma32(qf, pf, o);
    }
#pragma unroll
    for (int r = 0; r < 16; ++r) OL[(qi * 32 + crow16(r, hi)) * 132 + vj * 32 + r32] = o[r];
    __syncthreads();
    {
        const int q = F.tid >> 3, part = F.tid & 7; const size_t row = (size_t)b * SEQ + t0 + q;
        f32x4 x[4];
#pragma unroll
        for (int e = 0; e < 4; ++e) x[e] = *(const LAS f32x4*)(OL + q * 132 + part * 16 + 4 * e);
        if (ODD) {
            float s = 0.f;
#pragma unroll
            for (int e = 0; e < 4; ++e) s += (x[e][0] + x[e][1]) + (x[e][2] + x[e][3]);
            s += __shfl_xor(s, 1); s += __shfl_xor(s, 2); s += __shfl_xor(s, 4);
            const float mu = s * (1.0f / 128.0f);
#pragma unroll
            for (int e = 0; e < 4; ++e) x[e] = x[e] - mu;
        }
        float s2 = 0.f;
#pragma unroll
        for (int e = 0; e < 4; ++e) s2 += (x[e][0] * x[e][0] + x[e][1] * x[e][1]) + (x[e][2] * x[e][2] + x[e][3] * x[e][3]);
        s2 += __shfl_xor(s2, 1); s2 += __shfl_xor(s2, 2); s2 += __shfl_xor(s2, 4);
        const float rs = 1.0f / sqrtf(s2 * (1.0f / 128.0f) + RMS_EPS);
        const int c0 = h * 128 + part * 16, yb = ODD ? 0 : 512;
        const v4u* gp = (const v4u*)(A.Z + row * NZ + ZC_GATE + yb + c0); v4u* yp = (v4u*)(A.Y + row * DMODEL + yb + c0);
#pragma unroll
        for (int e2 = 0; e2 < 2; ++e2) {
            const v4u gt = gp[e2]; v4u ov;
#pragma unroll
            for (int e = 0; e < 4; ++e) {
                const int c = c0 + 8 * e2 + 2 * e; const f32x4 xv = x[2 * e2 + (e >> 1)]; const float xa = xv[(2 * e) & 3], xb = xv[(2 * e + 1) & 3];
                float ya = xa * rs * A.g1[c], yb2 = xb * rs * A.g1[c + 1];
                if (ODD) { ya += A.g2[c]; yb2 += A.g2[c + 1]; }
                ov[e] = cvtpk(ya * bflo(gt[e]), yb2 * bfhi(gt[e]));
            }
            yp[e2] = ov;
        }
    }
}

constexpr int DK_LD = 72;
constexpr int DV_LD = 392;
constexpr int DA_K = 0, DA_VT = DA_K + 384 * DK_LD * 2, DA_WS = DA_VT + 64 * DV_LD * 2, DA_END = DA_WS + 8 * 128 * 4;
static_assert(DA_END <= RING_BYTES, "dilated-attention LDS map");

template <int PAT> __device__ __forceinline__ void dil_unit(Frame& F, const bf16* Z, bf16* Y, float* LSE, int u) {
    constexpr int DIL = (PAT == 0) ? 1 : (PAT == 1) ? 4 : 16;
    const int bh = u >> 4, rem = u & 15, b = bh >> 3, h = bh & 7, r = rem % DIL, blk = rem / DIL, i0 = 256 * blk;
    LAS bf16* KL = (LAS bf16*)(F.lds + RING_OFF + DA_K); LAS bf16* VT = (LAS bf16*)(F.lds + RING_OFF + DA_VT);
    LAS float* wsc = (LAS float*)(F.lds + RING_OFF + DA_WS) + F.wave * 128;
    const int r32 = F.lane & 31, hi = F.lane >> 5;
    const bf16* zb = Z + (size_t)b * SEQ * NZ + h * 64;
    __syncthreads();
#pragma unroll
    for (int e = 0; e < 6; ++e) {
        const int pi = F.tid + 512 * e, row = pi >> 3, c = pi & 7, idx = i0 - 128 + row;
        v4u kx = {0u, 0u, 0u, 0u}, vx = {0u, 0u, 0u, 0u};
        if (idx >= 0) { const bf16* tp = zb + (size_t)(idx * DIL + r) * NZ; kx = *(const v4u*)(tp + ZC_AK + 8 * c); vx = *(const v4u*)(tp + ZC_AV + 8 * c); }
        *(LAS v4u*)(KL + row * DK_LD + 8 * c) = kx;
#pragma unroll
        for (int q = 0; q < 4; ++q) { VT[(8 * c + 2 * q) * DV_LD + row] = (bf16)(vx[q] & 0xffffu); VT[(8 * c + 2 * q + 1) * DV_LD + row] = (bf16)(vx[q] >> 16); }
    }
    const int qidx = i0 + 32 * F.wave + r32; const size_t qrow = (size_t)b * SEQ + (size_t)qidx * DIL + r;
    bf16x8 qf[4];
#pragma unroll
    for (int s = 0; s < 4; ++s) qf[s] = *(const bf16x8*)(Z + qrow * NZ + ZC_AQ + h * 64 + 16 * s + 8 * hi);
    __syncthreads();
    const int kb_lo = (i0 + 32 * F.wave - 128 < 0) ? (128 - i0 - 32 * F.wave) / 32 : 0;
    f32x16 st[5];
#pragma unroll
    for (int kb = 0; kb < 5; ++kb) {
        st[kb] = (f32x16){};
        if (kb >= kb_lo) {
#pragma unroll
            for (int s = 0; s < 4; ++s) { const bf16x8 kf = *(const LAS bf16x8*)(KL + (32 * F.wave + 32 * kb + r32) * DK_LD + 16 * s + 8 * hi); st[kb] = mfma32(kf, qf[s], st[kb]); }
        }
    }
    float mx = -INFINITY;
#pragma unroll
    for (int kb = 0; kb < 5; ++kb)
#pragma unroll
        for (int rr = 0; rr < 16; ++rr) {
            const int kl = crow16(rr, hi); bool ok = kb >= kb_lo;
            if (kb == 0) ok = ok && (kl >= r32);
            if (kb == 4) ok = ok && (kl <= r32);
            const float sv = ok ? st[kb][rr] : -INFINITY; st[kb][rr] = sv; mx = fmaxf(mx, sv);
        }
    mx = fmaxf(mx, __shfl_xor(mx, 32));
    float l = 0.f;
#pragma unroll
    for (int kb = 0; kb < 5; ++kb)
#pragma unroll
        for (int rr = 0; rr < 16; ++rr) { const float p = exp2f(st[kb][rr] - mx); st[kb][rr] = p; l += p; }
    l += __shfl_xor(l, 32);
    f32x16 o0 = {}, o1 = {};
#pragma unroll
    for (int kb = 0; kb < 5; ++kb) {
        if (kb >= kb_lo) {
#pragma unroll
            for (int s2 = 0; s2 < 2; ++s2) {
                const bf16x8 pa = pack8(st[kb], s2);
                const int base = 32 * F.wave + 32 * kb + 16 * s2 + 4 * hi;
                o0 = mfma32(pa, ld_perm8(VT + r32 * DV_LD + base), o0);
                o1 = mfma32(pa, ld_perm8(VT + (32 + r32) * DV_LD + base), o1);
            }
        }
    }
    const float lse_cur = mx + __log2f(l);
    float w_old = 0.f, w_cur = 1.0f / l;
    if (PAT > 0) {
        const float lse_old = LSE[qrow * 8 + h];
        const float m2 = fmaxf(lse_old, lse_cur), lse_new = m2 + __log2f(exp2f(lse_old - m2) + exp2f(lse_cur - m2));
        w_old = exp2f(lse_old - lse_new); w_cur = exp2f(lse_cur - lse_new) / l;
        if (PAT < 2 && hi == 0) LSE[qrow * 8 + h] = lse_new;
    } else { if (hi == 0) LSE[qrow * 8 + h] = lse_cur; }
    if (hi == 0) { wsc[r32] = w_old; wsc[32 + r32] = w_cur; }
    __builtin_amdgcn_fence(__ATOMIC_RELEASE, "workgroup"); __builtin_amdgcn_wave_barrier(); __builtin_amdgcn_fence(__ATOMIC_ACQUIRE, "workgroup");
#pragma unroll
    for (int rr = 0; rr < 16; ++rr) {
        const int ql = crow16(rr, hi); const float wo = wsc[ql], wc = wsc[32 + ql];
        const size_t row = (size_t)b * SEQ + (size_t)(i0 + 32 * F.wave + ql) * DIL + r;
        bf16* yp = Y + row * DMODEL + 512 + h * 64 + r32;
        float a0 = o0[rr] * wc, a1 = o1[rr] * wc;
        if (PAT > 0) { a0 += wo * bf1(yp[0]); a1 += wo * bf1(yp[32]); }
        if (PAT == 2) { const bf16* gp = Z + row * NZ + ZC_GATE + 512 + h * 64 + r32; a0 *= bf1(gp[0]); a1 *= bf1(gp[32]); }
        yp[0] = (bf16)f2bf(a0); yp[32] = (bf16)f2bf(a1);
    }
}
struct Args { const float* in[14]; float* out; unsigned char* ws; int ph_lo, ph_hi, li, pad; };

constexpr size_t W_LAYER_BYTES = 9 * MiB;
__device__ __forceinline__ bf16* w_in_ptr(unsigned char* ws, int L) { return (bf16*)(ws + WS_W + (size_t)L * W_LAYER_BYTES); }
__device__ __forceinline__ bf16* w_out_ptr(unsigned char* ws, int L) { return (bf16*)(ws + WS_W + (size_t)L * W_LAYER_BYTES + 7 * MiB); }

__device__ __forceinline__ void p0_prologue(Frame& F, const Args& a) {
    LAS float* scr = (LAS float*)(F.lds + RING_OFF + F.wave * 16384);
    const int gw = F.vcu * NWAVES + F.wave, NGW = F.G * NWAVES;
    constexpr int I_IN = 16 * 112, I_OUT = 16 * 32, I_SK = 16, PER_LAYER = I_IN + I_OUT, NITEMS = 4 * PER_LAYER + 2 * I_SK;
    for (int it = gw; it < NITEMS; it += NGW) {
        if (it < 4 * PER_LAYER) {
            const int L = it / PER_LAYER; int r = it % PER_LAYER; const int j = L >> 1, odd = L & 1;
            if (r < I_IN) {
                const float* W = odd ? a.in[9] + (size_t)j * DMODEL * ODD_IN : a.in[2] + (size_t)j * DMODEL * EVEN_IN;
                const float* gain = (odd ? a.in[8] : a.in[1]) + j * DMODEL;
                p0_transpose_item(W, odd ? ODD_IN : EVEN_IN, odd ? 1 : 0, gain, w_in_ptr(a.ws, L), 112, scr, r, F.lane);
            } else {
                r -= I_IN;
                const float* W = (odd ? a.in[12] : a.in[7]) + (size_t)j * DMODEL * DMODEL;
                p0_transpose_item(W, DMODEL, 2, nullptr, w_out_ptr(a.ws, L), 32, scr, r, F.lane);
            }
        } else {
            const int r = it - 4 * PER_LAYER; const int j = r / I_SK;
            p0_transpose_item(a.in[2] + (size_t)j * DMODEL * EVEN_IN, EVEN_IN, 3, a.in[1] + j * DMODEL, (bf16*)(a.ws + WS_WSK) + (size_t)j * 32 * DMODEL, 1, scr, r % I_SK, F.lane);
        }
    }
    {
        bf16* HB = (bf16*)(a.ws + WS_HB); float* SS = (float*)(a.ws + WS_SS);
        for (int m = gw; m < M; m += NGW) {
            const GAS f32x4* xr = (const GAS f32x4*)(a.in[0] + (size_t)m * DMODEL) + F.lane;
            GAS unsigned long long* o8 = (GAS unsigned long long*)(HB + (size_t)m * DMODEL) + F.lane;
            float s = 0.f;
#pragma unroll
            for (int j = 0; j < 4; ++j) { const f32x4 v = xr[64 * j]; s += (v.x * v.x + v.y * v.y) + (v.z * v.z + v.w * v.w);
                o8[64 * j] = (unsigned long long)pk2(v.x, v.y) | ((unsigned long long)pk2(v.z, v.w) << 32); }
            s = wave_sum(s);
            if (F.lane < 16) SS[(size_t)m * 16 + F.lane] = (F.lane == 0) ? s : 0.f;
        }
    }
    {
        float* RP = (float*)(a.ws + WS_ROPE);
        for (int e = F.vcu * 512 + F.tid; e < SEQ * 32; e += F.G * 512) {
            const int t = e >> 5, j = e & 31;
            const float inv = (float)exp(-(double)j * (9.210340371976184 / 32.0));
            const float ang = (float)t * inv;
            double sn, cs; sincos((double)ang, &sn, &cs);
            RP[2 * e] = (float)cs; RP[2 * e + 1] = (float)sn;
        }
    }
}

__device__ __forceinline__ void skinny_phase(Frame& F, const bf16* HB, const bf16* WSK, const float* SS, const float* b_f, float* FFo, float* GLRo) {
    typedef float f32x4_t __attribute__((ext_vector_type(4)));
    const int lr = F.lane & 15, kq = F.lane >> 4;
    for (int rb = blockIdx.x; rb < M / 128; rb += F.G) {
        const int r0 = rb * 128 + F.wave * 16;
        f32x4_t acc0 = {0.f, 0.f, 0.f, 0.f}, acc1 = {0.f, 0.f, 0.f, 0.f};
        const bf16* ap = HB + (size_t)(r0 + lr) * DMODEL + 8 * kq;
        const bf16* bp0 = WSK + (size_t)lr * DMODEL + 8 * kq;
        const bf16* bp1 = WSK + (size_t)(16 + lr) * DMODEL + 8 * kq;
#pragma unroll 8
        for (int k0 = 0; k0 < DMODEL; k0 += 32) {
            const bf16x8 av = *(const bf16x8*)(ap + k0), b0 = *(const bf16x8*)(bp0 + k0), b1 = *(const bf16x8*)(bp1 + k0);
            acc0 = __builtin_amdgcn_mfma_f32_16x16x32_bf16(av, b0, acc0, 0, 0, 0);
            acc1 = __builtin_amdgcn_mfma_f32_16x16x32_bf16(av, b1, acc1, 0, 0, 0);
        }
#pragma unroll
        for (int reg = 0; reg < 4; ++reg) {
            const int row = r0 + 4 * kq + reg;
            const f32x4* sp = (const f32x4*)(SS + (size_t)row * 16);
            const f32x4 s0 = sp[0], s1 = sp[1], s2 = sp[2], s3 = sp[3];
            const float tot = ((s0[0] + s0[1]) + (s0[2] + s0[3])) + ((s1[0] + s1[1]) + (s1[2] + s1[3])) + ((s2[0] + s2[1]) + (s2[2] + s2[3])) + ((s3[0] + s3[1]) + (s3[2] + s3[3]));
            const float rinv = 1.0f / sqrtf(tot * (1.0f / 1024.0f) + RMS_EPS);
            const float v0 = acc0[reg] * rinv, v1 = acc1[reg] * rinv;
            if (lr < 8) { FFo[(size_t)row * 8 + lr] = logsigmoidf(v0 + b_f[lr]); GLRo[(size_t)row * 16 + 8 + lr] = v1; }
            else GLRo[(size_t)row * 16 + (lr - 8)] = v0;
        }
    }
}

__device__ __forceinline__ void cumsum_unit(Frame& F, int bh, const float* FFp, float* CB) {
    LAS float* wsum = (LAS float*)(F.lds + RING_OFF);
    const int b = bh >> 3, h = bh & 7;
    float v[8]; float run = 0.f;
#pragma unroll
    for (int i = 0; i < 8; ++i) { run += FFp[((size_t)b * SEQ + F.tid * 8 + i) * 8 + h]; v[i] = run; }
    float x = run;
#pragma unroll
    for (int o = 1; o < 64; o <<= 1) { const float y = __shfl_up(x, o); if (F.lane >= o) x += y; }
    if (F.lane == 63) wsum[F.wave] = x;
    __syncthreads();
    float off = x - run;
    for (int w = 0; w < F.wave; ++w) off += wsum[w];
#pragma unroll
    for (int i = 0; i < 8; ++i) CB[(size_t)bh * SEQ + F.tid * 8 + i] = v[i] + off;
    __syncthreads();
}

__device__ __forceinline__ void lin_naive_unit(Frame& F, int b, bool odd, const bf16* Z, const float* GLRp, const float* w_lr, const float* b_lr, const float* g1, const float* g2, bf16* Y) {
    float* qs = (float*)(F.lds + RING_OFF);
    float* ks = qs + 4096;
    float* al = ks + 4096;
    float* vs = al + 4096;
    float* os = vs + 8192;
    const int tid = F.tid, hd = tid >> 7;
    float S[64];
#pragma unroll
    for (int d = 0; d < 64; ++d) S[d] = 0.f;
    for (int t0 = 0; t0 < SEQ; t0 += 16) {
        for (int i = 0; i < 8; ++i) {
            const int e = tid + 512 * i, tok = e >> 8, c = e & 255; const size_t row = (size_t)b * SEQ + t0 + tok;
            qs[e] = bf1(Z[row * NZ + ZC_LQ + c]); ks[e] = bf1(Z[row * NZ + ZC_LK + c]);
            float a;
            if (odd) a = 1.0f - exp2f(-5.0f - (float)(c >> 6));
            else { float x = b_lr[c];
#pragma unroll
                for (int r = 0; r < 16; ++r) x += GLRp[row * 16 + r] * w_lr[r * 256 + c];
                a = __expf(logsigmoidf(x) * (1.0f / 16.0f)); }
            al[e] = a;
        }
        for (int i = 0; i < 16; ++i) vs[i * 512 + tid] = bf1(Z[((size_t)b * SEQ + t0 + i) * NZ + ZC_LV + tid]);
        __syncthreads();
        for (int tok = 0; tok < 16; ++tok) {
            const f32x4* q4 = (const f32x4*)(qs + tok * 256 + hd * 64); const f32x4* k4 = (const f32x4*)(ks + tok * 256 + hd * 64); const f32x4* a4 = (const f32x4*)(al + tok * 256 + hd * 64);
            const float vv = vs[tok * 512 + tid]; float o = 0.f;
#pragma unroll
            for (int d4 = 0; d4 < 16; ++d4) { const f32x4 qq = q4[d4], kk = k4[d4], aa = a4[d4];
#pragma unroll
                for (int e = 0; e < 4; ++e) { S[4 * d4 + e] = aa[e] * S[4 * d4 + e] + kk[e] * vv; o += qq[e] * S[4 * d4 + e]; } }
            os[tok * 512 + tid] = o;
        }
        __syncthreads();
        for (int i = 0; i < 8; ++i) {
            const int p = F.wave * 8 + i, tok = p >> 2, hh = p & 3; const size_t row = (size_t)b * SEQ + t0 + tok;
            float x0 = os[tok * 512 + hh * 128 + F.lane], x1 = os[tok * 512 + hh * 128 + 64 + F.lane];
            if (odd) { const float mu = wave_sum(x0 + x1) * (1.0f / 128.0f); x0 -= mu; x1 -= mu; }
            const float var = wave_sum(x0 * x0 + x1 * x1) * (1.0f / 128.0f); const float rs = 1.0f / sqrtf(var + RMS_EPS);
            const int c0 = hh * 128 + F.lane, c1 = c0 + 64;
            float y0 = x0 * rs * g1[c0], y1 = x1 * rs * g1[c1];
            if (odd) { y0 += g2[c0]; y1 += g2[c1]; }
            const int yb = odd ? 0 : 512;
            y0 *= bf1(Z[row * NZ + ZC_GATE + yb + c0]); y1 *= bf1(Z[row * NZ + ZC_GATE + yb + c1]);
            Y[row * DMODEL + yb + c0] = (bf16)f2bf(y0); Y[row * DMODEL + yb + c1] = (bf16)f2bf(y1);
        }
        __syncthreads();
    }
}

__device__ __forceinline__ void dil_naive_unit(Frame& F, int u, const bf16* Z, bf16* Y) {
    const int bh = u >> 3, tb = u & 7, b = bh >> 3, h = bh & 7, t = tb * 512 + F.tid;
    const bf16* zb = Z + (size_t)b * SEQ * NZ;
    float q[64], acc[64];
    { const v4u* qp = (const v4u*)(zb + (size_t)t * NZ + ZC_AQ + h * 64);
#pragma unroll
      for (int c = 0; c < 8; ++c) { const v4u w = qp[c];
#pragma unroll
          for (int e = 0; e < 4; ++e) { q[8 * c + 2 * e] = bflo(w[e]); q[8 * c + 2 * e + 1] = bfhi(w[e]); } } }
#pragma unroll
    for (int d = 0; d < 64; ++d) acc[d] = 0.f;
    float mx = -INFINITY, l = 0.f;
    for (int p = 0; p < 3; ++p) {
        const int dil = (p == 0) ? 1 : (p == 1) ? 4 : 16;
        for (int j = 0; j <= 128; ++j) {
            const int pos = t - j * dil; if (pos < 0) break;
            const v4u* kp = (const v4u*)(zb + (size_t)pos * NZ + ZC_AK + h * 64);
            float s = 0.f;
#pragma unroll
            for (int c = 0; c < 8; ++c) { const v4u w = kp[c];
#pragma unroll
                for (int e = 0; e < 4; ++e) { s += q[8 * c + 2 * e] * bflo(w[e]); s += q[8 * c + 2 * e + 1] * bfhi(w[e]); } }
            if (s > mx) { const float sc = exp2f(mx - s); l *= sc;
#pragma unroll
                for (int d = 0; d < 64; ++d) acc[d] *= sc;
                mx = s; }
            const float pr = exp2f(s - mx); l += pr;
            const v4u* vp = (const v4u*)(zb + (size_t)pos * NZ + ZC_AV + h * 64);
#pragma unroll
            for (int c = 0; c < 8; ++c) { const v4u w = vp[c];
#pragma unroll
                for (int e = 0; e < 4; ++e) { acc[8 * c + 2 * e] += pr * bflo(w[e]); acc[8 * c + 2 * e + 1] += pr * bfhi(w[e]); } }
        }
    }
    const float inv = 1.0f / l; const size_t row = (size_t)b * SEQ + t;
    const v4u* gp = (const v4u*)(Z + row * NZ + ZC_GATE + 512 + h * 64); v4u* yp = (v4u*)(Y + row * DMODEL + 512 + h * 64);
#pragma unroll
    for (int c = 0; c < 8; ++c) { const v4u g = gp[c]; v4u o;
#pragma unroll
        for (int e = 0; e < 4; ++e) o[e] = pk2(acc[8 * c + 2 * e] * inv * bflo(g[e]), acc[8 * c + 2 * e + 1] * inv * bfhi(g[e]));
        yp[c] = o; }
}

__device__ __forceinline__ void final_norm_phase(Frame& F, const bf16* HB, const float* SS, float* out, const float* g) {
    const int gw = F.vcu * NWAVES + F.wave, NGW = F.G * NWAVES;
    f32x4 gv[4];
#pragma unroll
    for (int j = 0; j < 4; ++j) gv[j] = ((const f32x4*)g)[F.lane + 64 * j];
    for (int m = gw; m < M; m += NGW) {
        const float sv = (F.lane < 16) ? SS[(size_t)m * 16 + F.lane] : 0.f;
        const float r = 1.0f / sqrtf(wave_sum(sv) * (1.0f / 1024.0f) + RMS_EPS);
        const GAS unsigned long long* hr = (const GAS unsigned long long*)(HB + (size_t)m * DMODEL) + F.lane;
        GAS f32x4* xr = (GAS f32x4*)(out + (size_t)m * DMODEL) + F.lane;
#pragma unroll
        for (int j = 0; j < 4; ++j) { const unsigned long long w = hr[64 * j]; const unsigned lo = (unsigned)w, hi2 = (unsigned)(w >> 32);
            f32x4 v; v.x = bflo(lo); v.y = bfhi(lo); v.z = bflo(hi2); v.w = bfhi(hi2); xr[64 * j] = v * r * gv[j]; }
    }
}

constexpr int PH_PER_LAYER = 5, N_PHASES = 2 + 4 * PH_PER_LAYER;
#ifndef MK_N_LAUNCHES
#define MK_N_LAUNCHES 1
#endif

#define IN(k) (lo <= (k) && (k) < hi)
#define SEAM(k) do { if (IN(k) && IN((k) + 1)) { for (int rb_ = 0; rb_ < REP_BAR; ++rb_) xcd_barrier(bar); } } while (0)
__device__ __forceinline__ unsigned char* launder_ptr(unsigned char* p) { asm volatile("" : "+s"(p)); return p; }
__device__ __forceinline__ void refresh(Frame& F) { int t = threadIdx.x; asm volatile("" : "+v"(t)); F.tid = t; F.lane = t & 63; F.wave = __builtin_amdgcn_readfirstlane(t >> 6); }
#ifndef REP_PRO
#define REP_PRO 1
#endif
#ifndef REP_INPROJ
#define REP_INPROJ 1
#endif
#ifndef REP_OUT0
#define REP_OUT0 1
#endif
#ifndef REP_X1
#define REP_X1 1
#endif
#ifndef REP_X2
#define REP_X2 1
#endif
#ifndef REP_X3
#define REP_X3 1
#endif
#ifndef REP_FOX
#define REP_FOX 1
#endif
#ifndef REP_DIL0
#define REP_DIL0 1
#endif
#ifndef REP_BAR
#define REP_BAR 1
#endif
#ifndef LIN_MFMA
#define LIN_MFMA 1
#endif
#ifndef DIL_MFMA
#define DIL_MFMA 1
#endif
template <int L> __device__ __forceinline__ LinArgs make_lin_args(unsigned char* ws, const Args& args) {
    constexpr int j = L >> 1; constexpr bool odd = (L & 1) != 0;
    LinArgs A;
    A.Z = (const bf16*)(ws + WS_Z); A.GLR = (const float*)(ws + WS_GLR); A.w_lr = args.in[4] + (size_t)j * 16 * 256; A.b_lr = args.in[5] + j * 256;
    A.g1 = odd ? args.in[10] + j * 512 : args.in[6] + j * 512; A.g2 = odd ? args.in[11] + j * 512 : nullptr;
    A.KV = (float*)(ws + WS_KV); A.DEC = (float*)(ws + WS_DECAY); A.PREV = (bf16*)(ws + WS_PREV); A.Y = (bf16*)(ws + WS_Y);
    return A;
}
template <int L> __device__ __forceinline__ void run_layer(Frame& F, const Args& args, const XcdBarrier& bar, const int lo, const int hi, unsigned char* lds) {
    constexpr int pb = 1 + PH_PER_LAYER * L; constexpr int j = L >> 1; constexpr bool odd = (L & 1) != 0;
    if (IN(pb)) {
        unsigned char* ws = launder_ptr(args.ws); refresh(F);
        bf16* Z = (bf16*)(ws + WS_Z); bf16* HB = (bf16*)(ws + WS_HB); float* SS = (float*)(ws + WS_SS);
        pg8::Gemm g{HB, w_in_ptr(ws, L), M, NZ, DMODEL}; pg8::StaticOrder S; S.init(M, NZ, F.G, (int)blockIdx.x);
        pg8::EpiIn E{Z, NZ, SS, (const float*)(ws + WS_ROPE), odd ? 1 : 0, 0.125f, C2};
        for (int rp_ = 0; rp_ < REP_INPROJ; ++rp_) {
        pg8::gemm_phase<pg8::EpiIn, pg8::StaticOrder, true, true>(F.lds + RING_OFF, g, S, E);
        if (!odd) skinny_phase(F, HB, (const bf16*)(ws + WS_WSK) + (size_t)j * 32 * DMODEL, SS, args.in[3] + j * 8, (float*)(ws + WS_FF), (float*)(ws + WS_GLR));
        }
    }
    SEAM(pb);
    if (IN(pb + 1)) {
        unsigned char* ws = launder_ptr(args.ws); refresh(F);
        bf16* Z = (bf16*)(ws + WS_Z); bf16* Y = (bf16*)(ws + WS_Y);
#if LIN_MFMA
        { const LinArgs A = make_lin_args<L>(ws, args); for (int rp_ = 0; rp_ < REP_X1; ++rp_) for (int u = F.vcu; u < 2048; u += F.G) lin_kv_unit<odd>(F, A, u); }
#else
        for (int u = blockIdx.x; u < 8; u += F.G) lin_naive_unit(F, u, odd, Z, (const float*)(ws + WS_GLR), args.in[4] + (size_t)j * 16 * 256, args.in[5] + j * 256, odd ? args.in[10] + j * 512 : args.in[6] + j * 512, odd ? args.in[11] + j * 512 : nullptr, Y);
#endif
        if (!odd) { for (int u = F.vcu; u < 64; u += F.G) cumsum_unit(F, u, (const float*)(ws + WS_FF), (float*)(ws + WS_CB)); }
        else {
#if DIL_MFMA
            for (int rp_ = 0; rp_ < REP_DIL0; ++rp_) for (int u = F.vcu; u < 1024; u += F.G) dil_unit<0>(F, Z, Y, (float*)(ws + WS_LSE), u);
#else
            for (int u = blockIdx.x; u < 512; u += F.G) dil_naive_unit(F, u, Z, Y);
#endif
        }
    }
    SEAM(pb + 1);
    if (IN(pb + 2)) {
        unsigned char* ws = launder_ptr(args.ws); refresh(F);
#if LIN_MFMA
        { const LinArgs A = make_lin_args<L>(ws, args); for (int rp_ = 0; rp_ < REP_X2; ++rp_) lin_scan_phase(F, A); }
#endif
        if (!odd) {
            bf16* Z = (bf16*)(ws + WS_Z);
            const attn_body::AttnTensors AT{(const attn_body::bf16*)(Z + ZC_AQ), (const attn_body::bf16*)(Z + ZC_AK), (const attn_body::bf16*)(Z + ZC_AV), (const attn_body::bf16*)(Z + ZC_GATE), (const float*)(ws + WS_CB), (attn_body::bf16*)(ws + WS_Y)};
            const attn_body::StaticOrder S((int)F.G, (int)blockIdx.x, 0);
            for (int rp_ = 0; rp_ < REP_FOX; ++rp_) attn_body::attn_phase<attn_body::StaticOrder>((char*)lds + RING_OFF, AT, S);
        } else {
#if DIL_MFMA
            for (int u = F.vcu; u < 1024; u += F.G) dil_unit<1>(F, (const bf16*)(ws + WS_Z), (bf16*)(ws + WS_Y), (float*)(ws + WS_LSE), u);
#endif
        }
    }
    SEAM(pb + 2);
    if (IN(pb + 3)) {
        unsigned char* ws = launder_ptr(args.ws); refresh(F);
#if LIN_MFMA
        { const LinArgs A = make_lin_args<L>(ws, args); for (int rp_ = 0; rp_ < REP_X3; ++rp_) for (int u = F.vcu; u < 2048; u += F.G) lin_out_unit<odd>(F, A, u); }
#endif
        if (!odd) {
            bf16* Z = (bf16*)(ws + WS_Z);
            const attn_body::AttnTensors AT{(const attn_body::bf16*)(Z + ZC_AQ), (const attn_body::bf16*)(Z + ZC_AK), (const attn_body::bf16*)(Z + ZC_AV), (const attn_body::bf16*)(Z + ZC_GATE), (const float*)(ws + WS_CB), (attn_body::bf16*)(ws + WS_Y)};
            const attn_body::StaticOrder S((int)F.G, (int)blockIdx.x, 1);
            __syncthreads();
            for (int rp_ = 0; rp_ < REP_FOX; ++rp_) attn_body::attn_phase<attn_body::StaticOrder>((char*)lds + RING_OFF, AT, S);
        } else {
#if DIL_MFMA
            for (int u = F.vcu; u < 1024; u += F.G) dil_unit<2>(F, (const bf16*)(ws + WS_Z), (bf16*)(ws + WS_Y), (float*)(ws + WS_LSE), u);
#endif
        }
    }
    SEAM(pb + 3);
    if (IN(pb + 4)) {
        unsigned char* ws = launder_ptr(args.ws); refresh(F);
        pg8::Gemm g{(bf16*)(ws + WS_Y), w_out_ptr(ws, L), M, DMODEL, DMODEL}; pg8::StaticOrder S; S.init(M, DMODEL, F.G, (int)blockIdx.x);
        pg8::EpiOut E{(bf16*)(ws + WS_HB), (float*)(ws + WS_SS)};
        for (int rp_ = 0; rp_ < REP_OUT0 * 0 + 1; ++rp_) pg8::gemm_phase<pg8::EpiOut, pg8::StaticOrder, true, true>(F.lds + RING_OFF, g, S, E);
    }
    SEAM(pb + 4);
}
#undef IN
#undef SEAM

__global__ void __launch_bounds__(NWAVES * 64, 2) trunk_fwd(Args args) {
    extern __shared__ __attribute__((aligned(16))) unsigned char lds[];
    Frame F;
    F.lds = (LAS unsigned char*)lds;
    F.MISC = (volatile LAS unsigned*)(F.lds + MISC_OFF);
    F.tid = threadIdx.x; F.lane = F.tid & 63; F.wave = __builtin_amdgcn_readfirstlane(F.tid >> 6);
    F.G = gridDim.x; { const int bx = blockIdx.x; F.vcu = (F.G % 8 == 0) ? (bx % 8) * (F.G / 8) + bx / 8 : bx; }
    F.ws = args.ws; F.ctl = (gu32*)(args.ws + WS_CTL);
    for (int u = F.tid; u < (LDS_BYTES - LDSCTL_OFF) / 4; u += NWAVES * 64) ((LAS unsigned*)(F.lds + LDSCTL_OFF))[u] = 0u;
    __syncthreads();
    XcdBarrier bar = xcd_barrier_post((unsigned*)(F.ctl + CW_BAR) + args.li * XCD_BAR_WORDS, F.MISC + 8);
    const int lo = args.ph_lo, hi = args.ph_hi;
#define IN(k) (lo <= (k) && (k) < hi)
#define SEAM(k) do { if (IN(k) && IN((k) + 1)) { for (int rb_ = 0; rb_ < REP_BAR; ++rb_) xcd_barrier(bar); } } while (0)

    if (IN(0)) { for (int rp_ = 0; rp_ < REP_PRO; ++rp_) p0_prologue(F, args); }
    SEAM(0);

    run_layer<0>(F, args, bar, lo, hi, lds); run_layer<1>(F, args, bar, lo, hi, lds); run_layer<2>(F, args, bar, lo, hi, lds); run_layer<3>(F, args, bar, lo, hi, lds);
    if (IN(N_PHASES - 1)) { refresh(F); unsigned char* ws = launder_ptr(args.ws); final_norm_phase(F, (const bf16*)(ws + WS_HB), (const float*)(ws + WS_SS), args.out, args.in[13]); }
#undef IN
#undef SEAM
}

extern "C" void kernel_launch(void* const* d_in, const int* in_sizes, int n_in, void* d_out, int out_size, void* d_ws, size_t ws_size, hipStream_t stream) {
    static int grid = 0;
    if (grid == 0) {
        if (n_in != 14 || in_sizes[0] != M * DMODEL || out_size != M * DMODEL || ws_size < WS_END) { fprintf(stderr, "kernel_launch: unexpected shapes: n_in %d in0 %d out %d ws %zu (need %zu)\n", n_in, n_in > 0 ? in_sizes[0] : -1, out_size, ws_size, (size_t)WS_END); grid = -1; return; }
        int dev = 0, cus = 0, per_cu = 0;
        if (hipGetDevice(&dev) != hipSuccess || hipDeviceGetAttribute(&cus, hipDeviceAttributeMultiprocessorCount, dev) != hipSuccess) { fprintf(stderr, "kernel_launch: device query failed\n"); grid = -1; return; }
        if (hipFuncSetAttribute((const void*)trunk_fwd, hipFuncAttributeMaxDynamicSharedMemorySize, LDS_BYTES) != hipSuccess) { fprintf(stderr, "kernel_launch: hipFuncSetAttribute failed\n"); grid = -1; return; }
        if (hipOccupancyMaxActiveBlocksPerMultiprocessor(&per_cu, (const void*)trunk_fwd, NWAVES * 64, LDS_BYTES) != hipSuccess || per_cu < 1) fprintf(stderr, "kernel_launch: note: occupancy query reports %d blocks per CU\n", per_cu);
        (void)hipGetLastError();
        grid = cus;
    }
    if (grid < 0) return;
    if (hipMemsetAsync((char*)d_ws + WS_CTL, 0, CTL_ZERO_BYTES, stream) != hipSuccess) { fprintf(stderr, "kernel_launch: memset failed\n"); return; }
    Args a{};
    for (int i = 0; i < 14; ++i) a.in[i] = (const float*)d_in[i];
    a.out = (float*)d_out; a.ws = (unsigned char*)d_ws;
    constexpr int NL = MK_N_LAUNCHES;
    for (int li = 0; li < NL; ++li) {
        a.ph_lo = (NL == 1) ? 0 : li; a.ph_hi = (NL == 1) ? N_PHASES : li + 1; a.li = li;
        hipLaunchKernelGGL(trunk_fwd, dim3(grid), dim3(NWAVES * 64), LDS_BYTES, stream, a);
        const hipError_t le = hipPeekAtLastError();
        if (le != hipSuccess) { fprintf(stderr, "kernel_launch: launch %d failed: %s\n", li, hipGetErrorName(le)); break; }
    }
}
```

```cpp
#include <hip/hip_runtime.h>
#include <hip/hip_bf16.h>
#include <cstdio>
#include <cstdint>
#include <cmath>

namespace pg8 {
#define PG8_LAS __attribute__((address_space(3)))
typedef unsigned short bf16_t;
typedef short bf16x8 __attribute__((ext_vector_type(8)));
typedef float f32x4 __attribute__((ext_vector_type(4)));
typedef unsigned u32x4 __attribute__((ext_vector_type(4)));
constexpr int BM = 256, BK = 64, HALF = 128, HTB = HALF * BK * 2  , STAGE_BYTES = 8 * HTB, NXCD = 8, WGM = 8;

__host__ __device__ __forceinline__ int lds_byte(int r, int c) { const int st = (r >> 4) * 2 + (c >> 5), rr = r & 15, cc = c & 31, ob = rr * 64 + cc * 2; return st * 1024 + (ob ^ (((ob >> 9) & 1) << 5)); }
__host__ __device__ __forceinline__ void stage_rc(int b, int& R, int& C) { const int st = b / 1024, sb = b % 1024, swz = sb ^ (((sb >> 9) & 1) << 5); R = (st >> 1) * 16 + swz / 64; C = (st & 1) * 32 + (swz % 64) / 2; }
__host__ __device__ __forceinline__ int perm32(int rho) { const int n = rho >> 4, i = rho & 15; return 8 * (i >> 2) + 4 * n + (i & 3); }

struct Unit { int pm, pn; };
struct Gemm { const bf16_t* A; const bf16_t* Bt; int M, N, K; };

struct StaticOrder {
    int nM, nN, nwg, G, c;
    __host__ __device__ void init(int M, int N, int G_, int c_) { nM = M / BM; nN = N / BM; nwg = nM * nN; G = G_; c = c_; }
    __host__ __device__ bool next(int i, Unit& u) const {
        const long L = (long)i * G + c; if (L >= nwg) return false;
        int wgid = (int)L; { const int q = nwg / NXCD, r = nwg % NXCD, xcd = wgid % NXCD, off = wgid / NXCD; wgid = (xcd < r ? xcd * (q + 1) : r * (q + 1) + (xcd - r) * q) + off; }
        const int nig = WGM * nN, gid = wgid / nig, fm = gid * WGM, gsz = (nM - fm) < WGM ? (nM - fm) : WGM;
        u.pm = fm + ((wgid % nig) % gsz); u.pn = (wgid % nig) / gsz; return true;
    }
    __device__ __forceinline__ void a_ready(const Unit&) const {}
    __device__ __forceinline__ void done(const Unit&) const {}
};

__device__ __forceinline__ unsigned cvt_pk_bf16(float lo, float hi) { unsigned r; asm volatile("v_cvt_pk_bf16_f32 %0, %1, %2" : "=v"(r) : "v"(lo), "v"(hi)); return r; }

struct EpiIn {
    static constexpr bool PERM = true, AFTER_DRAIN = false;
    bf16_t* Z; int ldz; const float* ss; const float* rope; int odd; float qscale, ascale;
    const PG8_LAS float* rtab; const PG8_LAS int* rtag;
    __device__ __forceinline__ void operator()(const f32x4 (&acc)[2][2][4][2], const Unit& u, int wr, int wc, int fr, int fq) const {
        const int row0 = u.pm * BM + wr * 64 + fr; const int pn = u.pn;
        const float cs = (pn == 0) ? qscale : ((pn == 4 || pn == 5) ? ascale : 1.0f);
        const bool do_rope = odd && (pn <= 1 || (pn >= 4 && pn <= 7));
        const bool do_silu = pn >= 10;
        const int col0 = pn * BM + wc * 32 + 8 * fq;
        const int slot = (u.pm >> 3) & 1; const bool have_tab = rtag[slot] == u.pm;
#pragma unroll
        for (int ai = 0; ai < 2; ++ai)
#pragma unroll
            for (int m = 0; m < 4; ++m) {
                const int row = row0 + ai * HALF + m * 16;
                float sc;
                if (have_tab) sc = cs * rtab[slot * 256 + (row & 255)];
                else {
                    const f32x4* sp = (const f32x4*)(ss + (size_t)row * 16);
                    const f32x4 s0 = sp[0], s1 = sp[1], s2 = sp[2], s3 = sp[3];
                    const float tot = ((s0[0] + s0[1]) + (s0[2] + s0[3])) + ((s1[0] + s1[1]) + (s1[2] + s1[3])) + ((s2[0] + s2[1]) + (s2[2] + s2[3])) + ((s3[0] + s3[1]) + (s3[2] + s3[3]));
                    sc = cs / sqrtf(tot * (1.0f / 1024.0f) + 1e-6f);
                }
                bf16_t* rowp = Z + (size_t)row * ldz + col0;
#pragma unroll
                for (int bj = 0; bj < 2; ++bj) {
                    f32x4 v0 = acc[ai][bj][m][0] * sc, v1 = acc[ai][bj][m][1] * sc;
                    if (do_rope) {
                        const int t = row & 4095; const int j0 = ((bj * HALF + wc * 32 + 8 * fq) & 63) >> 1;
                        const f32x4* rp = (const f32x4*)(rope + ((size_t)t * 32 + j0) * 2);
                        const f32x4 c01 = rp[0], c23 = rp[1];
                        f32x4 w0, w1;
                        w0[0] = v0[0] * c01[0] - v0[1] * c01[1]; w0[1] = v0[1] * c01[0] + v0[0] * c01[1];
                        w0[2] = v0[2] * c01[2] - v0[3] * c01[3]; w0[3] = v0[3] * c01[2] + v0[2] * c01[3];
                        w1[0] = v1[0] * c23[0] - v1[1] * c23[1]; w1[1] = v1[1] * c23[0] + v1[0] * c23[1];
                        w1[2] = v1[2] * c23[2] - v1[3] * c23[3]; w1[3] = v1[3] * c23[2] + v1[2] * c23[3];
                        v0 = w0; v1 = w1;
                    }
                    if (do_silu) {
#pragma unroll
                        for (int e = 0; e < 4; ++e) { v0[e] = v0[e] * __builtin_amdgcn_rcpf(1.0f + __builtin_amdgcn_exp2f(-1.4426950408889634f * v0[e])); v1[e] = v1[e] * __builtin_amdgcn_rcpf(1.0f + __builtin_amdgcn_exp2f(-1.4426950408889634f * v1[e])); }
                    }
                    u32x4 w; w.x = cvt_pk_bf16(v0[0], v0[1]); w.y = cvt_pk_bf16(v0[2], v0[3]); w.z = cvt_pk_bf16(v1[0], v1[1]); w.w = cvt_pk_bf16(v1[2], v1[3]);
                    *(u32x4*)(rowp + bj * HALF) = w;
                }
            }
    }
};

template <class Sched> __device__ __forceinline__ void epi_in_fill(const Sched& S, const float* ss, PG8_LAS float* rtab, PG8_LAS int* rtag) {
    if (threadIdx.x < 2) rtag[threadIdx.x] = -1;
    __syncthreads();
    Unit u;
    for (int i = 0; S.next(i, u); ++i) {
        const int slot = (u.pm >> 3) & 1;
        if (rtag[slot] == -1) {
            __syncthreads();
            if (threadIdx.x < 256) {
                const int row = u.pm * BM + threadIdx.x; const f32x4* sp = (const f32x4*)(ss + (size_t)row * 16);
                const f32x4 s0 = sp[0], s1 = sp[1], s2 = sp[2], s3 = sp[3];
                const float tot = ((s0[0] + s0[1]) + (s0[2] + s0[3])) + ((s1[0] + s1[1]) + (s1[2] + s1[3])) + ((s2[0] + s2[1]) + (s2[2] + s2[3])) + ((s3[0] + s3[1]) + (s3[2] + s3[3]));
                rtab[slot * 256 + threadIdx.x] = 1.0f / sqrtf(tot * (1.0f / 1024.0f) + 1e-6f);
                if (threadIdx.x == 0) rtag[slot] = u.pm;
            }
            __syncthreads();
        }
    }
    __syncthreads();
}

struct EpiOut {
    static constexpr bool PERM = true, AFTER_DRAIN = false;
    bf16_t* hb; float* ss;
    __device__ __forceinline__ void operator()(const f32x4 (&acc)[2][2][4][2], const Unit& u, int wr, int wc, int fr, int fq) const {
        const int row0 = u.pm * BM + wr * 64 + fr; const int col0 = u.pn * BM + wc * 32 + 8 * fq;
#pragma unroll
        for (int ai = 0; ai < 2; ++ai)
#pragma unroll
            for (int m = 0; m < 4; ++m) {
                const int row = row0 + ai * HALF + m * 16; const size_t off = (size_t)row * 1024 + col0; float q = 0.f;
#pragma unroll
                for (int bj = 0; bj < 2; ++bj) {
                    const u32x4 old = *(const u32x4*)(hb + off + bj * HALF);
                    f32x4 v0 = acc[ai][bj][m][0], v1 = acc[ai][bj][m][1];
                    v0[0] += __uint_as_float(old.x << 16); v0[1] += __uint_as_float(old.x & 0xffff0000u); v0[2] += __uint_as_float(old.y << 16); v0[3] += __uint_as_float(old.y & 0xffff0000u);
                    v1[0] += __uint_as_float(old.z << 16); v1[1] += __uint_as_float(old.z & 0xffff0000u); v1[2] += __uint_as_float(old.w << 16); v1[3] += __uint_as_float(old.w & 0xffff0000u);
                    q += (v0[0] * v0[0] + v0[1] * v0[1]) + (v0[2] * v0[2] + v0[3] * v0[3]) + (v1[0] * v1[0] + v1[1] * v1[1]) + (v1[2] * v1[2] + v1[3] * v1[3]);
                    u32x4 w; w.x = cvt_pk_bf16(v0[0], v0[1]); w.y = cvt_pk_bf16(v0[2], v0[3]); w.z = cvt_pk_bf16(v1[0], v1[1]); w.w = cvt_pk_bf16(v1[2], v1[3]);
                    *(u32x4*)(hb + off + bj * HALF) = w;
                }
                q += __shfl_xor(q, 16); q += __shfl_xor(q, 32);
                if (fq == 0) ss[(size_t)row * 16 + u.pn * 4 + wc] = q;
            }
    }
};

template <class Epi, class Sched, bool ALIGN_EPI = false, bool SP2 = false>
__device__ __forceinline__ void gemm_phase(PG8_LAS unsigned char* lds, const Gemm g, const Sched& S, const Epi& E) {
    int tid_ = threadIdx.x; asm volatile("" : "+v"(tid_));
    const int tid = tid_, wid = __builtin_amdgcn_readfirstlane(tid >> 6), lane = tid & 63, wr = wid >> 2, wc = wid & 3, fr = lane & 15, fq = lane >> 4;
    const int K = g.K, nt = K / BK;
    unsigned voffA[2], voffB[2];
#pragma unroll
    for (int i = 0; i < 2; ++i) { int R, C; stage_rc(tid * 16 + i * 8192, R, C); const int Rb = Epi::PERM ? ((R & ~31) + perm32(R & 31)) : R;
        voffA[i] = (unsigned)(R * K + C) * 2u; voffB[i] = (unsigned)(Rb * K + C) * 2u; }
    const size_t kstep = (size_t)(BK * 2);
    const size_t hstep = (size_t)HALF * K * 2;
    const size_t tstep = 2 * hstep;
    const unsigned ldsw = (unsigned)wid * 1024u;
    const int aoff = lds_byte(wr * 64 + fr, fq * 8), boff = lds_byte(wc * 32 + fr, fq * 8);
#define PG8_SA(b, h) (((b) * 2 + (h)) * HTB)
#define PG8_SB(b, h) ((4 + (b) * 2 + (h)) * HTB)
#define PG8_STAGE(bufoff, gbase, voff) do { _Pragma("unroll") for (int _i = 0; _i < 2; ++_i) \
        __builtin_amdgcn_global_load_lds((const unsigned*)((const char*)(gbase) + (voff)[_i]), (PG8_LAS unsigned*)(lds + (bufoff) + ldsw + _i * 8192), 16, 0, 0); } while (0)
#define PG8_LDA(dst, b, h) do { _Pragma("unroll") for (int m = 0; m < 4; ++m) _Pragma("unroll") for (int k = 0; k < 2; ++k) dst[m][k] = *(const PG8_LAS bf16x8*)(lds + PG8_SA(b, h) + aoff + m * 2048 + k * 1024); } while (0)
#define PG8_LDB(dst, b, h) do { _Pragma("unroll") for (int n = 0; n < 2; ++n) _Pragma("unroll") for (int k = 0; k < 2; ++k) dst[n][k] = *(const PG8_LAS bf16x8*)(lds + PG8_SB(b, h) + boff + n * 2048 + k * 1024); } while (0)
#define PG8_MMA(ai, bj, At, Bt) do { __builtin_amdgcn_s_setprio(1); _Pragma("unroll") for (int m = 0; m < 4; ++m) _Pragma("unroll") for (int n = 0; n < 2; ++n) _Pragma("unroll") for (int k = 0; k < 2; ++k) \
        acc[ai][bj][m][n] = __builtin_amdgcn_mfma_f32_16x16x32_bf16(Bt[n][k], At[m][k], acc[ai][bj][m][n], 0, 0, 0); __builtin_amdgcn_s_setprio(0); } while (0)
#define PG8_WAIT_V(n) asm volatile("s_waitcnt vmcnt(" #n ")" ::: "memory")
#define PG8_WAIT_L(n) asm volatile("s_waitcnt lgkmcnt(" #n ")" ::: "memory")
#define PG8_BAR __builtin_amdgcn_s_barrier()
#define PG8_SCHED __builtin_amdgcn_sched_barrier(0)
    Unit cur, nxt; int ui = 0;
    if (!S.next(0, cur)) return;
    f32x4 acc[2][2][4][2];
#pragma unroll
    for (int a = 0; a < 2; ++a)
#pragma unroll
        for (int b = 0; b < 2; ++b)
#pragma unroll
            for (int m = 0; m < 4; ++m)
#pragma unroll
                for (int n = 0; n < 2; ++n) acc[a][b][m][n] = (f32x4){0.f, 0.f, 0.f, 0.f};
    bf16x8 At[4][2], B0[2][2], B1[2][2];
    const char* cA = (const char*)g.A + (size_t)cur.pm * tstep; const char* cB = (const char*)g.Bt + (size_t)cur.pn * tstep;
    S.a_ready(cur);
    if constexpr (SP2) {
        PG8_STAGE(PG8_SB(0, 0), cB, voffB); PG8_STAGE(PG8_SB(0, 1), cB + hstep, voffB); PG8_STAGE(PG8_SA(0, 0), cA, voffA); PG8_STAGE(PG8_SA(0, 1), cA + hstep, voffA);
        if (wr == 1) PG8_BAR;
        PG8_WAIT_V(2); PG8_BAR;
        PG8_STAGE(PG8_SB(1, 0), cB + kstep, voffB); PG8_STAGE(PG8_SA(1, 0), cA + kstep, voffA); PG8_STAGE(PG8_SB(1, 1), cB + hstep + kstep, voffB);
        PG8_WAIT_V(6); PG8_BAR;
    } else {
        PG8_STAGE(PG8_SB(0, 0), cB, voffB); PG8_STAGE(PG8_SA(0, 0), cA, voffA); PG8_STAGE(PG8_SB(0, 1), cB + hstep, voffB); PG8_STAGE(PG8_SA(0, 1), cA + hstep, voffA);
        if (wr == 1) PG8_BAR;
        PG8_WAIT_V(4); PG8_BAR;
        PG8_STAGE(PG8_SB(1, 0), cB + kstep, voffB); PG8_STAGE(PG8_SA(1, 0), cA + kstep, voffA); PG8_STAGE(PG8_SB(1, 1), cB + hstep + kstep, voffB);
        PG8_WAIT_V(6); PG8_BAR;
    }
    for (;;) {
        const bool has_next = S.next(ui + 1, nxt);
        const char* nA = has_next ? (const char*)g.A + (size_t)nxt.pm * tstep : cA; const char* nB = has_next ? (const char*)g.Bt + (size_t)nxt.pn * tstep : cB;
        for (int t = 0; t < nt; t += 2) {
            const bool last = (t == nt - 2);
            const char* a1 = cA + (size_t)(t + 1) * kstep;
            const char* a2 = last ? nA : cA + (size_t)(t + 2) * kstep; const char* b2 = last ? nB : cB + (size_t)(t + 2) * kstep;
            const char* a3 = a2 + kstep; const char* b3 = b2 + kstep;
            if (last && has_next) S.a_ready(nxt);
            if constexpr (SP2) {
            PG8_LDB(B0, 0, 0); PG8_LDB(B1, 0, 1); PG8_SCHED; PG8_LDA(At, 0, 0); PG8_STAGE(PG8_SA(1, 1), a1 + hstep, voffA);
            PG8_WAIT_V(8); PG8_WAIT_L(0); PG8_BAR; PG8_MMA(0, 0, At, B0); PG8_MMA(0, 1, At, B1); PG8_BAR; PG8_SCHED;
            PG8_LDA(At, 0, 1); PG8_STAGE(PG8_SB(0, 0), b2, voffB); PG8_STAGE(PG8_SB(0, 1), b2 + hstep, voffB); PG8_STAGE(PG8_SA(0, 0), a2, voffA);
            PG8_WAIT_V(8); PG8_WAIT_L(0); PG8_BAR; PG8_MMA(1, 0, At, B0); PG8_MMA(1, 1, At, B1); PG8_BAR; PG8_SCHED;
            PG8_LDB(B0, 1, 0); PG8_LDB(B1, 1, 1); PG8_SCHED; PG8_LDA(At, 1, 0); PG8_STAGE(PG8_SA(0, 1), a2 + hstep, voffA);
            PG8_WAIT_V(8); PG8_WAIT_L(0); PG8_BAR; PG8_MMA(0, 0, At, B0); PG8_MMA(0, 1, At, B1); PG8_BAR; PG8_SCHED;
            PG8_LDA(At, 1, 1); PG8_STAGE(PG8_SB(1, 0), b3, voffB); PG8_STAGE(PG8_SB(1, 1), b3 + hstep, voffB); PG8_STAGE(PG8_SA(1, 0), a3, voffA);
            PG8_WAIT_V(8); PG8_WAIT_L(0); PG8_BAR; PG8_MMA(1, 0, At, B0); PG8_MMA(1, 1, At, B1); PG8_BAR; PG8_SCHED;
            } else {
            PG8_LDB(B0, 0, 0); PG8_SCHED; PG8_LDA(At, 0, 0); PG8_STAGE(PG8_SA(1, 1), a1 + hstep, voffA);
            PG8_WAIT_L(8); PG8_BAR; PG8_WAIT_L(0); PG8_MMA(0, 0, At, B0); PG8_BAR; PG8_SCHED;
            PG8_LDB(B1, 0, 1); PG8_STAGE(PG8_SB(0, 0), b2, voffB);
            PG8_BAR; PG8_WAIT_L(0); PG8_MMA(0, 1, At, B1); PG8_BAR;
            PG8_LDA(At, 0, 1); PG8_STAGE(PG8_SA(0, 0), a2, voffA);
            PG8_BAR; PG8_WAIT_L(0); PG8_MMA(1, 0, At, B0); PG8_BAR; PG8_SCHED;
            PG8_STAGE(PG8_SB(0, 1), b2 + hstep, voffB);
            PG8_WAIT_V(6); PG8_BAR; PG8_MMA(1, 1, At, B1); PG8_BAR;
            PG8_LDB(B0, 1, 0); PG8_SCHED; PG8_LDA(At, 1, 0); PG8_STAGE(PG8_SA(0, 1), a2 + hstep, voffA);
            PG8_WAIT_L(8); PG8_BAR; PG8_WAIT_L(0); PG8_MMA(0, 0, At, B0); PG8_BAR; PG8_SCHED;
            PG8_LDB(B1, 1, 1); PG8_STAGE(PG8_SB(1, 0), b3, voffB);
            PG8_BAR; PG8_WAIT_L(0); PG8_MMA(0, 1, At, B1); PG8_BAR;
            PG8_LDA(At, 1, 1); PG8_STAGE(PG8_SA(1, 0), a3, voffA);
            PG8_BAR; PG8_WAIT_L(0); PG8_MMA(1, 0, At, B0); PG8_BAR; PG8_SCHED;
            PG8_STAGE(PG8_SB(1, 1), b3 + hstep, voffB);
            PG8_WAIT_V(6); PG8_BAR; PG8_MMA(1, 1, At, B1); PG8_BAR;
            }
        }
        if constexpr (ALIGN_EPI) { if (wr == 0) PG8_BAR; }
        if constexpr (!Epi::AFTER_DRAIN) { E(acc, cur, wr, wc, fr, fq); S.done(cur); }
        if (!has_next) break;
#pragma unroll
        for (int a = 0; a < 2; ++a)
#pragma unroll
            for (int b = 0; b < 2; ++b)
#pragma unroll
                for (int m = 0; m < 4; ++m)
#pragma unroll
                    for (int n = 0; n < 2; ++n) acc[a][b][m][n] = (f32x4){0.f, 0.f, 0.f, 0.f};
        cur = nxt; cA = nA; cB = nB; ++ui;
        if constexpr (ALIGN_EPI) { if (wr == 1) PG8_BAR; }
    }
    PG8_WAIT_V(0);
    if constexpr (!ALIGN_EPI) { if (wr == 0) PG8_BAR; }
    PG8_BAR;
#undef PG8_SA
#undef PG8_SB
#undef PG8_STAGE
#undef PG8_LDA
#undef PG8_LDB
#undef PG8_MMA
#undef PG8_WAIT_V
#undef PG8_WAIT_L
#undef PG8_BAR
#undef PG8_SCHED
}
}
namespace attn_body {
using bf16=__hip_bfloat16;
using bf16x8=__attribute__((ext_vector_type(8)))short;
using s16x4=__attribute__((ext_vector_type(4)))short;
using f32x16=__attribute__((ext_vector_type(16)))float;
using u32x4=__attribute__((ext_vector_type(4)))unsigned;
constexpr int BATCH=8,NHEAD=8,SEQ=4096,D=64,DM=3584,OP=1024;
constexpr int NW=8,QBLK=32,QB=QBLK*NW,KVBLK=64,NQB=SEQ/QB;
constexpr int ATTN_PITCH=DM, ATTN_UNIT_ROWS=QB;
__device__ __forceinline__ int crow(int r,int hi){return (r&3)+8*(r>>2)+4*hi;}
#define SBAR() __builtin_amdgcn_sched_barrier(0)
__device__ __forceinline__ void cmask(f32x16&p0,f32x16&p1,int jb,int qrel,int hi){
  const float NEG=-INFINITY; int kb=64*jb+4*hi;
  #pragma unroll
  for(int r=0;r<16;++r){int kv=kb+(r&3)+8*(r>>2); if(kv>qrel)p0[r]=NEG; if(kv+32>qrel)p1[r]=NEG;}
}

constexpr int NSLOT=3, SLOTB=8192;
constexpr int LDS_K=0, LDS_V=NSLOT*SLOTB, LDS_WS=2*NSLOT*SLOTB, LDS_OST=LDS_WS+NW*64*4, LDS_BIAS=LDS_OST+NW*4096, LDS_BYTES=LDS_BIAS+SEQ*4;
constexpr float C2=0.125f*1.4426950408889634f;
__device__ __forceinline__ void glds16(const void*gsrc,unsigned lds_dst){unsigned keep;
  asm volatile("s_mov_b32 %0, m0\n\ts_mov_b32 m0, %2\n\ts_nop 0\n\tglobal_load_lds_dwordx4 %1, off\n\ts_mov_b32 m0, %0":"=&s"(keep):"v"(gsrc),"s"(lds_dst):"memory");}
__device__ __forceinline__ float max3f(float a,float b,float c){float r;asm("v_max3_f32 %0, %1, %2, %3":"=v"(r):"v"(a),"v"(b),"v"(c));return r;}
__device__ __forceinline__ float max2f(float a,float b){float r;asm("v_max_f32_e32 %0, %1, %2":"=v"(r):"v"(a),"v"(b));return r;}
__device__ __forceinline__ float fadd_s(float a,float b){float r;asm("v_add_f32_e32 %0, %1, %2":"=v"(r):"v"(a),"v"(b));return r;}
__device__ __forceinline__ float fsub_s(float a,float b){float r;asm("v_sub_f32_e32 %0, %1, %2":"=v"(r):"v"(a),"v"(b));return r;}
typedef float f32x4v __attribute__((ext_vector_type(4))); typedef float f32x2_t __attribute__((ext_vector_type(2))); typedef __bf16 bf16x2_t __attribute__((ext_vector_type(2)));
__device__ __forceinline__ unsigned cvtpk_s(float lo,float hi){f32x2_t v={lo,hi};bf16x2_t b=__builtin_convertvector(v,bf16x2_t);return __builtin_bit_cast(unsigned,b);}
#define WAIT_BAR(N) asm volatile("s_waitcnt vmcnt(" #N ") lgkmcnt(0)\n\ts_barrier":::"memory")

__device__ __forceinline__ void qkt(f32x16&p0,f32x16&p1,const char*Kslot,const bf16x8*qr,const f32x16&negm,int r32,int hi){
  const char*kb=Kslot+hi*1024+r32*16;
  #pragma unroll
  for(int d0=0;d0<4;++d0){
    const bf16x8 b0=*reinterpret_cast<const bf16x8*>(kb+d0*2048);
    const bf16x8 b1=*reinterpret_cast<const bf16x8*>(kb+d0*2048+512);
    if(d0==0){p0=__builtin_amdgcn_mfma_f32_32x32x16_bf16(b0,qr[0],negm,0,0,0);p1=__builtin_amdgcn_mfma_f32_32x32x16_bf16(b1,qr[0],negm,0,0,0);}
    else{p0=__builtin_amdgcn_mfma_f32_32x32x16_bf16(b0,qr[d0],p0,0,0,0);p1=__builtin_amdgcn_mfma_f32_32x32x16_bf16(b1,qr[d0],p1,0,0,0);}}
}
typedef __attribute__((address_space(3))) const char* lds_cptr;
typedef short v4i16_t __attribute__((ext_vector_type(4)));
__device__ __forceinline__ void kload8(bf16x8*kf,lds_cptr kp){
  kf[0]=*(const __attribute__((address_space(3))) bf16x8*)(kp);      kf[1]=*(const __attribute__((address_space(3))) bf16x8*)(kp+512);
  kf[2]=*(const __attribute__((address_space(3))) bf16x8*)(kp+2048); kf[3]=*(const __attribute__((address_space(3))) bf16x8*)(kp+2560);
  kf[4]=*(const __attribute__((address_space(3))) bf16x8*)(kp+4096); kf[5]=*(const __attribute__((address_space(3))) bf16x8*)(kp+4608);
  kf[6]=*(const __attribute__((address_space(3))) bf16x8*)(kp+6144); kf[7]=*(const __attribute__((address_space(3))) bf16x8*)(kp+6656);
}
__device__ __forceinline__ void kload2(bf16x8*kf,lds_cptr kp,int j){ kf[2*j]=*(const __attribute__((address_space(3))) bf16x8*)(kp+j*2048); kf[2*j+1]=*(const __attribute__((address_space(3))) bf16x8*)(kp+j*2048+512); }
__device__ __forceinline__ s16x4 vtr(lds_cptr p){ return __builtin_bit_cast(s16x4,__builtin_amdgcn_ds_read_tr16_b64_v4i16((__attribute__((address_space(3))) v4i16_t*)p)); }
__device__ __forceinline__ float rowmax(const f32x16&p0,const f32x16&p1){
  float a=max3f(p0[0],p0[1],p1[0]),b=max3f(p0[2],p0[3],p1[1]);a=max3f(a,p1[2],p1[3]);
  #pragma unroll
  for(int r=4;r<16;r+=4){a=max3f(a,p0[r],p0[r+1]);b=max3f(b,p0[r+2],p0[r+3]);a=max3f(a,p1[r],p1[r+1]);b=max3f(b,p1[r+2],p1[r+3]);}
  const float m=max2f(a,b);
  auto rr=__builtin_amdgcn_permlane32_swap(__float_as_uint(m),__float_as_uint(m),false,false);
  return max2f(__uint_as_float(rr[0]),__uint_as_float(rr[1]));
}
__device__ __forceinline__ void pv(f32x16*o,int vb,bf16x8 pa0,bf16x8 pa1,bf16x8 pa2,bf16x8 pa3){
  #pragma unroll
  for(int d0=0;d0<2;++d0){s16x4 lo[4],hi[4];
    #pragma unroll
    for(int ks=0;ks<4;++ks){
      asm volatile("ds_read_b64_tr_b16 %0,%1 offset:%c2":"=&v"(lo[ks]):"v"(vb),"i"(d0*4096+ks*1024):"memory");
      asm volatile("ds_read_b64_tr_b16 %0,%1 offset:%c2":"=&v"(hi[ks]):"v"(vb),"i"(d0*4096+ks*1024+512):"memory");}
    asm volatile("s_waitcnt lgkmcnt(0)":::"memory");SBAR();
    #define PK(k) (bf16x8){lo[k][0],lo[k][1],lo[k][2],lo[k][3],hi[k][0],hi[k][1],hi[k][2],hi[k][3]}
    o[d0]=__builtin_amdgcn_mfma_f32_32x32x16_bf16(pa0,PK(0),o[d0],0,0,0);
    o[d0]=__builtin_amdgcn_mfma_f32_32x32x16_bf16(pa1,PK(1),o[d0],0,0,0);
    o[d0]=__builtin_amdgcn_mfma_f32_32x32x16_bf16(pa2,PK(2),o[d0],0,0,0);
    o[d0]=__builtin_amdgcn_mfma_f32_32x32x16_bf16(pa3,PK(3),o[d0],0,0,0);
    #undef PK
  }
}

#ifndef ATTN_STORE16
#define ATTN_STORE16(p,v) (*(u32x4*)(p)=(v))
#endif
template<int THRL> __device__ __forceinline__ void attn_unit(int b,int h,int qb,const bf16*Q,const bf16*__restrict__ K,const bf16*__restrict__ V,const bf16*__restrict__ GT,const float*__restrict__ CB,const float*__restrict__ KN,const float*__restrict__ QN,bf16*O,char*shm){
  int tid_=threadIdx.x; asm volatile("":"+v"(tid_)); const int tid=tid_,lane=tid&63,r32=lane&31,hi=lane>>5; const int wid=__builtin_amdgcn_readfirstlane(tid>>6);
  const long rowbase=(long)b*SEQ; const int q0=qb*QB;
  const bf16*Qw=Q+(rowbase+q0+wid*QBLK)*DM+h*D;
  int tstart=0;
  { const float*cbh=CB+(long)(b*NHEAD+h)*SEQ; const float*kn=KN+(b*NHEAD+h)*64; const float*qn=QN+(b*NHEAD+h)*32;
    const int NT0=(q0+QB)/KVBLK; const float cref=cbh[q0];
    const float Qn=__builtin_fmaxf(qn[2*qb],qn[2*qb+1]);
    const float KnU=__builtin_fmaxf(__builtin_fmaxf(kn[4*qb],kn[4*qb+1]),__builtin_fmaxf(kn[4*qb+2],kn[4*qb+3]));
    float kt=(lane<NT0)?kn[lane]:0.f;
    #pragma unroll
    for(int o_=1;o_<64;o_<<=1){ const float y_=__shfl_up(kt,o_); if(lane>=o_)kt=__builtin_fmaxf(kt,y_); }
    const float bmax=(lane<NT0)?(cref-cbh[64*lane+63])*1.4426950408889634f:0.f;
    const bool skip_=(lane<NT0-4)&&(bmax+Qn*(kt+KnU)<-44.0f);
    const unsigned long long m_=__ballot(skip_);
    tstart=__builtin_amdgcn_readfirstlane(((int)__builtin_ctzll(~m_))&~1); }
  const bf16*Kh=K+(rowbase+(long)tstart*KVBLK)*DM+h*D,*Vh=V+(rowbase+(long)tstart*KVBLK)*DM+h*D;
  const unsigned lds0=(unsigned)(uintptr_t)shm;
  float*wsf=(float*)(shm+LDS_WS)+wid*64;
  const bf16*ksrc=Kh+(long)lane*DM+wid*8;
  const bf16*vsrc=Vh+(long)(16*(wid&3)+(lane>>2))*DM+(wid>>2)*32+(lane&3)*8;
  const unsigned kdst=lds0+LDS_K+wid*1024, vdst=lds0+LDS_V+wid*1024;
  #define DMA_K(t,slot) glds16(ksrc+(long)(t)*KVBLK*DM,(unsigned)__builtin_amdgcn_readfirstlane(kdst+(slot)))
  #define DMA_V(t,slot) glds16(vsrc+(long)(t)*KVBLK*DM,(unsigned)__builtin_amdgcn_readfirstlane(vdst+(slot)))
  const int vb0=(int)(lds0+LDS_V)+((lane>>4)&1)*32+(lane&3)*8+(4*hi+((lane&15)>>2))*64;
  const char*Kbase=shm+LDS_K; bf16x8 kf[8];
  const lds_cptr shm3=(lds_cptr)shm; const lds_cptr kp0=shm3+LDS_K+hi*1024+r32*16; const lds_cptr vp0=shm3+LDS_V+((lane>>4)&1)*32+(lane&3)*8+(4*hi+((lane&15)>>2))*64;
  const int NT=(q0+QB)/KVBLK-tstart;
  { const float*cbh=CB+(long)(b*NHEAD+h)*SEQ; const float cref=cbh[q0]; float*bl=(float*)(shm+LDS_BIAS); const int nk=q0+QB;
    for(int i=tid+tstart*KVBLK;i<nk;i+=NW*64) bl[i]=(cref-cbh[i])*1.4426950408889634f; }
  const __attribute__((address_space(3))) float* biasp=(const __attribute__((address_space(3))) float*)((lds_cptr)shm+LDS_BIAS)+4*hi+tstart*KVBLK;
  #define BIASADD(P0,P1,t) do{ const __attribute__((address_space(3))) float* bp_=biasp+64*(t); \
    _Pragma("unroll") for(int g_=0;g_<4;++g_){ f32x4v x0_=*(const __attribute__((address_space(3))) f32x4v*)(bp_+8*g_); f32x4v x1_=*(const __attribute__((address_space(3))) f32x4v*)(bp_+32+8*g_); \
      x0_=x0_-mhat; x1_=x1_-mhat; \
      P0[4*g_]+=x0_[0];P0[4*g_+1]+=x0_[1];P0[4*g_+2]+=x0_[2];P0[4*g_+3]+=x0_[3]; P1[4*g_]+=x1_[0];P1[4*g_+1]+=x1_[1];P1[4*g_+2]+=x1_[2];P1[4*g_+3]+=x1_[3]; } }while(0)
  DMA_K(0,0);DMA_V(0,0);DMA_K(1,SLOTB);
  bf16x8 qr[4];
  #pragma unroll
  for(int d0=0;d0<4;++d0)qr[d0]=*reinterpret_cast<const bf16x8*>(&Qw[(long)r32*DM+d0*16+hi*8]);
  float mhat=0.f,l_reg=0.f;f32x16 o[2];o[0]=f32x16{};o[1]=f32x16{};const f32x16 negm=f32x16{};
  const int qrel=wid*QBLK+r32;
  #define CMASK(P0,P1,t) do{int jb_=(t)-(NT-4); if(jb_>=0)cmask(P0,P1,jb_,qrel,hi);}while(0)
  bool resc=false;
  #define START(P0,P1) do{ const float rm=rowmax(P0,P1); resc=false; \
    { const float dl=rm; mhat=fadd_s(mhat,dl); \
      _Pragma("unroll") for(int r=0;r<16;++r){P0[r]=fsub_s(P0[r],dl);P1[r]=fsub_s(P1[r],dl);} \
      } \
    _Pragma("unroll") for(int r=0;r<16;++r)P0[r]=__builtin_amdgcn_exp2f(P0[r]); }while(0)
  #define RESC() do{ if(resc){ asm volatile("s_waitcnt lgkmcnt(0)":::"memory"); \
      _Pragma("unroll") for(int d_=0;d_<2;++d_) _Pragma("unroll") for(int r=0;r<16;++r)o[d_][r]*=wsf[crow(r,hi)]; } }while(0)
  f32x16 pA0,pA1,pB0,pB1;
  int sl_prev=0,sl_cur=0,sl_next=SLOTB;
  #define ROT() do{sl_prev=sl_cur;sl_cur=sl_next;sl_next=(sl_next==(NSLOT-1)*SLOTB)?0:sl_next+SLOTB;}while(0)
  DMA_K(2,2*SLOTB);
  WAIT_BAR(3);
  qkt(pA0,pA1,Kbase,qr,negm,r32,hi);asm volatile("s_nop 15\n\ts_nop 7":"+v"(pA0),"+v"(pA1));BIASADD(pA0,pA1,0);CMASK(pA0,pA1,0);
  START(pA0,pA1);
  _Pragma("unroll") for(int r=0;r<16;++r)pA1[r]=__builtin_amdgcn_exp2f(pA1[r]);
  WAIT_BAR(0);
  DMA_K(3,0);DMA_V(1,SLOTB);
  ROT();
  kload8(kf,kp0+sl_cur);
  WAIT_BAR(2);
  s16x4 vlo[8],vhi[8]; u32x4 pw0,pw1,pw2,pw3;
  #define PKW(P,B) cvtpk_s(P[B],P[B+1])
  #define PAF(k) __builtin_bit_cast(bf16x8,pw##k)
  #define VFR(i) (bf16x8){vlo[i][0],vlo[i][1],vlo[i][2],vlo[i][3],vhi[i][0],vhi[i][1],vhi[i][2],vhi[i][3]}
  #define PIN(x) asm volatile("":"+v"(x))
  #define MX3(a,b,c) __builtin_fmaxf(__builtin_fmaxf((a),(b)),(c))
  #define GAPA(MF,A0,A1,A2,A3,W0,W1,PW) do{ MF; sacc+=A0; sacc+=A1; sacc+=A2; sacc+=A3; PIN(sacc); W0; W1; PIN(PW); SBAR(); }while(0)
  #define EX(v) __builtin_amdgcn_exp2f(v)
  #define GAPB(MF,X,B) do{ MF; X[B]=EX(X[B]); X[B+1]=EX(X[B+1]); X[B+2]=EX(X[B+2]); X[B+3]=EX(X[B+3]); PIN(X); SBAR(); }while(0)
  #define VRD(i) do{ vlo[i]=vtr(vp_+(((i)>>2)*4096+((i)&3)*1024)); vhi[i]=vtr(vp_+(((i)>>2)*4096+((i)&3)*1024+512)); }while(0)
  #define KRD(G,j) do{ if(G){ kload2(kf,kp0+sl_next,j); SBAR(); } }while(0)
  #define STEP(C0,C1,P0,P1,t,GK,GV,GL) do{ SBAR(); \
    const lds_cptr vp_=vp0+sl_prev; \
    VRD(0); SBAR(); float sacc=(P0[0]+P0[1]); \
    GAPA(C0=__builtin_amdgcn_mfma_f32_32x32x16_bf16(kf[0],qr[0],negm,0,0,0), P0[2],P0[3],P0[4],P0[5],     pw0[0]=PKW(P0,0), pw0[1]=PKW(P0,2), pw0); \
    VRD(4); SBAR(); GAPA(C1=__builtin_amdgcn_mfma_f32_32x32x16_bf16(kf[1],qr[0],negm,0,0,0), P0[6],P0[7],P0[8],P0[9],     pw0[2]=PKW(P0,4), pw0[3]=PKW(P0,6), pw0); \
    VRD(1); SBAR(); GAPA(C0=__builtin_amdgcn_mfma_f32_32x32x16_bf16(kf[2],qr[1],C0,0,0,0),   P0[10],P0[11],P0[12],P0[13], pw1[0]=PKW(P0,8), pw1[1]=PKW(P0,10), pw1); \
    VRD(5); SBAR(); GAPA(C1=__builtin_amdgcn_mfma_f32_32x32x16_bf16(kf[3],qr[1],C1,0,0,0),   P0[14],P0[15],P1[0],P1[1],   pw1[2]=PKW(P0,12),pw1[3]=PKW(P0,14), pw1); \
    VRD(2); SBAR(); GAPA(C0=__builtin_amdgcn_mfma_f32_32x32x16_bf16(kf[4],qr[2],C0,0,0,0),   P1[2],P1[3],P1[4],P1[5],     pw2[0]=PKW(P1,0), pw2[1]=PKW(P1,2), pw2); \
    VRD(6); SBAR(); GAPA(C1=__builtin_amdgcn_mfma_f32_32x32x16_bf16(kf[5],qr[2],C1,0,0,0),   P1[6],P1[7],P1[8],P1[9],     pw2[2]=PKW(P1,4), pw2[3]=PKW(P1,6), pw2); \
    VRD(3); SBAR(); GAPA(C0=__builtin_amdgcn_mfma_f32_32x32x16_bf16(kf[6],qr[3],C0,0,0,0),   P1[10],P1[11],P1[12],P1[13], pw3[0]=PKW(P1,8), pw3[1]=PKW(P1,10), pw3); \
    VRD(7); SBAR(); GAPA(C1=__builtin_amdgcn_mfma_f32_32x32x16_bf16(kf[7],qr[3],C1,0,0,0),   P1[14],P1[15],0.f,0.f,       pw3[2]=PKW(P1,12),pw3[3]=PKW(P1,14), pw3); \
    l_reg+=sacc; \
    if(GK){DMA_K((t)+3,sl_cur);} if(GV){DMA_V((t)+1,sl_next);} \
    BIASADD(C0,C1,t); CMASK(C0,C1,t); \
    { float a=MX3(C0[0],C0[1],C1[0]),b=MX3(C0[2],C0[3],C1[1]); a=MX3(a,C1[2],C1[3]); \
      _Pragma("unroll") for(int r=4;r<16;r+=4){a=MX3(a,C0[r],C0[r+1]);b=MX3(b,C0[r+2],C0[r+3]);a=MX3(a,C1[r],C1[r+1]);b=MX3(b,C1[r+2],C1[r+3]);} \
      float rm=__builtin_fmaxf(a,b); { auto rr=__builtin_amdgcn_permlane32_swap(__float_as_uint(rm),__float_as_uint(rm),false,false); rm=__builtin_fmaxf(__uint_as_float(rr[0]),__uint_as_float(rr[1])); } \
      resc=false; \
      if(__builtin_expect(__any(rm>(float)THRL),0)){ const float dl=__builtin_fmaxf(rm,0.f); mhat+=dl; \
        _Pragma("unroll") for(int r=0;r<16;++r){C0[r]-=dl;C1[r]-=dl;} \
        const float f=__builtin_amdgcn_exp2f(-dl); l_reg*=f; if(hi==0)wsf[r32]=f; resc=true; } } \
    SBAR(); \
    GAPB(o[0]=__builtin_amdgcn_mfma_f32_32x32x16_bf16(PAF(0),VFR(0),o[0],0,0,0), C0,0); \
    GAPB(o[1]=__builtin_amdgcn_mfma_f32_32x32x16_bf16(PAF(0),VFR(4),o[1],0,0,0), C0,4); \
    KRD(GL,0); GAPB(o[0]=__builtin_amdgcn_mfma_f32_32x32x16_bf16(PAF(1),VFR(1),o[0],0,0,0), C0,8); \
    KRD(GL,1); GAPB(o[1]=__builtin_amdgcn_mfma_f32_32x32x16_bf16(PAF(1),VFR(5),o[1],0,0,0), C0,12); \
    KRD(GL,2); GAPB(o[0]=__builtin_amdgcn_mfma_f32_32x32x16_bf16(PAF(2),VFR(2),o[0],0,0,0), C1,0); \
    KRD(GL,3); GAPB(o[1]=__builtin_amdgcn_mfma_f32_32x32x16_bf16(PAF(2),VFR(6),o[1],0,0,0), C1,4); \
    GAPB(o[0]=__builtin_amdgcn_mfma_f32_32x32x16_bf16(PAF(3),VFR(3),o[0],0,0,0), C1,8); \
    GAPB(o[1]=__builtin_amdgcn_mfma_f32_32x32x16_bf16(PAF(3),VFR(7),o[1],0,0,0), C1,12); \
    }while(0)
  int t=1;
  #undef CMASK
  #define CMASK(P0,P1,t) do{}while(0)
  for(;t+5<NT;t+=2){
    STEP(pB0,pB1,pA0,pA1,t,true,true,true);     WAIT_BAR(2); RESC(); ROT();
    STEP(pA0,pA1,pB0,pB1,t+1,true,true,true);   WAIT_BAR(2); RESC(); ROT();
  }
  #undef CMASK
  #define CMASK(P0,P1,t) do{int jb_=(t)-(NT-4); if(jb_>=0)cmask(P0,P1,jb_,qrel,hi);}while(0)
  #define ENDW(tt) do{ if((tt)+3<NT){WAIT_BAR(2);} else if((tt)+2<NT){WAIT_BAR(1);} else {WAIT_BAR(0);} }while(0)
  for(;t+1<NT;t+=2){
    STEP(pB0,pB1,pA0,pA1,t,(t+3<NT),(t+1<NT),(t+1<NT));       ENDW(t);   RESC(); ROT();
    STEP(pA0,pA1,pB0,pB1,t+1,(t+4<NT),(t+2<NT),(t+2<NT));     ENDW(t+1); RESC(); ROT();
  }
  STEP(pB0,pB1,pA0,pA1,NT-1,false,false,false); RESC();
  { float sacc=pB0[0]+pB0[1]; _Pragma("unroll") for(int r=2;r<16;++r)sacc+=pB0[r]; _Pragma("unroll") for(int r=0;r<16;++r)sacc+=pB1[r]; l_reg+=sacc;
    pw0=(u32x4){PKW(pB0,0),PKW(pB0,2),PKW(pB0,4),PKW(pB0,6)};pw1=(u32x4){PKW(pB0,8),PKW(pB0,10),PKW(pB0,12),PKW(pB0,14)};pw2=(u32x4){PKW(pB1,0),PKW(pB1,2),PKW(pB1,4),PKW(pB1,6)};pw3=(u32x4){PKW(pB1,8),PKW(pB1,10),PKW(pB1,12),PKW(pB1,14)};
    SBAR(); pv(o,vb0+sl_cur,PAF(0),PAF(1),PAF(2),PAF(3)); }
  #undef PKW
  #undef PAF
  #undef VFR
  #undef PIN
  #undef MX3
  #undef GAPA
  #undef GAPB
  #undef EX
  #undef VRD
  #undef KRD
  #undef STEP
  #undef ENDW
  {auto rr=__builtin_amdgcn_permlane32_swap(__float_as_uint(l_reg),__float_as_uint(l_reg),false,false);l_reg=__uint_as_float(rr[0])+__uint_as_float(rr[1]);}
  if(hi==0)wsf[32+r32]=l_reg;asm volatile("s_waitcnt lgkmcnt(0)":::"memory");
  float rli[16];
  #pragma unroll
  for(int r=0;r<16;++r)rli[r]=__builtin_amdgcn_rcpf(wsf[32+crow(r,hi)]);
  bf16*Ow=O+(rowbase+q0+wid*QBLK)*OP+h*D; const bf16*Gw=GT+(rowbase+q0+wid*QBLK)*DM+h*D;
  { bf16*stg=(bf16*)(shm+LDS_OST)+wid*2048;
    #pragma unroll
    for(int r=0;r<16;++r){const int orow=crow(r,hi);
      #pragma unroll
      for(int d0=0;d0<2;++d0)stg[orow*64+d0*32+r32]=__float2bfloat16(o[d0][r]*rli[r]);}
    asm volatile("s_waitcnt lgkmcnt(0)":::"memory");
    #pragma unroll
    for(int i=0;i<4;++i){const int row=i*8+(lane>>3),ch=lane&7; const u32x4 v=*(const u32x4*)(stg+row*64+ch*8); const u32x4 g=*(const u32x4*)(Gw+(long)row*DM+ch*8); u32x4 w;
      _Pragma("unroll") for(int e=0;e<4;++e){ const float a0=__uint_as_float(v[e]<<16)*__uint_as_float(g[e]<<16), a1=__uint_as_float(v[e]&0xffff0000u)*__uint_as_float(g[e]&0xffff0000u); w[e]=cvtpk_s(a0,a1); }
      ATTN_STORE16(Ow+(long)row*OP+ch*8,w);} }
  asm volatile("s_waitcnt lgkmcnt(0)\n\ts_barrier":::"memory");
  #undef BIASADD
  #undef DMA_K
  #undef DMA_V
  #undef CMASK
  #undef START
  #undef RESC
  #undef ROT
}
constexpr int ATTN_LDS_BYTES=LDS_BYTES;
struct AttnTensors { const bf16* Q; const bf16* K; const bf16* V; const bf16* GT; const float* CB; const float* KN; const float* QN; bf16* O; };
struct AttnUnit { int bh; int qb; };
struct StaticOrder {
  int vcu,G,half;
  __device__ __forceinline__ explicit StaticOrder(int grid,int block,int half_):vcu((grid%8==0)?(block%8)*(grid/8)+block/8:block),G(grid),half(half_){}
  __device__ __forceinline__ bool next(int i,AttnUnit&u)const{
    if(G==256){ if(i>=2)return false; const int s=vcu&3,k=vcu>>2;
      u.bh=(half==0)?((i==0)?k:(k^4)):((i==0)?(k^2):(k^6)); u.qb=(half==0)?((i==0)?s:15-s):((i==0)?7-s:8+s); return true; }
    const int idx=i*G+vcu; if(idx>=BATCH*NHEAD*NQB/2)return false; const int k=idx&7; u.bh=idx>>3; u.qb=(half==0)?((k<4)?k:8+k):4+k; return true; }
  __device__ __forceinline__ void a_ready(const AttnUnit&)const{}
  __device__ __forceinline__ void done(const AttnUnit&)const{}
};
template<class Sched,int THRL=8> __device__ __forceinline__ void attn_phase(char*lds,const AttnTensors&T,const Sched&S){
  AttnUnit u;
  for(int i=0;S.next(i,u);++i){ S.a_ready(u); attn_unit<THRL>(u.bh/NHEAD,u.bh%NHEAD,u.qb,T.Q,T.K,T.V,T.GT,T.CB,T.KN,T.QN,T.O,lds); S.done(u); }
}
#undef SBAR
#undef WAIT_BAR
}
constexpr int NWAVES = 8;
constexpr int BATCH = 8, SEQ = 4096, DMODEL = 1024, M = BATCH * SEQ;
constexpr int NZ = 3584;
constexpr int ZC_LQ = 0, ZC_LK = 256, ZC_LV = 512, ZC_AQ = 1024, ZC_AK = 1536, ZC_AV = 2048, ZC_GATE = 2560;
constexpr int EVEN_IN = 3608, ODD_IN = 3584;
constexpr float RMS_EPS = 1e-6f;
constexpr float LOG2E = 1.4426950408889634f;
constexpr float C2 = 0.125f * LOG2E;

constexpr size_t MiB = 1u << 20;
constexpr size_t WS_CTL = 0, CTL_ZERO_BYTES = 1 * MiB;
constexpr size_t WS_ROPE = 1 * MiB;
constexpr size_t WS_SS = 2 * MiB;
constexpr size_t WS_FF = 4 * MiB;
constexpr size_t WS_GLR = 5 * MiB;
constexpr size_t WS_CB = 7 * MiB;
constexpr size_t WS_LSE = 8 * MiB;
constexpr size_t WS_DECAY = 9 * MiB;
constexpr size_t WS_KN = 9 * MiB + 512 * 1024;
constexpr size_t WS_QN = WS_KN + 16 * 1024;
constexpr size_t WS_WSK = 10 * MiB;
constexpr size_t WS_W = 11 * MiB;
constexpr size_t WS_Z = 48 * MiB;
constexpr size_t WS_Y = 272 * MiB;
constexpr size_t WS_HB = 336 * MiB;
constexpr size_t WS_KV = 400 * MiB;
constexpr size_t WS_PREV = 464 * MiB;
constexpr size_t WS_END = 496 * MiB;
constexpr int CW_TMO = 0, CW_CODE = 1;
constexpr int CW_BAR = 4096;

constexpr int RING_OFF = 0, RING_BYTES = 131072;
constexpr int LDSCTL_OFF = RING_BYTES, MISC_OFF = LDSCTL_OFF + 320;
constexpr int LDS_BYTES = 147456;
static_assert(MISC_OFF + 128 <= LDS_BYTES, "LDS map");

#define GAS __attribute__((address_space(1)))
#define LAS __attribute__((address_space(3)))
typedef unsigned short bf16;
typedef unsigned v4u __attribute__((ext_vector_type(4)));
typedef float f32x4 __attribute__((ext_vector_type(4)));
typedef short bf16x8 __attribute__((ext_vector_type(8)));
typedef GAS unsigned gu32;
#define RLX_AGENT __ATOMIC_RELAXED, __HIP_MEMORY_SCOPE_AGENT
#define LDS_WAIT() asm volatile("s_waitcnt lgkmcnt(0)" ::: "memory")
#define VM_WAIT() asm volatile("s_waitcnt vmcnt(0)" ::: "memory")
__device__ __forceinline__ unsigned f2bf(float f) { unsigned u = __builtin_bit_cast(unsigned, f); return (u + 0x7fffu + ((u >> 16) & 1u)) >> 16; }
__device__ __forceinline__ unsigned pk2(float lo, float hi) { return f2bf(lo) | (f2bf(hi) << 16); }
__device__ __forceinline__ float bflo(unsigned w) { return __uint_as_float(w << 16); }
__device__ __forceinline__ float bfhi(unsigned w) { return __uint_as_float(w & 0xffff0000u); }
__device__ __forceinline__ float bf1(bf16 h) { return __uint_as_float((unsigned)h << 16); }
__device__ __forceinline__ float logsigmoidf(float x) { return x < 0.f ? x - log1pf(__expf(x)) : -log1pf(__expf(-x)); }
__device__ __forceinline__ float logsigmoid_fast(float x) { return fminf(x, 0.f) - 0.6931471805599453f * __builtin_amdgcn_logf(1.0f + __builtin_amdgcn_exp2f(-fabsf(x) * 1.4426950408889634f)); }

#define XB_TMO      128
#define XB_XCNT(j)  (256  + 64 * (j))
#define XB_XSUB(j)  (1280 + 64 * (j))
#define XB_XGEN(j)  (2304 + 64 * (j))
#define XB_TOP      3328
#define XB_TOPGEN   3392
#define XCD_BAR_WORDS 3456
#define XB_SPIN_CAP (1u << 18)

__device__ __forceinline__ unsigned xb_ld(unsigned* p)              { return __hip_atomic_load(p, __ATOMIC_RELAXED, __HIP_MEMORY_SCOPE_AGENT); }
__device__ __forceinline__ unsigned xb_add(unsigned* p, unsigned v) { return __hip_atomic_fetch_add(p, v, __ATOMIC_RELAXED, __HIP_MEMORY_SCOPE_AGENT); }
__device__ __forceinline__ unsigned xb_xcc_id() { return (unsigned)__builtin_amdgcn_s_getreg((3 << 11) | 20) & 0xFu; }
#define XB_SPIN(cond, bar) do { unsigned _sp = 0; while (cond) { __builtin_amdgcn_s_sleep(1); \
    if ((++_sp & 255u) == 0u) { if (xb_ld(&(bar)[XB_TMO])) break; if (_sp > XB_SPIN_CAP) { atomicAdd(&(bar)[XB_TMO], 1u); break; } } } } while (0)

struct XcdBarrier { unsigned* bar; unsigned x; volatile LAS unsigned* st; };

__device__ __forceinline__ XcdBarrier xcd_barrier_post(unsigned* bar, volatile LAS unsigned* st) {
    XcdBarrier b; b.bar = bar; b.x = xb_xcc_id(); b.st = st;
    if (threadIdx.x == 0) (void)xb_add(&bar[XB_XCNT(b.x)], 1u);
    return b;
}
__device__ __forceinline__ void xcd_barrier_complete(unsigned* bar, unsigned x, unsigned& nloc, unsigned& nx) {
    const unsigned G = gridDim.x * gridDim.y * gridDim.z;
    unsigned sum, cnt, mine, sp = 0u;
    for (;;) {
        sum = 0u; cnt = 0u; mine = 0u;
#pragma unroll
        for (unsigned j = 0; j < 16; ++j) { const unsigned c = xb_ld(&bar[XB_XCNT(j)]); sum += c; cnt += (c > 0u) ? 1u : 0u; mine = (j == x) ? c : mine; }
        if (sum == G) break;
        __builtin_amdgcn_s_sleep(1);
        if ((++sp & 255u) == 0u) { if (xb_ld(&bar[XB_TMO])) break; if (sp > XB_SPIN_CAP) { atomicAdd(&bar[XB_TMO], 1u); break; } }
    }
    nloc = mine > 0u ? mine : 1u; nx = cnt > 0u ? cnt : 1u;
}
__device__ __forceinline__ void xcd_barrier(const XcdBarrier& b) {
    asm volatile("s_waitcnt vmcnt(0)" ::: "memory");
    __syncthreads();
    if (threadIdx.x == 0) {
        unsigned* bar = b.bar;
        __builtin_amdgcn_s_waitcnt(0);
        unsigned nloc = b.st[0], nx = b.st[1];
        if (nloc == 0u) { xcd_barrier_complete(bar, b.x, nloc, nx); b.st[0] = nloc; b.st[1] = nx; }
        const unsigned old = xb_add(&bar[XB_XSUB(b.x)], 1u);
        const unsigned gen = old / nloc;
        if (old + 1u == (gen + 1u) * nloc) {
            __builtin_amdgcn_fence(__ATOMIC_RELEASE, "agent");
            asm volatile("s_waitcnt vmcnt(0)" ::: "memory");
            const unsigned og = xb_add(&bar[XB_TOP], 1u);
            const unsigned tg = og / nx;
            if (og + 1u == (tg + 1u) * nx) xb_add(&bar[XB_TOPGEN], 1u);
            else XB_SPIN(xb_ld(&bar[XB_TOPGEN]) == tg, bar);
            __builtin_amdgcn_fence(__ATOMIC_ACQUIRE, "agent");
            xb_add(&bar[XB_XGEN(b.x)], 1u);
            asm volatile("s_waitcnt vmcnt(0)" ::: "memory");
        } else {
            XB_SPIN(xb_ld(&bar[XB_XGEN(b.x)]) == gen, bar);
            __builtin_amdgcn_fence(__ATOMIC_ACQUIRE, "agent");
            asm volatile("s_waitcnt vmcnt(0)" ::: "memory");
        }
    }
    __syncthreads();
}

struct Frame {
    LAS unsigned char* lds;
    volatile LAS unsigned* MISC;
    gu32* ctl;
    int tid, lane, wave;
    int vcu, G;
    unsigned char* ws;
};

__device__ __forceinline__ float wave_sum(float v) {
#pragma unroll
    for (int o = 1; o < 64; o <<= 1) v += __shfl_xor(v, o);
    return v;
}

__device__ __forceinline__ int wsrc_col(int kind, int n) {
    if (kind == 0) {
        if (n < 256) return 1544 + n;
        if (n < 512) return 1800 + (n - 256);
        if (n < 1024) return 2056 + (n - 512);
        if (n < 1536) return n - 1024;
        if (n < 2048) return 512 + (n - 1536);
        if (n < 2560) return 1024 + (n - 2048);
        return 2584 + (n - 2560);
    } else if (kind == 1) {
        const bool il = (n < 512) || (n >= 1024 && n < 2048);
        if (!il) return n;
        const int p = n & 63; return (n & ~63) + (p >> 1) + 32 * (p & 1);
    } else if (kind == 2) {
        return n;
    } else {
        if (n < 8) return 1536 + n;
        if (n < 24) return 2568 + (n - 8);
        return -1;
    }
}
__device__ __forceinline__ void p0_transpose_item(const float* W, int Nsrc, int kind, const float* gain, bf16* WT, int nblk, LAS float* scr, int item, int lane) {
    const int K = DMODEL; const int kb = item / nblk, nb = item % nblk, k0 = 64 * kb, n0 = 32 * nb;
    const int sc = wsrc_col(kind, n0 + (lane & 31));
#pragma unroll 8
    for (int i = 0; i < 32; ++i) { const int kk = 2 * i + (lane >> 5); const float g = gain ? gain[k0 + kk] : 1.0f;
        scr[kk * 33 + (lane & 31)] = (sc >= 0) ? W[(size_t)(k0 + kk) * Nsrc + sc] * g : 0.f; }
    LDS_WAIT(); asm volatile("" ::: "memory");
    const int c = lane & 7;
#pragma unroll
    for (int j = 0; j < 4; ++j) { const int n = (lane >> 3) + 8 * j; const LAS float* s = scr + (8 * c) * 33 + n;
        v4u o; o.x = pk2(s[0 * 33], s[1 * 33]); o.y = pk2(s[2 * 33], s[3 * 33]); o.z = pk2(s[4 * 33], s[5 * 33]); o.w = pk2(s[6 * 33], s[7 * 33]);
        *(GAS v4u*)(WT + (size_t)(n0 + n) * K + k0 + 8 * c) = o; }
    LDS_WAIT(); asm volatile("" ::: "memory");
}
typedef float f32x16 __attribute__((ext_vector_type(16)));
typedef float f32x2 __attribute__((ext_vector_type(2)));
typedef unsigned v2u __attribute__((ext_vector_type(2)));
typedef __bf16 bf16x2_t __attribute__((ext_vector_type(2)));
__device__ __forceinline__ unsigned cvtpk(float lo, float hi) { f32x2 v = {lo, hi}; bf16x2_t b = __builtin_convertvector(v, bf16x2_t); return __builtin_bit_cast(unsigned, b); }
__device__ __forceinline__ int crow16(int r, int hi) { return (r & 3) + 8 * (r >> 2) + 4 * hi; }
__device__ __forceinline__ f32x16 mfma32(bf16x8 a, bf16x8 b, f32x16 c) { return __builtin_amdgcn_mfma_f32_32x32x16_bf16(a, b, c, 0, 0, 0); }
__device__ __forceinline__ bf16x8 pack8(const f32x16& p, int s2) {
    v4u w; w.x = cvtpk(p[8 * s2 + 0], p[8 * s2 + 1]); w.y = cvtpk(p[8 * s2 + 2], p[8 * s2 + 3]); w.z = cvtpk(p[8 * s2 + 4], p[8 * s2 + 5]); w.w = cvtpk(p[8 * s2 + 6], p[8 * s2 + 7]);
    return __builtin_bit_cast(bf16x8, w);
}
__device__ __forceinline__ bf16x8 ld_perm8(const LAS bf16* p) {
    const v2u a = *(const LAS v2u*)p, b = *(const LAS v2u*)(p + 8);
    v4u w; w.x = a.x; w.y = a.y; w.z = b.x; w.w = b.y; return __builtin_bit_cast(bf16x8, w);
}

constexpr int LC = 64;
constexpr int LLD = 72;
constexpr int L1_W = 0, L1_BL = 16384, L1_BUF = 17408, L1_KZ = 0, L1_VT = 64 * LLD * 2, L1_BUFSZ = L1_VT + 128 * LLD * 2;
static_assert(L1_BUF + 2 * L1_BUFSZ <= RING_BYTES, "X1 LDS map");
constexpr int L3_TLD = 136, L3_ST = 8704, L3_WAVE = 9216;
static_assert(2 * 32 * 33 * 4 <= L3_ST && 32 * L3_TLD * 2 <= L3_ST && 8 * L3_WAVE <= RING_BYTES, "X3 LDS map");

struct LinArgs {
    bf16* Z; const float* GLR; const float* w_lr; const float* b_lr;
    const float* g1; const float* g2;
    float* KV; float* DEC; bf16* PREV; bf16* VP; bf16* Y;
};
struct LinRaw { v4u kx, qx, vx0, vx1; f32x4 gl[4]; };

template <bool ODD> __device__ __forceinline__ void lin_prep_load(Frame& F, const LinArgs& A, int u, LinRaw& R) {
    const int bh = u >> 6, n = u & 63, b = bh >> 2, h = bh & 3; const size_t row = (size_t)b * SEQ + n * LC + F.lane;
    const bf16* zr = A.Z + row * NZ;
    R.kx = *(const v4u*)(zr + ZC_LK + h * 64 + 8 * F.wave); R.qx = *(const v4u*)(zr + ZC_LQ + h * 64 + 8 * F.wave);
    R.vx0 = *(const v4u*)(zr + ZC_LV + h * 128 + 16 * F.wave); R.vx1 = *(const v4u*)(zr + ZC_LV + h * 128 + 16 * F.wave + 8);
    if (!ODD) {
#pragma unroll
        for (int i = 0; i < 4; ++i) R.gl[i] = *(const f32x4*)(A.GLR + row * 16 + 4 * i);
    }
}

template <bool ODD> __device__ __forceinline__ void lin_prep_phase(Frame& F, const LinArgs& A, const bool dry = false) {
    LAS float* wL = (LAS float*)(F.lds + RING_OFF + L1_W); LAS float* bL = (LAS float*)(F.lds + RING_OFF + L1_BL);
    if (!ODD) { for (int i = F.tid; i < 4096; i += 512) wL[i] = A.w_lr[i]; if (F.tid < 256) bL[F.tid] = A.b_lr[F.tid]; }
    const int r32 = F.lane & 31, hi = F.lane >> 5, w = F.wave;
    int u = F.vcu; int par = 0;
    LinRaw R;
    if (u < 2048) lin_prep_load<ODD>(F, A, u, R);
    __syncthreads();
    for (; u < 2048; u += F.G) {
        const int bh = u >> 6, n = u & 63, b = bh >> 2, h = bh & 3; const size_t row = (size_t)b * SEQ + n * LC + F.lane;
        LAS bf16* KzT = (LAS bf16*)(F.lds + RING_OFF + L1_BUF + par * L1_BUFSZ + L1_KZ); LAS bf16* VT = (LAS bf16*)(F.lds + RING_OFF + L1_BUF + par * L1_BUFSZ + L1_VT);
        float bv[8], blast[8];
        if (ODD) {
            const float lg = __logf(1.0f - exp2f(-5.0f - (float)h));
#pragma unroll
            for (int e = 0; e < 8; ++e) { bv[e] = lg * (float)(F.lane + 1); blast[e] = lg * 64.0f; }
        } else {
            const LAS float* wp = wL + h * 64 + 8 * w;
            f32x4 x0 = *(const LAS f32x4*)(bL + h * 64 + 8 * w), x1 = *(const LAS f32x4*)(bL + h * 64 + 8 * w + 4);
#pragma unroll
            for (int r = 0; r < 16; ++r) { const float g = R.gl[r >> 2][r & 3]; x0 += g * *(const LAS f32x4*)(wp + r * 256); x1 += g * *(const LAS f32x4*)(wp + r * 256 + 4); }
#pragma unroll
            for (int e = 0; e < 8; ++e) bv[e] = logsigmoid_fast(e < 4 ? x0[e & 3] : x1[e & 3]) * (1.0f / 16.0f);
#pragma unroll
            for (int o = 1; o < 64; o <<= 1) {
#pragma unroll
                for (int e = 0; e < 8; ++e) { const float y = __shfl_up(bv[e], o); if (F.lane >= o) bv[e] += y; }
            }
#pragma unroll
            for (int e = 0; e < 8; ++e) blast[e] = __shfl(bv[e], 63);
        }
        {
            v4u qo, ko;
#pragma unroll
            for (int e2 = 0; e2 < 4; ++e2) {
                const float q0 = bflo(R.qx[e2]), q1 = bfhi(R.qx[e2]), k0 = bflo(R.kx[e2]), k1 = bfhi(R.kx[e2]);
                const float e0 = __expf(bv[2 * e2]), e1 = __expf(bv[2 * e2 + 1]);
                qo[e2] = cvtpk(q0 * e0, q1 * e1);
                ko[e2] = cvtpk(k0 * __builtin_amdgcn_rcpf(e0), k1 * __builtin_amdgcn_rcpf(e1));
                KzT[(8 * w + 2 * e2) * LLD + F.lane] = (bf16)f2bf(k0 * __expf(blast[2 * e2] - bv[2 * e2]));
                KzT[(8 * w + 2 * e2 + 1) * LLD + F.lane] = (bf16)f2bf(k1 * __expf(blast[2 * e2 + 1] - bv[2 * e2 + 1]));
            }
            bf16* zr = dry ? A.PREV + row * 512 - ZC_LQ : A.Z + row * NZ;
            *(v4u*)(zr + ZC_LQ + h * 64 + 8 * w) = qo; *(v4u*)(zr + ZC_LK + h * 64 + 8 * w) = ko;
#pragma unroll
            for (int e = 0; e < 4; ++e) {
                VT[(16 * w + 2 * e) * LLD + F.lane] = (bf16)(R.vx0[e] & 0xffffu); VT[(16 * w + 2 * e + 1) * LLD + F.lane] = (bf16)(R.vx0[e] >> 16);
                VT[(16 * w + 8 + 2 * e) * LLD + F.lane] = (bf16)(R.vx1[e] & 0xffffu); VT[(16 * w + 8 + 2 * e + 1) * LLD + F.lane] = (bf16)(R.vx1[e] >> 16);
            }
            if (F.lane == 63) { float* dp = A.DEC + ((size_t)bh * 64 + n) * 64 + 8 * w;
#pragma unroll
                for (int e = 0; e < 8; ++e) dp[e] = __expf(blast[e]); }
        }
        if (u + F.G < 2048) lin_prep_load<ODD>(F, A, u + F.G, R);
        __syncthreads();
        {
            const int vb = w >> 1, db = w & 1;
            f32x16 acc = {};
#pragma unroll
            for (int s = 0; s < 4; ++s) {
                const bf16x8 a = *(const LAS bf16x8*)(VT + (vb * 32 + r32) * LLD + 16 * s + 8 * hi);
                const bf16x8 bb = *(const LAS bf16x8*)(KzT + (db * 32 + r32) * LLD + 16 * s + 8 * hi);
                acc = mfma32(a, bb, acc);
            }
            float* dst = A.KV + ((size_t)bh * 64 + n) * (128 * 64) + db * 32 + r32;
#pragma unroll
            for (int r = 0; r < 16; ++r) dst[(size_t)(vb * 32 + crow16(r, hi)) * 64] = acc[r];
            v4u* vp = (v4u*)(A.VP + ((size_t)bh * 64 + n) * (128 * 64));
#pragma unroll
            for (int e = 0; e < 2; ++e) { const int pi = F.tid + 512 * e, v = pi >> 3, j = pi & 7; const int base = 32 * (j >> 2) + 16 * ((j >> 1) & 1) + 4 * (j & 1);
                vp[pi] = __builtin_bit_cast(v4u, ld_perm8(VT + v * LLD + base)); }
        }
        par ^= 1;
    }
    __syncthreads();
}

__device__ __forceinline__ void lin_scan_phase(Frame& F, const LinArgs& A) {
    const int gt = F.vcu * 512 + F.tid;
    for (int e = gt; e < 32 * 128 * 32; e += F.G * 512) {
        const int bh = e >> 12, rem = e & 4095;
        const f32x2* kvp = (const f32x2*)(A.KV + (size_t)bh * 64 * (128 * 64) + rem * 2);
        const f32x2* dcp = (const f32x2*)(A.DEC + (size_t)bh * 64 * 64 + (rem & 31) * 2);
        unsigned* pp = (unsigned*)(A.PREV + (size_t)bh * 64 * (128 * 64) + rem * 2);
        f32x2 st = {0.f, 0.f};
        for (int n0 = 0; n0 < 64; n0 += 8) {
            f32x2 kv[8], dc[8];
#pragma unroll
            for (int i = 0; i < 8; ++i) { kv[i] = kvp[(size_t)(n0 + i) * 4096]; dc[i] = dcp[(n0 + i) * 32]; }
#pragma unroll
            for (int i = 0; i < 8; ++i) { pp[(size_t)(n0 + i) * 4096] = cvtpk(st.x, st.y); st = st * dc[i] + kv[i]; }
        }
    }
}

__device__ __forceinline__ void wave_lds_sync() { asm volatile("s_waitcnt lgkmcnt(0)" ::: "memory"); }

template <bool ODD> __device__ __forceinline__ void lin_out_wave(Frame& F, const LinArgs& A, int wu) {
    const int c = wu >> 1, qi = wu & 1, bh = c >> 6, n = c & 63, b = bh >> 2, h = bh & 3;
    const int r32 = F.lane & 31, hi = F.lane >> 5;
    const size_t row0 = (size_t)b * SEQ + n * LC;
    const bf16* zq = A.Z + (row0 + qi * 32 + r32) * NZ + ZC_LQ + h * 64 + 8 * hi;
    const bf16* zk = A.Z + (row0 + r32) * NZ + ZC_LK + h * 64 + 8 * hi;
    bf16x8 qf[4];
#pragma unroll
    for (int s = 0; s < 4; ++s) qf[s] = *(const bf16x8*)(zq + 16 * s);
    f32x16 st0 = {}, st1 = {};
#pragma unroll
    for (int s = 0; s < 4; ++s) st0 = mfma32(*(const bf16x8*)(zk + 16 * s), qf[s], st0);
    if (qi == 1) {
#pragma unroll
        for (int s = 0; s < 4; ++s) st1 = mfma32(*(const bf16x8*)(zk + (size_t)32 * NZ + 16 * s), qf[s], st1);
    }
#pragma unroll
    for (int r = 0; r < 16; ++r) { const int kl = crow16(r, hi); if (qi == 0) { if (kl > r32) st0[r] = 0.f; } else { if (kl > r32) st1[r] = 0.f; } }
    const bf16x8 pa00 = pack8(st0, 0), pa01 = pack8(st0, 1), pa10 = pack8(st1, 0), pa11 = pack8(st1, 1);
    const bf16* vp = A.VP + ((size_t)c * 128 + r32) * 64 + 8 * hi;
    const bf16* pp = A.PREV + ((size_t)c * 128 + r32) * 64 + 8 * hi;
    f32x16 o[4];
#pragma unroll
    for (int vj = 0; vj < 4; ++vj) {
        f32x16 acc = {};
        acc = mfma32(pa00, *(const bf16x8*)(vp + vj * 2048), acc);
        acc = mfma32(pa01, *(const bf16x8*)(vp + vj * 2048 + 16), acc);
        if (qi == 1) { acc = mfma32(pa10, *(const bf16x8*)(vp + vj * 2048 + 32), acc); acc = mfma32(pa11, *(const bf16x8*)(vp + vj * 2048 + 48), acc); }
#pragma unroll
        for (int s = 0; s < 4; ++s) acc = mfma32(qf[s], *(const bf16x8*)(pp + vj * 2048 + 16 * s), acc);
        o[vj] = acc;
    }
    LAS unsigned char* scr = F.lds + RING_OFF + F.wave * L3_WAVE;
    LAS float* S1 = (LAS float*)scr; LAS float* S2 = S1 + 32 * 33; LAS f32x2* ST = (LAS f32x2*)(scr + L3_ST); LAS bf16* T = (LAS bf16*)scr;
#pragma unroll
    for (int r = 0; r < 16; ++r) {
        const float a0 = o[0][r], a1 = o[1][r], a2 = o[2][r], a3 = o[3][r];
        S1[crow16(r, hi) * 33 + r32] = (a0 + a1) + (a2 + a3); S2[crow16(r, hi) * 33 + r32] = (a0 * a0 + a1 * a1) + (a2 * a2 + a3 * a3);
    }
    wave_lds_sync();
    {
        float t1 = 0.f, t2 = 0.f;
#pragma unroll
        for (int j = 0; j < 16; ++j) { t1 += S1[r32 * 33 + 16 * hi + j]; t2 += S2[r32 * 33 + 16 * hi + j]; }
        t1 += __shfl_xor(t1, 32); t2 += __shfl_xor(t2, 32);
        const float mu = ODD ? t1 * (1.0f / 128.0f) : 0.f;
        const float var = t2 * (1.0f / 128.0f) - mu * mu;
        if (hi == 0) ST[r32] = (f32x2){mu, 1.0f / sqrtf(fmaxf(var, 0.f) + RMS_EPS)};
    }
    wave_lds_sync();
    f32x2 stt[16];
#pragma unroll
    for (int r = 0; r < 16; ++r) stt[r] = ST[crow16(r, hi)];
    wave_lds_sync();
    const int yb = ODD ? 0 : 512;
#pragma unroll
    for (int vj = 0; vj < 4; ++vj) {
        const float g1 = A.g1[h * 128 + vj * 32 + r32]; const float g2 = ODD ? A.g2[h * 128 + vj * 32 + r32] : 0.f;
#pragma unroll
        for (int r = 0; r < 16; ++r) T[crow16(r, hi) * L3_TLD + vj * 32 + r32] = (bf16)f2bf((o[vj][r] - stt[r].x) * stt[r].y * g1 + g2);
    }
    wave_lds_sync();
#pragma unroll
    for (int e = 0; e < 8; ++e) {
        const int pi = F.lane + 64 * e, rw = pi >> 4, pc = pi & 15; const size_t row = row0 + qi * 32 + rw;
        const v4u t = *(const LAS v4u*)(T + rw * L3_TLD + pc * 8);
        const v4u g = *(const v4u*)(A.Z + row * NZ + ZC_GATE + yb + h * 128 + pc * 8);
        v4u ov;
#pragma unroll
        for (int q = 0; q < 4; ++q) ov[q] = cvtpk(bflo(t[q]) * bflo(g[q]), bfhi(t[q]) * bfhi(g[q]));
        *(v4u*)(A.Y + row * DMODEL + yb + h * 128 + pc * 8) = ov;
    }
    wave_lds_sync();
}

constexpr int DK_LD = 72;
constexpr int DV_LD = 392;
constexpr int DA_K = 0, DA_VT = DA_K + 384 * DK_LD * 2, DA_WS = DA_VT + 64 * DV_LD * 2, DA_END = DA_WS + 8 * 128 * 4;
static_assert(DA_END <= RING_BYTES, "dilated-attention LDS map");

template <int PAT> __device__ __forceinline__ void dil_unit(Frame& F, const bf16* Z, bf16* Y, float* LSE, int u) {
    constexpr int DIL = (PAT == 0) ? 1 : (PAT == 1) ? 4 : 16;
    const int bh = u >> 4, rem = u & 15, b = bh >> 3, h = bh & 7, r = rem % DIL, blk = rem / DIL, i0 = 256 * blk;
    LAS bf16* KL = (LAS bf16*)(F.lds + RING_OFF + DA_K); LAS bf16* VT = (LAS bf16*)(F.lds + RING_OFF + DA_VT);
    LAS float* wsc = (LAS float*)(F.lds + RING_OFF + DA_WS) + F.wave * 128;
    const int r32 = F.lane & 31, hi = F.lane >> 5;
    const bf16* zb = Z + (size_t)b * SEQ * NZ + h * 64;
    __syncthreads();
#pragma unroll
    for (int e = 0; e < 6; ++e) {
        const int pi = F.tid + 512 * e, row = pi >> 3, c = pi & 7, idx = i0 - 128 + row;
        v4u kx = {0u, 0u, 0u, 0u}, vx = {0u, 0u, 0u, 0u};
        if (idx >= 0) { const bf16* tp = zb + (size_t)(idx * DIL + r) * NZ; kx = *(const v4u*)(tp + ZC_AK + 8 * c); vx = *(const v4u*)(tp + ZC_AV + 8 * c); }
        *(LAS v4u*)(KL + row * DK_LD + 8 * c) = kx;
#pragma unroll
        for (int q = 0; q < 4; ++q) { VT[(8 * c + 2 * q) * DV_LD + row] = (bf16)(vx[q] & 0xffffu); VT[(8 * c + 2 * q + 1) * DV_LD + row] = (bf16)(vx[q] >> 16); }
    }
    const int qidx = i0 + 32 * F.wave + r32; const size_t qrow = (size_t)b * SEQ + (size_t)qidx * DIL + r;
    bf16x8 qf[4];
#pragma unroll
    for (int s = 0; s < 4; ++s) qf[s] = *(const bf16x8*)(Z + qrow * NZ + ZC_AQ + h * 64 + 16 * s + 8 * hi);
    __syncthreads();
    const int kb_lo = (i0 + 32 * F.wave - 128 < 0) ? (128 - i0 - 32 * F.wave) / 32 : 0;
    f32x16 st[5];
#pragma unroll
    for (int kb = 0; kb < 5; ++kb) {
        st[kb] = (f32x16){};
        if (kb >= kb_lo) {
#pragma unroll
            for (int s = 0; s < 4; ++s) { const bf16x8 kf = *(const LAS bf16x8*)(KL + (32 * F.wave + 32 * kb + r32) * DK_LD + 16 * s + 8 * hi); st[kb] = mfma32(kf, qf[s], st[kb]); }
        }
    }
    float mx = -INFINITY;
#pragma unroll
    for (int kb = 0; kb < 5; ++kb)
#pragma unroll
        for (int rr = 0; rr < 16; ++rr) {
            const int kl = crow16(rr, hi); bool ok = kb >= kb_lo;
            if (kb == 0) ok = ok && (kl >= r32);
            if (kb == 4) ok = ok && (kl <= r32);
            const float sv = ok ? st[kb][rr] : -INFINITY; st[kb][rr] = sv; mx = fmaxf(mx, sv);
        }
    mx = fmaxf(mx, __shfl_xor(mx, 32));
    float l = 0.f;
#pragma unroll
    for (int kb = 0; kb < 5; ++kb)
#pragma unroll
        for (int rr = 0; rr < 16; ++rr) { const float p = exp2f(st[kb][rr] - mx); st[kb][rr] = p; l += p; }
    l += __shfl_xor(l, 32);
    f32x16 o0 = {}, o1 = {};
#pragma unroll
    for (int kb = 0; kb < 5; ++kb) {
        if (kb >= kb_lo) {
#pragma unroll
            for (int s2 = 0; s2 < 2; ++s2) {
                const bf16x8 pa = pack8(st[kb], s2);
                const int base = 32 * F.wave + 32 * kb + 16 * s2 + 4 * hi;
                o0 = mfma32(pa, ld_perm8(VT + r32 * DV_LD + base), o0);
                o1 = mfma32(pa, ld_perm8(VT + (32 + r32) * DV_LD + base), o1);
            }
        }
    }
    const float lse_cur = mx + __log2f(l);
    float w_old = 0.f, w_cur = 1.0f / l;
    if (PAT > 0) {
        const float lse_old = LSE[qrow * 8 + h];
        const float m2 = fmaxf(lse_old, lse_cur), lse_new = m2 + __log2f(exp2f(lse_old - m2) + exp2f(lse_cur - m2));
        w_old = exp2f(lse_old - lse_new); w_cur = exp2f(lse_cur - lse_new) / l;
        if (PAT < 2 && hi == 0) LSE[qrow * 8 + h] = lse_new;
    } else { if (hi == 0) LSE[qrow * 8 + h] = lse_cur; }
    if (hi == 0) { wsc[r32] = w_old; wsc[32 + r32] = w_cur; }
    wave_lds_sync();
#pragma unroll
    for (int rr = 0; rr < 16; ++rr) {
        const int ql = crow16(rr, hi); const float wo = wsc[ql], wc = wsc[32 + ql];
        const size_t row = (size_t)b * SEQ + (size_t)(i0 + 32 * F.wave + ql) * DIL + r;
        bf16* yp = Y + row * DMODEL + 512 + h * 64 + r32;
        float a0 = o0[rr] * wc, a1 = o1[rr] * wc;
        if (PAT > 0) { a0 += wo * bf1(yp[0]); a1 += wo * bf1(yp[32]); }
        if (PAT == 2) { const bf16* gp = Z + row * NZ + ZC_GATE + 512 + h * 64 + r32; a0 *= bf1(gp[0]); a1 *= bf1(gp[32]); }
        yp[0] = (bf16)f2bf(a0); yp[32] = (bf16)f2bf(a1);
    }
}
struct Args { const float* in[14]; float* out; unsigned char* ws; int ph_lo, ph_hi, li, pad; };

constexpr size_t W_LAYER_BYTES = 9 * MiB;
__device__ __forceinline__ bf16* w_in_ptr(unsigned char* ws, int L) { return (bf16*)(ws + WS_W + (size_t)L * W_LAYER_BYTES); }
__device__ __forceinline__ bf16* w_out_ptr(unsigned char* ws, int L) { return (bf16*)(ws + WS_W + (size_t)L * W_LAYER_BYTES + 7 * MiB); }

__device__ __forceinline__ void p0_prologue(Frame& F, const Args& a) {
    LAS float* scr = (LAS float*)(F.lds + RING_OFF + F.wave * 16384);
    const int gw = F.vcu * NWAVES + F.wave, NGW = F.G * NWAVES;
    constexpr int I_IN = 16 * 112, I_OUT = 16 * 32, I_SK = 16, PER_LAYER = I_IN + I_OUT, NITEMS = 4 * PER_LAYER + 2 * I_SK;
    for (int it = gw; it < NITEMS; it += NGW) {
        if (it < 4 * PER_LAYER) {
            const int L = it / PER_LAYER; int r = it % PER_LAYER; const int j = L >> 1, odd = L & 1;
            if (r < I_IN) {
                const float* W = odd ? a.in[9] + (size_t)j * DMODEL * ODD_IN : a.in[2] + (size_t)j * DMODEL * EVEN_IN;
                const float* gain = (odd ? a.in[8] : a.in[1]) + j * DMODEL;
                p0_transpose_item(W, odd ? ODD_IN : EVEN_IN, odd ? 1 : 0, gain, w_in_ptr(a.ws, L), 112, scr, r, F.lane);
            } else {
                r -= I_IN;
                const float* W = (odd ? a.in[12] : a.in[7]) + (size_t)j * DMODEL * DMODEL;
                p0_transpose_item(W, DMODEL, 2, nullptr, w_out_ptr(a.ws, L), 32, scr, r, F.lane);
            }
        } else {
            const int r = it - 4 * PER_LAYER; const int j = r / I_SK;
            p0_transpose_item(a.in[2] + (size_t)j * DMODEL * EVEN_IN, EVEN_IN, 3, a.in[1] + j * DMODEL, (bf16*)(a.ws + WS_WSK) + (size_t)j * 32 * DMODEL, 1, scr, r % I_SK, F.lane);
        }
    }
    {
        bf16* HB = (bf16*)(a.ws + WS_HB); float* SS = (float*)(a.ws + WS_SS);
        for (int m = gw; m < M; m += NGW) {
            const GAS f32x4* xr = (const GAS f32x4*)(a.in[0] + (size_t)m * DMODEL) + F.lane;
            GAS unsigned long long* o8 = (GAS unsigned long long*)(HB + (size_t)m * DMODEL) + F.lane;
            float s = 0.f; f32x4 v[4];
#pragma unroll
            for (int j = 0; j < 4; ++j) v[j] = xr[64 * j];
#pragma unroll
            for (int j = 0; j < 4; ++j) { s += (v[j].x * v[j].x + v[j].y * v[j].y) + (v[j].z * v[j].z + v[j].w * v[j].w);
                o8[64 * j] = (unsigned long long)pk2(v[j].x, v[j].y) | ((unsigned long long)pk2(v[j].z, v[j].w) << 32); }
            s = wave_sum(s);
            if (F.lane < 16) SS[(size_t)m * 16 + F.lane] = (F.lane == 0) ? s : 0.f;
        }
    }
    {
        float* RP = (float*)(a.ws + WS_ROPE);
        for (int e = F.vcu * 512 + F.tid; e < SEQ * 32; e += F.G * 512) {
            const int t = e >> 5, j = e & 31;
            const float inv = (float)exp(-(double)j * (9.210340371976184 / 32.0));
            const float ang = (float)t * inv;
            double sn, cs; sincos((double)ang, &sn, &cs);
            RP[2 * e] = (float)cs; RP[2 * e + 1] = (float)sn;
        }
    }
}

__device__ __forceinline__ void skinny_phase(Frame& F, const bf16* HB, const bf16* WSK, const float* SS, const float* b_f, float* FFo, float* GLRo) {
    typedef float f32x4_t __attribute__((ext_vector_type(4)));
    const int lr = F.lane & 15, kq = F.lane >> 4;
    for (int rb = blockIdx.x; rb < M / 128; rb += F.G) {
        const int r0 = rb * 128 + F.wave * 16;
        f32x4_t acc0 = {0.f, 0.f, 0.f, 0.f}, acc1 = {0.f, 0.f, 0.f, 0.f};
        const bf16* ap = HB + (size_t)(r0 + lr) * DMODEL + 8 * kq;
        const bf16* bp0 = WSK + (size_t)lr * DMODEL + 8 * kq;
        const bf16* bp1 = WSK + (size_t)(16 + lr) * DMODEL + 8 * kq;
        for (int k0 = 0; k0 < DMODEL; k0 += 256) {
            bf16x8 av[8], b0[8], b1[8];
#pragma unroll
            for (int i = 0; i < 8; ++i) { av[i] = *(const bf16x8*)(ap + k0 + 32 * i); b0[i] = *(const bf16x8*)(bp0 + k0 + 32 * i); b1[i] = *(const bf16x8*)(bp1 + k0 + 32 * i); }
#pragma unroll
            for (int i = 0; i < 8; ++i) { acc0 = __builtin_amdgcn_mfma_f32_16x16x32_bf16(av[i], b0[i], acc0, 0, 0, 0); acc1 = __builtin_amdgcn_mfma_f32_16x16x32_bf16(av[i], b1[i], acc1, 0, 0, 0); }
        }
#pragma unroll
        for (int reg = 0; reg < 4; ++reg) {
            const int row = r0 + 4 * kq + reg;
            const f32x4* sp = (const f32x4*)(SS + (size_t)row * 16);
            const f32x4 s0 = sp[0], s1 = sp[1], s2 = sp[2], s3 = sp[3];
            const float tot = ((s0[0] + s0[1]) + (s0[2] + s0[3])) + ((s1[0] + s1[1]) + (s1[2] + s1[3])) + ((s2[0] + s2[1]) + (s2[2] + s2[3])) + ((s3[0] + s3[1]) + (s3[2] + s3[3]));
            const float rinv = 1.0f / sqrtf(tot * (1.0f / 1024.0f) + RMS_EPS);
            const float v0 = acc0[reg] * rinv, v1 = acc1[reg] * rinv;
            if (lr < 8) { FFo[(size_t)row * 8 + lr] = logsigmoidf(v0 + b_f[lr]); GLRo[(size_t)row * 16 + 8 + lr] = v1; }
            else GLRo[(size_t)row * 16 + (lr - 8)] = v0;
        }
    }
}

__device__ __forceinline__ void fox_norm_unit(Frame& F, int u, const bf16* Z, float* KN, float* QN) {
    const int bh = u >> 2, qz = u & 3, b = bh >> 3, h = bh & 7;
    float k2 = 0.f, q2 = 0.f;
#pragma unroll
    for (int rr = 0; rr < 2; ++rr) {
        const size_t row = (size_t)b * SEQ + 1024 * qz + 128 * F.wave + 2 * F.lane + rr;
        const v4u* kp = (const v4u*)(Z + row * NZ + ZC_AK + h * 64); const v4u* qp = (const v4u*)(Z + row * NZ + ZC_AQ + h * 64);
        v4u kx[8], qx[8];
#pragma unroll
        for (int c = 0; c < 8; ++c) { kx[c] = kp[c]; qx[c] = qp[c]; }
        float ks = 0.f, qs = 0.f;
#pragma unroll
        for (int c = 0; c < 8; ++c)
#pragma unroll
            for (int e = 0; e < 4; ++e) { const float a = bflo(kx[c][e]), bb = bfhi(kx[c][e]), cc = bflo(qx[c][e]), dd = bfhi(qx[c][e]); ks += a * a + bb * bb; qs += cc * cc + dd * dd; }
        k2 = fmaxf(k2, ks); q2 = fmaxf(q2, qs);
    }
#pragma unroll
    for (int o = 1; o < 32; o <<= 1) { k2 = fmaxf(k2, __shfl_xor(k2, o)); q2 = fmaxf(q2, __shfl_xor(q2, o)); }
    q2 = fmaxf(q2, __shfl_xor(q2, 32));
    if ((F.lane & 31) == 0) KN[bh * 64 + qz * 16 + 2 * F.wave + (F.lane >> 5)] = sqrtf(k2) * 1.001f;
    if (F.lane == 0) QN[bh * 32 + qz * 8 + F.wave] = sqrtf(q2) * 1.001f;
}

__device__ __forceinline__ void cumsum_unit(Frame& F, int bh, const float* FFp, float* CB) {
    LAS float* wsum = (LAS float*)(F.lds + RING_OFF);
    const int b = bh >> 3, h = bh & 7;
    float v[8]; float run = 0.f;
#pragma unroll
    for (int i = 0; i < 8; ++i) { run += FFp[((size_t)b * SEQ + F.tid * 8 + i) * 8 + h]; v[i] = run; }
    float x = run;
#pragma unroll
    for (int o = 1; o < 64; o <<= 1) { const float y = __shfl_up(x, o); if (F.lane >= o) x += y; }
    if (F.lane == 63) wsum[F.wave] = x;
    __syncthreads();
    float off = x - run;
    for (int w = 0; w < F.wave; ++w) off += wsum[w];
#pragma unroll
    for (int i = 0; i < 8; ++i) CB[(size_t)bh * SEQ + F.tid * 8 + i] = v[i] + off;
    __syncthreads();
}

__device__ __forceinline__ void lin_naive_unit(Frame& F, int b, bool odd, const bf16* Z, const float* GLRp, const float* w_lr, const float* b_lr, const float* g1, const float* g2, bf16* Y) {
    float* qs = (float*)(F.lds + RING_OFF);
    float* ks = qs + 4096;
    float* al = ks + 4096;
    float* vs = al + 4096;
    float* os = vs + 8192;
    const int tid = F.tid, hd = tid >> 7;
    float S[64];
#pragma unroll
    for (int d = 0; d < 64; ++d) S[d] = 0.f;
    for (int t0 = 0; t0 < SEQ; t0 += 16) {
        for (int i = 0; i < 8; ++i) {
            const int e = tid + 512 * i, tok = e >> 8, c = e & 255; const size_t row = (size_t)b * SEQ + t0 + tok;
            qs[e] = bf1(Z[row * NZ + ZC_LQ + c]); ks[e] = bf1(Z[row * NZ + ZC_LK + c]);
            float a;
            if (odd) a = 1.0f - exp2f(-5.0f - (float)(c >> 6));
            else { float x = b_lr[c];
#pragma unroll
                for (int r = 0; r < 16; ++r) x += GLRp[row * 16 + r] * w_lr[r * 256 + c];
                a = __expf(logsigmoidf(x) * (1.0f / 16.0f)); }
            al[e] = a;
        }
        for (int i = 0; i < 16; ++i) vs[i * 512 + tid] = bf1(Z[((size_t)b * SEQ + t0 + i) * NZ + ZC_LV + tid]);
        __syncthreads();
        for (int tok = 0; tok < 16; ++tok) {
            const f32x4* q4 = (const f32x4*)(qs + tok * 256 + hd * 64); const f32x4* k4 = (const f32x4*)(ks + tok * 256 + hd * 64); const f32x4* a4 = (const f32x4*)(al + tok * 256 + hd * 64);
            const float vv = vs[tok * 512 + tid]; float o = 0.f;
#pragma unroll
            for (int d4 = 0; d4 < 16; ++d4) { const f32x4 qq = q4[d4], kk = k4[d4], aa = a4[d4];
#pragma unroll
                for (int e = 0; e < 4; ++e) { S[4 * d4 + e] = aa[e] * S[4 * d4 + e] + kk[e] * vv; o += qq[e] * S[4 * d4 + e]; } }
            os[tok * 512 + tid] = o;
        }
        __syncthreads();
        for (int i = 0; i < 8; ++i) {
            const int p = F.wave * 8 + i, tok = p >> 2, hh = p & 3; const size_t row = (size_t)b * SEQ + t0 + tok;
            float x0 = os[tok * 512 + hh * 128 + F.lane], x1 = os[tok * 512 + hh * 128 + 64 + F.lane];
            if (odd) { const float mu = wave_sum(x0 + x1) * (1.0f / 128.0f); x0 -= mu; x1 -= mu; }
            const float var = wave_sum(x0 * x0 + x1 * x1) * (1.0f / 128.0f); const float rs = 1.0f / sqrtf(var + RMS_EPS);
            const int c0 = hh * 128 + F.lane, c1 = c0 + 64;
            float y0 = x0 * rs * g1[c0], y1 = x1 * rs * g1[c1];
            if (odd) { y0 += g2[c0]; y1 += g2[c1]; }
            const int yb = odd ? 0 : 512;
            y0 *= bf1(Z[row * NZ + ZC_GATE + yb + c0]); y1 *= bf1(Z[row * NZ + ZC_GATE + yb + c1]);
            Y[row * DMODEL + yb + c0] = (bf16)f2bf(y0); Y[row * DMODEL + yb + c1] = (bf16)f2bf(y1);
        }
        __syncthreads();
    }
}

__device__ __forceinline__ void dil_naive_unit(Frame& F, int u, const bf16* Z, bf16* Y) {
    const int bh = u >> 3, tb = u & 7, b = bh >> 3, h = bh & 7, t = tb * 512 + F.tid;
    const bf16* zb = Z + (size_t)b * SEQ * NZ;
    float q[64], acc[64];
    { const v4u* qp = (const v4u*)(zb + (size_t)t * NZ + ZC_AQ + h * 64);
#pragma unroll
      for (int c = 0; c < 8; ++c) { const v4u w = qp[c];
#pragma unroll
          for (int e = 0; e < 4; ++e) { q[8 * c + 2 * e] = bflo(w[e]); q[8 * c + 2 * e + 1] = bfhi(w[e]); } } }
#pragma unroll
    for (int d = 0; d < 64; ++d) acc[d] = 0.f;
    float mx = -INFINITY, l = 0.f;
    for (int p = 0; p < 3; ++p) {
        const int dil = (p == 0) ? 1 : (p == 1) ? 4 : 16;
        for (int j = 0; j <= 128; ++j) {
            const int pos = t - j * dil; if (pos < 0) break;
            const v4u* kp = (const v4u*)(zb + (size_t)pos * NZ + ZC_AK + h * 64);
            float s = 0.f;
#pragma unroll
            for (int c = 0; c < 8; ++c) { const v4u w = kp[c];
#pragma unroll
                for (int e = 0; e < 4; ++e) { s += q[8 * c + 2 * e] * bflo(w[e]); s += q[8 * c + 2 * e + 1] * bfhi(w[e]); } }
            if (s > mx) { const float sc = exp2f(mx - s); l *= sc;
#pragma unroll
                for (int d = 0; d < 64; ++d) acc[d] *= sc;
                mx = s; }
            const float pr = exp2f(s - mx); l += pr;
            const v4u* vp = (const v4u*)(zb + (size_t)pos * NZ + ZC_AV + h * 64);
#pragma unroll
            for (int c = 0; c < 8; ++c) { const v4u w = vp[c];
#pragma unroll
                for (int e = 0; e < 4; ++e) { acc[8 * c + 2 * e] += pr * bflo(w[e]); acc[8 * c + 2 * e + 1] += pr * bfhi(w[e]); } }
        }
    }
    const float inv = 1.0f / l; const size_t row = (size_t)b * SEQ + t;
    const v4u* gp = (const v4u*)(Z + row * NZ + ZC_GATE + 512 + h * 64); v4u* yp = (v4u*)(Y + row * DMODEL + 512 + h * 64);
#pragma unroll
    for (int c = 0; c < 8; ++c) { const v4u g = gp[c]; v4u o;
#pragma unroll
        for (int e = 0; e < 4; ++e) o[e] = pk2(acc[8 * c + 2 * e] * inv * bflo(g[e]), acc[8 * c + 2 * e + 1] * inv * bfhi(g[e]));
        yp[c] = o; }
}

__device__ __forceinline__ void final_norm_phase(Frame& F, const bf16* HB, const float* SS, float* out, const float* g) {
    const int gw = F.vcu * NWAVES + F.wave, NGW = F.G * NWAVES;
    f32x4 gv[4];
#pragma unroll
    for (int j = 0; j < 4; ++j) gv[j] = ((const f32x4*)g)[F.lane + 64 * j];
    for (int m = gw; m < M; m += NGW) {
        const float sv = (F.lane < 16) ? SS[(size_t)m * 16 + F.lane] : 0.f;
        const float r = 1.0f / sqrtf(wave_sum(sv) * (1.0f / 1024.0f) + RMS_EPS);
        const GAS unsigned long long* hr = (const GAS unsigned long long*)(HB + (size_t)m * DMODEL) + F.lane;
        GAS f32x4* xr = (GAS f32x4*)(out + (size_t)m * DMODEL) + F.lane;
#pragma unroll
        for (int j = 0; j < 4; ++j) { const unsigned long long w = hr[64 * j]; const unsigned lo = (unsigned)w, hi2 = (unsigned)(w >> 32);
            f32x4 v; v.x = bflo(lo); v.y = bfhi(lo); v.z = bflo(hi2); v.w = bfhi(hi2); xr[64 * j] = v * r * gv[j]; }
    }
}

constexpr int PH_PER_LAYER = 5, N_PHASES = 2 + 4 * PH_PER_LAYER;
#ifndef MK_N_LAUNCHES
#define MK_N_LAUNCHES 1
#endif

#define IN(k) (lo <= (k) && (k) < hi)
#define SEAM(k) do { if (IN(k) && IN((k) + 1)) { for (int rb_ = 0; rb_ < REP_BAR; ++rb_) xcd_barrier(bar); } } while (0)
__device__ __forceinline__ unsigned char* launder_ptr(unsigned char* p) { asm volatile("" : "+s"(p)); return p; }
__device__ __forceinline__ void refresh(Frame& F) { int t = threadIdx.x; asm volatile("" : "+v"(t)); F.tid = t; F.lane = t & 63; F.wave = __builtin_amdgcn_readfirstlane(t >> 6); }
#ifndef REP_PRO
#define REP_PRO 1
#endif
#ifndef REP_INPROJ
#define REP_INPROJ 1
#endif
#ifndef REP_OUT0
#define REP_OUT0 1
#endif
#ifndef REP_X1
#define REP_X1 1
#endif
#ifndef REP_X1_PAR
#define REP_X1_PAR 2
#endif
#ifndef REP_X2
#define REP_X2 1
#endif
#ifndef REP_X3
#define REP_X3 1
#endif
#ifndef REP_FOX
#define REP_FOX 1
#endif
#ifndef REP_DIL0
#define REP_DIL0 1
#endif
#ifndef REP_BAR
#define REP_BAR 1
#endif
#ifndef LIN_MFMA
#define LIN_MFMA 1
#endif
#ifndef DIL_MFMA
#define DIL_MFMA 1
#endif
template <int L> __device__ __forceinline__ LinArgs make_lin_args(unsigned char* ws, const Args& args) {
    constexpr int j = L >> 1; constexpr bool odd = (L & 1) != 0;
    LinArgs A;
    A.Z = (bf16*)(ws + WS_Z); A.GLR = (const float*)(ws + WS_GLR); A.w_lr = args.in[4] + (size_t)j * 16 * 256; A.b_lr = args.in[5] + j * 256;
    A.g1 = odd ? args.in[10] + j * 512 : args.in[6] + j * 512; A.g2 = odd ? args.in[11] + j * 512 : nullptr;
    A.KV = (float*)(ws + WS_KV); A.DEC = (float*)(ws + WS_DECAY); A.PREV = (bf16*)(ws + WS_PREV); A.VP = (bf16*)args.out; A.Y = (bf16*)(ws + WS_Y);
    return A;
}
template <int L> __device__ __forceinline__ void run_layer(Frame& F, const Args& args, const XcdBarrier& bar, const int lo, const int hi, unsigned char* lds) {
    constexpr int pb = 1 + PH_PER_LAYER * L; constexpr int j = L >> 1; constexpr bool odd = (L & 1) != 0;
    if (IN(pb)) {
        unsigned char* ws = launder_ptr(args.ws); refresh(F);
        bf16* Z = (bf16*)(ws + WS_Z); bf16* HB = (bf16*)(ws + WS_HB); float* SS = (float*)(ws + WS_SS);
        pg8::Gemm g{HB, w_in_ptr(ws, L), M, NZ, DMODEL}; pg8::StaticOrder S; S.init(M, NZ, F.G, (int)blockIdx.x);
        LAS float* rtab = (LAS float*)(F.lds + LDSCTL_OFF + 1024); LAS int* rtag = (LAS int*)(F.lds + LDSCTL_OFF + 1024 + 2048);
        pg8::epi_in_fill(S, SS, rtab, rtag);
        pg8::EpiIn E{Z, NZ, SS, (const float*)(ws + WS_ROPE), odd ? 1 : 0, 0.125f, C2, rtab, rtag};
        for (int rp_ = 0; rp_ < REP_INPROJ; ++rp_) {
        pg8::gemm_phase<pg8::EpiIn, pg8::StaticOrder, true, true>(F.lds + RING_OFF, g, S, E);
        if (!odd) skinny_phase(F, HB, (const bf16*)(ws + WS_WSK) + (size_t)j * 32 * DMODEL, SS, args.in[3] + j * 8, (float*)(ws + WS_FF), (float*)(ws + WS_GLR));
        }
    }
    SEAM(pb);
    if (IN(pb + 1)) {
        unsigned char* ws = launder_ptr(args.ws); refresh(F);
        bf16* Z = (bf16*)(ws + WS_Z); bf16* Y = (bf16*)(ws + WS_Y);
#if LIN_MFMA
        { const LinArgs A = make_lin_args<L>(ws, args); for (int rp_ = 1; rp_ < ((REP_X1_PAR == 2 || REP_X1_PAR == (odd ? 1 : 0)) ? REP_X1 : 1); ++rp_) lin_prep_phase<odd>(F, A, true); lin_prep_phase<odd>(F, A); }
#else
        for (int u = blockIdx.x; u < 8; u += F.G) lin_naive_unit(F, u, odd, Z, (const float*)(ws + WS_GLR), args.in[4] + (size_t)j * 16 * 256, args.in[5] + j * 256, odd ? args.in[10] + j * 512 : args.in[6] + j * 512, odd ? args.in[11] + j * 512 : nullptr, Y);
#endif
        if (!odd) { for (int u = F.vcu; u < 64; u += F.G) cumsum_unit(F, u, (const float*)(ws + WS_FF), (float*)(ws + WS_CB));
                    for (int u = F.vcu; u < 256; u += F.G) fox_norm_unit(F, u, Z, (float*)(ws + WS_KN), (float*)(ws + WS_QN)); }
        else {
#if DIL_MFMA
            for (int rp_ = 0; rp_ < REP_DIL0; ++rp_) for (int u = F.vcu; u < 1024; u += F.G) dil_unit<0>(F, Z, Y, (float*)(ws + WS_LSE), u);
#else
            for (int u = blockIdx.x; u < 512; u += F.G) dil_naive_unit(F, u, Z, Y);
#endif
        }
    }
    SEAM(pb + 1);
    if (IN(pb + 2)) {
        unsigned char* ws = launder_ptr(args.ws); refresh(F);
#if LIN_MFMA
        { const LinArgs A = make_lin_args<L>(ws, args); for (int rp_ = 0; rp_ < REP_X2; ++rp_) lin_scan_phase(F, A); }
#endif
        if (!odd) {
            bf16* Z = (bf16*)(ws + WS_Z);
            const attn_body::AttnTensors AT{(const attn_body::bf16*)(Z + ZC_AQ), (const attn_body::bf16*)(Z + ZC_AK), (const attn_body::bf16*)(Z + ZC_AV), (const attn_body::bf16*)(Z + ZC_GATE), (const float*)(ws + WS_CB), (const float*)(ws + WS_KN), (const float*)(ws + WS_QN), (attn_body::bf16*)(ws + WS_Y)};
            const attn_body::StaticOrder S((int)F.G, (int)blockIdx.x, 0);
            for (int rp_ = 0; rp_ < REP_FOX; ++rp_) attn_body::attn_phase<attn_body::StaticOrder>((char*)lds + RING_OFF, AT, S);
        } else {
#if DIL_MFMA
            for (int u = F.vcu; u < 1024; u += F.G) dil_unit<1>(F, (const bf16*)(ws + WS_Z), (bf16*)(ws + WS_Y), (float*)(ws + WS_LSE), u);
#endif
        }
    }
    SEAM(pb + 2);
    if (IN(pb + 3)) {
        unsigned char* ws = launder_ptr(args.ws); refresh(F);
#if LIN_MFMA
        { const LinArgs A = make_lin_args<L>(ws, args); for (int rp_ = 0; rp_ < REP_X3; ++rp_) for (int wu = F.vcu * NWAVES + F.wave; wu < 4096; wu += F.G * NWAVES) lin_out_wave<odd>(F, A, wu); }
#endif
        if (!odd) {
            bf16* Z = (bf16*)(ws + WS_Z);
            const attn_body::AttnTensors AT{(const attn_body::bf16*)(Z + ZC_AQ), (const attn_body::bf16*)(Z + ZC_AK), (const attn_body::bf16*)(Z + ZC_AV), (const attn_body::bf16*)(Z + ZC_GATE), (const float*)(ws + WS_CB), (const float*)(ws + WS_KN), (const float*)(ws + WS_QN), (attn_body::bf16*)(ws + WS_Y)};
            const attn_body::StaticOrder S((int)F.G, (int)blockIdx.x, 1);
            __syncthreads();
            for (int rp_ = 0; rp_ < REP_FOX; ++rp_) attn_body::attn_phase<attn_body::StaticOrder>((char*)lds + RING_OFF, AT, S);
        } else {
#if DIL_MFMA
            for (int u = F.vcu; u < 1024; u += F.G) dil_unit<2>(F, (const bf16*)(ws + WS_Z), (bf16*)(ws + WS_Y), (float*)(ws + WS_LSE), u);
#endif
        }
    }
    SEAM(pb + 3);
    if (IN(pb + 4)) {
        unsigned char* ws = launder_ptr(args.ws); refresh(F);
        pg8::Gemm g{(bf16*)(ws + WS_Y), w_out_ptr(ws, L), M, DMODEL, DMODEL}; pg8::StaticOrder S; S.init(M, DMODEL, F.G, (int)blockIdx.x);
        pg8::EpiOut E{(bf16*)(ws + WS_HB), (float*)(ws + WS_SS)};
        for (int rp_ = 0; rp_ < REP_OUT0 * 0 + 1; ++rp_) pg8::gemm_phase<pg8::EpiOut, pg8::StaticOrder, true, true>(F.lds + RING_OFF, g, S, E);
    }
    SEAM(pb + 4);
}
#undef IN
#undef SEAM

__global__ void __launch_bounds__(NWAVES * 64, 2) trunk_fwd(Args args) {
    extern __shared__ __attribute__((aligned(16))) unsigned char lds[];
    Frame F;
    F.lds = (LAS unsigned char*)lds;
    F.MISC = (volatile LAS unsigned*)(F.lds + MISC_OFF);
    F.tid = threadIdx.x; F.lane = F.tid & 63; F.wave = __builtin_amdgcn_readfirstlane(F.tid >> 6);
    F.G = gridDim.x; { const int bx = blockIdx.x; F.vcu = (F.G % 8 == 0) ? (bx % 8) * (F.G / 8) + bx / 8 : bx; }
    F.ws = args.ws; F.ctl = (gu32*)(args.ws + WS_CTL);
    for (int u = F.tid; u < (LDS_BYTES - LDSCTL_OFF) / 4; u += NWAVES * 64) ((LAS unsigned*)(F.lds + LDSCTL_OFF))[u] = 0u;
    __syncthreads();
    XcdBarrier bar = xcd_barrier_post((unsigned*)(F.ctl + CW_BAR) + args.li * XCD_BAR_WORDS, F.MISC + 8);
    const int lo = args.ph_lo, hi = args.ph_hi;
#define IN(k) (lo <= (k) && (k) < hi)
#define SEAM(k) do { if (IN(k) && IN((k) + 1)) { for (int rb_ = 0; rb_ < REP_BAR; ++rb_) xcd_barrier(bar); } } while (0)

    if (IN(0)) { for (int rp_ = 0; rp_ < REP_PRO; ++rp_) p0_prologue(F, args); }
    SEAM(0);

    run_layer<0>(F, args, bar, lo, hi, lds); run_layer<1>(F, args, bar, lo, hi, lds); run_layer<2>(F, args, bar, lo, hi, lds); run_layer<3>(F, args, bar, lo, hi, lds);
    if (IN(N_PHASES - 1)) { refresh(F); unsigned char* ws = launder_ptr(args.ws); final_norm_phase(F, (const bf16*)(ws + WS_HB), (const float*)(ws + WS_SS), args.out, args.in[13]); }
#undef IN
#undef SEAM
}

extern "C" void kernel_launch(void* const* d_in, const int* in_sizes, int n_in, void* d_out, int out_size, void* d_ws, size_t ws_size, hipStream_t stream) {
    static int grid = 0;
    if (grid == 0) {
        if (n_in != 14 || in_sizes[0] != M * DMODEL || out_size != M * DMODEL || ws_size < WS_END) { fprintf(stderr, "kernel_launch: unexpected shapes: n_in %d in0 %d out %d ws %zu (need %zu)\n", n_in, n_in > 0 ? in_sizes[0] : -1, out_size, ws_size, (size_t)WS_END); grid = -1; return; }
        int dev = 0, cus = 0, per_cu = 0;
        if (hipGetDevice(&dev) != hipSuccess || hipDeviceGetAttribute(&cus, hipDeviceAttributeMultiprocessorCount, dev) != hipSuccess) { fprintf(stderr, "kernel_launch: device query failed\n"); grid = -1; return; }
        if (hipFuncSetAttribute((const void*)trunk_fwd, hipFuncAttributeMaxDynamicSharedMemorySize, LDS_BYTES) != hipSuccess) { fprintf(stderr, "kernel_launch: hipFuncSetAttribute failed\n"); grid = -1; return; }
        if (hipOccupancyMaxActiveBlocksPerMultiprocessor(&per_cu, (const void*)trunk_fwd, NWAVES * 64, LDS_BYTES) != hipSuccess || per_cu < 1) fprintf(stderr, "kernel_launch: note: occupancy query reports %d blocks per CU\n", per_cu);
        (void)hipGetLastError();
        grid = cus;
    }
    if (grid < 0) return;
    if (hipMemsetAsync((char*)d_ws + WS_CTL, 0, CTL_ZERO_BYTES, stream) != hipSuccess) { fprintf(stderr, "kernel_launch: memset failed\n"); return; }
    Args a{};
    for (int i = 0; i < 14; ++i) a.in[i] = (const float*)d_in[i];
    a.out = (float*)d_out; a.ws = (unsigned char*)d_ws;
    constexpr int NL = MK_N_LAUNCHES;
    for (int li = 0; li < NL; ++li) {
        a.ph_lo = (NL == 1) ? 0 : li; a.ph_hi = (NL == 1) ? N_PHASES : li + 1; a.li = li;
        hipLaunchKernelGGL(trunk_fwd, dim3(grid), dim3(NWAVES * 64), LDS_BYTES, stream, a);
        const hipError_t le = hipPeekAtLastError();
        if (le != hipSuccess) { fprintf(stderr, "kernel_launch: launch %d failed: %s\n", li, hipGetErrorName(le)); break; }
    }
}
```

```cpp
#include <hip/hip_runtime.h>
#include <hip/hip_bf16.h>
#include <cstdio>
#include <cstdint>
#include <cmath>

namespace pg8 {
#define PG8_LAS __attribute__((address_space(3)))
typedef unsigned short bf16_t;
typedef short bf16x8 __attribute__((ext_vector_type(8)));
typedef float f32x4 __attribute__((ext_vector_type(4)));
typedef unsigned u32x4 __attribute__((ext_vector_type(4)));
#ifndef PG_WGM
#define PG_WGM 8
#endif
constexpr int BM = 256, BK = 64, HALF = 128, HTB = HALF * BK * 2  , STAGE_BYTES = 8 * HTB, NXCD = 8, WGM = PG_WGM;

__host__ __device__ __forceinline__ int lds_byte(int r, int c) { const int st = (r >> 4) * 2 + (c >> 5), rr = r & 15, cc = c & 31, ob = rr * 64 + cc * 2; return st * 1024 + (ob ^ (((ob >> 9) & 1) << 5)); }
__host__ __device__ __forceinline__ void stage_rc(int b, int& R, int& C) { const int st = b / 1024, sb = b % 1024, swz = sb ^ (((sb >> 9) & 1) << 5); R = (st >> 1) * 16 + swz / 64; C = (st & 1) * 32 + (swz % 64) / 2; }
__host__ __device__ __forceinline__ int perm32(int rho) { const int n = rho >> 4, i = rho & 15; return 8 * (i >> 2) + 4 * n + (i & 3); }

struct Unit { int pm, pn; };
struct Gemm { const bf16_t* A; const bf16_t* Bt; int M, N, K; };

struct StaticOrder {
    int nM, nN, nwg, G, c;
    __host__ __device__ void init(int M, int N, int G_, int c_) { nM = M / BM; nN = N / BM; nwg = nM * nN; G = G_; c = c_; }
    __host__ __device__ bool next(int i, Unit& u) const {
        const long L = (long)i * G + c; if (L >= nwg) return false;
        int wgid = (int)L; { const int q = nwg / NXCD, r = nwg % NXCD, xcd = wgid % NXCD, off = wgid / NXCD; wgid = (xcd < r ? xcd * (q + 1) : r * (q + 1) + (xcd - r) * q) + off; }
        const int nig = WGM * nN, gid = wgid / nig, fm = gid * WGM, gsz = (nM - fm) < WGM ? (nM - fm) : WGM;
        u.pm = fm + ((wgid % nig) % gsz); u.pn = (wgid % nig) / gsz; return true;
    }
    __device__ __forceinline__ void a_ready(const Unit&) const {}
    __device__ __forceinline__ void done(const Unit&) const {}
};

__device__ __forceinline__ unsigned cvt_pk_bf16(float lo, float hi) { unsigned r; asm volatile("v_cvt_pk_bf16_f32 %0, %1, %2" : "=v"(r) : "v"(lo), "v"(hi)); return r; }

struct EpiIn {
    static constexpr bool PERM = true, AFTER_DRAIN = false;
    bf16_t* Z; int ldz; const float* ss; const float* rope; int odd; float qscale, ascale;
    int plain;
    const PG8_LAS float* rtab; const PG8_LAS int* rtag;
    __device__ __forceinline__ void operator()(const f32x4 (&acc)[2][2][4][2], const Unit& u, int wr, int wc, int fr, int fq) const {
        const int row0 = u.pm * BM + wr * 64 + fr; const int pn = u.pn;
        const float cs = (pn == 0) ? qscale : ((pn == 4 || pn == 5) ? ascale : 1.0f);
        const bool do_rope = !plain && odd && (pn <= 1 || (pn >= 4 && pn <= 7));
        const bool do_silu = !plain && pn >= 10;
        const int rbase_col = (pn < 2) ? pn * 256 : (pn < 4) ? 512 : (pn < 10) ? 1024 + ((pn - 4) >> 1) * 512 : 2560;
        const int hw_log = (pn >= 10) ? 10 : (pn == 2 || pn == 3) ? 7 : 6; const int nh_log = (pn >= 10) ? 0 : (pn < 4) ? 2 : 3;
        const int col0 = pn * BM + wc * 32 + 8 * fq - rbase_col;
        const size_t zbase = (size_t)rbase_col * 32768;
        const int slot = (u.pm >> 3) & 1; const bool have_tab = rtag[slot] == u.pm;
#pragma unroll
        for (int ai = 0; ai < 2; ++ai)
#pragma unroll
            for (int m = 0; m < 4; ++m) {
                const int row = row0 + ai * HALF + m * 16;
                float sc;
                if (plain) sc = 1.0f;
                else if (have_tab) sc = cs * rtab[slot * 256 + (row & 255)];
                else {
                    const f32x4* sp = (const f32x4*)(ss + (size_t)row * 16);
                    const f32x4 s0 = sp[0], s1 = sp[1], s2 = sp[2], s3 = sp[3];
                    const float tot = ((s0[0] + s0[1]) + (s0[2] + s0[3])) + ((s1[0] + s1[1]) + (s1[2] + s1[3])) + ((s2[0] + s2[1]) + (s2[2] + s2[3])) + ((s3[0] + s3[1]) + (s3[2] + s3[3]));
                    sc = cs / sqrtf(tot * (1.0f / 1024.0f) + 1e-6f);
                }
                const int bidx = row >> 12, tt = row & 4095;
#pragma unroll
                for (int bj = 0; bj < 2; ++bj) {
                    f32x4 v0 = acc[ai][bj][m][0] * sc, v1 = acc[ai][bj][m][1] * sc;
                    if (do_rope) {
                        const int t = row & 4095; const int j0 = ((bj * HALF + wc * 32 + 8 * fq) & 63) >> 1;
                        const f32x4* rp = (const f32x4*)(rope + ((size_t)t * 32 + j0) * 2);
                        const f32x4 c01 = rp[0], c23 = rp[1];
                        f32x4 w0, w1;
                        w0[0] = v0[0] * c01[0] - v0[1] * c01[1]; w0[1] = v0[1] * c01[0] + v0[0] * c01[1];
                        w0[2] = v0[2] * c01[2] - v0[3] * c01[3]; w0[3] = v0[3] * c01[2] + v0[2] * c01[3];
                        w1[0] = v1[0] * c23[0] - v1[1] * c23[1]; w1[1] = v1[1] * c23[0] + v1[0] * c23[1];
                        w1[2] = v1[2] * c23[2] - v1[3] * c23[3]; w1[3] = v1[3] * c23[2] + v1[2] * c23[3];
                        v0 = w0; v1 = w1;
                    }
                    if (do_silu) {
#pragma unroll
                        for (int e = 0; e < 4; ++e) { v0[e] = v0[e] * __builtin_amdgcn_rcpf(1.0f + __builtin_amdgcn_exp2f(-1.4426950408889634f * v0[e])); v1[e] = v1[e] * __builtin_amdgcn_rcpf(1.0f + __builtin_amdgcn_exp2f(-1.4426950408889634f * v1[e])); }
                    }
                    u32x4 w; w.x = cvt_pk_bf16(v0[0], v0[1]); w.y = cvt_pk_bf16(v0[2], v0[3]); w.z = cvt_pk_bf16(v1[0], v1[1]); w.w = cvt_pk_bf16(v1[2], v1[3]);
                    const int c = col0 + bj * HALF;
                    if (plain != 2 || (w.x == 0x7fc12345u && w.y == 0x7fc12345u))
                        *(u32x4*)(Z + zbase + ((((((size_t)((bidx << nh_log) + (c >> hw_log))) << 12) + (size_t)tt)) << hw_log) + (c & ((1 << hw_log) - 1))) = w;
                }
            }
    }
};

template <class Sched> __device__ __forceinline__ void epi_in_fill(const Sched& S, const float* ss, PG8_LAS float* rtab, PG8_LAS int* rtag) {
    if (threadIdx.x < 2) rtag[threadIdx.x] = -1;
    __syncthreads();
    Unit u;
    for (int i = 0; S.next(i, u); ++i) {
        const int slot = (u.pm >> 3) & 1;
        if (rtag[slot] == -1) {
            __syncthreads();
            if (threadIdx.x < 256) {
                const int row = u.pm * BM + threadIdx.x; const f32x4* sp = (const f32x4*)(ss + (size_t)row * 16);
                const f32x4 s0 = sp[0], s1 = sp[1], s2 = sp[2], s3 = sp[3];
                const float tot = ((s0[0] + s0[1]) + (s0[2] + s0[3])) + ((s1[0] + s1[1]) + (s1[2] + s1[3])) + ((s2[0] + s2[1]) + (s2[2] + s2[3])) + ((s3[0] + s3[1]) + (s3[2] + s3[3]));
                rtab[slot * 256 + threadIdx.x] = 1.0f / sqrtf(tot * (1.0f / 1024.0f) + 1e-6f);
                if (threadIdx.x == 0) rtag[slot] = u.pm;
            }
            __syncthreads();
        }
    }
    __syncthreads();
}

struct EpiOut {
    static constexpr bool PERM = true, AFTER_DRAIN = false;
    bf16_t* hb; float* ss; bf16_t* hbo;
    __device__ __forceinline__ void operator()(const f32x4 (&acc)[2][2][4][2], const Unit& u, int wr, int wc, int fr, int fq) const {
        const int row0 = u.pm * BM + wr * 64 + fr; const int col0 = u.pn * BM + wc * 32 + 8 * fq;
#pragma unroll
        for (int ai = 0; ai < 2; ++ai)
#pragma unroll
            for (int m = 0; m < 4; ++m) {
                const int row = row0 + ai * HALF + m * 16; const size_t off = (size_t)row * 1024 + col0; float q = 0.f;
#pragma unroll
                for (int bj = 0; bj < 2; ++bj) {
                    const u32x4 old = *(const u32x4*)(hb + off + bj * HALF);
                    f32x4 v0 = acc[ai][bj][m][0], v1 = acc[ai][bj][m][1];
                    v0[0] += __uint_as_float(old.x << 16); v0[1] += __uint_as_float(old.x & 0xffff0000u); v0[2] += __uint_as_float(old.y << 16); v0[3] += __uint_as_float(old.y & 0xffff0000u);
                    v1[0] += __uint_as_float(old.z << 16); v1[1] += __uint_as_float(old.z & 0xffff0000u); v1[2] += __uint_as_float(old.w << 16); v1[3] += __uint_as_float(old.w & 0xffff0000u);
                    q += (v0[0] * v0[0] + v0[1] * v0[1]) + (v0[2] * v0[2] + v0[3] * v0[3]) + (v1[0] * v1[0] + v1[1] * v1[1]) + (v1[2] * v1[2] + v1[3] * v1[3]);
                    u32x4 w; w.x = cvt_pk_bf16(v0[0], v0[1]); w.y = cvt_pk_bf16(v0[2], v0[3]); w.z = cvt_pk_bf16(v1[0], v1[1]); w.w = cvt_pk_bf16(v1[2], v1[3]);
                    *(u32x4*)(hbo + off + bj * HALF) = w;
                }
                q += __shfl_xor(q, 16); q += __shfl_xor(q, 32);
                if (fq == 0) ss[(size_t)row * 16 + u.pn * 4 + wc] = q;
            }
    }
};

template <class Epi, class Sched, bool ALIGN_EPI = false, bool SP2 = false>
__device__ __forceinline__ void gemm_phase(PG8_LAS unsigned char* lds, const Gemm g, const Sched& S, const Epi& E) {
    int tid_ = threadIdx.x; asm volatile("" : "+v"(tid_));
    const int tid = tid_, wid = __builtin_amdgcn_readfirstlane(tid >> 6), lane = tid & 63, wr = wid >> 2, wc = wid & 3, fr = lane & 15, fq = lane >> 4;
    const int K = g.K, nt = K / BK;
    unsigned voffA[2], voffB[2];
#pragma unroll
    for (int i = 0; i < 2; ++i) { int R, C; stage_rc(tid * 16 + i * 8192, R, C); const int Rb = Epi::PERM ? ((R & ~31) + perm32(R & 31)) : R;
        voffA[i] = (unsigned)(R * K + C) * 2u; voffB[i] = (unsigned)(Rb * K + C) * 2u; }
    const size_t kstep = (size_t)(BK * 2);
    const size_t hstep = (size_t)HALF * K * 2;
    const size_t tstep = 2 * hstep;
    const unsigned ldsw = (unsigned)wid * 1024u;
    const int aoff = lds_byte(wr * 64 + fr, fq * 8), boff = lds_byte(wc * 32 + fr, fq * 8);
#define PG8_SA(b, h) (((b) * 2 + (h)) * HTB)
#define PG8_SB(b, h) ((4 + (b) * 2 + (h)) * HTB)
#define PG8_STAGE(bufoff, gbase, voff) do { _Pragma("unroll") for (int _i = 0; _i < 2; ++_i) \
        __builtin_amdgcn_global_load_lds((const unsigned*)((const char*)(gbase) + (voff)[_i]), (PG8_LAS unsigned*)(lds + (bufoff) + ldsw + _i * 8192), 16, 0, 0); } while (0)
#define PG8_LDA(dst, b, h) do { _Pragma("unroll") for (int m = 0; m < 4; ++m) _Pragma("unroll") for (int k = 0; k < 2; ++k) dst[m][k] = *(const PG8_LAS bf16x8*)(lds + PG8_SA(b, h) + aoff + m * 2048 + k * 1024); } while (0)
#define PG8_LDB(dst, b, h) do { _Pragma("unroll") for (int n = 0; n < 2; ++n) _Pragma("unroll") for (int k = 0; k < 2; ++k) dst[n][k] = *(const PG8_LAS bf16x8*)(lds + PG8_SB(b, h) + boff + n * 2048 + k * 1024); } while (0)
#define PG8_MMA(ai, bj, At, Bt) do { __builtin_amdgcn_s_setprio(1); _Pragma("unroll") for (int m = 0; m < 4; ++m) _Pragma("unroll") for (int n = 0; n < 2; ++n) _Pragma("unroll") for (int k = 0; k < 2; ++k) \
        acc[ai][bj][m][n] = __builtin_amdgcn_mfma_f32_16x16x32_bf16(Bt[n][k], At[m][k], acc[ai][bj][m][n], 0, 0, 0); __builtin_amdgcn_s_setprio(0); } while (0)
#define PG8_WAIT_V(n) asm volatile("s_waitcnt vmcnt(" #n ")" ::: "memory")
#define PG8_WAIT_L(n) asm volatile("s_waitcnt lgkmcnt(" #n ")" ::: "memory")
#define PG8_BAR __builtin_amdgcn_s_barrier()
#define PG8_SCHED __builtin_amdgcn_sched_barrier(0)
    Unit cur, nxt; int ui = 0;
    if (!S.next(0, cur)) return;
    f32x4 acc[2][2][4][2];
#pragma unroll
    for (int a = 0; a < 2; ++a)
#pragma unroll
        for (int b = 0; b < 2; ++b)
#pragma unroll
            for (int m = 0; m < 4; ++m)
#pragma unroll
                for (int n = 0; n < 2; ++n) acc[a][b][m][n] = (f32x4){0.f, 0.f, 0.f, 0.f};
    bf16x8 At[4][2], B0[2][2], B1[2][2];
    const char* cA = (const char*)g.A + (size_t)cur.pm * tstep; const char* cB = (const char*)g.Bt + (size_t)cur.pn * tstep;
    S.a_ready(cur);
    if constexpr (SP2) {
        PG8_STAGE(PG8_SB(0, 0), cB, voffB); PG8_STAGE(PG8_SB(0, 1), cB + hstep, voffB); PG8_STAGE(PG8_SA(0, 0), cA, voffA); PG8_STAGE(PG8_SA(0, 1), cA + hstep, voffA);
        if (wr == 1) PG8_BAR;
        PG8_WAIT_V(2); PG8_BAR;
        PG8_STAGE(PG8_SB(1, 0), cB + kstep, voffB); PG8_STAGE(PG8_SA(1, 0), cA + kstep, voffA); PG8_STAGE(PG8_SB(1, 1), cB + hstep + kstep, voffB);
        PG8_WAIT_V(6); PG8_BAR;
    } else {
        PG8_STAGE(PG8_SB(0, 0), cB, voffB); PG8_STAGE(PG8_SA(0, 0), cA, voffA); PG8_STAGE(PG8_SB(0, 1), cB + hstep, voffB); PG8_STAGE(PG8_SA(0, 1), cA + hstep, voffA);
        if (wr == 1) PG8_BAR;
        PG8_WAIT_V(4); PG8_BAR;
        PG8_STAGE(PG8_SB(1, 0), cB + kstep, voffB); PG8_STAGE(PG8_SA(1, 0), cA + kstep, voffA); PG8_STAGE(PG8_SB(1, 1), cB + hstep + kstep, voffB);
        PG8_WAIT_V(6); PG8_BAR;
    }
    for (;;) {
        const bool has_next = S.next(ui + 1, nxt);
        const char* nA = has_next ? (const char*)g.A + (size_t)nxt.pm * tstep : cA; const char* nB = has_next ? (const char*)g.Bt + (size_t)nxt.pn * tstep : cB;
        for (int t = 0; t < nt; t += 2) {
            const bool last = (t == nt - 2);
            const char* a1 = cA + (size_t)(t + 1) * kstep;
            const char* a2 = last ? nA : cA + (size_t)(t + 2) * kstep; const char* b2 = last ? nB : cB + (size_t)(t + 2) * kstep;
            const char* a3 = a2 + kstep; const char* b3 = b2 + kstep;
            if (last && has_next) S.a_ready(nxt);
            if constexpr (SP2) {
            PG8_LDB(B0, 0, 0); PG8_LDB(B1, 0, 1); PG8_SCHED; PG8_LDA(At, 0, 0); PG8_STAGE(PG8_SA(1, 1), a1 + hstep, voffA);
            PG8_WAIT_V(8); PG8_WAIT_L(0); PG8_BAR; PG8_MMA(0, 0, At, B0); PG8_MMA(0, 1, At, B1); PG8_BAR; PG8_SCHED;
            PG8_LDA(At, 0, 1); PG8_STAGE(PG8_SB(0, 0), b2, voffB); PG8_STAGE(PG8_SB(0, 1), b2 + hstep, voffB); PG8_STAGE(PG8_SA(0, 0), a2, voffA);
            PG8_WAIT_V(8); PG8_WAIT_L(0); PG8_BAR; PG8_MMA(1, 0, At, B0); PG8_MMA(1, 1, At, B1); PG8_BAR; PG8_SCHED;
            PG8_LDB(B0, 1, 0); PG8_LDB(B1, 1, 1); PG8_SCHED; PG8_LDA(At, 1, 0); PG8_STAGE(PG8_SA(0, 1), a2 + hstep, voffA);
            PG8_WAIT_V(8); PG8_WAIT_L(0); PG8_BAR; PG8_MMA(0, 0, At, B0); PG8_MMA(0, 1, At, B1); PG8_BAR; PG8_SCHED;
            PG8_LDA(At, 1, 1); PG8_STAGE(PG8_SB(1, 0), b3, voffB); PG8_STAGE(PG8_SB(1, 1), b3 + hstep, voffB); PG8_STAGE(PG8_SA(1, 0), a3, voffA);
            PG8_WAIT_V(8); PG8_WAIT_L(0); PG8_BAR; PG8_MMA(1, 0, At, B0); PG8_MMA(1, 1, At, B1); PG8_BAR; PG8_SCHED;
            } else {
            PG8_LDB(B0, 0, 0); PG8_SCHED; PG8_LDA(At, 0, 0); PG8_STAGE(PG8_SA(1, 1), a1 + hstep, voffA);
            PG8_WAIT_L(8); PG8_BAR; PG8_WAIT_L(0); PG8_MMA(0, 0, At, B0); PG8_BAR; PG8_SCHED;
            PG8_LDB(B1, 0, 1); PG8_STAGE(PG8_SB(0, 0), b2, voffB);
            PG8_BAR; PG8_WAIT_L(0); PG8_MMA(0, 1, At, B1); PG8_BAR;
            PG8_LDA(At, 0, 1); PG8_STAGE(PG8_SA(0, 0), a2, voffA);
            PG8_BAR; PG8_WAIT_L(0); PG8_MMA(1, 0, At, B0); PG8_BAR; PG8_SCHED;
            PG8_STAGE(PG8_SB(0, 1), b2 + hstep, voffB);
            PG8_WAIT_V(6); PG8_BAR; PG8_MMA(1, 1, At, B1); PG8_BAR;
            PG8_LDB(B0, 1, 0); PG8_SCHED; PG8_LDA(At, 1, 0); PG8_STAGE(PG8_SA(0, 1), a2 + hstep, voffA);
            PG8_WAIT_L(8); PG8_BAR; PG8_WAIT_L(0); PG8_MMA(0, 0, At, B0); PG8_BAR; PG8_SCHED;
            PG8_LDB(B1, 1, 1); PG8_STAGE(PG8_SB(1, 0), b3, voffB);
            PG8_BAR; PG8_WAIT_L(0); PG8_MMA(0, 1, At, B1); PG8_BAR;
            PG8_LDA(At, 1, 1); PG8_STAGE(PG8_SA(1, 0), a3, voffA);
            PG8_BAR; PG8_WAIT_L(0); PG8_MMA(1, 0, At, B0); PG8_BAR; PG8_SCHED;
            PG8_STAGE(PG8_SB(1, 1), b3 + hstep, voffB);
            PG8_WAIT_V(6); PG8_BAR; PG8_MMA(1, 1, At, B1); PG8_BAR;
            }
        }
        if constexpr (ALIGN_EPI) { if (wr == 0) PG8_BAR; }
        if constexpr (!Epi::AFTER_DRAIN) { E(acc, cur, wr, wc, fr, fq); S.done(cur); }
        if (!has_next) break;
#pragma unroll
        for (int a = 0; a < 2; ++a)
#pragma unroll
            for (int b = 0; b < 2; ++b)
#pragma unroll
                for (int m = 0; m < 4; ++m)
#pragma unroll
                    for (int n = 0; n < 2; ++n) acc[a][b][m][n] = (f32x4){0.f, 0.f, 0.f, 0.f};
        cur = nxt; cA = nA; cB = nB; ++ui;
        if constexpr (ALIGN_EPI) { if (wr == 1) PG8_BAR; }
    }
    PG8_WAIT_V(0);
    if constexpr (!ALIGN_EPI) { if (wr == 0) PG8_BAR; }
    PG8_BAR;
#undef PG8_SA
#undef PG8_SB
#undef PG8_STAGE
#undef PG8_LDA
#undef PG8_LDB
#undef PG8_MMA
#undef PG8_WAIT_V
#undef PG8_WAIT_L
#undef PG8_BAR
#undef PG8_SCHED
}
}
namespace attn_body {
using bf16=__hip_bfloat16;
using bf16x8=__attribute__((ext_vector_type(8)))short;
using s16x4=__attribute__((ext_vector_type(4)))short;
using f32x16=__attribute__((ext_vector_type(16)))float;
using u32x4=__attribute__((ext_vector_type(4)))unsigned;
constexpr int BATCH=8,NHEAD=8,SEQ=4096,D=64,DM=64,OP=1024;
constexpr int NW=8,QBLK=32,QB=QBLK*NW,KVBLK=64,NQB=SEQ/QB;
constexpr int ATTN_PITCH=DM, ATTN_UNIT_ROWS=QB;
__device__ __forceinline__ int crow(int r,int hi){return (r&3)+8*(r>>2)+4*hi;}
#define SBAR() __builtin_amdgcn_sched_barrier(0)
__device__ __forceinline__ void cmask(f32x16&p0,f32x16&p1,int jb,int qrel,int hi){
  const float NEG=-INFINITY; int kb=64*jb+4*hi;
  #pragma unroll
  for(int r=0;r<16;++r){int kv=kb+(r&3)+8*(r>>2); if(kv>qrel)p0[r]=NEG; if(kv+32>qrel)p1[r]=NEG;}
}

constexpr int NSLOT=3, SLOTB=8192;
constexpr int LDS_K=0, LDS_V=NSLOT*SLOTB, LDS_WS=2*NSLOT*SLOTB, LDS_OST=LDS_WS+NW*64*4, LDS_BIAS=LDS_OST+NW*4096, LDS_BYTES=LDS_BIAS+SEQ*4;
constexpr float C2=0.125f*1.4426950408889634f;
__device__ __forceinline__ void glds16(const void*gsrc,unsigned lds_dst){unsigned keep;
  asm volatile("s_mov_b32 %0, m0\n\ts_mov_b32 m0, %2\n\ts_nop 0\n\tglobal_load_lds_dwordx4 %1, off\n\ts_mov_b32 m0, %0":"=&s"(keep):"v"(gsrc),"s"(lds_dst):"memory");}
__device__ __forceinline__ float max3f(float a,float b,float c){float r;asm("v_max3_f32 %0, %1, %2, %3":"=v"(r):"v"(a),"v"(b),"v"(c));return r;}
__device__ __forceinline__ float max2f(float a,float b){float r;asm("v_max_f32_e32 %0, %1, %2":"=v"(r):"v"(a),"v"(b));return r;}
__device__ __forceinline__ float fadd_s(float a,float b){float r;asm("v_add_f32_e32 %0, %1, %2":"=v"(r):"v"(a),"v"(b));return r;}
__device__ __forceinline__ float fsub_s(float a,float b){float r;asm("v_sub_f32_e32 %0, %1, %2":"=v"(r):"v"(a),"v"(b));return r;}
typedef float f32x4v __attribute__((ext_vector_type(4))); typedef float f32x2_t __attribute__((ext_vector_type(2))); typedef __bf16 bf16x2_t __attribute__((ext_vector_type(2)));
__device__ __forceinline__ unsigned cvtpk_s(float lo,float hi){f32x2_t v={lo,hi};bf16x2_t b=__builtin_convertvector(v,bf16x2_t);return __builtin_bit_cast(unsigned,b);}
#define WAIT_BAR(N) asm volatile("s_waitcnt vmcnt(" #N ") lgkmcnt(0)\n\ts_barrier":::"memory")

__device__ __forceinline__ void qkt(f32x16&p0,f32x16&p1,const char*Kslot,const bf16x8*qr,const f32x16&negm,int r32,int hi){
  const char*kb=Kslot+hi*1024+r32*16;
  #pragma unroll
  for(int d0=0;d0<4;++d0){
    const bf16x8 b0=*reinterpret_cast<const bf16x8*>(kb+d0*2048);
    const bf16x8 b1=*reinterpret_cast<const bf16x8*>(kb+d0*2048+512);
    if(d0==0){p0=__builtin_amdgcn_mfma_f32_32x32x16_bf16(b0,qr[0],negm,0,0,0);p1=__builtin_amdgcn_mfma_f32_32x32x16_bf16(b1,qr[0],negm,0,0,0);}
    else{p0=__builtin_amdgcn_mfma_f32_32x32x16_bf16(b0,qr[d0],p0,0,0,0);p1=__builtin_amdgcn_mfma_f32_32x32x16_bf16(b1,qr[d0],p1,0,0,0);}}
}
typedef __attribute__((address_space(3))) const char* lds_cptr;
typedef short v4i16_t __attribute__((ext_vector_type(4)));
__device__ __forceinline__ void kload8(bf16x8*kf,lds_cptr kp){
  kf[0]=*(const __attribute__((address_space(3))) bf16x8*)(kp);      kf[1]=*(const __attribute__((address_space(3))) bf16x8*)(kp+512);
  kf[2]=*(const __attribute__((address_space(3))) bf16x8*)(kp+2048); kf[3]=*(const __attribute__((address_space(3))) bf16x8*)(kp+2560);
  kf[4]=*(const __attribute__((address_space(3))) bf16x8*)(kp+4096); kf[5]=*(const __attribute__((address_space(3))) bf16x8*)(kp+4608);
  kf[6]=*(const __attribute__((address_space(3))) bf16x8*)(kp+6144); kf[7]=*(const __attribute__((address_space(3))) bf16x8*)(kp+6656);
}
__device__ __forceinline__ void kload2(bf16x8*kf,lds_cptr kp,int j){ kf[2*j]=*(const __attribute__((address_space(3))) bf16x8*)(kp+j*2048); kf[2*j+1]=*(const __attribute__((address_space(3))) bf16x8*)(kp+j*2048+512); }
__device__ __forceinline__ s16x4 vtr(lds_cptr p){ return __builtin_bit_cast(s16x4,__builtin_amdgcn_ds_read_tr16_b64_v4i16((__attribute__((address_space(3))) v4i16_t*)p)); }
__device__ __forceinline__ float rowmax(const f32x16&p0,const f32x16&p1){
  float a=max3f(p0[0],p0[1],p1[0]),b=max3f(p0[2],p0[3],p1[1]);a=max3f(a,p1[2],p1[3]);
  #pragma unroll
  for(int r=4;r<16;r+=4){a=max3f(a,p0[r],p0[r+1]);b=max3f(b,p0[r+2],p0[r+3]);a=max3f(a,p1[r],p1[r+1]);b=max3f(b,p1[r+2],p1[r+3]);}
  const float m=max2f(a,b);
  auto rr=__builtin_amdgcn_permlane32_swap(__float_as_uint(m),__float_as_uint(m),false,false);
  return max2f(__uint_as_float(rr[0]),__uint_as_float(rr[1]));
}
__device__ __forceinline__ void pv(f32x16*o,int vb,bf16x8 pa0,bf16x8 pa1,bf16x8 pa2,bf16x8 pa3){
  #pragma unroll
  for(int d0=0;d0<2;++d0){s16x4 lo[4],hi[4];
    #pragma unroll
    for(int ks=0;ks<4;++ks){
      asm volatile("ds_read_b64_tr_b16 %0,%1 offset:%c2":"=&v"(lo[ks]):"v"(vb),"i"(d0*4096+ks*1024):"memory");
      asm volatile("ds_read_b64_tr_b16 %0,%1 offset:%c2":"=&v"(hi[ks]):"v"(vb),"i"(d0*4096+ks*1024+512):"memory");}
    asm volatile("s_waitcnt lgkmcnt(0)":::"memory");SBAR();
    #define PK(k) (bf16x8){lo[k][0],lo[k][1],lo[k][2],lo[k][3],hi[k][0],hi[k][1],hi[k][2],hi[k][3]}
    o[d0]=__builtin_amdgcn_mfma_f32_32x32x16_bf16(pa0,PK(0),o[d0],0,0,0);
    o[d0]=__builtin_amdgcn_mfma_f32_32x32x16_bf16(pa1,PK(1),o[d0],0,0,0);
    o[d0]=__builtin_amdgcn_mfma_f32_32x32x16_bf16(pa2,PK(2),o[d0],0,0,0);
    o[d0]=__builtin_amdgcn_mfma_f32_32x32x16_bf16(pa3,PK(3),o[d0],0,0,0);
    #undef PK
  }
}

#ifndef ATTN_STORE16
#define ATTN_STORE16(p,v) (*(u32x4*)(p)=(v))
#endif
template<int THRL> __device__ __forceinline__ void attn_unit(int b,int h,int qb,const bf16*Q,const bf16*__restrict__ K,const bf16*__restrict__ V,const bf16*__restrict__ GT,const float*__restrict__ CB,const float*__restrict__ KN,const float*__restrict__ QN,bf16*O,char*shm){
  int tid_=threadIdx.x; asm volatile("":"+v"(tid_)); const int tid=tid_,lane=tid&63,r32=lane&31,hi=lane>>5; const int wid=__builtin_amdgcn_readfirstlane(tid>>6);
  const long rowbase=(long)b*SEQ; const long hbase=(long)(b*NHEAD+h)*SEQ; const int q0=qb*QB;
  const bf16*Qw=Q+(hbase+q0+wid*QBLK)*DM;
  int tstart=0;
  { const float*cbh=CB+(long)(b*NHEAD+h)*SEQ; const float*kn=KN+(b*NHEAD+h)*64; const float*qn=QN+(b*NHEAD+h)*32;
    const int NT0=(q0+QB)/KVBLK; const float cref=cbh[q0];
    const float Qn=__builtin_fmaxf(qn[2*qb],qn[2*qb+1]);
    const float Dmin=__builtin_fminf(qn[2048+2*qb],qn[2048+2*qb+1]);
    float kt=(lane<NT0)?kn[lane]:0.f;
    #pragma unroll
    for(int o_=1;o_<64;o_<<=1){ const float y_=__shfl_up(kt,o_); if(lane>=o_)kt=__builtin_fmaxf(kt,y_); }
    const float bmax=(lane<NT0)?(cref-cbh[64*lane+63])*1.4426950408889634f:0.f;
    const bool skip_=(lane<NT0-4)&&(bmax+Qn*kt-Dmin<-44.0f);
    const unsigned long long m_=__ballot(skip_);
    tstart=__builtin_amdgcn_readfirstlane(((int)__builtin_ctzll(~m_))&~1); }
  const bf16*Kh=K+(hbase+(long)tstart*KVBLK)*DM,*Vh=V+(hbase+(long)tstart*KVBLK)*DM;
  const unsigned lds0=(unsigned)(uintptr_t)shm;
  float*wsf=(float*)(shm+LDS_WS)+wid*64;
  const bf16*ksrc=Kh+(long)lane*DM+wid*8;
  const bf16*vsrc=Vh+(long)(16*(wid&3)+(lane>>2))*DM+(wid>>2)*32+(lane&3)*8;
  const unsigned kdst=lds0+LDS_K+wid*1024, vdst=lds0+LDS_V+wid*1024;
  #define DMA_K(t,slot) glds16(ksrc+(long)(t)*KVBLK*DM,(unsigned)__builtin_amdgcn_readfirstlane(kdst+(slot)))
  #define DMA_V(t,slot) glds16(vsrc+(long)(t)*KVBLK*DM,(unsigned)__builtin_amdgcn_readfirstlane(vdst+(slot)))
  const int vb0=(int)(lds0+LDS_V)+((lane>>4)&1)*32+(lane&3)*8+(4*hi+((lane&15)>>2))*64;
  const char*Kbase=shm+LDS_K; bf16x8 kf[8];
  const lds_cptr shm3=(lds_cptr)shm; const lds_cptr kp0=shm3+LDS_K+hi*1024+r32*16; const lds_cptr vp0=shm3+LDS_V+((lane>>4)&1)*32+(lane&3)*8+(4*hi+((lane&15)>>2))*64;
  const int NT=(q0+QB)/KVBLK-tstart;
  DMA_K(0,0);DMA_V(0,0);DMA_K(1,SLOTB);
  { const float*cbh=CB+(long)(b*NHEAD+h)*SEQ; const float cref=cbh[q0]; float*bl=(float*)(shm+LDS_BIAS); const int nk=q0+QB;
    float cv_[8];
    #pragma unroll
    for(int e_=0;e_<8;++e_){ const int i=tid+tstart*KVBLK+e_*NW*64; cv_[e_]=(i<nk)?cbh[i]:0.f; }
    #pragma unroll
    for(int e_=0;e_<8;++e_){ const int i=tid+tstart*KVBLK+e_*NW*64; if(i<nk) bl[i]=(cref-cv_[e_])*1.4426950408889634f; } }
  const __attribute__((address_space(3))) float* biasp=(const __attribute__((address_space(3))) float*)((lds_cptr)shm+LDS_BIAS)+4*hi+tstart*KVBLK;
  #define BIASADD(P0,P1,t) do{ const __attribute__((address_space(3))) float* bp_=biasp+64*(t); \
    _Pragma("unroll") for(int g_=0;g_<4;++g_){ f32x4v x0_=*(const __attribute__((address_space(3))) f32x4v*)(bp_+8*g_); f32x4v x1_=*(const __attribute__((address_space(3))) f32x4v*)(bp_+32+8*g_); \
      x0_=x0_-mhat; x1_=x1_-mhat; \
      P0[4*g_]+=x0_[0];P0[4*g_+1]+=x0_[1];P0[4*g_+2]+=x0_[2];P0[4*g_+3]+=x0_[3]; P1[4*g_]+=x1_[0];P1[4*g_+1]+=x1_[1];P1[4*g_+2]+=x1_[2];P1[4*g_+3]+=x1_[3]; } }while(0)
  #define LDB(P0,P1,t) do{ const __attribute__((address_space(3))) float* bp_=biasp+64*(t); \
    _Pragma("unroll") for(int g_=0;g_<4;++g_){ f32x4v x0_=*(const __attribute__((address_space(3))) f32x4v*)(bp_+8*g_); f32x4v x1_=*(const __attribute__((address_space(3))) f32x4v*)(bp_+32+8*g_); \
      x0_=x0_-mhat; x1_=x1_-mhat; \
      P0[4*g_]=x0_[0];P0[4*g_+1]=x0_[1];P0[4*g_+2]=x0_[2];P0[4*g_+3]=x0_[3]; P1[4*g_]=x1_[0];P1[4*g_+1]=x1_[1];P1[4*g_+2]=x1_[2];P1[4*g_+3]=x1_[3]; } }while(0)
  bf16x8 qr[4];
  #pragma unroll
  for(int d0=0;d0<4;++d0)qr[d0]=*reinterpret_cast<const bf16x8*>(&Qw[(long)r32*DM+d0*16+hi*8]);
  float mhat=0.f,l_reg=0.f;f32x16 o[2];o[0]=f32x16{};o[1]=f32x16{};const f32x16 negm=f32x16{};
  const int qrel=wid*QBLK+r32;
  #define CMASK(P0,P1,t) do{int jb_=(t)-(NT-4); if(jb_>=0)cmask(P0,P1,jb_,qrel,hi);}while(0)
  bool resc=false;
  #define START(P0,P1) do{ const float rm=rowmax(P0,P1); resc=false; \
    { const float dl=rm; mhat=fadd_s(mhat,dl); \
      _Pragma("unroll") for(int r=0;r<16;++r){P0[r]=fsub_s(P0[r],dl);P1[r]=fsub_s(P1[r],dl);} \
      } \
    _Pragma("unroll") for(int r=0;r<16;++r)P0[r]=__builtin_amdgcn_exp2f(P0[r]); }while(0)
  #define RESC() do{ if(resc){ asm volatile("s_waitcnt lgkmcnt(0)":::"memory"); \
      _Pragma("unroll") for(int d_=0;d_<2;++d_) _Pragma("unroll") for(int r=0;r<16;++r)o[d_][r]*=wsf[crow(r,hi)]; } }while(0)
  f32x16 pA0,pA1,pB0,pB1;
  int sl_prev=0,sl_cur=0,sl_next=SLOTB;
  #define ROT() do{sl_prev=sl_cur;sl_cur=sl_next;sl_next=(sl_next==(NSLOT-1)*SLOTB)?0:sl_next+SLOTB;}while(0)
  DMA_K(2,2*SLOTB);
  WAIT_BAR(3);
  qkt(pA0,pA1,Kbase,qr,negm,r32,hi);asm volatile("s_nop 15\n\ts_nop 7":"+v"(pA0),"+v"(pA1));BIASADD(pA0,pA1,0);CMASK(pA0,pA1,0);
  START(pA0,pA1);
  _Pragma("unroll") for(int r=0;r<16;++r)pA1[r]=__builtin_amdgcn_exp2f(pA1[r]);
  WAIT_BAR(0);
  DMA_K(3,0);DMA_V(1,SLOTB);
  ROT();
  kload8(kf,kp0+sl_cur);
  WAIT_BAR(2);
  s16x4 vlo[8],vhi[8]; u32x4 pw0,pw1,pw2,pw3;
  #define PKW(P,B) cvtpk_s(P[B],P[B+1])
  #define PAF(k) __builtin_bit_cast(bf16x8,pw##k)
  #define VFR(i) (bf16x8){vlo[i][0],vlo[i][1],vlo[i][2],vlo[i][3],vhi[i][0],vhi[i][1],vhi[i][2],vhi[i][3]}
  #define PIN(x) asm volatile("":"+v"(x))
  #define MX3(a,b,c) __builtin_fmaxf(__builtin_fmaxf((a),(b)),(c))
  #define GAPA(MF,A0,A1,A2,A3,W0,W1,PW) do{ MF; sacc+=A0; sacc+=A1; sacc+=A2; sacc+=A3; PIN(sacc); W0; W1; PIN(PW); SBAR(); }while(0)
  #define EX(v) __builtin_amdgcn_exp2f(v)
  #define GAPB(MF,X,B) do{ MF; X[B]=EX(X[B]); X[B+1]=EX(X[B+1]); X[B+2]=EX(X[B+2]); X[B+3]=EX(X[B+3]); PIN(X); SBAR(); }while(0)
  #define VRD(i) do{ vlo[i]=vtr(vp_+(((i)>>2)*4096+((i)&3)*1024)); vhi[i]=vtr(vp_+(((i)>>2)*4096+((i)&3)*1024+512)); }while(0)
  #define KRD(G,j) do{ if(G){ kload2(kf,kp0+sl_next,j); SBAR(); } }while(0)
  #define STEP(C0,C1,P0,P1,t,GK,GV,GL) do{ SBAR(); \
    const lds_cptr vp_=vp0+sl_prev; \
    VRD(0); SBAR(); float sacc=(P0[0]+P0[1]); \
    GAPA(C0=__builtin_amdgcn_mfma_f32_32x32x16_bf16(kf[0],qr[0],C0,0,0,0), P0[2],P0[3],P0[4],P0[5],     pw0[0]=PKW(P0,0), pw0[1]=PKW(P0,2), pw0); \
    VRD(4); SBAR(); GAPA(C1=__builtin_amdgcn_mfma_f32_32x32x16_bf16(kf[1],qr[0],C1,0,0,0), P0[6],P0[7],P0[8],P0[9],     pw0[2]=PKW(P0,4), pw0[3]=PKW(P0,6), pw0); \
    VRD(1); SBAR(); GAPA(C0=__builtin_amdgcn_mfma_f32_32x32x16_bf16(kf[2],qr[1],C0,0,0,0),   P0[10],P0[11],P0[12],P0[13], pw1[0]=PKW(P0,8), pw1[1]=PKW(P0,10), pw1); \
    VRD(5); SBAR(); GAPA(C1=__builtin_amdgcn_mfma_f32_32x32x16_bf16(kf[3],qr[1],C1,0,0,0),   P0[14],P0[15],P1[0],P1[1],   pw1[2]=PKW(P0,12),pw1[3]=PKW(P0,14), pw1); \
    VRD(2); SBAR(); GAPA(C0=__builtin_amdgcn_mfma_f32_32x32x16_bf16(kf[4],qr[2],C0,0,0,0),   P1[2],P1[3],P1[4],P1[5],     pw2[0]=PKW(P1,0), pw2[1]=PKW(P1,2), pw2); \
    VRD(6); SBAR(); GAPA(C1=__builtin_amdgcn_mfma_f32_32x32x16_bf16(kf[5],qr[2],C1,0,0,0),   P1[6],P1[7],P1[8],P1[9],     pw2[2]=PKW(P1,4), pw2[3]=PKW(P1,6), pw2); \
    VRD(3); SBAR(); GAPA(C0=__builtin_amdgcn_mfma_f32_32x32x16_bf16(kf[6],qr[3],C0,0,0,0),   P1[10],P1[11],P1[12],P1[13], pw3[0]=PKW(P1,8), pw3[1]=PKW(P1,10), pw3); \
    VRD(7); SBAR(); GAPA(C1=__builtin_amdgcn_mfma_f32_32x32x16_bf16(kf[7],qr[3],C1,0,0,0),   P1[14],P1[15],0.f,0.f,       pw3[2]=PKW(P1,12),pw3[3]=PKW(P1,14), pw3); \
    l_reg+=sacc; \
    if(GK){DMA_K((t)+3,sl_cur);} if(GV){DMA_V((t)+1,sl_next);} \
    CMASK(C0,C1,t); \
    { float a=MX3(C0[0],C0[1],C1[0]),b=MX3(C0[2],C0[3],C1[1]); a=MX3(a,C1[2],C1[3]); \
      _Pragma("unroll") for(int r=4;r<16;r+=4){a=MX3(a,C0[r],C0[r+1]);b=MX3(b,C0[r+2],C0[r+3]);a=MX3(a,C1[r],C1[r+1]);b=MX3(b,C1[r+2],C1[r+3]);} \
      float rm=__builtin_fmaxf(a,b); { auto rr=__builtin_amdgcn_permlane32_swap(__float_as_uint(rm),__float_as_uint(rm),false,false); rm=__builtin_fmaxf(__uint_as_float(rr[0]),__uint_as_float(rr[1])); } \
      resc=false; \
      if(__builtin_expect(__any(rm>(float)THRL),0)){ const float dl=__builtin_fmaxf(rm,0.f); mhat+=dl; \
        _Pragma("unroll") for(int r=0;r<16;++r){C0[r]-=dl;C1[r]-=dl;} \
        const float f=__builtin_amdgcn_exp2f(-dl); l_reg*=f; if(hi==0)wsf[r32]=f; resc=true; } } \
    SBAR(); \
    GAPB(o[0]=__builtin_amdgcn_mfma_f32_32x32x16_bf16(PAF(0),VFR(0),o[0],0,0,0), C0,0); \
    GAPB(o[1]=__builtin_amdgcn_mfma_f32_32x32x16_bf16(PAF(0),VFR(4),o[1],0,0,0), C0,4); \
    KRD(GL,0); GAPB(o[0]=__builtin_amdgcn_mfma_f32_32x32x16_bf16(PAF(1),VFR(1),o[0],0,0,0), C0,8); \
    KRD(GL,1); GAPB(o[1]=__builtin_amdgcn_mfma_f32_32x32x16_bf16(PAF(1),VFR(5),o[1],0,0,0), C0,12); \
    KRD(GL,2); GAPB(o[0]=__builtin_amdgcn_mfma_f32_32x32x16_bf16(PAF(2),VFR(2),o[0],0,0,0), C1,0); \
    KRD(GL,3); GAPB(o[1]=__builtin_amdgcn_mfma_f32_32x32x16_bf16(PAF(2),VFR(6),o[1],0,0,0), C1,4); \
    GAPB(o[0]=__builtin_amdgcn_mfma_f32_32x32x16_bf16(PAF(3),VFR(3),o[0],0,0,0), C1,8); \
    GAPB(o[1]=__builtin_amdgcn_mfma_f32_32x32x16_bf16(PAF(3),VFR(7),o[1],0,0,0), C1,12); \
    LDB(P0,P1,(t)+1);     \
    }while(0)
  LDB(pB0,pB1,1);
  int t=1;
  #undef CMASK
  #define CMASK(P0,P1,t) do{}while(0)
  for(;t+5<NT;t+=2){
    STEP(pB0,pB1,pA0,pA1,t,true,true,true);     WAIT_BAR(2); RESC(); ROT();
    STEP(pA0,pA1,pB0,pB1,t+1,true,true,true);   WAIT_BAR(2); RESC(); ROT();
  }
  #undef CMASK
  #define CMASK(P0,P1,t) do{int jb_=(t)-(NT-4); if(jb_>=0)cmask(P0,P1,jb_,qrel,hi);}while(0)
  #define ENDW(tt) do{ if((tt)+3<NT){WAIT_BAR(2);} else if((tt)+2<NT){WAIT_BAR(1);} else {WAIT_BAR(0);} }while(0)
  for(;t+1<NT;t+=2){
    STEP(pB0,pB1,pA0,pA1,t,(t+3<NT),(t+1<NT),(t+1<NT));       ENDW(t);   RESC(); ROT();
    STEP(pA0,pA1,pB0,pB1,t+1,(t+4<NT),(t+2<NT),(t+2<NT));     ENDW(t+1); RESC(); ROT();
  }
  STEP(pB0,pB1,pA0,pA1,NT-1,false,false,false); RESC();
  { float sacc=pB0[0]+pB0[1]; _Pragma("unroll") for(int r=2;r<16;++r)sacc+=pB0[r]; _Pragma("unroll") for(int r=0;r<16;++r)sacc+=pB1[r]; l_reg+=sacc;
    pw0=(u32x4){PKW(pB0,0),PKW(pB0,2),PKW(pB0,4),PKW(pB0,6)};pw1=(u32x4){PKW(pB0,8),PKW(pB0,10),PKW(pB0,12),PKW(pB0,14)};pw2=(u32x4){PKW(pB1,0),PKW(pB1,2),PKW(pB1,4),PKW(pB1,6)};pw3=(u32x4){PKW(pB1,8),PKW(pB1,10),PKW(pB1,12),PKW(pB1,14)};
    SBAR(); pv(o,vb0+sl_cur,PAF(0),PAF(1),PAF(2),PAF(3)); }
  #undef PKW
  #undef PAF
  #undef VFR
  #undef PIN
  #undef MX3
  #undef GAPA
  #undef GAPB
  #undef EX
  #undef VRD
  #undef KRD
  #undef STEP
  #undef ENDW
  {auto rr=__builtin_amdgcn_permlane32_swap(__float_as_uint(l_reg),__float_as_uint(l_reg),false,false);l_reg=__uint_as_float(rr[0])+__uint_as_float(rr[1]);}
  if(hi==0)wsf[32+r32]=l_reg;asm volatile("s_waitcnt lgkmcnt(0)":::"memory");
  float rli[16];
  #pragma unroll
  for(int r=0;r<16;++r)rli[r]=__builtin_amdgcn_rcpf(wsf[32+crow(r,hi)]);
  bf16*Ow=O+(rowbase+q0+wid*QBLK)*OP+h*D; const bf16*Gw=GT+(rowbase+q0+wid*QBLK)*OP+h*D;
  { bf16*stg=(bf16*)(shm+LDS_OST)+wid*2048;
    #pragma unroll
    for(int r=0;r<16;++r){const int orow=crow(r,hi);
      #pragma unroll
      for(int d0=0;d0<2;++d0)stg[orow*64+d0*32+r32]=__float2bfloat16(o[d0][r]*rli[r]);}
    asm volatile("s_waitcnt lgkmcnt(0)":::"memory");
    #pragma unroll
    for(int i=0;i<4;++i){const int row=i*8+(lane>>3),ch=lane&7; const u32x4 v=*(const u32x4*)(stg+row*64+ch*8); const u32x4 g=*(const u32x4*)(Gw+(long)row*OP+ch*8); u32x4 w;
      _Pragma("unroll") for(int e=0;e<4;++e){ const float a0=__uint_as_float(v[e]<<16)*__uint_as_float(g[e]<<16), a1=__uint_as_float(v[e]&0xffff0000u)*__uint_as_float(g[e]&0xffff0000u); w[e]=cvtpk_s(a0,a1); }
      ATTN_STORE16(Ow+(long)row*OP+ch*8,w);} }
  asm volatile("s_waitcnt lgkmcnt(0)\n\ts_barrier":::"memory");
  #undef BIASADD
  #undef LDB
  #undef DMA_K
  #undef DMA_V
  #undef CMASK
  #undef START
  #undef RESC
  #undef ROT
}
constexpr int ATTN_LDS_BYTES=LDS_BYTES;
struct AttnTensors { const bf16* Q; const bf16* K; const bf16* V; const bf16* GT; const float* CB; const float* KN; const float* QN; bf16* O; };
struct AttnUnit { int bh; int qb; };
struct QueueOrder {
  unsigned* ctr; int xg, limit;
  __device__ __forceinline__ QueueOrder(unsigned* counters,int grid,int block,int limit_):limit(limit_){ const int vcu=(grid%8==0)?(block%8)*(grid/8)+block/8:block; xg=(vcu*8)/grid; ctr=counters+64*xg; }
  __device__ __forceinline__ bool next(int i,volatile __attribute__((address_space(3))) unsigned* slot,AttnUnit&u)const{
    if(i>=limit)return false;
    if(threadIdx.x==0) *slot=__hip_atomic_fetch_add(ctr,1u,__ATOMIC_RELAXED,__HIP_MEMORY_SCOPE_AGENT);
    __syncthreads(); const unsigned idx=*slot; __syncthreads();
    if(idx>=128u)return false;
    u.bh=xg*NHEAD+(int)(idx&7u); u.qb=15-(int)(idx>>3); return true; }
};
template<int THRL=64> __device__ __forceinline__ void attn_phase(char*lds,const AttnTensors&T,const QueueOrder&S,volatile __attribute__((address_space(3))) unsigned* slot){
  AttnUnit u;
  for(int i=0;S.next(i,slot,u);++i){ attn_unit<THRL>(u.bh/NHEAD,u.bh%NHEAD,u.qb,T.Q,T.K,T.V,T.GT,T.CB,T.KN,T.QN,T.O,lds); }
}
#undef SBAR
#undef WAIT_BAR
}
constexpr int NWAVES = 8;
constexpr int BATCH = 8, SEQ = 4096, DMODEL = 1024, M = BATCH * SEQ;
constexpr int NZ = 3584;
constexpr int ZC_LQ = 0, ZC_LK = 256, ZC_LV = 512, ZC_AQ = 1024, ZC_AK = 1536, ZC_AV = 2048, ZC_GATE = 2560;
constexpr size_t ZR_LQ = 0, ZR_LK = (size_t)M * 256, ZR_LV = (size_t)M * 512, ZR_AQ = (size_t)M * 1024, ZR_AK = (size_t)M * 1536, ZR_AV = (size_t)M * 2048, ZR_GATE = (size_t)M * 2560;
constexpr int EVEN_IN = 3608, ODD_IN = 3584;
constexpr float RMS_EPS = 1e-6f;
constexpr float LOG2E = 1.4426950408889634f;
constexpr float C2 = 0.125f * LOG2E;

constexpr size_t MiB = 1u << 20;
constexpr size_t WS_CTL = 0, CTL_ZERO_BYTES = 1 * MiB;
constexpr size_t WS_ROPE = 1 * MiB;
constexpr size_t WS_SS = 2 * MiB;
constexpr size_t WS_FF = 4 * MiB;
constexpr size_t WS_GLR = 5 * MiB;
constexpr size_t WS_CB = 7 * MiB;
constexpr size_t WS_LSE = 8 * MiB;
constexpr size_t WS_DECAY = 9 * MiB;
constexpr size_t WS_KN = 9 * MiB + 512 * 1024;
constexpr size_t WS_QN = WS_KN + 16 * 1024;
constexpr size_t WS_WSK = 10 * MiB;
constexpr size_t WS_W = 11 * MiB;
constexpr size_t WS_Z = 48 * MiB;
constexpr size_t WS_Y = 272 * MiB;
constexpr size_t WS_HB = 336 * MiB;
constexpr size_t WS_KV = 400 * MiB;
constexpr size_t WS_PREV = 464 * MiB;
constexpr size_t WS_END = 496 * MiB;
constexpr int CW_TMO = 0, CW_CODE = 1;
constexpr int CW_BAR = 4096;
constexpr int CW_QUEUE = 131072;

constexpr int RING_OFF = 0, RING_BYTES = 131072;
constexpr int LDSCTL_OFF = RING_BYTES, MISC_OFF = LDSCTL_OFF + 320;
constexpr int LDS_BYTES = 147456;
static_assert(MISC_OFF + 128 <= LDS_BYTES, "LDS map");

#define GAS __attribute__((address_space(1)))
#define LAS __attribute__((address_space(3)))
typedef unsigned short bf16;
typedef unsigned v4u __attribute__((ext_vector_type(4)));
typedef float f32x4 __attribute__((ext_vector_type(4)));
typedef short bf16x8 __attribute__((ext_vector_type(8)));
typedef GAS unsigned gu32;
#define RLX_AGENT __ATOMIC_RELAXED, __HIP_MEMORY_SCOPE_AGENT
#define LDS_WAIT() asm volatile("s_waitcnt lgkmcnt(0)" ::: "memory")
#define VM_WAIT() asm volatile("s_waitcnt vmcnt(0)" ::: "memory")
__device__ __forceinline__ unsigned f2bf(float f) { unsigned u = __builtin_bit_cast(unsigned, f); return (u + 0x7fffu + ((u >> 16) & 1u)) >> 16; }
__device__ __forceinline__ unsigned pk2(float lo, float hi) { return f2bf(lo) | (f2bf(hi) << 16); }
__device__ __forceinline__ float bflo(unsigned w) { return __uint_as_float(w << 16); }
__device__ __forceinline__ float bfhi(unsigned w) { return __uint_as_float(w & 0xffff0000u); }
__device__ __forceinline__ float bf1(bf16 h) { return __uint_as_float((unsigned)h << 16); }
__device__ __forceinline__ float logsigmoidf(float x) { return x < 0.f ? x - log1pf(__expf(x)) : -log1pf(__expf(-x)); }
__device__ __forceinline__ float logsigmoid_fast(float x) { return fminf(x, 0.f) - 0.6931471805599453f * __builtin_amdgcn_logf(1.0f + __builtin_amdgcn_exp2f(-fabsf(x) * 1.4426950408889634f)); }

#define XB_TMO      128
#define XB_XCNT(j)  (256  + 64 * (j))
#define XB_XSUB(j)  (1280 + 64 * (j))
#define XB_XGEN(j)  (2304 + 64 * (j))
#define XB_TOP      3328
#define XB_TOPGEN   3392
#define XCD_BAR_WORDS 3456
#define XB_SPIN_CAP (1u << 18)

__device__ __forceinline__ unsigned xb_ld(unsigned* p)              { return __hip_atomic_load(p, __ATOMIC_RELAXED, __HIP_MEMORY_SCOPE_AGENT); }
__device__ __forceinline__ unsigned xb_add(unsigned* p, unsigned v) { return __hip_atomic_fetch_add(p, v, __ATOMIC_RELAXED, __HIP_MEMORY_SCOPE_AGENT); }
__device__ __forceinline__ unsigned xb_xcc_id() { return (unsigned)__builtin_amdgcn_s_getreg((3 << 11) | 20) & 0xFu; }
#define XB_SPIN(cond, bar) do { unsigned _sp = 0; while (cond) { __builtin_amdgcn_s_sleep(1); \
    if ((++_sp & 255u) == 0u) { if (xb_ld(&(bar)[XB_TMO])) break; if (_sp > XB_SPIN_CAP) { atomicAdd(&(bar)[XB_TMO], 1u); break; } } } } while (0)

struct XcdBarrier { unsigned* bar; unsigned x; volatile LAS unsigned* st; };

__device__ __forceinline__ XcdBarrier xcd_barrier_post(unsigned* bar, volatile LAS unsigned* st) {
    XcdBarrier b; b.bar = bar; b.x = xb_xcc_id(); b.st = st;
    if (threadIdx.x == 0) (void)xb_add(&bar[XB_XCNT(b.x)], 1u);
    return b;
}
__device__ __forceinline__ void xcd_barrier_complete(unsigned* bar, unsigned x, unsigned& nloc, unsigned& nx) {
    const unsigned G = gridDim.x * gridDim.y * gridDim.z;
    unsigned sum, cnt, mine, sp = 0u;
    for (;;) {
        sum = 0u; cnt = 0u; mine = 0u;
#pragma unroll
        for (unsigned j = 0; j < 16; ++j) { const unsigned c = xb_ld(&bar[XB_XCNT(j)]); sum += c; cnt += (c > 0u) ? 1u : 0u; mine = (j == x) ? c : mine; }
        if (sum == G) break;
        __builtin_amdgcn_s_sleep(1);
        if ((++sp & 255u) == 0u) { if (xb_ld(&bar[XB_TMO])) break; if (sp > XB_SPIN_CAP) { atomicAdd(&bar[XB_TMO], 1u); break; } }
    }
    nloc = mine > 0u ? mine : 1u; nx = cnt > 0u ? cnt : 1u;
}
__device__ __forceinline__ void xcd_barrier(const XcdBarrier& b) {
    asm volatile("s_waitcnt vmcnt(0)" ::: "memory");
    __syncthreads();
    if (threadIdx.x == 0) {
        unsigned* bar = b.bar;
        __builtin_amdgcn_s_waitcnt(0);
        unsigned nloc = b.st[0], nx = b.st[1];
        if (nloc == 0u) { xcd_barrier_complete(bar, b.x, nloc, nx); b.st[0] = nloc; b.st[1] = nx; }
        const unsigned old = xb_add(&bar[XB_XSUB(b.x)], 1u);
        const unsigned gen = old / nloc;
        if (old + 1u == (gen + 1u) * nloc) {
            __builtin_amdgcn_fence(__ATOMIC_RELEASE, "agent");
            asm volatile("s_waitcnt vmcnt(0)" ::: "memory");
            const unsigned og = xb_add(&bar[XB_TOP], 1u);
            const unsigned tg = og / nx;
            if (og + 1u == (tg + 1u) * nx) xb_add(&bar[XB_TOPGEN], 1u);
            else XB_SPIN(xb_ld(&bar[XB_TOPGEN]) == tg, bar);
            __builtin_amdgcn_fence(__ATOMIC_ACQUIRE, "agent");
            xb_add(&bar[XB_XGEN(b.x)], 1u);
            asm volatile("s_waitcnt vmcnt(0)" ::: "memory");
        } else {
            XB_SPIN(xb_ld(&bar[XB_XGEN(b.x)]) == gen, bar);
            __builtin_amdgcn_fence(__ATOMIC_ACQUIRE, "agent");
            asm volatile("s_waitcnt vmcnt(0)" ::: "memory");
        }
    }
    __syncthreads();
}

struct Frame {
    LAS unsigned char* lds;
    volatile LAS unsigned* MISC;
    gu32* ctl;
    int tid, lane, wave;
    int vcu, G;
    unsigned char* ws;
};

__device__ __forceinline__ float wave_sum(float v) {
#pragma unroll
    for (int o = 1; o < 64; o <<= 1) v += __shfl_xor(v, o);
    return v;
}

__device__ __forceinline__ int wsrc_col(int kind, int n) {
    if (kind == 0) {
        if (n < 256) return 1544 + n;
        if (n < 512) return 1800 + (n - 256);
        if (n < 1024) return 2056 + (n - 512);
        if (n < 1536) return n - 1024;
        if (n < 2048) return 512 + (n - 1536);
        if (n < 2560) return 1024 + (n - 2048);
        return 2584 + (n - 2560);
    } else if (kind == 1) {
        const bool il = (n < 512) || (n >= 1024 && n < 2048);
        if (!il) return n;
        const int p = n & 63; return (n & ~63) + (p >> 1) + 32 * (p & 1);
    } else if (kind == 2) {
        return n;
    } else {
        if (n < 8) return 1536 + n;
        if (n < 24) return 2568 + (n - 8);
        return -1;
    }
}
__device__ __forceinline__ void p0_transpose_item(const float* W, int Nsrc, int kind, const float* gain, bf16* WT, int nblk, LAS float* scr, int item, int lane) {
    const int K = DMODEL; const int kb = item / nblk, nb = item % nblk, k0 = 64 * kb, n0 = 32 * nb;
    const int sc = wsrc_col(kind, n0 + (lane & 31));
    float wv[32];
#pragma unroll
    for (int i = 0; i < 32; ++i) { const int kk = 2 * i + (lane >> 5); wv[i] = (sc >= 0) ? W[(size_t)(k0 + kk) * Nsrc + sc] : 0.f; }
#pragma unroll
    for (int i = 0; i < 32; ++i) { const int kk = 2 * i + (lane >> 5); const float g = gain ? gain[k0 + kk] : 1.0f; scr[kk * 33 + (lane & 31)] = wv[i] * g; }
    LDS_WAIT(); asm volatile("" ::: "memory");
    const int c = lane & 7;
#pragma unroll
    for (int j = 0; j < 4; ++j) { const int n = (lane >> 3) + 8 * j; const LAS float* s = scr + (8 * c) * 33 + n;
        v4u o; o.x = pk2(s[0 * 33], s[1 * 33]); o.y = pk2(s[2 * 33], s[3 * 33]); o.z = pk2(s[4 * 33], s[5 * 33]); o.w = pk2(s[6 * 33], s[7 * 33]);
        *(GAS v4u*)(WT + (size_t)(n0 + n) * K + k0 + 8 * c) = o; }
    LDS_WAIT(); asm volatile("" ::: "memory");
}
typedef float f32x16 __attribute__((ext_vector_type(16)));
typedef float f32x2 __attribute__((ext_vector_type(2)));
typedef unsigned v2u __attribute__((ext_vector_type(2)));
typedef __bf16 bf16x2_t __attribute__((ext_vector_type(2)));
__device__ __forceinline__ unsigned cvtpk(float lo, float hi) { f32x2 v = {lo, hi}; bf16x2_t b = __builtin_convertvector(v, bf16x2_t); return __builtin_bit_cast(unsigned, b); }
__device__ __forceinline__ int crow16(int r, int hi) { return (r & 3) + 8 * (r >> 2) + 4 * hi; }
__device__ __forceinline__ f32x16 mfma32(bf16x8 a, bf16x8 b, f32x16 c) { return __builtin_amdgcn_mfma_f32_32x32x16_bf16(a, b, c, 0, 0, 0); }
__device__ __forceinline__ bf16x8 pack8(const f32x16& p, int s2) {
    v4u w; w.x = cvtpk(p[8 * s2 + 0], p[8 * s2 + 1]); w.y = cvtpk(p[8 * s2 + 2], p[8 * s2 + 3]); w.z = cvtpk(p[8 * s2 + 4], p[8 * s2 + 5]); w.w = cvtpk(p[8 * s2 + 6], p[8 * s2 + 7]);
    return __builtin_bit_cast(bf16x8, w);
}

__device__ __forceinline__ void wave_lds_sync() { asm volatile("s_waitcnt lgkmcnt(0)" ::: "memory"); }

constexpr int LC = 64;
constexpr int LLD = 72;
constexpr int L1_W = 0, L1_BL = 16384, L1_BUF = 17408, L1_KZ = 0, L1_VT = 64 * LLD * 2, L1_BUFSZ = L1_VT + 128 * LLD * 2;
static_assert(L1_BUF + 2 * L1_BUFSZ <= RING_BYTES, "X1 LDS map");

struct LinArgs {
    bf16* Z; const float* GLR; const float* w_lr; const float* b_lr;
    const float* g1; const float* g2;
    bf16* KV; float* DEC; bf16* PREV; bf16* Y;
};
constexpr int L1R_K = 17408, L1R_Q = L1R_K + 64 * LLD * 2, L1R_V = L1R_Q + 64 * LLD * 2, L1R_VLD = 136, L1R_G = L1R_V + 64 * L1R_VLD * 2, L1R_GLD = 20, L1R_END = L1R_G + 64 * L1R_GLD * 4;
constexpr int L1I = L1R_END;
static_assert(L1R_K == L1_BUF && L1I + 2 * L1_BUFSZ <= RING_BYTES, "X1 LDS map");
struct LinRaw { v4u kx, qx, vx0, vx1; f32x4 gl; };

template <bool ODD> __device__ __forceinline__ void lin_prep_load(Frame& F, const LinArgs& A, int u, LinRaw& R) {
    const int bh = u >> 6, n = u & 63, b = bh >> 2; const int tok = F.tid >> 3, c = F.tid & 7;
    const size_t hrow = (size_t)bh * SEQ + n * LC + tok;
    R.kx = *(const v4u*)(A.Z + ZR_LK + hrow * 64 + 8 * c); R.qx = *(const v4u*)(A.Z + ZR_LQ + hrow * 64 + 8 * c);
    R.vx0 = *(const v4u*)(A.Z + ZR_LV + hrow * 128 + 16 * c); R.vx1 = *(const v4u*)(A.Z + ZR_LV + hrow * 128 + 16 * c + 8);
    if (!ODD) { R.gl = (f32x4){0.f, 0.f, 0.f, 0.f}; if (F.tid < 256) R.gl = *(const f32x4*)(A.GLR + ((size_t)b * SEQ + n * LC + (F.tid >> 2)) * 16 + 4 * (F.tid & 3)); }
}

template <bool ODD> __device__ __forceinline__ void lin_prep_phase(Frame& F, const LinArgs& A, const bool dry = false) {
    LAS float* wL = (LAS float*)(F.lds + RING_OFF + L1_W); LAS float* bL = (LAS float*)(F.lds + RING_OFF + L1_BL);
    LAS bf16* KR = (LAS bf16*)(F.lds + RING_OFF + L1R_K); LAS bf16* QR = (LAS bf16*)(F.lds + RING_OFF + L1R_Q); LAS bf16* VR = (LAS bf16*)(F.lds + RING_OFF + L1R_V); LAS float* GR = (LAS float*)(F.lds + RING_OFF + L1R_G);
    if (!ODD) { for (int i = F.tid; i < 4096; i += 512) wL[i] = A.w_lr[i]; if (F.tid < 256) bL[F.tid] = A.b_lr[F.tid]; }
    const int r32 = F.lane & 31, hi = F.lane >> 5, w = F.wave, ctok = F.tid >> 3, cc = F.tid & 7;
    int u = F.vcu; int par = 0;
    LinRaw R;
    if (u < 2048) lin_prep_load<ODD>(F, A, u, R);
    for (; u < 2048; u += F.G) {
        const int bh = u >> 6, n = u & 63, h = bh & 3;
        LAS bf16* KzT = (LAS bf16*)(F.lds + RING_OFF + L1I + par * L1_BUFSZ + L1_KZ); LAS bf16* VT = (LAS bf16*)(F.lds + RING_OFF + L1I + par * L1_BUFSZ + L1_VT);
        __syncthreads();
        *(LAS v4u*)(KR + ctok * LLD + 8 * cc) = R.kx; *(LAS v4u*)(QR + ctok * LLD + 8 * cc) = R.qx;
        *(LAS v4u*)(VR + ctok * L1R_VLD + 16 * cc) = R.vx0; *(LAS v4u*)(VR + ctok * L1R_VLD + 16 * cc + 8) = R.vx1;
        if (!ODD && F.tid < 256) *(LAS f32x4*)(GR + (F.tid >> 2) * L1R_GLD + 4 * (F.tid & 3)) = R.gl;
        __syncthreads();
        if (u + F.G < 2048) lin_prep_load<ODD>(F, A, u + F.G, R);
        const v4u kx = *(const LAS v4u*)(KR + F.lane * LLD + 8 * w), qx = *(const LAS v4u*)(QR + F.lane * LLD + 8 * w);
        const v4u vx0 = *(const LAS v4u*)(VR + F.lane * L1R_VLD + 16 * w), vx1 = *(const LAS v4u*)(VR + F.lane * L1R_VLD + 16 * w + 8);
        float bv[8], blast[8];
        if (ODD) {
            const float lg = __logf(1.0f - exp2f(-5.0f - (float)h));
#pragma unroll
            for (int e = 0; e < 8; ++e) { bv[e] = lg * (float)(F.lane + 1); blast[e] = lg * 64.0f; }
        } else {
            f32x4 gl[4];
#pragma unroll
            for (int i = 0; i < 4; ++i) gl[i] = *(const LAS f32x4*)(GR + F.lane * L1R_GLD + 4 * i);
            const LAS float* wp = wL + h * 64 + 8 * w;
            f32x4 x0 = *(const LAS f32x4*)(bL + h * 64 + 8 * w), x1 = *(const LAS f32x4*)(bL + h * 64 + 8 * w + 4);
#pragma unroll
            for (int r = 0; r < 16; ++r) { const float g = gl[r >> 2][r & 3]; x0 += g * *(const LAS f32x4*)(wp + r * 256); x1 += g * *(const LAS f32x4*)(wp + r * 256 + 4); }
#pragma unroll
            for (int e = 0; e < 8; ++e) bv[e] = logsigmoid_fast(e < 4 ? x0[e & 3] : x1[e & 3]) * (1.0f / 16.0f);
#pragma unroll
            for (int o = 1; o < 64; o <<= 1) {
#pragma unroll
                for (int e = 0; e < 8; ++e) { const float y = __shfl_up(bv[e], o); if (F.lane >= o) bv[e] += y; }
            }
#pragma unroll
            for (int e = 0; e < 8; ++e) blast[e] = __shfl(bv[e], 63);
        }
        {
            v4u qo, ko;
#pragma unroll
            for (int e2 = 0; e2 < 4; ++e2) {
                const float q0 = bflo(qx[e2]), q1 = bfhi(qx[e2]), k0 = bflo(kx[e2]), k1 = bfhi(kx[e2]);
                const float e0 = __expf(bv[2 * e2]), e1 = __expf(bv[2 * e2 + 1]);
                qo[e2] = cvtpk(q0 * e0, q1 * e1);
                ko[e2] = cvtpk(k0 * __builtin_amdgcn_rcpf(e0), k1 * __builtin_amdgcn_rcpf(e1));
                KzT[(8 * w + 2 * e2) * LLD + F.lane] = (bf16)f2bf(k0 * __expf(blast[2 * e2] - bv[2 * e2]));
                KzT[(8 * w + 2 * e2 + 1) * LLD + F.lane] = (bf16)f2bf(k1 * __expf(blast[2 * e2 + 1] - bv[2 * e2 + 1]));
            }
            *(LAS v4u*)(QR + F.lane * LLD + 8 * w) = qo; *(LAS v4u*)(KR + F.lane * LLD + 8 * w) = ko;
#pragma unroll
            for (int e = 0; e < 4; ++e) {
                VT[(16 * w + 2 * e) * LLD + F.lane] = (bf16)(vx0[e] & 0xffffu); VT[(16 * w + 2 * e + 1) * LLD + F.lane] = (bf16)(vx0[e] >> 16);
                VT[(16 * w + 8 + 2 * e) * LLD + F.lane] = (bf16)(vx1[e] & 0xffffu); VT[(16 * w + 8 + 2 * e + 1) * LLD + F.lane] = (bf16)(vx1[e] >> 16);
            }
            if (F.lane == 63) { float* dp = A.DEC + ((size_t)bh * 64 + n) * 64 + 8 * w;
#pragma unroll
                for (int e = 0; e < 8; ++e) dp[e] = __expf(blast[e]); }
        }
        __syncthreads();
        {
            const size_t hrow = (size_t)bh * SEQ + n * LC + ctok;
            const v4u qo = *(const LAS v4u*)(QR + ctok * LLD + 8 * cc), ko = *(const LAS v4u*)(KR + ctok * LLD + 8 * cc);
            if (dry) { *(v4u*)(A.PREV + hrow * 128 + 8 * cc) = qo; *(v4u*)(A.PREV + hrow * 128 + 64 + 8 * cc) = ko; }
            else { *(v4u*)(A.Z + ZR_LQ + hrow * 64 + 8 * cc) = qo; *(v4u*)(A.Z + ZR_LK + hrow * 64 + 8 * cc) = ko; }
            const int vb = w >> 1, db = w & 1;
            f32x16 acc = {};
#pragma unroll
            for (int s = 0; s < 4; ++s) {
                const bf16x8 a = *(const LAS bf16x8*)(VT + (vb * 32 + r32) * LLD + 16 * s + 8 * hi);
                const bf16x8 bb = *(const LAS bf16x8*)(KzT + (db * 32 + r32) * LLD + 16 * s + 8 * hi);
                acc = mfma32(a, bb, acc);
            }
            LAS bf16* T = VR + w * (32 * 40);
#pragma unroll
            for (int r = 0; r < 16; ++r) T[crow16(r, hi) * 40 + r32] = (bf16)f2bf(acc[r]);
            wave_lds_sync();
            bf16* dst = A.KV + ((size_t)bh * 64 + n) * (128 * 64) + (size_t)(vb * 32) * 64 + db * 32;
#pragma unroll
            for (int e = 0; e < 2; ++e) { const int pi = F.lane + 64 * e, rw = pi >> 2, pc = pi & 3; *(v4u*)(dst + rw * 64 + 8 * pc) = *(const LAS v4u*)(T + rw * 40 + 8 * pc); }
        }
        par ^= 1;
    }
    __syncthreads();
}

__device__ __forceinline__ void lin_scan_phase(Frame& F, const LinArgs& A) {
    const int gt = F.vcu * 512 + F.tid;
    for (int e = gt; e < 32 * 128 * 32; e += F.G * 512) {
        const int bh = e >> 12, rem = e & 4095;
        const unsigned* kvp = (const unsigned*)(A.KV + (size_t)bh * 64 * (128 * 64) + rem * 2);
        const f32x2* dcp = (const f32x2*)(A.DEC + (size_t)bh * 64 * 64 + (rem & 31) * 2);
        unsigned* pp = (unsigned*)(A.PREV + (size_t)bh * 64 * (128 * 64) + rem * 2);
        f32x2 st = {0.f, 0.f};
        for (int n0 = 0; n0 < 64; n0 += 8) {
            f32x2 kv[8], dc[8];
#pragma unroll
            for (int i = 0; i < 8; ++i) { const unsigned w = kvp[(size_t)(n0 + i) * 4096]; kv[i] = (f32x2){bflo(w), bfhi(w)}; dc[i] = dcp[(n0 + i) * 32]; }
#pragma unroll
            for (int i = 0; i < 8; ++i) { pp[(size_t)(n0 + i) * 4096] = cvtpk(st.x, st.y); st = st * dc[i] + kv[i]; }
        }
    }
}


typedef short v4i16_t __attribute__((ext_vector_type(4)));
__device__ __forceinline__ bf16x8 ld_tr8(const LAS bf16* p) {
    const v4i16_t a = __builtin_amdgcn_ds_read_tr16_b64_v4i16((LAS v4i16_t*)p), b = __builtin_amdgcn_ds_read_tr16_b64_v4i16((LAS v4i16_t*)(p + 256));
    return (bf16x8){a[0], a[1], a[2], a[3], b[0], b[1], b[2], b[3]};
}

constexpr int L3_QT = 0, L3_KT = L3_QT + 64 * LLD * 2, L3_VP = L3_KT + 64 * LLD * 2  , L3_PL = L3_VP + 4 * 64 * 32 * 2, L3_GL = L3_PL + 128 * LLD * 2, L3_GLD = 136, L3_OL = L3_GL + 64 * L3_GLD * 2, L3_END = L3_OL + 64 * 132 * 4;
static_assert(L3_END <= RING_BYTES, "X3 LDS map");
struct LinOutRaw { v4u q, k, vv[2], pv[2], g[2]; };
template <bool ODD> __device__ __forceinline__ void lin_out_load(Frame& F, const LinArgs& A, int u, LinOutRaw& R) {
    const int bh = u >> 6, n = u & 63, b = bh >> 2, h = bh & 3; const size_t hrow0 = (size_t)bh * SEQ + n * LC;
    const int tok = F.tid >> 3, c = F.tid & 7;
    R.q = *(const v4u*)(A.Z + ZR_LQ + (hrow0 + tok) * 64 + 8 * c); R.k = *(const v4u*)(A.Z + ZR_LK + (hrow0 + tok) * 64 + 8 * c);
    const bf16* vsrc = A.Z + ZR_LV + (hrow0 + tok) * 128 + 16 * c; const v4u* pp = (const v4u*)(A.PREV + (size_t)u * (128 * 64));
    R.vv[0] = *(const v4u*)vsrc; R.vv[1] = *(const v4u*)(vsrc + 8); R.pv[0] = pp[F.tid]; R.pv[1] = pp[F.tid + 512];
    const bf16* gp = A.Z + ZR_GATE + ((size_t)b * SEQ + n * LC + tok) * 1024 + (ODD ? 0 : 512) + h * 128 + 16 * c;
    R.g[0] = *(const v4u*)gp; R.g[1] = *(const v4u*)(gp + 8);
}
template <bool ODD> __device__ __forceinline__ void lin_out_phase(Frame& F, const LinArgs& A) {
    LAS bf16* QtL = (LAS bf16*)(F.lds + RING_OFF + L3_QT); LAS bf16* KtL = (LAS bf16*)(F.lds + RING_OFF + L3_KT);
    LAS bf16* VPL = (LAS bf16*)(F.lds + RING_OFF + L3_VP); LAS bf16* PL = (LAS bf16*)(F.lds + RING_OFF + L3_PL);
    LAS bf16* GL = (LAS bf16*)(F.lds + RING_OFF + L3_GL); LAS float* OL = (LAS float*)(F.lds + RING_OFF + L3_OL);
    const int r32 = F.lane & 31, hi = F.lane >> 5, qi = F.wave >> 2, vj = F.wave & 3;
    int u = F.vcu;
    f32x4 g1v[4], g2v[4]; int hcur = (u >> 6) & 3;
    { const int c0 = hcur * 128 + (F.tid & 7) * 16;
#pragma unroll
      for (int e = 0; e < 4; ++e) { g1v[e] = *(const f32x4*)(A.g1 + c0 + 4 * e); g2v[e] = ODD ? *(const f32x4*)(A.g2 + c0 + 4 * e) : (f32x4){0.f, 0.f, 0.f, 0.f}; } }
    LinOutRaw R;
    if (u < 2048) lin_out_load<ODD>(F, A, u, R);
    for (; u < 2048; u += F.G) {
        const int bh = u >> 6, n = u & 63, b = bh >> 2, h = bh & 3;
        if (h != hcur) {
            hcur = h; const int c0 = h * 128 + (F.tid & 7) * 16;
#pragma unroll
            for (int e = 0; e < 4; ++e) { g1v[e] = *(const f32x4*)(A.g1 + c0 + 4 * e); g2v[e] = ODD ? *(const f32x4*)(A.g2 + c0 + 4 * e) : (f32x4){0.f, 0.f, 0.f, 0.f}; }
        }
        __syncthreads();
        { const int tok = F.tid >> 3, c = F.tid & 7;
          *(LAS v4u*)(QtL + tok * LLD + 8 * c) = R.q; *(LAS v4u*)(KtL + tok * LLD + 8 * c) = R.k;
          *(LAS v4u*)(GL + tok * L3_GLD + 16 * c) = R.g[0]; *(LAS v4u*)(GL + tok * L3_GLD + 16 * c + 8) = R.g[1];
#pragma unroll
          for (int e = 0; e < 2; ++e) { const int pi = F.tid + 512 * e; *(LAS v4u*)(PL + (pi >> 3) * LLD + (pi & 7) * 8) = R.pv[e];
              *(LAS v4u*)(VPL + (c >> 1) * 2048 + tok * 32 + (c & 1) * 16 + 8 * e) = R.vv[e]; } }
        __syncthreads();
        if (u + F.G < 2048) lin_out_load<ODD>(F, A, u + F.G, R);
        f32x16 st0 = {}, st1 = {};
        bf16x8 qf[4];
#pragma unroll
        for (int s = 0; s < 4; ++s) qf[s] = *(const LAS bf16x8*)(QtL + (qi * 32 + r32) * LLD + 16 * s + 8 * hi);
#pragma unroll
        for (int s = 0; s < 4; ++s) st0 = mfma32(*(const LAS bf16x8*)(KtL + r32 * LLD + 16 * s + 8 * hi), qf[s], st0);
        if (qi == 1) {
#pragma unroll
            for (int s = 0; s < 4; ++s) st1 = mfma32(*(const LAS bf16x8*)(KtL + (32 + r32) * LLD + 16 * s + 8 * hi), qf[s], st1);
        }
#pragma unroll
        for (int r = 0; r < 16; ++r) { const int kl = crow16(r, hi); if (qi == 0) { if (kl > r32) st0[r] = 0.f; } else { if (kl > r32) st1[r] = 0.f; } }
        f32x16 o = {};
        const LAS bf16* vlane = VPL + vj * 2048 + (4 * hi + ((F.lane & 15) >> 2)) * 32 + 16 * ((F.lane >> 4) & 1) + 4 * (F.lane & 3);
        o = mfma32(pack8(st0, 0), ld_tr8(vlane), o);
        o = mfma32(pack8(st0, 1), ld_tr8(vlane + 16 * 32), o);
        if (qi == 1) { o = mfma32(pack8(st1, 0), ld_tr8(vlane + 32 * 32), o); o = mfma32(pack8(st1, 1), ld_tr8(vlane + 48 * 32), o); }
#pragma unroll
        for (int s = 0; s < 4; ++s) o = mfma32(qf[s], *(const LAS bf16x8*)(PL + (vj * 32 + r32) * LLD + 16 * s + 8 * hi), o);
#pragma unroll
        for (int r = 0; r < 16; ++r) OL[(qi * 32 + crow16(r, hi)) * 132 + vj * 32 + r32] = o[r];
        __syncthreads();
        {
            const int q = F.tid >> 3, part = F.tid & 7; const size_t row = (size_t)b * SEQ + n * LC + q;
            f32x4 x[4];
#pragma unroll
            for (int e = 0; e < 4; ++e) x[e] = *(const LAS f32x4*)(OL + q * 132 + part * 16 + 4 * e);
            if (ODD) {
                float s = 0.f;
#pragma unroll
                for (int e = 0; e < 4; ++e) s += (x[e][0] + x[e][1]) + (x[e][2] + x[e][3]);
                s += __shfl_xor(s, 1); s += __shfl_xor(s, 2); s += __shfl_xor(s, 4);
                const float mu = s * (1.0f / 128.0f);
#pragma unroll
                for (int e = 0; e < 4; ++e) x[e] = x[e] - mu;
            }
            float s2 = 0.f;
#pragma unroll
            for (int e = 0; e < 4; ++e) s2 += (x[e][0] * x[e][0] + x[e][1] * x[e][1]) + (x[e][2] * x[e][2] + x[e][3] * x[e][3]);
            s2 += __shfl_xor(s2, 1); s2 += __shfl_xor(s2, 2); s2 += __shfl_xor(s2, 4);
            const float rs = 1.0f / sqrtf(s2 * (1.0f / 128.0f) + RMS_EPS);
            const int c0 = h * 128 + part * 16, yb = ODD ? 0 : 512;
            v4u* yp = (v4u*)(A.Y + row * DMODEL + yb + c0);
#pragma unroll
            for (int e2 = 0; e2 < 2; ++e2) {
                const v4u gt = *(const LAS v4u*)(GL + q * L3_GLD + part * 16 + 8 * e2); v4u ov;
                const f32x4 ya = x[2 * e2] * rs * g1v[2 * e2] + g2v[2 * e2], yb4 = x[2 * e2 + 1] * rs * g1v[2 * e2 + 1] + g2v[2 * e2 + 1];
                ov[0] = cvtpk(ya[0] * bflo(gt[0]), ya[1] * bfhi(gt[0])); ov[1] = cvtpk(ya[2] * bflo(gt[1]), ya[3] * bfhi(gt[1]));
                ov[2] = cvtpk(yb4[0] * bflo(gt[2]), yb4[1] * bfhi(gt[2])); ov[3] = cvtpk(yb4[2] * bflo(gt[3]), yb4[3] * bfhi(gt[3]));
                yp[e2] = ov;
            }
        }
    }
    __syncthreads();
}

constexpr int DK_LD = 72;
constexpr int DV_HALF = 384 * 32;
constexpr int DA_K = 0, DA_VT = DA_K + 384 * DK_LD * 2, DA_WS = DA_VT + 2 * DV_HALF * 2, DA_END = DA_WS + 8 * 512;
constexpr int DA_TLD = 68, DA_TILE = 32 * DA_TLD * 4;
static_assert(DA_END <= RING_BYTES && 8 * DA_TILE <= DA_WS, "dilated-attention LDS map");
constexpr size_t OD_OFF = (size_t)16 * 1024 * 1024;

struct DilRows { v4u kx[6], vx[6]; };
struct DilDesc { int bh, dil, r, blk, has_old, fin; };
template <int PH> __device__ __forceinline__ bool dil_desc(int first, int G, int i, DilDesc& d) {
    if (PH == 0) { const int su = first + (i >> 3) * G; if (su >= 256) return false; const int k = i & 7, span = su & 3;
        d.bh = su >> 2; d.has_old = k >> 2; d.fin = 0;
        if (k < 4) { d.dil = 1; d.r = 0; d.blk = 4 * span + k; } else { d.dil = 4; d.r = k & 3; d.blk = span; }
        return true; }
    const int u = first + i * G; if (u >= 1024) return false;
    d.bh = u >> 4; d.dil = 16; d.r = u & 15; d.blk = 0; d.has_old = 1; d.fin = 1; return true;
}
__device__ __forceinline__ void dil_load_rows(Frame& F, const bf16* Z, const DilDesc& d, DilRows& R) {
    const int i0 = 256 * d.blk; const size_t hb0 = (size_t)d.bh * SEQ;
#pragma unroll
    for (int e = 0; e < 6; ++e) {
        const int pi = F.tid + 512 * e, row = pi >> 3, c = pi & 7, idx = i0 - 128 + row;
        R.kx[e] = (v4u){0u, 0u, 0u, 0u}; R.vx[e] = (v4u){0u, 0u, 0u, 0u};
        if (idx >= 0) { const size_t ro = (hb0 + (size_t)(idx * d.dil + d.r)) * 64 + 8 * c; R.kx[e] = *(const v4u*)(Z + ZR_AK + ro); R.vx[e] = *(const v4u*)(Z + ZR_AV + ro); }
    }
}

template <int PH> __device__ __forceinline__ void dil_phase(Frame& F, const bf16* Z, bf16* Y, bf16* OD, float* LSE) {
    LAS bf16* KI = (LAS bf16*)(F.lds + RING_OFF + DA_K); LAS bf16* VH = (LAS bf16*)(F.lds + RING_OFF + DA_VT);
    LAS float* wsc = (LAS float*)(F.lds + RING_OFF + DA_WS + F.wave * 512); LAS float* T = (LAS float*)(F.lds + RING_OFF + F.wave * DA_TILE);
    const int r32 = F.lane & 31, hi = F.lane >> 5;
    DilDesc d, dn;
    DilRows R;
    bool have = dil_desc<PH>(F.vcu, F.G, 0, d);
    if (have) dil_load_rows(F, Z, d, R);
    for (int it = 0; have; ++it) {
        const int b = d.bh >> 3, h = d.bh & 7, r = d.r, DIL = d.dil, i0 = 256 * d.blk;
        const size_t hb0 = (size_t)d.bh * SEQ;
        if (PH == 0 && (it & 7) == 4) asm volatile("s_waitcnt vmcnt(0)" ::: "memory");
        __syncthreads();
#pragma unroll
        for (int e = 0; e < 6; ++e) {
            const int pi = F.tid + 512 * e, row = pi >> 3, c = pi & 7;
            *(LAS v4u*)(KI + row * DK_LD + 8 * c) = R.kx[e];
            *(LAS v4u*)(VH + (c >> 2) * DV_HALF + row * 32 + (c & 3) * 8) = R.vx[e];
        }
        const int qidx = i0 + 32 * F.wave + r32; const size_t qhrow = hb0 + (size_t)qidx * DIL + r;
        bf16x8 qf[4];
#pragma unroll
        for (int s = 0; s < 4; ++s) qf[s] = *(const bf16x8*)(Z + ZR_AQ + qhrow * 64 + 16 * s + 8 * hi);
        float lse_old = 0.f;
        if (d.has_old) lse_old = __builtin_nontemporal_load(LSE + qhrow);
        __syncthreads();
        have = dil_desc<PH>(F.vcu, F.G, it + 1, dn);
        if (have) dil_load_rows(F, Z, dn, R);
        const int kb_lo = (i0 + 32 * F.wave - 128 < 0) ? (128 - i0 - 32 * F.wave) / 32 : 0;
        f32x16 st[5];
#pragma unroll
        for (int kb = 0; kb < 5; ++kb) {
            st[kb] = (f32x16){};
            if (kb >= kb_lo) {
#pragma unroll
                for (int s = 0; s < 4; ++s) st[kb] = mfma32(*(const LAS bf16x8*)(KI + (32 * F.wave + 32 * kb + r32) * DK_LD + 16 * s + 8 * hi), qf[s], st[kb]);
            }
        }
        float mx = -INFINITY;
#pragma unroll
        for (int kb = 0; kb < 5; ++kb)
#pragma unroll
            for (int rr = 0; rr < 16; ++rr) {
                const int kl = crow16(rr, hi); bool ok = kb >= kb_lo;
                if (kb == 0) ok = ok && (kl >= r32);
                if (kb == 4) ok = ok && (kl <= r32);
                const float sv = ok ? st[kb][rr] : -INFINITY; st[kb][rr] = sv; mx = fmaxf(mx, sv);
            }
        mx = fmaxf(mx, __shfl_xor(mx, 32));
        float l = 0.f;
#pragma unroll
        for (int kb = 0; kb < 5; ++kb)
#pragma unroll
            for (int rr = 0; rr < 16; ++rr) { const float p = __builtin_amdgcn_exp2f(st[kb][rr] - mx); st[kb][rr] = p; l += p; }
        l += __shfl_xor(l, 32);
        const float lse_cur = mx + __log2f(l);
        float w_old = 0.f, w_cur = 1.0f / l, lse_new = lse_cur;
        if (d.has_old) {
            const float m2 = fmaxf(lse_old, lse_cur); lse_new = m2 + __log2f(exp2f(lse_old - m2) + exp2f(lse_cur - m2));
            w_old = exp2f(lse_old - lse_new); w_cur = exp2f(lse_cur - lse_new) / l;
        }
        if (!d.fin && hi == 0) LSE[qhrow] = lse_new;
        if (hi == 0) { wsc[r32] = w_old; wsc[32 + r32] = w_cur; }
        v4u oldv[4];
#pragma unroll
        for (int e = 0; e < 4; ++e) {
            const int pi = F.lane + 64 * e, ql = pi >> 3, c = pi & 7; const size_t tok = (size_t)(i0 + 32 * F.wave + ql) * DIL + r;
            oldv[e] = (v4u){0u, 0u, 0u, 0u};
            if (d.has_old) oldv[e] = __builtin_nontemporal_load((const v4u*)(OD + (hb0 + tok) * 64 + 8 * c));
        }
        f32x16 o0 = {}, o1 = {};
        const LAS bf16* vlane = VH + (32 * F.wave + 4 * hi + ((F.lane & 15) >> 2)) * 32 + 16 * ((F.lane >> 4) & 1) + 4 * (F.lane & 3);
#pragma unroll
        for (int kb = 0; kb < 5; ++kb) {
            if (kb >= kb_lo) {
#pragma unroll
                for (int s2 = 0; s2 < 2; ++s2) {
                    const bf16x8 pa = pack8(st[kb], s2);
                    const LAS bf16* vp = vlane + (32 * kb + 16 * s2) * 32;
                    o0 = mfma32(pa, ld_tr8(vp), o0);
                    o1 = mfma32(pa, ld_tr8(vp + DV_HALF), o1);
                }
            }
        }
        v4u gatev[4];
        if (PH == 1) {
#pragma unroll
            for (int e = 0; e < 4; ++e) { const int pi = F.lane + 64 * e, ql = pi >> 3, c = pi & 7; const size_t tok = (size_t)(i0 + 32 * F.wave + ql) * DIL + r;
                gatev[e] = *(const v4u*)(Z + ZR_GATE + ((size_t)b * SEQ + tok) * 1024 + 512 + h * 64 + 8 * c); }
        }
        __syncthreads();
#pragma unroll
        for (int rr = 0; rr < 16; ++rr) { const int ql = crow16(rr, hi); T[ql * DA_TLD + r32] = o0[rr]; T[ql * DA_TLD + 32 + r32] = o1[rr]; }
        wave_lds_sync();
#pragma unroll
        for (int e = 0; e < 4; ++e) {
            const int pi = F.lane + 64 * e, ql = pi >> 3, c = pi & 7;
            const f32x4 t0 = *(const LAS f32x4*)(T + ql * DA_TLD + 8 * c), t1 = *(const LAS f32x4*)(T + ql * DA_TLD + 8 * c + 4);
            const float wo = wsc[ql], wc = wsc[32 + ql];
            const size_t tok = (size_t)(i0 + 32 * F.wave + ql) * DIL + r;
            float a[8] = {t0[0] * wc, t0[1] * wc, t0[2] * wc, t0[3] * wc, t1[0] * wc, t1[1] * wc, t1[2] * wc, t1[3] * wc};
#pragma unroll
            for (int q = 0; q < 4; ++q) { a[2 * q] += wo * bflo(oldv[e][q]); a[2 * q + 1] += wo * bfhi(oldv[e][q]); }
            if (PH == 1) {
                v4u w;
#pragma unroll
                for (int q = 0; q < 4; ++q) w[q] = cvtpk(a[2 * q] * bflo(gatev[e][q]), a[2 * q + 1] * bfhi(gatev[e][q]));
                *(v4u*)(Y + ((size_t)b * SEQ + tok) * DMODEL + 512 + h * 64 + 8 * c) = w;
            } else {
                v4u w;
#pragma unroll
                for (int q = 0; q < 4; ++q) w[q] = cvtpk(a[2 * q], a[2 * q + 1]);
                *(v4u*)(OD + (hb0 + tok) * 64 + 8 * c) = w;
            }
        }
        d = dn;
    }
    __syncthreads();
}
struct Args { const float* in[14]; float* out; unsigned char* ws; int ph_lo, ph_hi, li, pad; };

constexpr size_t W_LAYER_BYTES = 9 * MiB;
__device__ __forceinline__ bf16* w_in_ptr(unsigned char* ws, int L) { return (bf16*)(ws + WS_W + (size_t)L * W_LAYER_BYTES); }
__device__ __forceinline__ bf16* w_out_ptr(unsigned char* ws, int L) { return (bf16*)(ws + WS_W + (size_t)L * W_LAYER_BYTES + 7 * MiB); }

__device__ __forceinline__ void p0_prologue(Frame& F, const Args& a) {
    LAS float* scr = (LAS float*)(F.lds + RING_OFF + F.wave * 16384);
    const int gw = F.vcu * NWAVES + F.wave, NGW = F.G * NWAVES;
    constexpr int I_IN = 16 * 112, I_OUT = 16 * 32, I_SK = 16, PER_LAYER = I_IN + I_OUT, NITEMS = 4 * PER_LAYER + 2 * I_SK;
    for (int it = gw; it < NITEMS; it += NGW) {
        if (it < 4 * PER_LAYER) {
            const int L = it / PER_LAYER; int r = it % PER_LAYER; const int j = L >> 1, odd = L & 1;
            if (r < I_IN) {
                const float* W = odd ? a.in[9] + (size_t)j * DMODEL * ODD_IN : a.in[2] + (size_t)j * DMODEL * EVEN_IN;
                const float* gain = (odd ? a.in[8] : a.in[1]) + j * DMODEL;
                p0_transpose_item(W, odd ? ODD_IN : EVEN_IN, odd ? 1 : 0, gain, w_in_ptr(a.ws, L), 112, scr, r, F.lane);
            } else {
                r -= I_IN;
                const float* W = (odd ? a.in[12] : a.in[7]) + (size_t)j * DMODEL * DMODEL;
                p0_transpose_item(W, DMODEL, 2, nullptr, w_out_ptr(a.ws, L), 32, scr, r, F.lane);
            }
        } else {
            const int r = it - 4 * PER_LAYER; const int j = r / I_SK;
            p0_transpose_item(a.in[2] + (size_t)j * DMODEL * EVEN_IN, EVEN_IN, 3, a.in[1] + j * DMODEL, (bf16*)(a.ws + WS_WSK) + (size_t)j * 32 * DMODEL, 1, scr, r % I_SK, F.lane);
        }
    }
    {
        bf16* HB = (bf16*)(a.ws + WS_HB); float* SS = (float*)(a.ws + WS_SS);
        for (int m0 = gw * 4; m0 < M; m0 += NGW * 4) {
            f32x4 v[4][4];
#pragma unroll
            for (int rr = 0; rr < 4; ++rr) { const GAS f32x4* xr = (const GAS f32x4*)(a.in[0] + (size_t)(m0 + rr) * DMODEL) + F.lane;
#pragma unroll
                for (int j = 0; j < 4; ++j) v[rr][j] = xr[64 * j]; }
#pragma unroll
            for (int rr = 0; rr < 4; ++rr) {
                GAS unsigned long long* o8 = (GAS unsigned long long*)(HB + (size_t)(m0 + rr) * DMODEL) + F.lane;
                float s = 0.f;
#pragma unroll
                for (int j = 0; j < 4; ++j) { s += (v[rr][j].x * v[rr][j].x + v[rr][j].y * v[rr][j].y) + (v[rr][j].z * v[rr][j].z + v[rr][j].w * v[rr][j].w);
                    o8[64 * j] = (unsigned long long)pk2(v[rr][j].x, v[rr][j].y) | ((unsigned long long)pk2(v[rr][j].z, v[rr][j].w) << 32); }
                s = wave_sum(s);
                if (F.lane < 16) SS[(size_t)(m0 + rr) * 16 + F.lane] = (F.lane == 0) ? s : 0.f;
            }
        }
    }
    {
        float* RP = (float*)(a.ws + WS_ROPE);
        for (int e = F.vcu * 512 + F.tid; e < SEQ * 32; e += F.G * 512) {
            const int t = e >> 5, j = e & 31;
            const float inv = (float)exp(-(double)j * (9.210340371976184 / 32.0));
            const float ang = (float)t * inv;
            double sn, cs; sincos((double)ang, &sn, &cs);
            RP[2 * e] = (float)cs; RP[2 * e + 1] = (float)sn;
        }
    }
}

__device__ __forceinline__ void skinny_phase(Frame& F, const bf16* HB, const bf16* WSK, const float* SS, const float* b_f, float* FFo, float* GLRo) {
    typedef float f32x4_t __attribute__((ext_vector_type(4)));
    const int lr = F.lane & 15, kq = F.lane >> 4;
    for (int rb = blockIdx.x; rb < M / 128; rb += F.G) {
        const int r0 = rb * 128 + F.wave * 16;
        f32x4_t acc0 = {0.f, 0.f, 0.f, 0.f}, acc1 = {0.f, 0.f, 0.f, 0.f};
        const bf16* ap = HB + (size_t)(r0 + lr) * DMODEL + 8 * kq;
        const bf16* bp0 = WSK + (size_t)lr * DMODEL + 8 * kq;
        const bf16* bp1 = WSK + (size_t)(16 + lr) * DMODEL + 8 * kq;
        for (int k0 = 0; k0 < DMODEL; k0 += 256) {
            bf16x8 av[8], b0[8], b1[8];
#pragma unroll
            for (int i = 0; i < 8; ++i) { av[i] = *(const bf16x8*)(ap + k0 + 32 * i); b0[i] = *(const bf16x8*)(bp0 + k0 + 32 * i); b1[i] = *(const bf16x8*)(bp1 + k0 + 32 * i); }
#pragma unroll
            for (int i = 0; i < 8; ++i) { acc0 = __builtin_amdgcn_mfma_f32_16x16x32_bf16(av[i], b0[i], acc0, 0, 0, 0); acc1 = __builtin_amdgcn_mfma_f32_16x16x32_bf16(av[i], b1[i], acc1, 0, 0, 0); }
        }
#pragma unroll
        for (int reg = 0; reg < 4; ++reg) {
            const int row = r0 + 4 * kq + reg;
            const f32x4* sp = (const f32x4*)(SS + (size_t)row * 16);
            const f32x4 s0 = sp[0], s1 = sp[1], s2 = sp[2], s3 = sp[3];
            const float tot = ((s0[0] + s0[1]) + (s0[2] + s0[3])) + ((s1[0] + s1[1]) + (s1[2] + s1[3])) + ((s2[0] + s2[1]) + (s2[2] + s2[3])) + ((s3[0] + s3[1]) + (s3[2] + s3[3]));
            const float rinv = 1.0f / sqrtf(tot * (1.0f / 1024.0f) + RMS_EPS);
            const float v0 = acc0[reg] * rinv, v1 = acc1[reg] * rinv;
            if (lr < 8) { FFo[(size_t)row * 8 + lr] = logsigmoidf(v0 + b_f[lr]); GLRo[(size_t)row * 16 + 8 + lr] = v1; }
            else GLRo[(size_t)row * 16 + (lr - 8)] = v0;
        }
    }
}

__device__ __forceinline__ void fox_norm_unit(Frame& F, int u, const bf16* Z, float* KN, float* QN) {
    const int bh = u >> 2, qz = u & 3, c = F.lane & 7, rl = F.lane >> 3;
    float q2 = 0.f, dmin = 3.0e38f;
#pragma unroll
    for (int tile = 0; tile < 2; ++tile) {
        v4u kx[8], qx[8];
#pragma unroll
        for (int ps = 0; ps < 8; ++ps) {
            const size_t hrow = (size_t)bh * SEQ + 1024 * qz + 128 * F.wave + 64 * tile + 8 * ps + rl;
            kx[ps] = *(const v4u*)(Z + ZR_AK + hrow * 64 + 8 * c); qx[ps] = *(const v4u*)(Z + ZR_AQ + hrow * 64 + 8 * c);
        }
        float k2 = 0.f;
#pragma unroll
        for (int ps = 0; ps < 8; ++ps) {
            float ks = 0.f, qs = 0.f, dg = 0.f;
#pragma unroll
            for (int e = 0; e < 4; ++e) { const float a = bflo(kx[ps][e]), bb = bfhi(kx[ps][e]), cc = bflo(qx[ps][e]), dd = bfhi(qx[ps][e]); ks += a * a + bb * bb; qs += cc * cc + dd * dd; dg += a * cc + bb * dd; }
#pragma unroll
            for (int o = 1; o < 8; o <<= 1) { ks += __shfl_xor(ks, o); qs += __shfl_xor(qs, o); dg += __shfl_xor(dg, o); }
            k2 = fmaxf(k2, ks); q2 = fmaxf(q2, qs); dmin = fminf(dmin, dg);
        }
#pragma unroll
        for (int o = 8; o < 64; o <<= 1) k2 = fmaxf(k2, __shfl_xor(k2, o));
        if (F.lane == 0) KN[bh * 64 + qz * 16 + 2 * F.wave + tile] = sqrtf(k2) * 1.001f;
    }
#pragma unroll
    for (int o = 8; o < 64; o <<= 1) { q2 = fmaxf(q2, __shfl_xor(q2, o)); dmin = fminf(dmin, __shfl_xor(dmin, o)); }
    if (F.lane == 0) { QN[bh * 32 + qz * 8 + F.wave] = sqrtf(q2) * 1.001f; QN[2048 + bh * 32 + qz * 8 + F.wave] = dmin - 1e-3f * fabsf(dmin) - 1e-3f; }
}

__device__ __forceinline__ void cumsum_unit(Frame& F, int bh, const float* FFp, float* CB) {
    LAS float* wsum = (LAS float*)(F.lds + RING_OFF);
    const int b = bh >> 3, h = bh & 7;
    float v[8]; float run = 0.f;
#pragma unroll
    for (int i = 0; i < 8; ++i) { run += FFp[((size_t)b * SEQ + F.tid * 8 + i) * 8 + h]; v[i] = run; }
    float x = run;
#pragma unroll
    for (int o = 1; o < 64; o <<= 1) { const float y = __shfl_up(x, o); if (F.lane >= o) x += y; }
    if (F.lane == 63) wsum[F.wave] = x;
    __syncthreads();
    float off = x - run;
    for (int w = 0; w < F.wave; ++w) off += wsum[w];
#pragma unroll
    for (int i = 0; i < 8; ++i) CB[(size_t)bh * SEQ + F.tid * 8 + i] = v[i] + off;
    __syncthreads();
}

__device__ __forceinline__ void final_norm_phase(Frame& F, const bf16* HB, const float* SS, float* out, const float* g) {
    const int gw = F.vcu * NWAVES + F.wave, NGW = F.G * NWAVES;
    f32x4 gv[4];
#pragma unroll
    for (int j = 0; j < 4; ++j) gv[j] = ((const f32x4*)g)[F.lane + 64 * j];
    for (int m = gw; m < M; m += NGW) {
        const float sv = (F.lane < 16) ? SS[(size_t)m * 16 + F.lane] : 0.f;
        const float r = 1.0f / sqrtf(wave_sum(sv) * (1.0f / 1024.0f) + RMS_EPS);
        const GAS unsigned long long* hr = (const GAS unsigned long long*)(HB + (size_t)m * DMODEL) + F.lane;
        GAS f32x4* xr = (GAS f32x4*)(out + (size_t)m * DMODEL) + F.lane;
#pragma unroll
        for (int j = 0; j < 4; ++j) { const unsigned long long w = hr[64 * j]; const unsigned lo = (unsigned)w, hi2 = (unsigned)(w >> 32);
            f32x4 v; v.x = bflo(lo); v.y = bfhi(lo); v.z = bflo(hi2); v.w = bfhi(hi2); xr[64 * j] = v * r * gv[j]; }
    }
}

constexpr int PH_PER_LAYER = 5, N_PHASES = 2 + 4 * PH_PER_LAYER;
#ifndef MK_N_LAUNCHES
#define MK_N_LAUNCHES 1
#endif

#define IN(k) (lo <= (k) && (k) < hi)
#if defined(PROBE_TS)
#define SEAM(k) do { if (IN(k) && IN((k) + 1)) { for (int rb_ = 0; rb_ < REP_BAR; ++rb_) xcd_barrier(bar); } \
    { const unsigned long long now_ = __builtin_amdgcn_s_memrealtime(); if (((PROBE_TS >> (k)) & 1) && PROBE_SEGSEL(9)) prof_val += (float)(now_ - prof_t) * 0.01f; prof_t = now_; } } while (0)
#else
#define SEAM(k) do { if (IN(k) && IN((k) + 1)) { for (int rb_ = 0; rb_ < REP_BAR; ++rb_) xcd_barrier(bar); } } while (0)
#endif
__device__ __forceinline__ unsigned char* launder_ptr(unsigned char* p) { asm volatile("" : "+s"(p)); return p; }
__device__ __forceinline__ void refresh(Frame& F) { int t = threadIdx.x; asm volatile("" : "+v"(t)); F.tid = t; F.lane = t & 63; F.wave = __builtin_amdgcn_readfirstlane(t >> 6); }
#ifndef REP_PRO
#define REP_PRO 1
#endif
#ifndef REP_INPROJ
#define REP_INPROJ 1
#endif
#ifndef REP_OUT0
#define REP_OUT0 1
#endif
#ifndef REP_X1
#define REP_X1 1
#endif
#ifndef REP_INPROJ_PLAINMODE
#define REP_INPROJ_PLAINMODE 1
#endif
#ifndef STAG_US
#define STAG_US 8
#endif
#ifndef PG_ALIGN_IN
#define PG_ALIGN_IN true
#endif
#ifndef PG_ALIGN_OUT
#define PG_ALIGN_OUT true
#endif
#ifndef PG_SP2
#define PG_SP2 true
#endif
#ifndef FOX_LIMIT1
#define FOX_LIMIT1 3
#endif
#ifndef REP_X1_PAR
#define REP_X1_PAR 2
#endif
#ifndef REP_X2
#define REP_X2 1
#endif
#ifndef REP_X3
#define REP_X3 1
#endif
#ifndef REP_FOX
#define REP_FOX 1
#endif
#ifndef REP_DIL0
#define REP_DIL0 1
#endif
#ifndef REP_BAR
#define REP_BAR 1
#endif
template <int L> __device__ __forceinline__ LinArgs make_lin_args(unsigned char* ws, const Args& args) {
    constexpr int j = L >> 1; constexpr bool odd = (L & 1) != 0;
    LinArgs A;
    A.Z = (bf16*)(ws + WS_Z); A.GLR = (const float*)(ws + WS_GLR); A.w_lr = args.in[4] + (size_t)j * 16 * 256; A.b_lr = args.in[5] + j * 256;
    A.g1 = odd ? args.in[10] + j * 512 : args.in[6] + j * 512; A.g2 = odd ? args.in[11] + j * 512 : nullptr;
    A.KV = (bf16*)(ws + WS_KV); A.DEC = (float*)(ws + WS_DECAY); A.PREV = (bf16*)(ws + WS_PREV); A.Y = (bf16*)(ws + WS_Y);
    return A;
}
#if defined(PROBE_SEG)
#define PROBE_SEGSEL(s) ((s) == PROBE_SEG)
#else
#define PROBE_SEGSEL(s) true
#endif
#if defined(PROBE_TS) && defined(PROBE_SEG)
#define SUBT(k, seg) do { const unsigned long long n2_ = __builtin_amdgcn_s_memrealtime(); if (((PROBE_TS >> (k)) & 1) && (seg) == PROBE_SEG) prof_val += (float)(n2_ - prof_t) * 0.01f; prof_t = n2_; } while (0)
#else
#define SUBT(k, seg) do {} while (0)
#endif
#if defined(PROBE_TS)
#define PROF_PARAMS , unsigned long long& prof_t, float& prof_val
#define PROF_ARGS , prof_t, prof_val
#else
#define PROF_PARAMS
#define PROF_ARGS
#endif
template <int L> __device__ __forceinline__ void run_layer(Frame& F, const Args& args, const XcdBarrier& bar, const int lo, const int hi, unsigned char* lds PROF_PARAMS) {
    constexpr int pb = 1 + PH_PER_LAYER * L; constexpr int j = L >> 1; constexpr bool odd = (L & 1) != 0;
    if (IN(pb)) {
        unsigned char* ws = launder_ptr(args.ws); refresh(F);
        bf16* Z = (bf16*)(ws + WS_Z); bf16* HB = (bf16*)(ws + WS_HB); float* SS = (float*)(ws + WS_SS);
        pg8::Gemm g{HB, w_in_ptr(ws, L), M, NZ, DMODEL}; pg8::StaticOrder S; S.init(M, NZ, F.G, (int)blockIdx.x);
        LAS float* rtab = (LAS float*)(F.lds + LDSCTL_OFF + 1024); LAS int* rtag = (LAS int*)(F.lds + LDSCTL_OFF + 1024 + 2048);
        pg8::epi_in_fill(S, SS, rtab, rtag);
        pg8::EpiIn E{Z, NZ, SS, (const float*)(ws + WS_ROPE), odd ? 1 : 0, 0.125f, C2, 0, rtab, rtag};
#if defined(REP_INPROJ_PLAIN)
        { pg8::EpiIn Ep = E; Ep.plain = REP_INPROJ_PLAINMODE; for (int rp_ = 0; rp_ < REP_INPROJ_PLAIN; ++rp_) pg8::gemm_phase<pg8::EpiIn, pg8::StaticOrder, PG_ALIGN_IN, PG_SP2>(F.lds + RING_OFF, g, S, Ep); }
#endif
        pg8::gemm_phase<pg8::EpiIn, pg8::StaticOrder, PG_ALIGN_IN, PG_SP2>(F.lds + RING_OFF, g, S, E);
        if (!odd) skinny_phase(F, HB, (const bf16*)(ws + WS_WSK) + (size_t)j * 32 * DMODEL, SS, args.in[3] + j * 8, (float*)(ws + WS_FF), (float*)(ws + WS_GLR));
    }
    SUBT(pb, 1);
    SEAM(pb);
    if (IN(pb + 1)) {
        unsigned char* ws = launder_ptr(args.ws); refresh(F);
        bf16* Z = (bf16*)(ws + WS_Z); bf16* Y = (bf16*)(ws + WS_Y);
        { const LinArgs A = make_lin_args<L>(ws, args); for (int rp_ = 1; rp_ < ((REP_X1_PAR == 2 || REP_X1_PAR == (odd ? 1 : 0)) ? REP_X1 : 1); ++rp_) lin_prep_phase<odd>(F, A, true); lin_prep_phase<odd>(F, A); }
        SUBT(pb + 1, 0);
        if (!odd) { for (int u = F.vcu; u < 64; u += F.G) cumsum_unit(F, u, (const float*)(ws + WS_FF), (float*)(ws + WS_CB));
                    for (int u = F.vcu; u < 256; u += F.G) fox_norm_unit(F, u, Z, (float*)(ws + WS_KN), (float*)(ws + WS_QN)); }
        else {
            dil_phase<0>(F, Z, Y, (bf16*)args.out + OD_OFF, (float*)(ws + WS_LSE));
        }
        SUBT(pb + 1, 1);
    }
    SEAM(pb + 1);
    if (IN(pb + 2)) {
        unsigned char* ws = launder_ptr(args.ws); refresh(F);
        { const LinArgs A = make_lin_args<L>(ws, args); for (int rp_ = 0; rp_ < REP_X2; ++rp_) lin_scan_phase(F, A); }
        SUBT(pb + 2, 0);
        if (!odd) {
            bf16* Z = (bf16*)(ws + WS_Z);
            const attn_body::AttnTensors AT{(const attn_body::bf16*)(Z + ZR_AQ), (const attn_body::bf16*)(Z + ZR_AK), (const attn_body::bf16*)(Z + ZR_AV), (const attn_body::bf16*)(Z + ZR_GATE), (const float*)(ws + WS_CB), (const float*)(ws + WS_KN), (const float*)(ws + WS_QN), (attn_body::bf16*)(ws + WS_Y)};
            const attn_body::QueueOrder S((unsigned*)(F.ctl + CW_QUEUE) + j * 512, (int)F.G, (int)blockIdx.x, FOX_LIMIT1);
            attn_body::attn_phase<>((char*)lds + RING_OFF, AT, S, F.MISC + 12);
        } else {
            dil_phase<1>(F, (const bf16*)(ws + WS_Z), (bf16*)(ws + WS_Y), (bf16*)args.out + OD_OFF, (float*)(ws + WS_LSE));
        }
    }
    SUBT(pb + 2, 1);
    SEAM(pb + 2);
    if (IN(pb + 3)) {
        unsigned char* ws = launder_ptr(args.ws); refresh(F);
        { const LinArgs A = make_lin_args<L>(ws, args); for (int rp_ = 0; rp_ < REP_X3; ++rp_) lin_out_phase<odd>(F, A); }
        SUBT(pb + 3, 0);
        if (!odd) {
            bf16* Z = (bf16*)(ws + WS_Z);
            const attn_body::AttnTensors AT{(const attn_body::bf16*)(Z + ZR_AQ), (const attn_body::bf16*)(Z + ZR_AK), (const attn_body::bf16*)(Z + ZR_AV), (const attn_body::bf16*)(Z + ZR_GATE), (const float*)(ws + WS_CB), (const float*)(ws + WS_KN), (const float*)(ws + WS_QN), (attn_body::bf16*)(ws + WS_Y)};
            const attn_body::QueueOrder S((unsigned*)(F.ctl + CW_QUEUE) + j * 512, (int)F.G, (int)blockIdx.x, 1 << 20);
            __syncthreads();
            attn_body::attn_phase<>((char*)lds + RING_OFF, AT, S, F.MISC + 12);
        } else {
        }
    }
    SUBT(pb + 3, 1);
    SEAM(pb + 3);
    if (IN(pb + 4)) {
        unsigned char* ws = launder_ptr(args.ws); refresh(F);
        pg8::Gemm g{(bf16*)(ws + WS_Y), w_out_ptr(ws, L), M, DMODEL, DMODEL}; pg8::StaticOrder S; S.init(M, DMODEL, F.G, (int)blockIdx.x);
        pg8::EpiOut E{(bf16*)(ws + WS_HB), (float*)(ws + WS_SS), (bf16*)(ws + WS_HB)};
#if defined(REP_OUT_DRY)
        { pg8::EpiOut Ed = E; Ed.hbo = (bf16*)(ws + WS_KV); for (int rp_ = 0; rp_ < REP_OUT_DRY; ++rp_) pg8::gemm_phase<pg8::EpiOut, pg8::StaticOrder, PG_ALIGN_OUT, PG_SP2>(F.lds + RING_OFF, g, S, Ed); }
#endif
        pg8::gemm_phase<pg8::EpiOut, pg8::StaticOrder, PG_ALIGN_OUT, PG_SP2>(F.lds + RING_OFF, g, S, E);
    }
    SUBT(pb + 4, 1);
    SEAM(pb + 4);
}
#undef IN
#undef SEAM

__global__ void __launch_bounds__(NWAVES * 64, 2) trunk_fwd(Args args) {
    extern __shared__ __attribute__((aligned(16))) unsigned char lds[];
    Frame F;
    F.lds = (LAS unsigned char*)lds;
    F.MISC = (volatile LAS unsigned*)(F.lds + MISC_OFF);
    F.tid = threadIdx.x; F.lane = F.tid & 63; F.wave = __builtin_amdgcn_readfirstlane(F.tid >> 6);
    F.G = gridDim.x; { const int bx = blockIdx.x; F.vcu = (F.G % 8 == 0) ? (bx % 8) * (F.G / 8) + bx / 8 : bx; }
    F.ws = args.ws; F.ctl = (gu32*)(args.ws + WS_CTL);
    for (int u = F.tid; u < (LDS_BYTES - LDSCTL_OFF) / 4; u += NWAVES * 64) ((LAS unsigned*)(F.lds + LDSCTL_OFF))[u] = 0u;
    __syncthreads();
    XcdBarrier bar = xcd_barrier_post((unsigned*)(F.ctl + CW_BAR) + args.li * XCD_BAR_WORDS, F.MISC + 8);
    const int lo = args.ph_lo, hi = args.ph_hi;
#define IN(k) (lo <= (k) && (k) < hi)
#if defined(PROBE_TS)
#define SEAM(k) do { if (IN(k) && IN((k) + 1)) { for (int rb_ = 0; rb_ < REP_BAR; ++rb_) xcd_barrier(bar); } \
    { const unsigned long long now_ = __builtin_amdgcn_s_memrealtime(); if (((PROBE_TS >> (k)) & 1) && PROBE_SEGSEL(9)) prof_val += (float)(now_ - prof_t) * 0.01f; prof_t = now_; } } while (0)
    unsigned long long prof_t = __builtin_amdgcn_s_memrealtime(); float prof_val = 0.f;
#else
#define SEAM(k) do { if (IN(k) && IN((k) + 1)) { for (int rb_ = 0; rb_ < REP_BAR; ++rb_) xcd_barrier(bar); } } while (0)
#endif

#if defined(REP_ALL)
    for (int ra_ = 0; ra_ < REP_ALL; ++ra_) {
#endif
    if (IN(0)) { for (int rp_ = 0; rp_ < REP_PRO; ++rp_) p0_prologue(F, args); }
    SEAM(0);

    run_layer<0>(F, args, bar, lo, hi, lds PROF_ARGS); run_layer<1>(F, args, bar, lo, hi, lds PROF_ARGS); run_layer<2>(F, args, bar, lo, hi, lds PROF_ARGS); run_layer<3>(F, args, bar, lo, hi, lds PROF_ARGS);
#if defined(REP_ALL)
    }
#endif
    if (IN(N_PHASES - 1)) { refresh(F); unsigned char* ws = launder_ptr(args.ws); final_norm_phase(F, (const bf16*)(ws + WS_HB), (const float*)(ws + WS_SS), args.out, args.in[13]);
#if defined(PROBE_TS)
        if (blockIdx.x == 0) { const unsigned long long t0_ = __builtin_amdgcn_s_memrealtime(); const unsigned long long wait_ = (unsigned long long)(prof_val * 100.0f * 4.0f);
            while (__builtin_amdgcn_s_memrealtime() - t0_ < wait_) __builtin_amdgcn_s_sleep(8); }
#endif
    }
#undef IN
#undef SEAM
}

extern "C" void kernel_launch(void* const* d_in, const int* in_sizes, int n_in, void* d_out, int out_size, void* d_ws, size_t ws_size, hipStream_t stream) {
    static int grid = 0;
    if (grid == 0) {
        if (n_in != 14 || in_sizes[0] != M * DMODEL || out_size != M * DMODEL || ws_size < WS_END) { fprintf(stderr, "kernel_launch: unexpected shapes: n_in %d in0 %d out %d ws %zu (need %zu)\n", n_in, n_in > 0 ? in_sizes[0] : -1, out_size, ws_size, (size_t)WS_END); grid = -1; return; }
        int dev = 0, cus = 0, per_cu = 0;
        if (hipGetDevice(&dev) != hipSuccess || hipDeviceGetAttribute(&cus, hipDeviceAttributeMultiprocessorCount, dev) != hipSuccess) { fprintf(stderr, "kernel_launch: device query failed\n"); grid = -1; return; }
        if (hipFuncSetAttribute((const void*)trunk_fwd, hipFuncAttributeMaxDynamicSharedMemorySize, LDS_BYTES) != hipSuccess) { fprintf(stderr, "kernel_launch: hipFuncSetAttribute failed\n"); grid = -1; return; }
        if (hipOccupancyMaxActiveBlocksPerMultiprocessor(&per_cu, (const void*)trunk_fwd, NWAVES * 64, LDS_BYTES) != hipSuccess || per_cu < 1) fprintf(stderr, "kernel_launch: note: occupancy query reports %d blocks per CU\n", per_cu);
        (void)hipGetLastError();
        grid = cus;
    }
    if (grid < 0) return;
    if (hipMemsetAsync((char*)d_ws + WS_CTL, 0, CTL_ZERO_BYTES, stream) != hipSuccess) { fprintf(stderr, "kernel_launch: memset failed\n"); return; }
    Args a{};
    for (int i = 0; i < 14; ++i) a.in[i] = (const float*)d_in[i];
    a.out = (float*)d_out; a.ws = (unsigned char*)d_ws;
#if defined(REP_LAUNCH)
    constexpr int NL = REP_LAUNCH;
    for (int li = 0; li < NL; ++li) {
        a.ph_lo = 0; a.ph_hi = N_PHASES; a.li = li;
#else
    constexpr int NL = MK_N_LAUNCHES;
    for (int li = 0; li < NL; ++li) {
        a.ph_lo = (NL == 1) ? 0 : li; a.ph_hi = (NL == 1) ? N_PHASES : li + 1; a.li = li;
#endif
        hipLaunchKernelGGL(trunk_fwd, dim3(grid), dim3(NWAVES * 64), LDS_BYTES, stream, a);
        const hipError_t le = hipPeekAtLastError();
        if (le != hipSuccess) { fprintf(stderr, "kernel_launch: launch %d failed: %s\n", li, hipGetErrorName(le)); break; }
    }
}
```

```cpp
#include <hip/hip_runtime.h>
#include <hip/hip_bf16.h>
#include <cstdio>
#include <cstdint>
#include <cmath>

namespace pg8 {
#define PG8_LAS __attribute__((address_space(3)))
typedef unsigned short bf16_t;
typedef short bf16x8 __attribute__((ext_vector_type(8)));
typedef float f32x4 __attribute__((ext_vector_type(4)));
typedef unsigned u32x4 __attribute__((ext_vector_type(4)));
#ifndef PG_WGM
#define PG_WGM 8
#endif
constexpr int BM = 256, BK = 64, HALF = 128, HTB = HALF * BK * 2  , STAGE_BYTES = 8 * HTB, NXCD = 8, WGM = PG_WGM;

__host__ __device__ __forceinline__ int lds_byte(int r, int c) { const int st = (r >> 4) * 2 + (c >> 5), rr = r & 15, cc = c & 31, ob = rr * 64 + cc * 2; return st * 1024 + (ob ^ (((ob >> 9) & 1) << 5)); }
__host__ __device__ __forceinline__ void stage_rc(int b, int& R, int& C) { const int st = b / 1024, sb = b % 1024, swz = sb ^ (((sb >> 9) & 1) << 5); R = (st >> 1) * 16 + swz / 64; C = (st & 1) * 32 + (swz % 64) / 2; }
__host__ __device__ __forceinline__ int perm32(int rho) { const int n = rho >> 4, i = rho & 15; return 8 * (i >> 2) + 4 * n + (i & 3); }

struct Unit { int pm, pn; };
struct Gemm { const bf16_t* A; const bf16_t* Bt; int M, N, K; };

struct StaticOrder {
    int nM, nN, nwg, G, c;
    __host__ __device__ void init(int M, int N, int G_, int c_) { nM = M / BM; nN = N / BM; nwg = nM * nN; G = G_; c = c_; }
    __host__ __device__ bool next(int i, Unit& u) const {
        const long L = (long)i * G + c; if (L >= nwg) return false;
        int wgid = (int)L; { const int q = nwg / NXCD, r = nwg % NXCD, xcd = wgid % NXCD, off = wgid / NXCD; wgid = (xcd < r ? xcd * (q + 1) : r * (q + 1) + (xcd - r) * q) + off; }
        const int nig = WGM * nN, gid = wgid / nig, fm = gid * WGM, gsz = (nM - fm) < WGM ? (nM - fm) : WGM;
        u.pm = fm + ((wgid % nig) % gsz); u.pn = (wgid % nig) / gsz; return true;
    }
    __device__ __forceinline__ void a_ready(const Unit&) const {}
    __device__ __forceinline__ void done(const Unit&) const {}
};

__device__ __forceinline__ unsigned cvt_pk_bf16(float lo, float hi) { unsigned r; asm volatile("v_cvt_pk_bf16_f32 %0, %1, %2" : "=v"(r) : "v"(lo), "v"(hi)); return r; }

struct EpiIn {
    static constexpr bool PERM = true, AFTER_DRAIN = false;
    bf16_t* Z; int ldz; const float* ss; const float* rope; int odd; float qscale, ascale;
    int plain;
    const PG8_LAS float* rtab; const PG8_LAS int* rtag;
    __device__ __forceinline__ void operator()(const f32x4 (&acc)[2][2][4][2], const Unit& u, int wr, int wc, int fr, int fq) const {
        const int row0 = u.pm * BM + wr * 64 + fr; const int pn = u.pn;
        const float cs = (pn == 0) ? qscale : ((pn == 4 || pn == 5) ? ascale : 1.0f);
        const bool do_rope = !plain && odd && (pn <= 1 || (pn >= 4 && pn <= 7));
        const bool do_silu = !plain && pn >= 10;
        const int rbase_col = (pn < 2) ? pn * 256 : (pn < 4) ? 512 : (pn < 10) ? 1024 + ((pn - 4) >> 1) * 512 : 2560;
        const int hw_log = (pn >= 10) ? 10 : (pn == 2 || pn == 3) ? 7 : 6; const int nh_log = (pn >= 10) ? 0 : (pn < 4) ? 2 : 3;
        const int col0 = pn * BM + wc * 32 + 8 * fq - rbase_col;
        const size_t zbase = (size_t)rbase_col * 32768;
        const int slot = (u.pm >> 3) & 1; const bool have_tab = rtag[slot] == u.pm;
#pragma unroll
        for (int ai = 0; ai < 2; ++ai)
#pragma unroll
            for (int m = 0; m < 4; ++m) {
                const int row = row0 + ai * HALF + m * 16;
                float sc;
                if (plain) sc = 1.0f;
                else if (have_tab) sc = cs * rtab[slot * 256 + (row & 255)];
                else {
                    const f32x4* sp = (const f32x4*)(ss + (size_t)row * 16);
                    const f32x4 s0 = sp[0], s1 = sp[1], s2 = sp[2], s3 = sp[3];
                    const float tot = ((s0[0] + s0[1]) + (s0[2] + s0[3])) + ((s1[0] + s1[1]) + (s1[2] + s1[3])) + ((s2[0] + s2[1]) + (s2[2] + s2[3])) + ((s3[0] + s3[1]) + (s3[2] + s3[3]));
                    sc = cs / sqrtf(tot * (1.0f / 1024.0f) + 1e-6f);
                }
                const int bidx = row >> 12, tt = row & 4095;
#pragma unroll
                for (int bj = 0; bj < 2; ++bj) {
                    f32x4 v0 = acc[ai][bj][m][0] * sc, v1 = acc[ai][bj][m][1] * sc;
                    if (do_rope) {
                        const int t = row & 4095; const int j0 = ((bj * HALF + wc * 32 + 8 * fq) & 63) >> 1;
                        const f32x4* rp = (const f32x4*)(rope + ((size_t)t * 32 + j0) * 2);
                        const f32x4 c01 = rp[0], c23 = rp[1];
                        f32x4 w0, w1;
                        w0[0] = v0[0] * c01[0] - v0[1] * c01[1]; w0[1] = v0[1] * c01[0] + v0[0] * c01[1];
                        w0[2] = v0[2] * c01[2] - v0[3] * c01[3]; w0[3] = v0[3] * c01[2] + v0[2] * c01[3];
                        w1[0] = v1[0] * c23[0] - v1[1] * c23[1]; w1[1] = v1[1] * c23[0] + v1[0] * c23[1];
                        w1[2] = v1[2] * c23[2] - v1[3] * c23[3]; w1[3] = v1[3] * c23[2] + v1[2] * c23[3];
                        v0 = w0; v1 = w1;
                    }
                    if (do_silu) {
#pragma unroll
                        for (int e = 0; e < 4; ++e) { v0[e] = v0[e] * __builtin_amdgcn_rcpf(1.0f + __builtin_amdgcn_exp2f(-1.4426950408889634f * v0[e])); v1[e] = v1[e] * __builtin_amdgcn_rcpf(1.0f + __builtin_amdgcn_exp2f(-1.4426950408889634f * v1[e])); }
                    }
                    u32x4 w; w.x = cvt_pk_bf16(v0[0], v0[1]); w.y = cvt_pk_bf16(v0[2], v0[3]); w.z = cvt_pk_bf16(v1[0], v1[1]); w.w = cvt_pk_bf16(v1[2], v1[3]);
                    const int c = col0 + bj * HALF;
                    if (plain != 2 || (w.x == 0x7fc12345u && w.y == 0x7fc12345u))
                        *(u32x4*)(Z + zbase + ((((((size_t)((bidx << nh_log) + (c >> hw_log))) << 12) + (size_t)tt)) << hw_log) + (c & ((1 << hw_log) - 1))) = w;
                }
            }
    }
};

template <class Sched> __device__ __forceinline__ void epi_in_fill(const Sched& S, const float* ss, PG8_LAS float* rtab, PG8_LAS int* rtag) {
    if (threadIdx.x < 2) rtag[threadIdx.x] = -1;
    __syncthreads();
    Unit u;
    for (int i = 0; S.next(i, u); ++i) {
        const int slot = (u.pm >> 3) & 1;
        if (rtag[slot] == -1) {
            __syncthreads();
            if (threadIdx.x < 256) {
                const int row = u.pm * BM + threadIdx.x; const f32x4* sp = (const f32x4*)(ss + (size_t)row * 16);
                const f32x4 s0 = sp[0], s1 = sp[1], s2 = sp[2], s3 = sp[3];
                const float tot = ((s0[0] + s0[1]) + (s0[2] + s0[3])) + ((s1[0] + s1[1]) + (s1[2] + s1[3])) + ((s2[0] + s2[1]) + (s2[2] + s2[3])) + ((s3[0] + s3[1]) + (s3[2] + s3[3]));
                rtab[slot * 256 + threadIdx.x] = 1.0f / sqrtf(tot * (1.0f / 1024.0f) + 1e-6f);
                if (threadIdx.x == 0) rtag[slot] = u.pm;
            }
            __syncthreads();
        }
    }
    __syncthreads();
}

struct EpiOut {
    static constexpr bool PERM = true, AFTER_DRAIN = false;
    bf16_t* hb; float* ss; bf16_t* hbo;
    __device__ __forceinline__ void operator()(const f32x4 (&acc)[2][2][4][2], const Unit& u, int wr, int wc, int fr, int fq) const {
        const int row0 = u.pm * BM + wr * 64 + fr; const int col0 = u.pn * BM + wc * 32 + 8 * fq;
#pragma unroll
        for (int ai = 0; ai < 2; ++ai)
#pragma unroll
            for (int m = 0; m < 4; ++m) {
                const int row = row0 + ai * HALF + m * 16; const size_t off = (size_t)row * 1024 + col0; float q = 0.f;
#pragma unroll
                for (int bj = 0; bj < 2; ++bj) {
                    const u32x4 old = *(const u32x4*)(hb + off + bj * HALF);
                    f32x4 v0 = acc[ai][bj][m][0], v1 = acc[ai][bj][m][1];
                    v0[0] += __uint_as_float(old.x << 16); v0[1] += __uint_as_float(old.x & 0xffff0000u); v0[2] += __uint_as_float(old.y << 16); v0[3] += __uint_as_float(old.y & 0xffff0000u);
                    v1[0] += __uint_as_float(old.z << 16); v1[1] += __uint_as_float(old.z & 0xffff0000u); v1[2] += __uint_as_float(old.w << 16); v1[3] += __uint_as_float(old.w & 0xffff0000u);
                    q += (v0[0] * v0[0] + v0[1] * v0[1]) + (v0[2] * v0[2] + v0[3] * v0[3]) + (v1[0] * v1[0] + v1[1] * v1[1]) + (v1[2] * v1[2] + v1[3] * v1[3]);
                    u32x4 w; w.x = cvt_pk_bf16(v0[0], v0[1]); w.y = cvt_pk_bf16(v0[2], v0[3]); w.z = cvt_pk_bf16(v1[0], v1[1]); w.w = cvt_pk_bf16(v1[2], v1[3]);
                    *(u32x4*)(hbo + off + bj * HALF) = w;
                }
                q += __shfl_xor(q, 16); q += __shfl_xor(q, 32);
                if (fq == 0) ss[(size_t)row * 16 + u.pn * 4 + wc] = q;
            }
    }
};

template <class Epi, class Sched, bool ALIGN_EPI = false, bool SP2 = false>
__device__ __forceinline__ void gemm_phase(PG8_LAS unsigned char* lds, const Gemm g, const Sched& S, const Epi& E) {
    int tid_ = threadIdx.x; asm volatile("" : "+v"(tid_));
    const int tid = tid_, wid = __builtin_amdgcn_readfirstlane(tid >> 6), lane = tid & 63, wr = wid >> 2, wc = wid & 3, fr = lane & 15, fq = lane >> 4;
    const int K = g.K, nt = K / BK;
    unsigned voffA[2], voffB[2];
#pragma unroll
    for (int i = 0; i < 2; ++i) { int R, C; stage_rc(tid * 16 + i * 8192, R, C); const int Rb = Epi::PERM ? ((R & ~31) + perm32(R & 31)) : R;
        voffA[i] = (unsigned)(R * K + C) * 2u; voffB[i] = (unsigned)(Rb * K + C) * 2u; }
    const size_t kstep = (size_t)(BK * 2);
    const size_t hstep = (size_t)HALF * K * 2;
    const size_t tstep = 2 * hstep;
    const unsigned ldsw = (unsigned)wid * 1024u;
    const int aoff = lds_byte(wr * 64 + fr, fq * 8), boff = lds_byte(wc * 32 + fr, fq * 8);
#define PG8_SA(b, h) (((b) * 2 + (h)) * HTB)
#define PG8_SB(b, h) ((4 + (b) * 2 + (h)) * HTB)
#define PG8_STAGE(bufoff, gbase, voff) do { _Pragma("unroll") for (int _i = 0; _i < 2; ++_i) \
        __builtin_amdgcn_global_load_lds((const unsigned*)((const char*)(gbase) + (voff)[_i]), (PG8_LAS unsigned*)(lds + (bufoff) + ldsw + _i * 8192), 16, 0, 0); } while (0)
#define PG8_LDA(dst, b, h) do { _Pragma("unroll") for (int m = 0; m < 4; ++m) _Pragma("unroll") for (int k = 0; k < 2; ++k) dst[m][k] = *(const PG8_LAS bf16x8*)(lds + PG8_SA(b, h) + aoff + m * 2048 + k * 1024); } while (0)
#define PG8_LDB(dst, b, h) do { _Pragma("unroll") for (int n = 0; n < 2; ++n) _Pragma("unroll") for (int k = 0; k < 2; ++k) dst[n][k] = *(const PG8_LAS bf16x8*)(lds + PG8_SB(b, h) + boff + n * 2048 + k * 1024); } while (0)
#define PG8_MMA(ai, bj, At, Bt) do { __builtin_amdgcn_s_setprio(1); _Pragma("unroll") for (int m = 0; m < 4; ++m) _Pragma("unroll") for (int n = 0; n < 2; ++n) _Pragma("unroll") for (int k = 0; k < 2; ++k) \
        acc[ai][bj][m][n] = __builtin_amdgcn_mfma_f32_16x16x32_bf16(Bt[n][k], At[m][k], acc[ai][bj][m][n], 0, 0, 0); __builtin_amdgcn_s_setprio(0); } while (0)
#define PG8_WAIT_V(n) asm volatile("s_waitcnt vmcnt(" #n ")" ::: "memory")
#define PG8_WAIT_L(n) asm volatile("s_waitcnt lgkmcnt(" #n ")" ::: "memory")
#define PG8_BAR __builtin_amdgcn_s_barrier()
#define PG8_SCHED __builtin_amdgcn_sched_barrier(0)
    Unit cur, nxt; int ui = 0;
    if (!S.next(0, cur)) return;
    f32x4 acc[2][2][4][2];
#pragma unroll
    for (int a = 0; a < 2; ++a)
#pragma unroll
        for (int b = 0; b < 2; ++b)
#pragma unroll
            for (int m = 0; m < 4; ++m)
#pragma unroll
                for (int n = 0; n < 2; ++n) acc[a][b][m][n] = (f32x4){0.f, 0.f, 0.f, 0.f};
    bf16x8 At[4][2], B0[2][2], B1[2][2];
    const char* cA = (const char*)g.A + (size_t)cur.pm * tstep; const char* cB = (const char*)g.Bt + (size_t)cur.pn * tstep;
    S.a_ready(cur);
    if constexpr (SP2) {
        PG8_STAGE(PG8_SB(0, 0), cB, voffB); PG8_STAGE(PG8_SB(0, 1), cB + hstep, voffB); PG8_STAGE(PG8_SA(0, 0), cA, voffA); PG8_STAGE(PG8_SA(0, 1), cA + hstep, voffA);
        if (wr == 1) PG8_BAR;
        PG8_WAIT_V(2); PG8_BAR;
        PG8_STAGE(PG8_SB(1, 0), cB + kstep, voffB); PG8_STAGE(PG8_SA(1, 0), cA + kstep, voffA); PG8_STAGE(PG8_SB(1, 1), cB + hstep + kstep, voffB);
        PG8_WAIT_V(6); PG8_BAR;
    } else {
        PG8_STAGE(PG8_SB(0, 0), cB, voffB); PG8_STAGE(PG8_SA(0, 0), cA, voffA); PG8_STAGE(PG8_SB(0, 1), cB + hstep, voffB); PG8_STAGE(PG8_SA(0, 1), cA + hstep, voffA);
        if (wr == 1) PG8_BAR;
        PG8_WAIT_V(4); PG8_BAR;
        PG8_STAGE(PG8_SB(1, 0), cB + kstep, voffB); PG8_STAGE(PG8_SA(1, 0), cA + kstep, voffA); PG8_STAGE(PG8_SB(1, 1), cB + hstep + kstep, voffB);
        PG8_WAIT_V(6); PG8_BAR;
    }
    for (;;) {
        const bool has_next = S.next(ui + 1, nxt);
        const char* nA = has_next ? (const char*)g.A + (size_t)nxt.pm * tstep : cA; const char* nB = has_next ? (const char*)g.Bt + (size_t)nxt.pn * tstep : cB;
        for (int t = 0; t < nt; t += 2) {
            const bool last = (t == nt - 2);
            const char* a1 = cA + (size_t)(t + 1) * kstep;
            const char* a2 = last ? nA : cA + (size_t)(t + 2) * kstep; const char* b2 = last ? nB : cB + (size_t)(t + 2) * kstep;
            const char* a3 = a2 + kstep; const char* b3 = b2 + kstep;
            if (last && has_next) S.a_ready(nxt);
            if constexpr (SP2) {
            PG8_LDB(B0, 0, 0); PG8_LDB(B1, 0, 1); PG8_SCHED; PG8_LDA(At, 0, 0); PG8_STAGE(PG8_SA(1, 1), a1 + hstep, voffA);
            PG8_WAIT_V(8); PG8_WAIT_L(0); PG8_BAR; PG8_MMA(0, 0, At, B0); PG8_MMA(0, 1, At, B1); PG8_BAR; PG8_SCHED;
            PG8_LDA(At, 0, 1); PG8_STAGE(PG8_SB(0, 0), b2, voffB); PG8_STAGE(PG8_SB(0, 1), b2 + hstep, voffB); PG8_STAGE(PG8_SA(0, 0), a2, voffA);
            PG8_WAIT_V(8); PG8_WAIT_L(0); PG8_BAR; PG8_MMA(1, 0, At, B0); PG8_MMA(1, 1, At, B1); PG8_BAR; PG8_SCHED;
            PG8_LDB(B0, 1, 0); PG8_LDB(B1, 1, 1); PG8_SCHED; PG8_LDA(At, 1, 0); PG8_STAGE(PG8_SA(0, 1), a2 + hstep, voffA);
            PG8_WAIT_V(8); PG8_WAIT_L(0); PG8_BAR; PG8_MMA(0, 0, At, B0); PG8_MMA(0, 1, At, B1); PG8_BAR; PG8_SCHED;
            PG8_LDA(At, 1, 1); PG8_STAGE(PG8_SB(1, 0), b3, voffB); PG8_STAGE(PG8_SB(1, 1), b3 + hstep, voffB); PG8_STAGE(PG8_SA(1, 0), a3, voffA);
            PG8_WAIT_V(8); PG8_WAIT_L(0); PG8_BAR; PG8_MMA(1, 0, At, B0); PG8_MMA(1, 1, At, B1); PG8_BAR; PG8_SCHED;
            } else {
            PG8_LDB(B0, 0, 0); PG8_SCHED; PG8_LDA(At, 0, 0); PG8_STAGE(PG8_SA(1, 1), a1 + hstep, voffA);
            PG8_WAIT_L(8); PG8_BAR; PG8_WAIT_L(0); PG8_MMA(0, 0, At, B0); PG8_BAR; PG8_SCHED;
            PG8_LDB(B1, 0, 1); PG8_STAGE(PG8_SB(0, 0), b2, voffB);
            PG8_BAR; PG8_WAIT_L(0); PG8_MMA(0, 1, At, B1); PG8_BAR;
            PG8_LDA(At, 0, 1); PG8_STAGE(PG8_SA(0, 0), a2, voffA);
            PG8_BAR; PG8_WAIT_L(0); PG8_MMA(1, 0, At, B0); PG8_BAR; PG8_SCHED;
            PG8_STAGE(PG8_SB(0, 1), b2 + hstep, voffB);
            PG8_WAIT_V(6); PG8_BAR; PG8_MMA(1, 1, At, B1); PG8_BAR;
            PG8_LDB(B0, 1, 0); PG8_SCHED; PG8_LDA(At, 1, 0); PG8_STAGE(PG8_SA(0, 1), a2 + hstep, voffA);
            PG8_WAIT_L(8); PG8_BAR; PG8_WAIT_L(0); PG8_MMA(0, 0, At, B0); PG8_BAR; PG8_SCHED;
            PG8_LDB(B1, 1, 1); PG8_STAGE(PG8_SB(1, 0), b3, voffB);
            PG8_BAR; PG8_WAIT_L(0); PG8_MMA(0, 1, At, B1); PG8_BAR;
            PG8_LDA(At, 1, 1); PG8_STAGE(PG8_SA(1, 0), a3, voffA);
            PG8_BAR; PG8_WAIT_L(0); PG8_MMA(1, 0, At, B0); PG8_BAR; PG8_SCHED;
            PG8_STAGE(PG8_SB(1, 1), b3 + hstep, voffB);
            PG8_WAIT_V(6); PG8_BAR; PG8_MMA(1, 1, At, B1); PG8_BAR;
            }
        }
        if constexpr (ALIGN_EPI) { if (wr == 0) PG8_BAR; }
        if constexpr (!Epi::AFTER_DRAIN) { E(acc, cur, wr, wc, fr, fq); S.done(cur); }
        if (!has_next) break;
#pragma unroll
        for (int a = 0; a < 2; ++a)
#pragma unroll
            for (int b = 0; b < 2; ++b)
#pragma unroll
                for (int m = 0; m < 4; ++m)
#pragma unroll
                    for (int n = 0; n < 2; ++n) acc[a][b][m][n] = (f32x4){0.f, 0.f, 0.f, 0.f};
        cur = nxt; cA = nA; cB = nB; ++ui;
        if constexpr (ALIGN_EPI) { if (wr == 1) PG8_BAR; }
    }
    PG8_WAIT_V(0);
    if constexpr (!ALIGN_EPI) { if (wr == 0) PG8_BAR; }
    PG8_BAR;
#undef PG8_SA
#undef PG8_SB
#undef PG8_STAGE
#undef PG8_LDA
#undef PG8_LDB
#undef PG8_MMA
#undef PG8_WAIT_V
#undef PG8_WAIT_L
#undef PG8_BAR
#undef PG8_SCHED
}
}
namespace attn_body {
using bf16=__hip_bfloat16;
using bf16x8=__attribute__((ext_vector_type(8)))short;
using s16x4=__attribute__((ext_vector_type(4)))short;
using f32x16=__attribute__((ext_vector_type(16)))float;
using u32x4=__attribute__((ext_vector_type(4)))unsigned;
constexpr int BATCH=8,NHEAD=8,SEQ=4096,D=64,DM=64,OP=1024;
constexpr int NW=8,QBLK=32,QB=QBLK*NW,KVBLK=64,NQB=SEQ/QB;
constexpr int ATTN_PITCH=DM, ATTN_UNIT_ROWS=QB;
__device__ __forceinline__ int crow(int r,int hi){return (r&3)+8*(r>>2)+4*hi;}
#define SBAR() __builtin_amdgcn_sched_barrier(0)
__device__ __forceinline__ void cmask(f32x16&p0,f32x16&p1,int jb,int qrel,int hi){
  const float NEG=-INFINITY; int kb=64*jb+4*hi;
  #pragma unroll
  for(int r=0;r<16;++r){int kv=kb+(r&3)+8*(r>>2); if(kv>qrel)p0[r]=NEG; if(kv+32>qrel)p1[r]=NEG;}
}

constexpr int NSLOT=3, SLOTB=8192;
constexpr int LDS_K=0, LDS_V=NSLOT*SLOTB, LDS_WS=2*NSLOT*SLOTB, LDS_OST=LDS_WS+NW*64*4, LDS_BIAS=LDS_OST+NW*4096, LDS_BYTES=LDS_BIAS+SEQ*4;
constexpr float C2=0.125f*1.4426950408889634f;
__device__ __forceinline__ void glds16(const void*gsrc,unsigned lds_dst){unsigned keep;
  asm volatile("s_mov_b32 %0, m0\n\ts_mov_b32 m0, %2\n\ts_nop 0\n\tglobal_load_lds_dwordx4 %1, off\n\ts_mov_b32 m0, %0":"=&s"(keep):"v"(gsrc),"s"(lds_dst):"memory");}
__device__ __forceinline__ float max3f(float a,float b,float c){float r;asm("v_max3_f32 %0, %1, %2, %3":"=v"(r):"v"(a),"v"(b),"v"(c));return r;}
__device__ __forceinline__ float max2f(float a,float b){float r;asm("v_max_f32_e32 %0, %1, %2":"=v"(r):"v"(a),"v"(b));return r;}
__device__ __forceinline__ float fadd_s(float a,float b){float r;asm("v_add_f32_e32 %0, %1, %2":"=v"(r):"v"(a),"v"(b));return r;}
__device__ __forceinline__ float fsub_s(float a,float b){float r;asm("v_sub_f32_e32 %0, %1, %2":"=v"(r):"v"(a),"v"(b));return r;}
typedef float f32x4v __attribute__((ext_vector_type(4))); typedef float f32x2_t __attribute__((ext_vector_type(2))); typedef __bf16 bf16x2_t __attribute__((ext_vector_type(2)));
__device__ __forceinline__ unsigned cvtpk_s(float lo,float hi){f32x2_t v={lo,hi};bf16x2_t b=__builtin_convertvector(v,bf16x2_t);return __builtin_bit_cast(unsigned,b);}
#define WAIT_BAR(N) asm volatile("s_waitcnt vmcnt(" #N ") lgkmcnt(0)\n\ts_barrier":::"memory")

__device__ __forceinline__ void qkt(f32x16&p0,f32x16&p1,const char*Kslot,const bf16x8*qr,const f32x16&negm,int r32,int hi){
  const char*kb=Kslot+hi*1024+r32*16;
  #pragma unroll
  for(int d0=0;d0<4;++d0){
    const bf16x8 b0=*reinterpret_cast<const bf16x8*>(kb+d0*2048);
    const bf16x8 b1=*reinterpret_cast<const bf16x8*>(kb+d0*2048+512);
    if(d0==0){p0=__builtin_amdgcn_mfma_f32_32x32x16_bf16(b0,qr[0],negm,0,0,0);p1=__builtin_amdgcn_mfma_f32_32x32x16_bf16(b1,qr[0],negm,0,0,0);}
    else{p0=__builtin_amdgcn_mfma_f32_32x32x16_bf16(b0,qr[d0],p0,0,0,0);p1=__builtin_amdgcn_mfma_f32_32x32x16_bf16(b1,qr[d0],p1,0,0,0);}}
}
typedef __attribute__((address_space(3))) const char* lds_cptr;
typedef short v4i16_t __attribute__((ext_vector_type(4)));
__device__ __forceinline__ void kload8(bf16x8*kf,lds_cptr kp){
  kf[0]=*(const __attribute__((address_space(3))) bf16x8*)(kp);      kf[1]=*(const __attribute__((address_space(3))) bf16x8*)(kp+512);
  kf[2]=*(const __attribute__((address_space(3))) bf16x8*)(kp+2048); kf[3]=*(const __attribute__((address_space(3))) bf16x8*)(kp+2560);
  kf[4]=*(const __attribute__((address_space(3))) bf16x8*)(kp+4096); kf[5]=*(const __attribute__((address_space(3))) bf16x8*)(kp+4608);
  kf[6]=*(const __attribute__((address_space(3))) bf16x8*)(kp+6144); kf[7]=*(const __attribute__((address_space(3))) bf16x8*)(kp+6656);
}
__device__ __forceinline__ void kload2(bf16x8*kf,lds_cptr kp,int j){ kf[2*j]=*(const __attribute__((address_space(3))) bf16x8*)(kp+j*2048); kf[2*j+1]=*(const __attribute__((address_space(3))) bf16x8*)(kp+j*2048+512); }
__device__ __forceinline__ s16x4 vtr(lds_cptr p){ return __builtin_bit_cast(s16x4,__builtin_amdgcn_ds_read_tr16_b64_v4i16((__attribute__((address_space(3))) v4i16_t*)p)); }
__device__ __forceinline__ float rowmax(const f32x16&p0,const f32x16&p1){
  float a=max3f(p0[0],p0[1],p1[0]),b=max3f(p0[2],p0[3],p1[1]);a=max3f(a,p1[2],p1[3]);
  #pragma unroll
  for(int r=4;r<16;r+=4){a=max3f(a,p0[r],p0[r+1]);b=max3f(b,p0[r+2],p0[r+3]);a=max3f(a,p1[r],p1[r+1]);b=max3f(b,p1[r+2],p1[r+3]);}
  const float m=max2f(a,b);
  auto rr=__builtin_amdgcn_permlane32_swap(__float_as_uint(m),__float_as_uint(m),false,false);
  return max2f(__uint_as_float(rr[0]),__uint_as_float(rr[1]));
}
__device__ __forceinline__ void pv(f32x16*o,int vb,bf16x8 pa0,bf16x8 pa1,bf16x8 pa2,bf16x8 pa3){
  #pragma unroll
  for(int d0=0;d0<2;++d0){s16x4 lo[4],hi[4];
    #pragma unroll
    for(int ks=0;ks<4;++ks){
      asm volatile("ds_read_b64_tr_b16 %0,%1 offset:%c2":"=&v"(lo[ks]):"v"(vb),"i"(d0*4096+ks*1024):"memory");
      asm volatile("ds_read_b64_tr_b16 %0,%1 offset:%c2":"=&v"(hi[ks]):"v"(vb),"i"(d0*4096+ks*1024+512):"memory");}
    asm volatile("s_waitcnt lgkmcnt(0)":::"memory");SBAR();
    #define PK(k) (bf16x8){lo[k][0],lo[k][1],lo[k][2],lo[k][3],hi[k][0],hi[k][1],hi[k][2],hi[k][3]}
    o[d0]=__builtin_amdgcn_mfma_f32_32x32x16_bf16(pa0,PK(0),o[d0],0,0,0);
    o[d0]=__builtin_amdgcn_mfma_f32_32x32x16_bf16(pa1,PK(1),o[d0],0,0,0);
    o[d0]=__builtin_amdgcn_mfma_f32_32x32x16_bf16(pa2,PK(2),o[d0],0,0,0);
    o[d0]=__builtin_amdgcn_mfma_f32_32x32x16_bf16(pa3,PK(3),o[d0],0,0,0);
    #undef PK
  }
}

#ifndef ATTN_STORE16
#define ATTN_STORE16(p,v) (*(u32x4*)(p)=(v))
#endif
template<int THRL> __device__ __forceinline__ void attn_unit(int b,int h,int qb,const bf16*Q,const bf16*__restrict__ K,const bf16*__restrict__ V,const bf16*__restrict__ GT,const float*__restrict__ CB,const float*__restrict__ KN,const float*__restrict__ QN,bf16*O,char*shm){
  int tid_=threadIdx.x; asm volatile("":"+v"(tid_)); const int tid=tid_,lane=tid&63,r32=lane&31,hi=lane>>5; const int wid=__builtin_amdgcn_readfirstlane(tid>>6);
  const long rowbase=(long)b*SEQ; const long hbase=(long)(b*NHEAD+h)*SEQ; const int q0=qb*QB;
  const bf16*Qw=Q+(hbase+q0+wid*QBLK)*DM;
  int tstart=0;
  { const float*cbh=CB+(long)(b*NHEAD+h)*SEQ; const float*kn=KN+(b*NHEAD+h)*64; const float*qn=QN+(b*NHEAD+h)*32;
    const int NT0=(q0+QB)/KVBLK; const float cref=cbh[q0];
    const float Qn=__builtin_fmaxf(qn[2*qb],qn[2*qb+1]);
    const float Dmin=__builtin_fminf(qn[2048+2*qb],qn[2048+2*qb+1]);
    float kt=(lane<NT0)?kn[lane]:0.f;
    #pragma unroll
    for(int o_=1;o_<64;o_<<=1){ const float y_=__shfl_up(kt,o_); if(lane>=o_)kt=__builtin_fmaxf(kt,y_); }
    const float bmax=(lane<NT0)?(cref-cbh[64*lane+63])*1.4426950408889634f:0.f;
    const bool skip_=(lane<NT0-4)&&(bmax+Qn*kt-Dmin<-44.0f);
    const unsigned long long m_=__ballot(skip_);
    tstart=__builtin_amdgcn_readfirstlane(((int)__builtin_ctzll(~m_))&~1); }
  const bf16*Kh=K+(hbase+(long)tstart*KVBLK)*DM,*Vh=V+(hbase+(long)tstart*KVBLK)*DM;
  const unsigned lds0=(unsigned)(uintptr_t)shm;
  float*wsf=(float*)(shm+LDS_WS)+wid*64;
  const bf16*ksrc=Kh+(long)lane*DM+wid*8;
  const bf16*vsrc=Vh+(long)(16*(wid&3)+(lane>>2))*DM+(wid>>2)*32+(lane&3)*8;
  const unsigned kdst=lds0+LDS_K+wid*1024, vdst=lds0+LDS_V+wid*1024;
  #define DMA_K(t,slot) glds16(ksrc+(long)(t)*KVBLK*DM,(unsigned)__builtin_amdgcn_readfirstlane(kdst+(slot)))
  #define DMA_V(t,slot) glds16(vsrc+(long)(t)*KVBLK*DM,(unsigned)__builtin_amdgcn_readfirstlane(vdst+(slot)))
  const int vb0=(int)(lds0+LDS_V)+((lane>>4)&1)*32+(lane&3)*8+(4*hi+((lane&15)>>2))*64;
  const char*Kbase=shm+LDS_K; bf16x8 kf[8];
  const lds_cptr shm3=(lds_cptr)shm; const lds_cptr kp0=shm3+LDS_K+hi*1024+r32*16; const lds_cptr vp0=shm3+LDS_V+((lane>>4)&1)*32+(lane&3)*8+(4*hi+((lane&15)>>2))*64;
  const int NT=(q0+QB)/KVBLK-tstart;
  DMA_K(0,0);DMA_V(0,0);DMA_K(1,SLOTB);
  { const float*cbh=CB+(long)(b*NHEAD+h)*SEQ; const float cref=cbh[q0]; float*bl=(float*)(shm+LDS_BIAS); const int nk=q0+QB;
    float cv_[8];
    #pragma unroll
    for(int e_=0;e_<8;++e_){ const int i=tid+tstart*KVBLK+e_*NW*64; cv_[e_]=(i<nk)?cbh[i]:0.f; }
    #pragma unroll
    for(int e_=0;e_<8;++e_){ const int i=tid+tstart*KVBLK+e_*NW*64; if(i<nk) bl[i]=(cref-cv_[e_])*1.4426950408889634f; } }
  const __attribute__((address_space(3))) float* biasp=(const __attribute__((address_space(3))) float*)((lds_cptr)shm+LDS_BIAS)+4*hi+tstart*KVBLK;
  #define BIASADD(P0,P1,t) do{ const __attribute__((address_space(3))) float* bp_=biasp+64*(t); \
    _Pragma("unroll") for(int g_=0;g_<4;++g_){ f32x4v x0_=*(const __attribute__((address_space(3))) f32x4v*)(bp_+8*g_); f32x4v x1_=*(const __attribute__((address_space(3))) f32x4v*)(bp_+32+8*g_); \
      x0_=x0_-mhat; x1_=x1_-mhat; \
      P0[4*g_]+=x0_[0];P0[4*g_+1]+=x0_[1];P0[4*g_+2]+=x0_[2];P0[4*g_+3]+=x0_[3]; P1[4*g_]+=x1_[0];P1[4*g_+1]+=x1_[1];P1[4*g_+2]+=x1_[2];P1[4*g_+3]+=x1_[3]; } }while(0)
  #define LDB(P0,P1,t) do{ const __attribute__((address_space(3))) float* bp_=biasp+64*(t); \
    _Pragma("unroll") for(int g_=0;g_<4;++g_){ f32x4v x0_=*(const __attribute__((address_space(3))) f32x4v*)(bp_+8*g_); f32x4v x1_=*(const __attribute__((address_space(3))) f32x4v*)(bp_+32+8*g_); \
      x0_=x0_-mhat; x1_=x1_-mhat; \
      P0[4*g_]=x0_[0];P0[4*g_+1]=x0_[1];P0[4*g_+2]=x0_[2];P0[4*g_+3]=x0_[3]; P1[4*g_]=x1_[0];P1[4*g_+1]=x1_[1];P1[4*g_+2]=x1_[2];P1[4*g_+3]=x1_[3]; } }while(0)
  bf16x8 qr[4];
  #pragma unroll
  for(int d0=0;d0<4;++d0)qr[d0]=*reinterpret_cast<const bf16x8*>(&Qw[(long)r32*DM+d0*16+hi*8]);
  float mhat=0.f,l_reg=0.f;f32x16 o[2];o[0]=f32x16{};o[1]=f32x16{};const f32x16 negm=f32x16{};
  const int qrel=wid*QBLK+r32;
  #define CMASK(P0,P1,t) do{int jb_=(t)-(NT-4); if(jb_>=0)cmask(P0,P1,jb_,qrel,hi);}while(0)
  bool resc=false;
  #define START(P0,P1) do{ const float rm=rowmax(P0,P1); resc=false; \
    { const float dl=rm; mhat=fadd_s(mhat,dl); \
      _Pragma("unroll") for(int r=0;r<16;++r){P0[r]=fsub_s(P0[r],dl);P1[r]=fsub_s(P1[r],dl);} \
      } \
    _Pragma("unroll") for(int r=0;r<16;++r)P0[r]=__builtin_amdgcn_exp2f(P0[r]); }while(0)
  #define RESC() do{ if(resc){ asm volatile("s_waitcnt lgkmcnt(0)":::"memory"); \
      _Pragma("unroll") for(int d_=0;d_<2;++d_) _Pragma("unroll") for(int r=0;r<16;++r)o[d_][r]*=wsf[crow(r,hi)]; } }while(0)
  f32x16 pA0,pA1,pB0,pB1;
  int sl_prev=0,sl_cur=0,sl_next=SLOTB;
  #define ROT() do{sl_prev=sl_cur;sl_cur=sl_next;sl_next=(sl_next==(NSLOT-1)*SLOTB)?0:sl_next+SLOTB;}while(0)
  DMA_K(2,2*SLOTB);
  WAIT_BAR(3);
  qkt(pA0,pA1,Kbase,qr,negm,r32,hi);asm volatile("s_nop 15\n\ts_nop 7":"+v"(pA0),"+v"(pA1));BIASADD(pA0,pA1,0);CMASK(pA0,pA1,0);
  START(pA0,pA1);
  _Pragma("unroll") for(int r=0;r<16;++r)pA1[r]=__builtin_amdgcn_exp2f(pA1[r]);
  WAIT_BAR(0);
  DMA_K(3,0);DMA_V(1,SLOTB);
  ROT();
  kload8(kf,kp0+sl_cur);
  WAIT_BAR(2);
  s16x4 vlo[8],vhi[8]; u32x4 pw0,pw1,pw2,pw3;
  #define PKW(P,B) cvtpk_s(P[B],P[B+1])
  #define PAF(k) __builtin_bit_cast(bf16x8,pw##k)
  #define VFR(i) (bf16x8){vlo[i][0],vlo[i][1],vlo[i][2],vlo[i][3],vhi[i][0],vhi[i][1],vhi[i][2],vhi[i][3]}
  #define PIN(x) asm volatile("":"+v"(x))
  #define MX3(a,b,c) __builtin_fmaxf(__builtin_fmaxf((a),(b)),(c))
  #define GAPA(MF,A0,A1,A2,A3,W0,W1,PW) do{ MF; sacc+=A0; sacc+=A1; sacc+=A2; sacc+=A3; PIN(sacc); W0; W1; PIN(PW); SBAR(); }while(0)
  #define EX(v) __builtin_amdgcn_exp2f(v)
  #define GAPB(MF,X,B) do{ MF; X[B]=EX(X[B]); X[B+1]=EX(X[B+1]); X[B+2]=EX(X[B+2]); X[B+3]=EX(X[B+3]); PIN(X); SBAR(); }while(0)
  #define VRD(i) do{ vlo[i]=vtr(vp_+(((i)>>2)*4096+((i)&3)*1024)); vhi[i]=vtr(vp_+(((i)>>2)*4096+((i)&3)*1024+512)); }while(0)
  #define KRD(G,j) do{ if(G){ kload2(kf,kp0+sl_next,j); SBAR(); } }while(0)
  #define STEP(C0,C1,P0,P1,t,GK,GV,GL) do{ SBAR(); \
    const lds_cptr vp_=vp0+sl_prev; \
    VRD(0); SBAR(); float sacc=(P0[0]+P0[1]); \
    GAPA(C0=__builtin_amdgcn_mfma_f32_32x32x16_bf16(kf[0],qr[0],C0,0,0,0), P0[2],P0[3],P0[4],P0[5],     pw0[0]=PKW(P0,0), pw0[1]=PKW(P0,2), pw0); \
    VRD(4); SBAR(); GAPA(C1=__builtin_amdgcn_mfma_f32_32x32x16_bf16(kf[1],qr[0],C1,0,0,0), P0[6],P0[7],P0[8],P0[9],     pw0[2]=PKW(P0,4), pw0[3]=PKW(P0,6), pw0); \
    VRD(1); SBAR(); GAPA(C0=__builtin_amdgcn_mfma_f32_32x32x16_bf16(kf[2],qr[1],C0,0,0,0),   P0[10],P0[11],P0[12],P0[13], pw1[0]=PKW(P0,8), pw1[1]=PKW(P0,10), pw1); \
    VRD(5); SBAR(); GAPA(C1=__builtin_amdgcn_mfma_f32_32x32x16_bf16(kf[3],qr[1],C1,0,0,0),   P0[14],P0[15],P1[0],P1[1],   pw1[2]=PKW(P0,12),pw1[3]=PKW(P0,14), pw1); \
    VRD(2); SBAR(); GAPA(C0=__builtin_amdgcn_mfma_f32_32x32x16_bf16(kf[4],qr[2],C0,0,0,0),   P1[2],P1[3],P1[4],P1[5],     pw2[0]=PKW(P1,0), pw2[1]=PKW(P1,2), pw2); \
    VRD(6); SBAR(); GAPA(C1=__builtin_amdgcn_mfma_f32_32x32x16_bf16(kf[5],qr[2],C1,0,0,0),   P1[6],P1[7],P1[8],P1[9],     pw2[2]=PKW(P1,4), pw2[3]=PKW(P1,6), pw2); \
    VRD(3); SBAR(); GAPA(C0=__builtin_amdgcn_mfma_f32_32x32x16_bf16(kf[6],qr[3],C0,0,0,0),   P1[10],P1[11],P1[12],P1[13], pw3[0]=PKW(P1,8), pw3[1]=PKW(P1,10), pw3); \
    VRD(7); SBAR(); GAPA(C1=__builtin_amdgcn_mfma_f32_32x32x16_bf16(kf[7],qr[3],C1,0,0,0),   P1[14],P1[15],0.f,0.f,       pw3[2]=PKW(P1,12),pw3[3]=PKW(P1,14), pw3); \
    l_reg+=sacc; \
    if(GK){DMA_K((t)+3,sl_cur);} if(GV){DMA_V((t)+1,sl_next);} \
    CMASK(C0,C1,t); \
    { float a=MX3(C0[0],C0[1],C1[0]),b=MX3(C0[2],C0[3],C1[1]); a=MX3(a,C1[2],C1[3]); \
      _Pragma("unroll") for(int r=4;r<16;r+=4){a=MX3(a,C0[r],C0[r+1]);b=MX3(b,C0[r+2],C0[r+3]);a=MX3(a,C1[r],C1[r+1]);b=MX3(b,C1[r+2],C1[r+3]);} \
      float rm=__builtin_fmaxf(a,b); { auto rr=__builtin_amdgcn_permlane32_swap(__float_as_uint(rm),__float_as_uint(rm),false,false); rm=__builtin_fmaxf(__uint_as_float(rr[0]),__uint_as_float(rr[1])); } \
      resc=false; \
      if(__builtin_expect(__any(rm>(float)THRL),0)){ const float dl=__builtin_fmaxf(rm,0.f); mhat+=dl; \
        _Pragma("unroll") for(int r=0;r<16;++r){C0[r]-=dl;C1[r]-=dl;} \
        const float f=__builtin_amdgcn_exp2f(-dl); l_reg*=f; if(hi==0)wsf[r32]=f; resc=true; } } \
    SBAR(); \
    GAPB(o[0]=__builtin_amdgcn_mfma_f32_32x32x16_bf16(PAF(0),VFR(0),o[0],0,0,0), C0,0); \
    GAPB(o[1]=__builtin_amdgcn_mfma_f32_32x32x16_bf16(PAF(0),VFR(4),o[1],0,0,0), C0,4); \
    KRD(GL,0); GAPB(o[0]=__builtin_amdgcn_mfma_f32_32x32x16_bf16(PAF(1),VFR(1),o[0],0,0,0), C0,8); \
    KRD(GL,1); GAPB(o[1]=__builtin_amdgcn_mfma_f32_32x32x16_bf16(PAF(1),VFR(5),o[1],0,0,0), C0,12); \
    KRD(GL,2); GAPB(o[0]=__builtin_amdgcn_mfma_f32_32x32x16_bf16(PAF(2),VFR(2),o[0],0,0,0), C1,0); \
    KRD(GL,3); GAPB(o[1]=__builtin_amdgcn_mfma_f32_32x32x16_bf16(PAF(2),VFR(6),o[1],0,0,0), C1,4); \
    GAPB(o[0]=__builtin_amdgcn_mfma_f32_32x32x16_bf16(PAF(3),VFR(3),o[0],0,0,0), C1,8); \
    GAPB(o[1]=__builtin_amdgcn_mfma_f32_32x32x16_bf16(PAF(3),VFR(7),o[1],0,0,0), C1,12); \
    LDB(P0,P1,(t)+1);     \
    }while(0)
  LDB(pB0,pB1,1);
  int t=1;
  #undef CMASK
  #define CMASK(P0,P1,t) do{}while(0)
  for(;t+5<NT;t+=2){
    STEP(pB0,pB1,pA0,pA1,t,true,true,true);     WAIT_BAR(2); RESC(); ROT();
    STEP(pA0,pA1,pB0,pB1,t+1,true,true,true);   WAIT_BAR(2); RESC(); ROT();
  }
  #undef CMASK
  #define CMASK(P0,P1,t) do{int jb_=(t)-(NT-4); if(jb_>=0)cmask(P0,P1,jb_,qrel,hi);}while(0)
  #define ENDW(tt) do{ if((tt)+3<NT){WAIT_BAR(2);} else if((tt)+2<NT){WAIT_BAR(1);} else {WAIT_BAR(0);} }while(0)
  for(;t+1<NT;t+=2){
    STEP(pB0,pB1,pA0,pA1,t,(t+3<NT),(t+1<NT),(t+1<NT));       ENDW(t);   RESC(); ROT();
    STEP(pA0,pA1,pB0,pB1,t+1,(t+4<NT),(t+2<NT),(t+2<NT));     ENDW(t+1); RESC(); ROT();
  }
  STEP(pB0,pB1,pA0,pA1,NT-1,false,false,false); RESC();
  { float sacc=pB0[0]+pB0[1]; _Pragma("unroll") for(int r=2;r<16;++r)sacc+=pB0[r]; _Pragma("unroll") for(int r=0;r<16;++r)sacc+=pB1[r]; l_reg+=sacc;
    pw0=(u32x4){PKW(pB0,0),PKW(pB0,2),PKW(pB0,4),PKW(pB0,6)};pw1=(u32x4){PKW(pB0,8),PKW(pB0,10),PKW(pB0,12),PKW(pB0,14)};pw2=(u32x4){PKW(pB1,0),PKW(pB1,2),PKW(pB1,4),PKW(pB1,6)};pw3=(u32x4){PKW(pB1,8),PKW(pB1,10),PKW(pB1,12),PKW(pB1,14)};
    SBAR(); pv(o,vb0+sl_cur,PAF(0),PAF(1),PAF(2),PAF(3)); }
  #undef PKW
  #undef PAF
  #undef VFR
  #undef PIN
  #undef MX3
  #undef GAPA
  #undef GAPB
  #undef EX
  #undef VRD
  #undef KRD
  #undef STEP
  #undef ENDW
  {auto rr=__builtin_amdgcn_permlane32_swap(__float_as_uint(l_reg),__float_as_uint(l_reg),false,false);l_reg=__uint_as_float(rr[0])+__uint_as_float(rr[1]);}
  if(hi==0)wsf[32+r32]=l_reg;asm volatile("s_waitcnt lgkmcnt(0)":::"memory");
  float rli[16];
  #pragma unroll
  for(int r=0;r<16;++r)rli[r]=__builtin_amdgcn_rcpf(wsf[32+crow(r,hi)]);
  bf16*Ow=O+(rowbase+q0+wid*QBLK)*OP+h*D; const bf16*Gw=GT+(rowbase+q0+wid*QBLK)*OP+h*D;
  { bf16*stg=(bf16*)(shm+LDS_OST)+wid*2048;
    #pragma unroll
    for(int r=0;r<16;++r){const int orow=crow(r,hi);
      #pragma unroll
      for(int d0=0;d0<2;++d0)stg[orow*64+d0*32+r32]=__float2bfloat16(o[d0][r]*rli[r]);}
    asm volatile("s_waitcnt lgkmcnt(0)":::"memory");
    #pragma unroll
    for(int i=0;i<4;++i){const int row=i*8+(lane>>3),ch=lane&7; const u32x4 v=*(const u32x4*)(stg+row*64+ch*8); const u32x4 g=*(const u32x4*)(Gw+(long)row*OP+ch*8); u32x4 w;
      _Pragma("unroll") for(int e=0;e<4;++e){ const float a0=__uint_as_float(v[e]<<16)*__uint_as_float(g[e]<<16), a1=__uint_as_float(v[e]&0xffff0000u)*__uint_as_float(g[e]&0xffff0000u); w[e]=cvtpk_s(a0,a1); }
      ATTN_STORE16(Ow+(long)row*OP+ch*8,w);} }
  asm volatile("s_waitcnt lgkmcnt(0)\n\ts_barrier":::"memory");
  #undef BIASADD
  #undef LDB
  #undef DMA_K
  #undef DMA_V
  #undef CMASK
  #undef START
  #undef RESC
  #undef ROT
}
constexpr int ATTN_LDS_BYTES=LDS_BYTES;
struct AttnTensors { const bf16* Q; const bf16* K; const bf16* V; const bf16* GT; const float* CB; const float* KN; const float* QN; bf16* O; };
struct AttnUnit { int bh; int qb; };
struct QueueOrder {
  unsigned* ctr; int xg, limit;
  __device__ __forceinline__ QueueOrder(unsigned* counters,int grid,int block,int limit_):limit(limit_){ const int vcu=(grid%8==0)?(block%8)*(grid/8)+block/8:block; xg=(vcu*8)/grid; ctr=counters+64*xg; }
  __device__ __forceinline__ bool next(int i,volatile __attribute__((address_space(3))) unsigned* slot,AttnUnit&u)const{
    if(i>=limit)return false;
    if(threadIdx.x==0) *slot=__hip_atomic_fetch_add(ctr,1u,__ATOMIC_RELAXED,__HIP_MEMORY_SCOPE_AGENT);
    __syncthreads(); const unsigned idx=*slot; __syncthreads();
    if(idx>=128u)return false;
    u.bh=xg*NHEAD+(int)(idx&7u); u.qb=15-(int)(idx>>3); return true; }
};
template<int THRL=64> __device__ __forceinline__ void attn_phase(char*lds,const AttnTensors&T,const QueueOrder&S,volatile __attribute__((address_space(3))) unsigned* slot){
  AttnUnit u;
  for(int i=0;S.next(i,slot,u);++i){ attn_unit<THRL>(u.bh/NHEAD,u.bh%NHEAD,u.qb,T.Q,T.K,T.V,T.GT,T.CB,T.KN,T.QN,T.O,lds); }
}
#undef SBAR
#undef WAIT_BAR
}
constexpr int NWAVES = 8;
constexpr int BATCH = 8, SEQ = 4096, DMODEL = 1024, M = BATCH * SEQ;
constexpr int NZ = 3584;
constexpr int ZC_LQ = 0, ZC_LK = 256, ZC_LV = 512, ZC_AQ = 1024, ZC_AK = 1536, ZC_AV = 2048, ZC_GATE = 2560;
constexpr size_t ZR_LQ = 0, ZR_LK = (size_t)M * 256, ZR_LV = (size_t)M * 512, ZR_AQ = (size_t)M * 1024, ZR_AK = (size_t)M * 1536, ZR_AV = (size_t)M * 2048, ZR_GATE = (size_t)M * 2560;
constexpr int EVEN_IN = 3608, ODD_IN = 3584;
constexpr float RMS_EPS = 1e-6f;
constexpr float LOG2E = 1.4426950408889634f;
constexpr float C2 = 0.125f * LOG2E;

constexpr size_t MiB = 1u << 20;
constexpr size_t WS_CTL = 0, CTL_ZERO_BYTES = 1 * MiB;
constexpr size_t WS_ROPE = 1 * MiB;
constexpr size_t WS_SS = 2 * MiB;
constexpr size_t WS_FF = 4 * MiB;
constexpr size_t WS_GLR = 5 * MiB;
constexpr size_t WS_CB = 7 * MiB;
constexpr size_t WS_LSE = 8 * MiB;
constexpr size_t WS_DECAY = 9 * MiB;
constexpr size_t WS_KN = 9 * MiB + 512 * 1024;
constexpr size_t WS_QN = WS_KN + 16 * 1024;
constexpr size_t WS_WSK = 10 * MiB;
constexpr size_t WS_W = 11 * MiB;
constexpr size_t WS_Z = 48 * MiB;
constexpr size_t WS_Y = 272 * MiB;
constexpr size_t WS_HB = 336 * MiB;
constexpr size_t WS_KV = 400 * MiB;
constexpr size_t WS_PREV = 464 * MiB;
constexpr size_t WS_END = 496 * MiB;
constexpr int CW_TMO = 0, CW_CODE = 1;
constexpr int CW_BAR = 4096;
constexpr int CW_QUEUE = 131072;

constexpr int RING_OFF = 0, RING_BYTES = 131072;
constexpr int LDSCTL_OFF = RING_BYTES, MISC_OFF = LDSCTL_OFF + 320;
constexpr int LDS_BYTES = 147456;
static_assert(MISC_OFF + 128 <= LDS_BYTES, "LDS map");

#define GAS __attribute__((address_space(1)))
#define LAS __attribute__((address_space(3)))
typedef unsigned short bf16;
typedef unsigned v4u __attribute__((ext_vector_type(4)));
typedef float f32x4 __attribute__((ext_vector_type(4)));
typedef short bf16x8 __attribute__((ext_vector_type(8)));
typedef GAS unsigned gu32;
#define RLX_AGENT __ATOMIC_RELAXED, __HIP_MEMORY_SCOPE_AGENT
#define LDS_WAIT() asm volatile("s_waitcnt lgkmcnt(0)" ::: "memory")
#define VM_WAIT() asm volatile("s_waitcnt vmcnt(0)" ::: "memory")
__device__ __forceinline__ unsigned f2bf(float f) { unsigned u = __builtin_bit_cast(unsigned, f); return (u + 0x7fffu + ((u >> 16) & 1u)) >> 16; }
__device__ __forceinline__ unsigned pk2(float lo, float hi) { return f2bf(lo) | (f2bf(hi) << 16); }
__device__ __forceinline__ float bflo(unsigned w) { return __uint_as_float(w << 16); }
__device__ __forceinline__ float bfhi(unsigned w) { return __uint_as_float(w & 0xffff0000u); }
__device__ __forceinline__ float bf1(bf16 h) { return __uint_as_float((unsigned)h << 16); }
__device__ __forceinline__ float logsigmoidf(float x) { return x < 0.f ? x - log1pf(__expf(x)) : -log1pf(__expf(-x)); }
__device__ __forceinline__ float logsigmoid_fast(float x) { return fminf(x, 0.f) - 0.6931471805599453f * __builtin_amdgcn_logf(1.0f + __builtin_amdgcn_exp2f(-fabsf(x) * 1.4426950408889634f)); }

#define XB_TMO      128
#define XB_XCNT(j)  (256  + 64 * (j))
#define XB_XSUB(j)  (1280 + 64 * (j))
#define XB_XGEN(j)  (2304 + 64 * (j))
#define XB_TOP      3328
#define XB_TOPGEN   3392
#define XCD_BAR_WORDS 3456
#define XB_SPIN_CAP (1u << 18)

__device__ __forceinline__ unsigned xb_ld(unsigned* p)              { return __hip_atomic_load(p, __ATOMIC_RELAXED, __HIP_MEMORY_SCOPE_AGENT); }
__device__ __forceinline__ unsigned xb_add(unsigned* p, unsigned v) { return __hip_atomic_fetch_add(p, v, __ATOMIC_RELAXED, __HIP_MEMORY_SCOPE_AGENT); }
__device__ __forceinline__ unsigned xb_xcc_id() { return (unsigned)__builtin_amdgcn_s_getreg((3 << 11) | 20) & 0xFu; }
#define XB_SPIN(cond, bar) do { unsigned _sp = 0; while (cond) { __builtin_amdgcn_s_sleep(1); \
    if ((++_sp & 255u) == 0u) { if (xb_ld(&(bar)[XB_TMO])) break; if (_sp > XB_SPIN_CAP) { atomicAdd(&(bar)[XB_TMO], 1u); break; } } } } while (0)

struct XcdBarrier { unsigned* bar; unsigned x; volatile LAS unsigned* st; };

__device__ __forceinline__ XcdBarrier xcd_barrier_post(unsigned* bar, volatile LAS unsigned* st) {
    XcdBarrier b; b.bar = bar; b.x = xb_xcc_id(); b.st = st;
    if (threadIdx.x == 0) (void)xb_add(&bar[XB_XCNT(b.x)], 1u);
    return b;
}
__device__ __forceinline__ void xcd_barrier_complete(unsigned* bar, unsigned x, unsigned& nloc, unsigned& nx) {
    const unsigned G = gridDim.x * gridDim.y * gridDim.z;
    unsigned sum, cnt, mine, sp = 0u;
    for (;;) {
        sum = 0u; cnt = 0u; mine = 0u;
#pragma unroll
        for (unsigned j = 0; j < 16; ++j) { const unsigned c = xb_ld(&bar[XB_XCNT(j)]); sum += c; cnt += (c > 0u) ? 1u : 0u; mine = (j == x) ? c : mine; }
        if (sum == G) break;
        __builtin_amdgcn_s_sleep(1);
        if ((++sp & 255u) == 0u) { if (xb_ld(&bar[XB_TMO])) break; if (sp > XB_SPIN_CAP) { atomicAdd(&bar[XB_TMO], 1u); break; } }
    }
    nloc = mine > 0u ? mine : 1u; nx = cnt > 0u ? cnt : 1u;
}
__device__ __forceinline__ void xcd_barrier(const XcdBarrier& b) {
    asm volatile("s_waitcnt vmcnt(0)" ::: "memory");
    __syncthreads();
    if (threadIdx.x == 0) {
        unsigned* bar = b.bar;
        __builtin_amdgcn_s_waitcnt(0);
        unsigned nloc = b.st[0], nx = b.st[1];
        if (nloc == 0u) { xcd_barrier_complete(bar, b.x, nloc, nx); b.st[0] = nloc; b.st[1] = nx; }
        const unsigned old = xb_add(&bar[XB_XSUB(b.x)], 1u);
        const unsigned gen = old / nloc;
        if (old + 1u == (gen + 1u) * nloc) {
            __builtin_amdgcn_fence(__ATOMIC_RELEASE, "agent");
            asm volatile("s_waitcnt vmcnt(0)" ::: "memory");
            const unsigned og = xb_add(&bar[XB_TOP], 1u);
            const unsigned tg = og / nx;
            if (og + 1u == (tg + 1u) * nx) xb_add(&bar[XB_TOPGEN], 1u);
            else XB_SPIN(xb_ld(&bar[XB_TOPGEN]) == tg, bar);
            __builtin_amdgcn_fence(__ATOMIC_ACQUIRE, "agent");
            xb_add(&bar[XB_XGEN(b.x)], 1u);
            asm volatile("s_waitcnt vmcnt(0)" ::: "memory");
        } else {
            XB_SPIN(xb_ld(&bar[XB_XGEN(b.x)]) == gen, bar);
            __builtin_amdgcn_fence(__ATOMIC_ACQUIRE, "agent");
            asm volatile("s_waitcnt vmcnt(0)" ::: "memory");
        }
    }
    __syncthreads();
}

struct Frame {
    LAS unsigned char* lds;
    volatile LAS unsigned* MISC;
    gu32* ctl;
    int tid, lane, wave;
    int vcu, G;
    unsigned char* ws;
};

__device__ __forceinline__ float wave_sum(float v) {
#pragma unroll
    for (int o = 1; o < 64; o <<= 1) v += __shfl_xor(v, o);
    return v;
}

__device__ __forceinline__ int wsrc_col(int kind, int n) {
    if (kind == 0) {
        if (n < 256) return 1544 + n;
        if (n < 512) return 1800 + (n - 256);
        if (n < 1024) return 2056 + (n - 512);
        if (n < 1536) return n - 1024;
        if (n < 2048) return 512 + (n - 1536);
        if (n < 2560) return 1024 + (n - 2048);
        return 2584 + (n - 2560);
    } else if (kind == 1) {
        const bool il = (n < 512) || (n >= 1024 && n < 2048);
        if (!il) return n;
        const int p = n & 63; return (n & ~63) + (p >> 1) + 32 * (p & 1);
    } else if (kind == 2) {
        return n;
    } else {
        if (n < 8) return 1536 + n;
        if (n < 24) return 2568 + (n - 8);
        return -1;
    }
}
__device__ __forceinline__ void p0_transpose_item(const float* W, int Nsrc, int kind, const float* gain, bf16* WT, int nblk, LAS float* scr, int item, int lane) {
    const int K = DMODEL; const int kb = item / nblk, nb = item % nblk, k0 = 64 * kb, n0 = 32 * nb;
    const int sc = wsrc_col(kind, n0 + (lane & 31));
    float wv[32];
#pragma unroll
    for (int i = 0; i < 32; ++i) { const int kk = 2 * i + (lane >> 5); wv[i] = (sc >= 0) ? W[(size_t)(k0 + kk) * Nsrc + sc] : 0.f; }
#pragma unroll
    for (int i = 0; i < 32; ++i) { const int kk = 2 * i + (lane >> 5); const float g = gain ? gain[k0 + kk] : 1.0f; scr[kk * 33 + (lane & 31)] = wv[i] * g; }
    LDS_WAIT(); asm volatile("" ::: "memory");
    const int c = lane & 7;
#pragma unroll
    for (int j = 0; j < 4; ++j) { const int n = (lane >> 3) + 8 * j; const LAS float* s = scr + (8 * c) * 33 + n;
        v4u o; o.x = pk2(s[0 * 33], s[1 * 33]); o.y = pk2(s[2 * 33], s[3 * 33]); o.z = pk2(s[4 * 33], s[5 * 33]); o.w = pk2(s[6 * 33], s[7 * 33]);
        *(GAS v4u*)(WT + (size_t)(n0 + n) * K + k0 + 8 * c) = o; }
    LDS_WAIT(); asm volatile("" ::: "memory");
}
typedef float f32x16 __attribute__((ext_vector_type(16)));
typedef float f32x2 __attribute__((ext_vector_type(2)));
typedef unsigned v2u __attribute__((ext_vector_type(2)));
typedef __bf16 bf16x2_t __attribute__((ext_vector_type(2)));
__device__ __forceinline__ unsigned cvtpk(float lo, float hi) { f32x2 v = {lo, hi}; bf16x2_t b = __builtin_convertvector(v, bf16x2_t); return __builtin_bit_cast(unsigned, b); }
__device__ __forceinline__ int crow16(int r, int hi) { return (r & 3) + 8 * (r >> 2) + 4 * hi; }
__device__ __forceinline__ f32x16 mfma32(bf16x8 a, bf16x8 b, f32x16 c) { return __builtin_amdgcn_mfma_f32_32x32x16_bf16(a, b, c, 0, 0, 0); }
__device__ __forceinline__ bf16x8 pack8(const f32x16& p, int s2) {
    v4u w; w.x = cvtpk(p[8 * s2 + 0], p[8 * s2 + 1]); w.y = cvtpk(p[8 * s2 + 2], p[8 * s2 + 3]); w.z = cvtpk(p[8 * s2 + 4], p[8 * s2 + 5]); w.w = cvtpk(p[8 * s2 + 6], p[8 * s2 + 7]);
    return __builtin_bit_cast(bf16x8, w);
}

__device__ __forceinline__ void wave_lds_sync() { asm volatile("s_waitcnt lgkmcnt(0)" ::: "memory"); }

constexpr int LC = 64;
constexpr int LLD = 72;
constexpr int RUNS = 256, RUN_CH = 8;

struct LinArgs {
    bf16* Z; const float* GLR; const float* w_lr; const float* b_lr;
    const float* g1; const float* g2;
    float* TRUN; float* SRUN; float* DRUN; float* DEC; bf16* Y;
};

typedef short v4i16_t __attribute__((ext_vector_type(4)));
template <int PITCH> __device__ __forceinline__ bf16x8 ld_tr8p(const LAS bf16* p) {
    const v4i16_t a = __builtin_amdgcn_ds_read_tr16_b64_v4i16((LAS v4i16_t*)p), b = __builtin_amdgcn_ds_read_tr16_b64_v4i16((LAS v4i16_t*)(p + 8 * PITCH));
    return (bf16x8){a[0], a[1], a[2], a[3], b[0], b[1], b[2], b[3]};
}
__device__ __forceinline__ bf16x8 ld_tr8(const LAS bf16* p) { return ld_tr8p<32>(p); }

constexpr int L1_W = 0, L1_BL = 16384;
constexpr int L1R_K = 17408, L1R_Q = L1R_K + 64 * LLD * 2, L1R_V = L1R_Q + 64 * LLD * 2, L1R_VLD = 136, L1R_G = L1R_V + 64 * L1R_VLD * 2, L1R_GLD = 20, L1R_D = L1R_G + 64 * L1R_GLD * 4, L1R_END = L1R_D + 256;
static_assert(L1R_END <= RING_BYTES, "X1 LDS map");
struct LinRaw { v4u kx, qx, vx0, vx1; f32x4 gl; };

template <bool ODD> __device__ __forceinline__ void lin_prep_load(Frame& F, const LinArgs& A, int u, LinRaw& R) {
    const int bh = u >> 6, n = u & 63, b = bh >> 2; const int tok = F.tid >> 3, c = F.tid & 7;
    const size_t hrow = (size_t)bh * SEQ + n * LC + tok;
    R.kx = *(const v4u*)(A.Z + ZR_LK + hrow * 64 + 8 * c); R.qx = *(const v4u*)(A.Z + ZR_LQ + hrow * 64 + 8 * c);
    R.vx0 = *(const v4u*)(A.Z + ZR_LV + hrow * 128 + 16 * c); R.vx1 = *(const v4u*)(A.Z + ZR_LV + hrow * 128 + 16 * c + 8);
    if (!ODD) { R.gl = (f32x4){0.f, 0.f, 0.f, 0.f}; if (F.tid < 256) R.gl = *(const f32x4*)(A.GLR + ((size_t)b * SEQ + n * LC + (F.tid >> 2)) * 16 + 4 * (F.tid & 3)); }
}

template <bool ODD> __device__ __forceinline__ void lin_prep_phase(Frame& F, const LinArgs& A) {
    LAS float* wL = (LAS float*)(F.lds + RING_OFF + L1_W); LAS float* bL = (LAS float*)(F.lds + RING_OFF + L1_BL);
    LAS bf16* KR = (LAS bf16*)(F.lds + RING_OFF + L1R_K); LAS bf16* QR = (LAS bf16*)(F.lds + RING_OFF + L1R_Q); LAS bf16* VR = (LAS bf16*)(F.lds + RING_OFF + L1R_V);
    LAS float* GR = (LAS float*)(F.lds + RING_OFF + L1R_G); LAS float* DL = (LAS float*)(F.lds + RING_OFF + L1R_D);
    if (!ODD) { for (int i = F.tid; i < 4096; i += 512) wL[i] = A.w_lr[i]; if (F.tid < 256) bL[F.tid] = A.b_lr[F.tid]; }
    const int r32 = F.lane & 31, hi = F.lane >> 5, w = F.wave, ctok = F.tid >> 3, cc = F.tid & 7, vb = w >> 1, db = w & 1;
    const int trow = 4 * hi + ((F.lane & 15) >> 2), tcol = 16 * ((F.lane >> 4) & 1) + 4 * (F.lane & 3);
    const LAS bf16* vtr = VR + trow * L1R_VLD + vb * 32 + tcol; const LAS bf16* ktr = KR + trow * LLD + db * 32 + tcol;
    LinRaw R;
    int run = F.vcu;
    if (run < RUNS) lin_prep_load<ODD>(F, A, run * RUN_CH, R);
    for (; run < RUNS; run += F.G) {
        const int bh = run >> 3, h = bh & 3;
        f32x16 acc = {}; float drun = 1.0f;
        for (int i = 0; i < RUN_CH; ++i) {
            const int u = run * RUN_CH + i, n = u & 63;
            __syncthreads();
            *(LAS v4u*)(KR + ctok * LLD + 8 * cc) = R.kx; *(LAS v4u*)(QR + ctok * LLD + 8 * cc) = R.qx;
            *(LAS v4u*)(VR + ctok * L1R_VLD + 16 * cc) = R.vx0; *(LAS v4u*)(VR + ctok * L1R_VLD + 16 * cc + 8) = R.vx1;
            if (!ODD && F.tid < 256) *(LAS f32x4*)(GR + (F.tid >> 2) * L1R_GLD + 4 * (F.tid & 3)) = R.gl;
            __syncthreads();
            { const int un = (i + 1 < RUN_CH) ? u + 1 : (run + F.G) * RUN_CH; if (i + 1 < RUN_CH || run + F.G < RUNS) lin_prep_load<ODD>(F, A, un, R); }
            const v4u kx = *(const LAS v4u*)(KR + F.lane * LLD + 8 * w), qx = *(const LAS v4u*)(QR + F.lane * LLD + 8 * w);
            float bv[8], blast[8];
            if (ODD) {
                const float lg = __logf(1.0f - exp2f(-5.0f - (float)h));
#pragma unroll
                for (int e = 0; e < 8; ++e) { bv[e] = lg * (float)(F.lane + 1); blast[e] = lg * 64.0f; }
            } else {
                f32x4 gl[4];
#pragma unroll
                for (int q = 0; q < 4; ++q) gl[q] = *(const LAS f32x4*)(GR + F.lane * L1R_GLD + 4 * q);
                const LAS float* wp = wL + h * 64 + 8 * w;
                f32x4 x0 = *(const LAS f32x4*)(bL + h * 64 + 8 * w), x1 = *(const LAS f32x4*)(bL + h * 64 + 8 * w + 4);
#pragma unroll
                for (int r = 0; r < 16; ++r) { const float g = gl[r >> 2][r & 3]; x0 += g * *(const LAS f32x4*)(wp + r * 256); x1 += g * *(const LAS f32x4*)(wp + r * 256 + 4); }
#pragma unroll
                for (int e = 0; e < 8; ++e) bv[e] = logsigmoid_fast(e < 4 ? x0[e & 3] : x1[e & 3]) * (1.0f / 16.0f);
#pragma unroll
                for (int o = 1; o < 64; o <<= 1) {
#pragma unroll
                    for (int e = 0; e < 8; ++e) { const float y = __shfl_up(bv[e], o); if (F.lane >= o) bv[e] += y; }
                }
#pragma unroll
                for (int e = 0; e < 8; ++e) blast[e] = __shfl(bv[e], 63);
            }
            {
                v4u qo, ko;
#pragma unroll
                for (int e2 = 0; e2 < 4; ++e2) {
                    const float q0 = bflo(qx[e2]), q1 = bfhi(qx[e2]), k0 = bflo(kx[e2]), k1 = bfhi(kx[e2]);
                    const float e0 = __expf(bv[2 * e2]), e1 = __expf(bv[2 * e2 + 1]);
                    qo[e2] = cvtpk(q0 * e0, q1 * e1);
                    ko[e2] = cvtpk(k0 * __builtin_amdgcn_rcpf(e0), k1 * __builtin_amdgcn_rcpf(e1));
                }
                *(LAS v4u*)(QR + F.lane * LLD + 8 * w) = qo; *(LAS v4u*)(KR + F.lane * LLD + 8 * w) = ko;
                if (F.lane == 63) { float* dp = A.DEC + (size_t)u * 64 + 8 * w;
#pragma unroll
                    for (int e = 0; e < 8; ++e) { const float dv = __expf(blast[e]); dp[e] = dv; DL[8 * w + e] = dv; } }
            }
            __syncthreads();
            {
                const size_t hrow = (size_t)bh * SEQ + n * LC + ctok;
                *(v4u*)(A.Z + ZR_LQ + hrow * 64 + 8 * cc) = *(const LAS v4u*)(QR + ctok * LLD + 8 * cc);
                *(v4u*)(A.Z + ZR_LK + hrow * 64 + 8 * cc) = *(const LAS v4u*)(KR + ctok * LLD + 8 * cc);
#pragma unroll
                for (int s = 0; s < 4; ++s) acc = mfma32(ld_tr8p<L1R_VLD>(vtr + 16 * s * L1R_VLD), ld_tr8p<LLD>(ktr + 16 * s * LLD), acc);
                const float dv = DL[db * 32 + r32];
#pragma unroll
                for (int r = 0; r < 16; ++r) acc[r] *= dv;
                drun *= dv;
            }
        }
        float* dst = A.TRUN + (size_t)run * (128 * 64) + db * 32 + r32;
#pragma unroll
        for (int r = 0; r < 16; ++r) dst[(size_t)(vb * 32 + crow16(r, hi)) * 64] = acc[r];
        if (vb == 0 && hi == 0) A.DRUN[run * 64 + db * 32 + r32] = drun;
    }
    __syncthreads();
}

__device__ __forceinline__ void lin_scan_phase(Frame& F, const LinArgs& A) {
    const int gt = F.vcu * 512 + F.tid;
    for (int e = gt; e < 32 * 128 * 32; e += F.G * 512) {
        const int bh = e >> 12, rem = e & 4095;
        const f32x2* tp = (const f32x2*)(A.TRUN + (size_t)bh * RUN_CH * (128 * 64) + rem * 2);
        const f32x2* dp = (const f32x2*)(A.DRUN + (size_t)bh * RUN_CH * 64 + (rem & 31) * 2);
        f32x2* sp = (f32x2*)(A.SRUN + (size_t)bh * RUN_CH * (128 * 64) + rem * 2);
        f32x2 tv[RUN_CH], dv[RUN_CH];
#pragma unroll
        for (int i = 0; i < RUN_CH; ++i) { tv[i] = tp[(size_t)i * 4096]; dv[i] = dp[i * 32]; }
        f32x2 st = {0.f, 0.f};
#pragma unroll
        for (int i = 0; i < RUN_CH; ++i) { sp[(size_t)i * 4096] = st; st = st * dv[i] + tv[i]; }
    }
}

constexpr int L3_QT = 0, L3_KT = L3_QT + 64 * LLD * 2, L3_VP = L3_KT + 64 * LLD * 2  , L3_PL = L3_VP + 4 * 64 * 32 * 2,
              L3_GL = L3_PL + 128 * LLD * 2, L3_GLD = 136, L3_OL = L3_GL + 64 * L3_GLD * 2, L3_D = L3_OL + 64 * 132 * 4, L3_END = L3_D + 256;
static_assert(L3_END <= RING_BYTES, "X3 LDS map");
struct LinOutRaw { v4u q, k, vv[2], g[2]; float dec; };
template <bool ODD> __device__ __forceinline__ void lin_out_load(Frame& F, const LinArgs& A, int u, LinOutRaw& R) {
    const int bh = u >> 6, n = u & 63, b = bh >> 2, h = bh & 3; const size_t hrow0 = (size_t)bh * SEQ + n * LC;
    const int tok = F.tid >> 3, c = F.tid & 7;
    R.q = *(const v4u*)(A.Z + ZR_LQ + (hrow0 + tok) * 64 + 8 * c); R.k = *(const v4u*)(A.Z + ZR_LK + (hrow0 + tok) * 64 + 8 * c);
    const bf16* vsrc = A.Z + ZR_LV + (hrow0 + tok) * 128 + 16 * c;
    R.vv[0] = *(const v4u*)vsrc; R.vv[1] = *(const v4u*)(vsrc + 8);
    const bf16* gp = A.Z + ZR_GATE + ((size_t)b * SEQ + n * LC + tok) * 1024 + (ODD ? 0 : 512) + h * 128 + 16 * c;
    R.g[0] = *(const v4u*)gp; R.g[1] = *(const v4u*)(gp + 8);
    R.dec = (F.tid < 64) ? A.DEC[(size_t)u * 64 + F.tid] : 0.f;
}
template <bool ODD> __device__ __forceinline__ void lin_out_phase(Frame& F, const LinArgs& A) {
    LAS bf16* QtL = (LAS bf16*)(F.lds + RING_OFF + L3_QT); LAS bf16* KtL = (LAS bf16*)(F.lds + RING_OFF + L3_KT);
    LAS bf16* VPL = (LAS bf16*)(F.lds + RING_OFF + L3_VP); LAS bf16* PL = (LAS bf16*)(F.lds + RING_OFF + L3_PL);
    LAS bf16* GL = (LAS bf16*)(F.lds + RING_OFF + L3_GL); LAS float* OL = (LAS float*)(F.lds + RING_OFF + L3_OL); LAS float* DL = (LAS float*)(F.lds + RING_OFF + L3_D);
    const int r32 = F.lane & 31, hi = F.lane >> 5, qi = F.wave >> 2, vj = F.wave & 3, vb = F.wave >> 1, db = F.wave & 1;
    const int trow = 4 * hi + ((F.lane & 15) >> 2), tcol = 16 * ((F.lane >> 4) & 1) + 4 * (F.lane & 3);
    int run = F.vcu;
    f32x4 g1v[4], g2v[4]; int hcur = -1;
    LinOutRaw R;
    if (run < RUNS) lin_out_load<ODD>(F, A, run * RUN_CH, R);
    for (; run < RUNS; run += F.G) {
        const int bh = run >> 3, b = bh >> 2, h = bh & 3;
        if (h != hcur) {
            hcur = h; const int c0 = h * 128 + (F.tid & 7) * 16;
#pragma unroll
            for (int e = 0; e < 4; ++e) { g1v[e] = *(const f32x4*)(A.g1 + c0 + 4 * e); g2v[e] = ODD ? *(const f32x4*)(A.g2 + c0 + 4 * e) : (f32x4){0.f, 0.f, 0.f, 0.f}; }
        }
        f32x16 S;
        { const float* sp = A.SRUN + (size_t)run * (128 * 64) + db * 32 + r32;
#pragma unroll
          for (int r = 0; r < 16; ++r) S[r] = sp[(size_t)(vb * 32 + crow16(r, hi)) * 64]; }
        for (int i = 0; i < RUN_CH; ++i) {
            const int u = run * RUN_CH + i, n = u & 63;
            __syncthreads();
            { const int tok = F.tid >> 3, c = F.tid & 7;
              *(LAS v4u*)(QtL + tok * LLD + 8 * c) = R.q; *(LAS v4u*)(KtL + tok * LLD + 8 * c) = R.k;
              *(LAS v4u*)(GL + tok * L3_GLD + 16 * c) = R.g[0]; *(LAS v4u*)(GL + tok * L3_GLD + 16 * c + 8) = R.g[1];
#pragma unroll
              for (int e = 0; e < 2; ++e) *(LAS v4u*)(VPL + (c >> 1) * 2048 + tok * 32 + (c & 1) * 16 + 8 * e) = R.vv[e];
              if (F.tid < 64) DL[F.tid] = R.dec; }
#pragma unroll
            for (int r = 0; r < 16; ++r) PL[(vb * 32 + crow16(r, hi)) * LLD + db * 32 + r32] = (bf16)f2bf(S[r]);
            __syncthreads();
            { const int un = (i + 1 < RUN_CH) ? u + 1 : (run + F.G) * RUN_CH; if (i + 1 < RUN_CH || run + F.G < RUNS) lin_out_load<ODD>(F, A, un, R); }
            f32x16 st0 = {}, st1 = {};
            bf16x8 qf[4];
#pragma unroll
            for (int s = 0; s < 4; ++s) qf[s] = *(const LAS bf16x8*)(QtL + (qi * 32 + r32) * LLD + 16 * s + 8 * hi);
#pragma unroll
            for (int s = 0; s < 4; ++s) st0 = mfma32(*(const LAS bf16x8*)(KtL + r32 * LLD + 16 * s + 8 * hi), qf[s], st0);
            if (qi == 1) {
#pragma unroll
                for (int s = 0; s < 4; ++s) st1 = mfma32(*(const LAS bf16x8*)(KtL + (32 + r32) * LLD + 16 * s + 8 * hi), qf[s], st1);
            }
#pragma unroll
            for (int r = 0; r < 16; ++r) { const int kl = crow16(r, hi); if (qi == 0) { if (kl > r32) st0[r] = 0.f; } else { if (kl > r32) st1[r] = 0.f; } }
            f32x16 o = {};
            const LAS bf16* vlane = VPL + vj * 2048 + trow * 32 + tcol;
            o = mfma32(pack8(st0, 0), ld_tr8(vlane), o);
            o = mfma32(pack8(st0, 1), ld_tr8(vlane + 16 * 32), o);
            if (qi == 1) { o = mfma32(pack8(st1, 0), ld_tr8(vlane + 32 * 32), o); o = mfma32(pack8(st1, 1), ld_tr8(vlane + 48 * 32), o); }
#pragma unroll
            for (int s = 0; s < 4; ++s) o = mfma32(qf[s], *(const LAS bf16x8*)(PL + (vj * 32 + r32) * LLD + 16 * s + 8 * hi), o);
#pragma unroll
            for (int r = 0; r < 16; ++r) OL[(qi * 32 + crow16(r, hi)) * 132 + vj * 32 + r32] = o[r];
            { const LAS bf16* va = VPL + vb * 2048 + trow * 32 + tcol; const LAS bf16* kb = KtL + trow * LLD + db * 32 + tcol;
#pragma unroll
              for (int s = 0; s < 4; ++s) S = mfma32(ld_tr8(va + 16 * s * 32), ld_tr8p<LLD>(kb + 16 * s * LLD), S);
              const float dv = DL[db * 32 + r32];
#pragma unroll
              for (int r = 0; r < 16; ++r) S[r] *= dv; }
            __syncthreads();
            {
                const int q = F.tid >> 3, part = F.tid & 7; const size_t row = (size_t)b * SEQ + n * LC + q;
                f32x4 x[4];
#pragma unroll
                for (int e = 0; e < 4; ++e) x[e] = *(const LAS f32x4*)(OL + q * 132 + part * 16 + 4 * e);
                if (ODD) {
                    float s = 0.f;
#pragma unroll
                    for (int e = 0; e < 4; ++e) s += (x[e][0] + x[e][1]) + (x[e][2] + x[e][3]);
                    s += __shfl_xor(s, 1); s += __shfl_xor(s, 2); s += __shfl_xor(s, 4);
                    const float mu = s * (1.0f / 128.0f);
#pragma unroll
                    for (int e = 0; e < 4; ++e) x[e] = x[e] - mu;
                }
                float s2 = 0.f;
#pragma unroll
                for (int e = 0; e < 4; ++e) s2 += (x[e][0] * x[e][0] + x[e][1] * x[e][1]) + (x[e][2] * x[e][2] + x[e][3] * x[e][3]);
                s2 += __shfl_xor(s2, 1); s2 += __shfl_xor(s2, 2); s2 += __shfl_xor(s2, 4);
                const float rs = 1.0f / sqrtf(s2 * (1.0f / 128.0f) + RMS_EPS);
                const int c0 = h * 128 + part * 16, yb = ODD ? 0 : 512;
                v4u* yp = (v4u*)(A.Y + row * DMODEL + yb + c0);
#pragma unroll
                for (int e2 = 0; e2 < 2; ++e2) {
                    const v4u gt = *(const LAS v4u*)(GL + q * L3_GLD + part * 16 + 8 * e2); v4u ov;
                    const f32x4 ya = x[2 * e2] * rs * g1v[2 * e2] + g2v[2 * e2], yb4 = x[2 * e2 + 1] * rs * g1v[2 * e2 + 1] + g2v[2 * e2 + 1];
                    ov[0] = cvtpk(ya[0] * bflo(gt[0]), ya[1] * bfhi(gt[0])); ov[1] = cvtpk(ya[2] * bflo(gt[1]), ya[3] * bfhi(gt[1]));
                    ov[2] = cvtpk(yb4[0] * bflo(gt[2]), yb4[1] * bfhi(gt[2])); ov[3] = cvtpk(yb4[2] * bflo(gt[3]), yb4[3] * bfhi(gt[3]));
                    yp[e2] = ov;
                }
            }
        }
    }
    __syncthreads();
}

constexpr int DK_LD = 72;
constexpr int DV_HALF = 384 * 32;
constexpr int DA_K = 0, DA_VT = DA_K + 384 * DK_LD * 2, DA_WS = DA_VT + 2 * DV_HALF * 2, DA_END = DA_WS + 8 * 512;
constexpr int DA_TLD = 68, DA_TILE = 32 * DA_TLD * 4;
static_assert(DA_END <= RING_BYTES && 8 * DA_TILE <= DA_WS, "dilated-attention LDS map");
constexpr size_t OD_OFF = (size_t)16 * 1024 * 1024;

struct DilRows { v4u kx[6], vx[6]; };
struct DilDesc { int bh, dil, r, blk, has_old, fin; };
template <int PH> __device__ __forceinline__ bool dil_desc(int first, int G, int i, DilDesc& d) {
    if (PH == 0) { const int su = first + (i >> 3) * G; if (su >= 256) return false; const int k = i & 7, span = su & 3;
        d.bh = su >> 2; d.has_old = k >> 2; d.fin = 0;
        if (k < 4) { d.dil = 1; d.r = 0; d.blk = 4 * span + k; } else { d.dil = 4; d.r = k & 3; d.blk = span; }
        return true; }
    const int u = first + i * G; if (u >= 1024) return false;
    d.bh = u >> 4; d.dil = 16; d.r = u & 15; d.blk = 0; d.has_old = 1; d.fin = 1; return true;
}
__device__ __forceinline__ void dil_load_rows(Frame& F, const bf16* Z, const DilDesc& d, DilRows& R) {
    const int i0 = 256 * d.blk; const size_t hb0 = (size_t)d.bh * SEQ;
#pragma unroll
    for (int e = 0; e < 6; ++e) {
        const int pi = F.tid + 512 * e, row = pi >> 3, c = pi & 7, idx = i0 - 128 + row;
        R.kx[e] = (v4u){0u, 0u, 0u, 0u}; R.vx[e] = (v4u){0u, 0u, 0u, 0u};
        if (idx >= 0) { const size_t ro = (hb0 + (size_t)(idx * d.dil + d.r)) * 64 + 8 * c; R.kx[e] = *(const v4u*)(Z + ZR_AK + ro); R.vx[e] = *(const v4u*)(Z + ZR_AV + ro); }
    }
}

template <int PH> __device__ __forceinline__ void dil_phase(Frame& F, const bf16* Z, bf16* Y, bf16* OD, float* LSE) {
    LAS bf16* KI = (LAS bf16*)(F.lds + RING_OFF + DA_K); LAS bf16* VH = (LAS bf16*)(F.lds + RING_OFF + DA_VT);
    LAS float* wsc = (LAS float*)(F.lds + RING_OFF + DA_WS + F.wave * 512); LAS float* T = (LAS float*)(F.lds + RING_OFF + F.wave * DA_TILE);
    const int r32 = F.lane & 31, hi = F.lane >> 5;
    DilDesc d, dn;
    DilRows R;
    bool have = dil_desc<PH>(F.vcu, F.G, 0, d);
    if (have) dil_load_rows(F, Z, d, R);
    for (int it = 0; have; ++it) {
        const int b = d.bh >> 3, h = d.bh & 7, r = d.r, DIL = d.dil, i0 = 256 * d.blk;
        const size_t hb0 = (size_t)d.bh * SEQ;
        if (PH == 0 && (it & 7) == 4) asm volatile("s_waitcnt vmcnt(0)" ::: "memory");
        __syncthreads();
#pragma unroll
        for (int e = 0; e < 6; ++e) {
            const int pi = F.tid + 512 * e, row = pi >> 3, c = pi & 7;
            *(LAS v4u*)(KI + row * DK_LD + 8 * c) = R.kx[e];
            *(LAS v4u*)(VH + (c >> 2) * DV_HALF + row * 32 + (c & 3) * 8) = R.vx[e];
        }
        const int qidx = i0 + 32 * F.wave + r32; const size_t qhrow = hb0 + (size_t)qidx * DIL + r;
        bf16x8 qf[4];
#pragma unroll
        for (int s = 0; s < 4; ++s) qf[s] = *(const bf16x8*)(Z + ZR_AQ + qhrow * 64 + 16 * s + 8 * hi);
        float lse_old = 0.f;
        if (d.has_old) lse_old = __builtin_nontemporal_load(LSE + qhrow);
        __syncthreads();
        have = dil_desc<PH>(F.vcu, F.G, it + 1, dn);
        if (have) dil_load_rows(F, Z, dn, R);
        const int kb_lo = (i0 + 32 * F.wave - 128 < 0) ? (128 - i0 - 32 * F.wave) / 32 : 0;
        f32x16 st[5];
#pragma unroll
        for (int kb = 0; kb < 5; ++kb) {
            st[kb] = (f32x16){};
            if (kb >= kb_lo) {
#pragma unroll
                for (int s = 0; s < 4; ++s) st[kb] = mfma32(*(const LAS bf16x8*)(KI + (32 * F.wave + 32 * kb + r32) * DK_LD + 16 * s + 8 * hi), qf[s], st[kb]);
            }
        }
        float mx = -INFINITY;
#pragma unroll
        for (int kb = 0; kb < 5; ++kb)
#pragma unroll
            for (int rr = 0; rr < 16; ++rr) {
                const int kl = crow16(rr, hi); bool ok = kb >= kb_lo;
                if (kb == 0) ok = ok && (kl >= r32);
                if (kb == 4) ok = ok && (kl <= r32);
                const float sv = ok ? st[kb][rr] : -INFINITY; st[kb][rr] = sv; mx = fmaxf(mx, sv);
            }
        mx = fmaxf(mx, __shfl_xor(mx, 32));
        float l = 0.f;
#pragma unroll
        for (int kb = 0; kb < 5; ++kb)
#pragma unroll
            for (int rr = 0; rr < 16; ++rr) { const float p = __builtin_amdgcn_exp2f(st[kb][rr] - mx); st[kb][rr] = p; l += p; }
        l += __shfl_xor(l, 32);
        const float lse_cur = mx + __log2f(l);
        float w_old = 0.f, w_cur = 1.0f / l, lse_new = lse_cur;
        if (d.has_old) {
            const float m2 = fmaxf(lse_old, lse_cur); lse_new = m2 + __log2f(exp2f(lse_old - m2) + exp2f(lse_cur - m2));
            w_old = exp2f(lse_old - lse_new); w_cur = exp2f(lse_cur - lse_new) / l;
        }
        if (!d.fin && hi == 0) LSE[qhrow] = lse_new;
        if (hi == 0) { wsc[r32] = w_old; wsc[32 + r32] = w_cur; }
        v4u oldv[4];
#pragma unroll
        for (int e = 0; e < 4; ++e) {
            const int pi = F.lane + 64 * e, ql = pi >> 3, c = pi & 7; const size_t tok = (size_t)(i0 + 32 * F.wave + ql) * DIL + r;
            oldv[e] = (v4u){0u, 0u, 0u, 0u};
            if (d.has_old) oldv[e] = __builtin_nontemporal_load((const v4u*)(OD + (hb0 + tok) * 64 + 8 * c));
        }
        f32x16 o0 = {}, o1 = {};
        const LAS bf16* vlane = VH + (32 * F.wave + 4 * hi + ((F.lane & 15) >> 2)) * 32 + 16 * ((F.lane >> 4) & 1) + 4 * (F.lane & 3);
#pragma unroll
        for (int kb = 0; kb < 5; ++kb) {
            if (kb >= kb_lo) {
#pragma unroll
                for (int s2 = 0; s2 < 2; ++s2) {
                    const bf16x8 pa = pack8(st[kb], s2);
                    const LAS bf16* vp = vlane + (32 * kb + 16 * s2) * 32;
                    o0 = mfma32(pa, ld_tr8(vp), o0);
                    o1 = mfma32(pa, ld_tr8(vp + DV_HALF), o1);
                }
            }
        }
        v4u gatev[4];
        if (PH == 1) {
#pragma unroll
            for (int e = 0; e < 4; ++e) { const int pi = F.lane + 64 * e, ql = pi >> 3, c = pi & 7; const size_t tok = (size_t)(i0 + 32 * F.wave + ql) * DIL + r;
                gatev[e] = *(const v4u*)(Z + ZR_GATE + ((size_t)b * SEQ + tok) * 1024 + 512 + h * 64 + 8 * c); }
        }
        __syncthreads();
#pragma unroll
        for (int rr = 0; rr < 16; ++rr) { const int ql = crow16(rr, hi); T[ql * DA_TLD + r32] = o0[rr]; T[ql * DA_TLD + 32 + r32] = o1[rr]; }
        wave_lds_sync();
#pragma unroll
        for (int e = 0; e < 4; ++e) {
            const int pi = F.lane + 64 * e, ql = pi >> 3, c = pi & 7;
            const f32x4 t0 = *(const LAS f32x4*)(T + ql * DA_TLD + 8 * c), t1 = *(const LAS f32x4*)(T + ql * DA_TLD + 8 * c + 4);
            const float wo = wsc[ql], wc = wsc[32 + ql];
            const size_t tok = (size_t)(i0 + 32 * F.wave + ql) * DIL + r;
            float a[8] = {t0[0] * wc, t0[1] * wc, t0[2] * wc, t0[3] * wc, t1[0] * wc, t1[1] * wc, t1[2] * wc, t1[3] * wc};
#pragma unroll
            for (int q = 0; q < 4; ++q) { a[2 * q] += wo * bflo(oldv[e][q]); a[2 * q + 1] += wo * bfhi(oldv[e][q]); }
            if (PH == 1) {
                v4u w;
#pragma unroll
                for (int q = 0; q < 4; ++q) w[q] = cvtpk(a[2 * q] * bflo(gatev[e][q]), a[2 * q + 1] * bfhi(gatev[e][q]));
                *(v4u*)(Y + ((size_t)b * SEQ + tok) * DMODEL + 512 + h * 64 + 8 * c) = w;
            } else {
                v4u w;
#pragma unroll
                for (int q = 0; q < 4; ++q) w[q] = cvtpk(a[2 * q], a[2 * q + 1]);
                *(v4u*)(OD + (hb0 + tok) * 64 + 8 * c) = w;
            }
        }
        d = dn;
    }
    __syncthreads();
}
struct Args { const float* in[14]; float* out; unsigned char* ws; int ph_lo, ph_hi, li, pad; };

constexpr size_t W_LAYER_BYTES = 9 * MiB;
__device__ __forceinline__ bf16* w_in_ptr(unsigned char* ws, int L) { return (bf16*)(ws + WS_W + (size_t)L * W_LAYER_BYTES); }
__device__ __forceinline__ bf16* w_out_ptr(unsigned char* ws, int L) { return (bf16*)(ws + WS_W + (size_t)L * W_LAYER_BYTES + 7 * MiB); }

__device__ __forceinline__ void p0_prologue(Frame& F, const Args& a) {
    LAS float* scr = (LAS float*)(F.lds + RING_OFF + F.wave * 16384);
    const int gw = F.vcu * NWAVES + F.wave, NGW = F.G * NWAVES;
    constexpr int I_IN = 16 * 112, I_OUT = 16 * 32, I_SK = 16, PER_LAYER = I_IN + I_OUT, NITEMS = 4 * PER_LAYER + 2 * I_SK;
    for (int it = gw; it < NITEMS; it += NGW) {
        if (it < 4 * PER_LAYER) {
            const int L = it / PER_LAYER; int r = it % PER_LAYER; const int j = L >> 1, odd = L & 1;
            if (r < I_IN) {
                const float* W = odd ? a.in[9] + (size_t)j * DMODEL * ODD_IN : a.in[2] + (size_t)j * DMODEL * EVEN_IN;
                const float* gain = (odd ? a.in[8] : a.in[1]) + j * DMODEL;
                p0_transpose_item(W, odd ? ODD_IN : EVEN_IN, odd ? 1 : 0, gain, w_in_ptr(a.ws, L), 112, scr, r, F.lane);
            } else {
                r -= I_IN;
                const float* W = (odd ? a.in[12] : a.in[7]) + (size_t)j * DMODEL * DMODEL;
                p0_transpose_item(W, DMODEL, 2, nullptr, w_out_ptr(a.ws, L), 32, scr, r, F.lane);
            }
        } else {
            const int r = it - 4 * PER_LAYER; const int j = r / I_SK;
            p0_transpose_item(a.in[2] + (size_t)j * DMODEL * EVEN_IN, EVEN_IN, 3, a.in[1] + j * DMODEL, (bf16*)(a.ws + WS_WSK) + (size_t)j * 32 * DMODEL, 1, scr, r % I_SK, F.lane);
        }
    }
    {
        bf16* HB = (bf16*)(a.ws + WS_HB); float* SS = (float*)(a.ws + WS_SS);
        for (int m0 = gw * 4; m0 < M; m0 += NGW * 4) {
            f32x4 v[4][4];
#pragma unroll
            for (int rr = 0; rr < 4; ++rr) { const GAS f32x4* xr = (const GAS f32x4*)(a.in[0] + (size_t)(m0 + rr) * DMODEL) + F.lane;
#pragma unroll
                for (int j = 0; j < 4; ++j) v[rr][j] = xr[64 * j]; }
#pragma unroll
            for (int rr = 0; rr < 4; ++rr) {
                GAS unsigned long long* o8 = (GAS unsigned long long*)(HB + (size_t)(m0 + rr) * DMODEL) + F.lane;
                float s = 0.f;
#pragma unroll
                for (int j = 0; j < 4; ++j) { s += (v[rr][j].x * v[rr][j].x + v[rr][j].y * v[rr][j].y) + (v[rr][j].z * v[rr][j].z + v[rr][j].w * v[rr][j].w);
                    o8[64 * j] = (unsigned long long)pk2(v[rr][j].x, v[rr][j].y) | ((unsigned long long)pk2(v[rr][j].z, v[rr][j].w) << 32); }
                s = wave_sum(s);
                if (F.lane < 16) SS[(size_t)(m0 + rr) * 16 + F.lane] = (F.lane == 0) ? s : 0.f;
            }
        }
    }
    {
        float* RP = (float*)(a.ws + WS_ROPE);
        for (int e = F.vcu * 512 + F.tid; e < SEQ * 32; e += F.G * 512) {
            const int t = e >> 5, j = e & 31;
            const float inv = (float)exp(-(double)j * (9.210340371976184 / 32.0));
            const float ang = (float)t * inv;
            double sn, cs; sincos((double)ang, &sn, &cs);
            RP[2 * e] = (float)cs; RP[2 * e + 1] = (float)sn;
        }
    }
}

__device__ __forceinline__ void skinny_phase(Frame& F, const bf16* HB, const bf16* WSK, const float* SS, const float* b_f, float* FFo, float* GLRo) {
    typedef float f32x4_t __attribute__((ext_vector_type(4)));
    const int lr = F.lane & 15, kq = F.lane >> 4;
    for (int rb = blockIdx.x; rb < M / 128; rb += F.G) {
        const int r0 = rb * 128 + F.wave * 16;
        f32x4_t acc0 = {0.f, 0.f, 0.f, 0.f}, acc1 = {0.f, 0.f, 0.f, 0.f};
        const bf16* ap = HB + (size_t)(r0 + lr) * DMODEL + 8 * kq;
        const bf16* bp0 = WSK + (size_t)lr * DMODEL + 8 * kq;
        const bf16* bp1 = WSK + (size_t)(16 + lr) * DMODEL + 8 * kq;
        for (int k0 = 0; k0 < DMODEL; k0 += 256) {
            bf16x8 av[8], b0[8], b1[8];
#pragma unroll
            for (int i = 0; i < 8; ++i) { av[i] = *(const bf16x8*)(ap + k0 + 32 * i); b0[i] = *(const bf16x8*)(bp0 + k0 + 32 * i); b1[i] = *(const bf16x8*)(bp1 + k0 + 32 * i); }
#pragma unroll
            for (int i = 0; i < 8; ++i) { acc0 = __builtin_amdgcn_mfma_f32_16x16x32_bf16(av[i], b0[i], acc0, 0, 0, 0); acc1 = __builtin_amdgcn_mfma_f32_16x16x32_bf16(av[i], b1[i], acc1, 0, 0, 0); }
        }
#pragma unroll
        for (int reg = 0; reg < 4; ++reg) {
            const int row = r0 + 4 * kq + reg;
            const f32x4* sp = (const f32x4*)(SS + (size_t)row * 16);
            const f32x4 s0 = sp[0], s1 = sp[1], s2 = sp[2], s3 = sp[3];
            const float tot = ((s0[0] + s0[1]) + (s0[2] + s0[3])) + ((s1[0] + s1[1]) + (s1[2] + s1[3])) + ((s2[0] + s2[1]) + (s2[2] + s2[3])) + ((s3[0] + s3[1]) + (s3[2] + s3[3]));
            const float rinv = 1.0f / sqrtf(tot * (1.0f / 1024.0f) + RMS_EPS);
            const float v0 = acc0[reg] * rinv, v1 = acc1[reg] * rinv;
            if (lr < 8) { FFo[(size_t)row * 8 + lr] = logsigmoidf(v0 + b_f[lr]); GLRo[(size_t)row * 16 + 8 + lr] = v1; }
            else GLRo[(size_t)row * 16 + (lr - 8)] = v0;
        }
    }
}

__device__ __forceinline__ void fox_norm_unit(Frame& F, int u, const bf16* Z, float* KN, float* QN) {
    const int bh = u >> 2, qz = u & 3, c = F.lane & 7, rl = F.lane >> 3;
    float q2 = 0.f, dmin = 3.0e38f;
#pragma unroll
    for (int tile = 0; tile < 2; ++tile) {
        v4u kx[8], qx[8];
#pragma unroll
        for (int ps = 0; ps < 8; ++ps) {
            const size_t hrow = (size_t)bh * SEQ + 1024 * qz + 128 * F.wave + 64 * tile + 8 * ps + rl;
            kx[ps] = *(const v4u*)(Z + ZR_AK + hrow * 64 + 8 * c); qx[ps] = *(const v4u*)(Z + ZR_AQ + hrow * 64 + 8 * c);
        }
        float k2 = 0.f;
#pragma unroll
        for (int ps = 0; ps < 8; ++ps) {
            float ks = 0.f, qs = 0.f, dg = 0.f;
#pragma unroll
            for (int e = 0; e < 4; ++e) { const float a = bflo(kx[ps][e]), bb = bfhi(kx[ps][e]), cc = bflo(qx[ps][e]), dd = bfhi(qx[ps][e]); ks += a * a + bb * bb; qs += cc * cc + dd * dd; dg += a * cc + bb * dd; }
#pragma unroll
            for (int o = 1; o < 8; o <<= 1) { ks += __shfl_xor(ks, o); qs += __shfl_xor(qs, o); dg += __shfl_xor(dg, o); }
            k2 = fmaxf(k2, ks); q2 = fmaxf(q2, qs); dmin = fminf(dmin, dg);
        }
#pragma unroll
        for (int o = 8; o < 64; o <<= 1) k2 = fmaxf(k2, __shfl_xor(k2, o));
        if (F.lane == 0) KN[bh * 64 + qz * 16 + 2 * F.wave + tile] = sqrtf(k2) * 1.001f;
    }
#pragma unroll
    for (int o = 8; o < 64; o <<= 1) { q2 = fmaxf(q2, __shfl_xor(q2, o)); dmin = fminf(dmin, __shfl_xor(dmin, o)); }
    if (F.lane == 0) { QN[bh * 32 + qz * 8 + F.wave] = sqrtf(q2) * 1.001f; QN[2048 + bh * 32 + qz * 8 + F.wave] = dmin - 1e-3f * fabsf(dmin) - 1e-3f; }
}

__device__ __forceinline__ void cumsum_unit(Frame& F, int bh, const float* FFp, float* CB) {
    LAS float* wsum = (LAS float*)(F.lds + RING_OFF);
    const int b = bh >> 3, h = bh & 7;
    float v[8]; float run = 0.f;
#pragma unroll
    for (int i = 0; i < 8; ++i) { run += FFp[((size_t)b * SEQ + F.tid * 8 + i) * 8 + h]; v[i] = run; }
    float x = run;
#pragma unroll
    for (int o = 1; o < 64; o <<= 1) { const float y = __shfl_up(x, o); if (F.lane >= o) x += y; }
    if (F.lane == 63) wsum[F.wave] = x;
    __syncthreads();
    float off = x - run;
    for (int w = 0; w < F.wave; ++w) off += wsum[w];
#pragma unroll
    for (int i = 0; i < 8; ++i) CB[(size_t)bh * SEQ + F.tid * 8 + i] = v[i] + off;
    __syncthreads();
}

__device__ __forceinline__ void final_norm_phase(Frame& F, const bf16* HB, const float* SS, float* out, const float* g) {
    const int gw = F.vcu * NWAVES + F.wave, NGW = F.G * NWAVES;
    f32x4 gv[4];
#pragma unroll
    for (int j = 0; j < 4; ++j) gv[j] = ((const f32x4*)g)[F.lane + 64 * j];
    for (int m = gw; m < M; m += NGW) {
        const float sv = (F.lane < 16) ? SS[(size_t)m * 16 + F.lane] : 0.f;
        const float r = 1.0f / sqrtf(wave_sum(sv) * (1.0f / 1024.0f) + RMS_EPS);
        const GAS unsigned long long* hr = (const GAS unsigned long long*)(HB + (size_t)m * DMODEL) + F.lane;
        GAS f32x4* xr = (GAS f32x4*)(out + (size_t)m * DMODEL) + F.lane;
#pragma unroll
        for (int j = 0; j < 4; ++j) { const unsigned long long w = hr[64 * j]; const unsigned lo = (unsigned)w, hi2 = (unsigned)(w >> 32);
            f32x4 v; v.x = bflo(lo); v.y = bfhi(lo); v.z = bflo(hi2); v.w = bfhi(hi2); xr[64 * j] = v * r * gv[j]; }
    }
}

constexpr int PH_PER_LAYER = 5, N_PHASES = 2 + 4 * PH_PER_LAYER;
#ifndef MK_N_LAUNCHES
#define MK_N_LAUNCHES 1
#endif

#define IN(k) (lo <= (k) && (k) < hi)
#if defined(PROBE_TS)
#define SEAM(k) do { if (IN(k) && IN((k) + 1)) { for (int rb_ = 0; rb_ < REP_BAR; ++rb_) xcd_barrier(bar); } \
    { const unsigned long long now_ = __builtin_amdgcn_s_memrealtime(); if (((PROBE_TS >> (k)) & 1) && PROBE_SEGSEL(9)) prof_val += (float)(now_ - prof_t) * 0.01f; prof_t = now_; } } while (0)
#else
#define SEAM(k) do { if (IN(k) && IN((k) + 1)) { for (int rb_ = 0; rb_ < REP_BAR; ++rb_) xcd_barrier(bar); } } while (0)
#endif
__device__ __forceinline__ unsigned char* launder_ptr(unsigned char* p) { asm volatile("" : "+s"(p)); return p; }
__device__ __forceinline__ void refresh(Frame& F) { int t = threadIdx.x; asm volatile("" : "+v"(t)); F.tid = t; F.lane = t & 63; F.wave = __builtin_amdgcn_readfirstlane(t >> 6); }
#ifndef REP_PRO
#define REP_PRO 1
#endif
#ifndef REP_INPROJ
#define REP_INPROJ 1
#endif
#ifndef REP_OUT0
#define REP_OUT0 1
#endif
#ifndef REP_X1
#define REP_X1 1
#endif
#ifndef REP_INPROJ_PLAINMODE
#define REP_INPROJ_PLAINMODE 1
#endif
#ifndef STAG_US
#define STAG_US 8
#endif
#ifndef PG_ALIGN_IN
#define PG_ALIGN_IN true
#endif
#ifndef PG_ALIGN_OUT
#define PG_ALIGN_OUT true
#endif
#ifndef PG_SP2
#define PG_SP2 true
#endif
#ifndef REP_X1_PAR
#define REP_X1_PAR 2
#endif
#ifndef REP_X2
#define REP_X2 1
#endif
#ifndef REP_X3
#define REP_X3 1
#endif
#ifndef REP_FOX
#define REP_FOX 1
#endif
#ifndef REP_DIL0
#define REP_DIL0 1
#endif
#ifndef REP_BAR
#define REP_BAR 1
#endif
template <int L> __device__ __forceinline__ LinArgs make_lin_args(unsigned char* ws, const Args& args) {
    constexpr int j = L >> 1; constexpr bool odd = (L & 1) != 0;
    LinArgs A;
    A.Z = (bf16*)(ws + WS_Z); A.GLR = (const float*)(ws + WS_GLR); A.w_lr = args.in[4] + (size_t)j * 16 * 256; A.b_lr = args.in[5] + j * 256;
    A.g1 = odd ? args.in[10] + j * 512 : args.in[6] + j * 512; A.g2 = odd ? args.in[11] + j * 512 : nullptr;
    A.TRUN = (float*)(ws + WS_KV); A.SRUN = (float*)(ws + WS_PREV); A.DRUN = (float*)(ws + WS_DECAY + 768 * 1024); A.DEC = (float*)(ws + WS_DECAY); A.Y = (bf16*)(ws + WS_Y);
    return A;
}
#if defined(PROBE_SEG)
#define PROBE_SEGSEL(s) ((s) == PROBE_SEG)
#else
#define PROBE_SEGSEL(s) true
#endif
#if defined(PROBE_TS) && defined(PROBE_SEG)
#define SUBT(k, seg) do { const unsigned long long n2_ = __builtin_amdgcn_s_memrealtime(); if (((PROBE_TS >> (k)) & 1) && (seg) == PROBE_SEG) prof_val += (float)(n2_ - prof_t) * 0.01f; prof_t = n2_; } while (0)
#else
#define SUBT(k, seg) do {} while (0)
#endif
#if defined(PROBE_TS)
#define PROF_PARAMS , unsigned long long& prof_t, float& prof_val
#define PROF_ARGS , prof_t, prof_val
#else
#define PROF_PARAMS
#define PROF_ARGS
#endif
template <int L> __device__ __forceinline__ void run_layer(Frame& F, const Args& args, const XcdBarrier& bar, const int lo, const int hi, unsigned char* lds PROF_PARAMS) {
    constexpr int pb = 1 + PH_PER_LAYER * L; constexpr int j = L >> 1; constexpr bool odd = (L & 1) != 0;
    if (IN(pb)) {
        unsigned char* ws = launder_ptr(args.ws); refresh(F);
        bf16* Z = (bf16*)(ws + WS_Z); bf16* HB = (bf16*)(ws + WS_HB); float* SS = (float*)(ws + WS_SS);
        pg8::Gemm g{HB, w_in_ptr(ws, L), M, NZ, DMODEL}; pg8::StaticOrder S; S.init(M, NZ, F.G, (int)blockIdx.x);
        LAS float* rtab = (LAS float*)(F.lds + LDSCTL_OFF + 1024); LAS int* rtag = (LAS int*)(F.lds + LDSCTL_OFF + 1024 + 2048);
        pg8::epi_in_fill(S, SS, rtab, rtag);
        pg8::EpiIn E{Z, NZ, SS, (const float*)(ws + WS_ROPE), odd ? 1 : 0, 0.125f, C2, 0, rtab, rtag};
#if defined(REP_INPROJ_PLAIN)
        { pg8::EpiIn Ep = E; Ep.plain = REP_INPROJ_PLAINMODE; for (int rp_ = 0; rp_ < REP_INPROJ_PLAIN; ++rp_) pg8::gemm_phase<pg8::EpiIn, pg8::StaticOrder, PG_ALIGN_IN, PG_SP2>(F.lds + RING_OFF, g, S, Ep); }
#endif
        pg8::gemm_phase<pg8::EpiIn, pg8::StaticOrder, PG_ALIGN_IN, PG_SP2>(F.lds + RING_OFF, g, S, E);
        if (!odd) skinny_phase(F, HB, (const bf16*)(ws + WS_WSK) + (size_t)j * 32 * DMODEL, SS, args.in[3] + j * 8, (float*)(ws + WS_FF), (float*)(ws + WS_GLR));
    }
    SUBT(pb, 1);
    SEAM(pb);
    if (IN(pb + 1)) {
        unsigned char* ws = launder_ptr(args.ws); refresh(F);
        bf16* Z = (bf16*)(ws + WS_Z); bf16* Y = (bf16*)(ws + WS_Y);
        { const LinArgs A = make_lin_args<L>(ws, args); lin_prep_phase<odd>(F, A); }
        SUBT(pb + 1, 0);
        if (!odd) { for (int u = F.vcu; u < 64; u += F.G) cumsum_unit(F, u, (const float*)(ws + WS_FF), (float*)(ws + WS_CB));
                    for (int u = F.vcu; u < 256; u += F.G) fox_norm_unit(F, u, Z, (float*)(ws + WS_KN), (float*)(ws + WS_QN)); }
        else {
            dil_phase<0>(F, Z, Y, (bf16*)args.out + OD_OFF, (float*)(ws + WS_LSE));
        }
        SUBT(pb + 1, 1);
    }
    SEAM(pb + 1);
    if (IN(pb + 2)) {
        unsigned char* ws = launder_ptr(args.ws); refresh(F);
        { const LinArgs A = make_lin_args<L>(ws, args); for (int rp_ = 0; rp_ < REP_X2; ++rp_) lin_scan_phase(F, A); }
        SUBT(pb + 2, 0);
        if (!odd) {
            bf16* Z = (bf16*)(ws + WS_Z);
            const attn_body::AttnTensors AT{(const attn_body::bf16*)(Z + ZR_AQ), (const attn_body::bf16*)(Z + ZR_AK), (const attn_body::bf16*)(Z + ZR_AV), (const attn_body::bf16*)(Z + ZR_GATE), (const float*)(ws + WS_CB), (const float*)(ws + WS_KN), (const float*)(ws + WS_QN), (attn_body::bf16*)(ws + WS_Y)};
            const attn_body::QueueOrder S((unsigned*)(F.ctl + CW_QUEUE) + j * 512, (int)F.G, (int)blockIdx.x, 2);
            attn_body::attn_phase<>((char*)lds + RING_OFF, AT, S, F.MISC + 12);
        } else {
            dil_phase<1>(F, (const bf16*)(ws + WS_Z), (bf16*)(ws + WS_Y), (bf16*)args.out + OD_OFF, (float*)(ws + WS_LSE));
        }
    }
    SUBT(pb + 2, 1);
    SEAM(pb + 2);
    if (IN(pb + 3)) {
        unsigned char* ws = launder_ptr(args.ws); refresh(F);
        { const LinArgs A = make_lin_args<L>(ws, args); for (int rp_ = 0; rp_ < REP_X3; ++rp_) lin_out_phase<odd>(F, A); }
        SUBT(pb + 3, 0);
        if (!odd) {
            bf16* Z = (bf16*)(ws + WS_Z);
            const attn_body::AttnTensors AT{(const attn_body::bf16*)(Z + ZR_AQ), (const attn_body::bf16*)(Z + ZR_AK), (const attn_body::bf16*)(Z + ZR_AV), (const attn_body::bf16*)(Z + ZR_GATE), (const float*)(ws + WS_CB), (const float*)(ws + WS_KN), (const float*)(ws + WS_QN), (attn_body::bf16*)(ws + WS_Y)};
            const attn_body::QueueOrder S((unsigned*)(F.ctl + CW_QUEUE) + j * 512, (int)F.G, (int)blockIdx.x, 1 << 20);
            __syncthreads();
            attn_body::attn_phase<>((char*)lds + RING_OFF, AT, S, F.MISC + 12);
        } else {
        }
    }
    SUBT(pb + 3, 1);
    SEAM(pb + 3);
    if (IN(pb + 4)) {
        unsigned char* ws = launder_ptr(args.ws); refresh(F);
        pg8::Gemm g{(bf16*)(ws + WS_Y), w_out_ptr(ws, L), M, DMODEL, DMODEL}; pg8::StaticOrder S; S.init(M, DMODEL, F.G, (int)blockIdx.x);
        pg8::EpiOut E{(bf16*)(ws + WS_HB), (float*)(ws + WS_SS), (bf16*)(ws + WS_HB)};
#if defined(REP_OUT_DRY)
        { pg8::EpiOut Ed = E; Ed.hbo = (bf16*)(ws + WS_KV); for (int rp_ = 0; rp_ < REP_OUT_DRY; ++rp_) pg8::gemm_phase<pg8::EpiOut, pg8::StaticOrder, PG_ALIGN_OUT, PG_SP2>(F.lds + RING_OFF, g, S, Ed); }
#endif
        pg8::gemm_phase<pg8::EpiOut, pg8::StaticOrder, PG_ALIGN_OUT, PG_SP2>(F.lds + RING_OFF, g, S, E);
    }
    SUBT(pb + 4, 1);
    SEAM(pb + 4);
}
#undef IN
#undef SEAM

__global__ void __launch_bounds__(NWAVES * 64, 2) trunk_fwd(Args args) {
    extern __shared__ __attribute__((aligned(16))) unsigned char lds[];
    Frame F;
    F.lds = (LAS unsigned char*)lds;
    F.MISC = (volatile LAS unsigned*)(F.lds + MISC_OFF);
    F.tid = threadIdx.x; F.lane = F.tid & 63; F.wave = __builtin_amdgcn_readfirstlane(F.tid >> 6);
    F.G = gridDim.x; { const int bx = blockIdx.x; F.vcu = (F.G % 8 == 0) ? (bx % 8) * (F.G / 8) + bx / 8 : bx; }
    F.ws = args.ws; F.ctl = (gu32*)(args.ws + WS_CTL);
    for (int u = F.tid; u < (LDS_BYTES - LDSCTL_OFF) / 4; u += NWAVES * 64) ((LAS unsigned*)(F.lds + LDSCTL_OFF))[u] = 0u;
    __syncthreads();
    XcdBarrier bar = xcd_barrier_post((unsigned*)(F.ctl + CW_BAR) + args.li * XCD_BAR_WORDS, F.MISC + 8);
    const int lo = args.ph_lo, hi = args.ph_hi;
#define IN(k) (lo <= (k) && (k) < hi)
#if defined(PROBE_TS)
#define SEAM(k) do { if (IN(k) && IN((k) + 1)) { for (int rb_ = 0; rb_ < REP_BAR; ++rb_) xcd_barrier(bar); } \
    { const unsigned long long now_ = __builtin_amdgcn_s_memrealtime(); if (((PROBE_TS >> (k)) & 1) && PROBE_SEGSEL(9)) prof_val += (float)(now_ - prof_t) * 0.01f; prof_t = now_; } } while (0)
    unsigned long long prof_t = __builtin_amdgcn_s_memrealtime(); float prof_val = 0.f;
#else
#define SEAM(k) do { if (IN(k) && IN((k) + 1)) { for (int rb_ = 0; rb_ < REP_BAR; ++rb_) xcd_barrier(bar); } } while (0)
#endif

#if defined(REP_ALL)
    for (int ra_ = 0; ra_ < REP_ALL; ++ra_) {
#endif
    if (IN(0)) { for (int rp_ = 0; rp_ < REP_PRO; ++rp_) p0_prologue(F, args); }
    SEAM(0);

    run_layer<0>(F, args, bar, lo, hi, lds PROF_ARGS); run_layer<1>(F, args, bar, lo, hi, lds PROF_ARGS); run_layer<2>(F, args, bar, lo, hi, lds PROF_ARGS); run_layer<3>(F, args, bar, lo, hi, lds PROF_ARGS);
#if defined(REP_ALL)
    }
#endif
    if (IN(N_PHASES - 1)) { refresh(F); unsigned char* ws = launder_ptr(args.ws); final_norm_phase(F, (const bf16*)(ws + WS_HB), (const float*)(ws + WS_SS), args.out, args.in[13]);
#if defined(PROBE_TS)
        if (blockIdx.x == 0) { const unsigned long long t0_ = __builtin_amdgcn_s_memrealtime(); const unsigned long long wait_ = (unsigned long long)(prof_val * 100.0f * 4.0f);
            while (__builtin_amdgcn_s_memrealtime() - t0_ < wait_) __builtin_amdgcn_s_sleep(8); }
#endif
    }
#undef IN
#undef SEAM
}

extern "C" void kernel_launch(void* const* d_in, const int* in_sizes, int n_in, void* d_out, int out_size, void* d_ws, size_t ws_size, hipStream_t stream) {
    static int grid = 0;
    if (grid == 0) {
        if (n_in != 14 || in_sizes[0] != M * DMODEL || out_size != M * DMODEL || ws_size < WS_END) { fprintf(stderr, "kernel_launch: unexpected shapes: n_in %d in0 %d out %d ws %zu (need %zu)\n", n_in, n_in > 0 ? in_sizes[0] : -1, out_size, ws_size, (size_t)WS_END); grid = -1; return; }
        int dev = 0, cus = 0, per_cu = 0;
        if (hipGetDevice(&dev) != hipSuccess || hipDeviceGetAttribute(&cus, hipDeviceAttributeMultiprocessorCount, dev) != hipSuccess) { fprintf(stderr, "kernel_launch: device query failed\n"); grid = -1; return; }
        if (hipFuncSetAttribute((const void*)trunk_fwd, hipFuncAttributeMaxDynamicSharedMemorySize, LDS_BYTES) != hipSuccess) { fprintf(stderr, "kernel_launch: hipFuncSetAttribute failed\n"); grid = -1; return; }
        if (hipOccupancyMaxActiveBlocksPerMultiprocessor(&per_cu, (const void*)trunk_fwd, NWAVES * 64, LDS_BYTES) != hipSuccess || per_cu < 1) fprintf(stderr, "kernel_launch: note: occupancy query reports %d blocks per CU\n", per_cu);
        (void)hipGetLastError();
        grid = cus;
    }
    if (grid < 0) return;
    if (hipMemsetAsync((char*)d_ws + WS_CTL, 0, CTL_ZERO_BYTES, stream) != hipSuccess) { fprintf(stderr, "kernel_launch: memset failed\n"); return; }
    Args a{};
    for (int i = 0; i < 14; ++i) a.in[i] = (const float*)d_in[i];
    a.out = (float*)d_out; a.ws = (unsigned char*)d_ws;
#if defined(REP_LAUNCH)
    constexpr int NL = REP_LAUNCH;
    for (int li = 0; li < NL; ++li) {
        a.ph_lo = 0; a.ph_hi = N_PHASES; a.li = li;
#else
    constexpr int NL = MK_N_LAUNCHES;
    for (int li = 0; li < NL; ++li) {
        a.ph_lo = (NL == 1) ? 0 : li; a.ph_hi = (NL == 1) ? N_PHASES : li + 1; a.li = li;
#endif
        hipLaunchKernelGGL(trunk_fwd, dim3(grid), dim3(NWAVES * 64), LDS_BYTES, stream, a);
        const hipError_t le = hipPeekAtLastError();
        if (le != hipSuccess) { fprintf(stderr, "kernel_launch: launch %d failed: %s\n", li, hipGetErrorName(le)); break; }
    }
}
```

```cpp
#include <hip/hip_runtime.h>
#include <hip/hip_bf16.h>
#include <cstdio>
#include <cstdint>
#include <cmath>

namespace pg8 {
#define PG8_LAS __attribute__((address_space(3)))
typedef unsigned short bf16_t;
typedef short bf16x8 __attribute__((ext_vector_type(8)));
typedef float f32x4 __attribute__((ext_vector_type(4)));
typedef unsigned u32x4 __attribute__((ext_vector_type(4)));
#ifndef PG_WGM
#define PG_WGM 8
#endif
constexpr int BM = 256, BK = 64, HALF = 128, HTB = HALF * BK * 2  , STAGE_BYTES = 8 * HTB, NXCD = 8, WGM = PG_WGM;

__host__ __device__ __forceinline__ int lds_byte(int r, int c) { const int st = (r >> 4) * 2 + (c >> 5), rr = r & 15, cc = c & 31, ob = rr * 64 + cc * 2; return st * 1024 + (ob ^ (((ob >> 9) & 1) << 5)); }
__host__ __device__ __forceinline__ void stage_rc(int b, int& R, int& C) { const int st = b / 1024, sb = b % 1024, swz = sb ^ (((sb >> 9) & 1) << 5); R = (st >> 1) * 16 + swz / 64; C = (st & 1) * 32 + (swz % 64) / 2; }
__host__ __device__ __forceinline__ int perm32(int rho) { const int n = rho >> 4, i = rho & 15; return 8 * (i >> 2) + 4 * n + (i & 3); }

struct Unit { int pm, pn; };
struct Gemm { const bf16_t* A; const bf16_t* Bt; int M, N, K; };

struct StaticOrder {
    int nM, nN, nwg, G, c;
    unsigned* lag = nullptr;
    __host__ __device__ void init(int M, int N, int G_, int c_) { nM = M / BM; nN = N / BM; nwg = nM * nN; G = G_; c = c_; }
    __host__ __device__ bool next(int i, Unit& u) const {
        const long L = (long)i * G + c; if (L >= nwg) return false;
        int wgid = (int)L; { const int q = nwg / NXCD, r = nwg % NXCD, xcd = wgid % NXCD, off = wgid / NXCD; wgid = (xcd < r ? xcd * (q + 1) : r * (q + 1) + (xcd - r) * q) + off; }
        const int nig = WGM * nN, gid = wgid / nig, fm = gid * WGM, gsz = (nM - fm) < WGM ? (nM - fm) : WGM;
        u.pm = fm + ((wgid % nig) % gsz); u.pn = (wgid % nig) / gsz; return true;
    }
    __device__ __forceinline__ void a_ready(const Unit&) const {}
    __device__ __forceinline__ void done(const Unit&) const {}
    __device__ __forceinline__ void lag_arrive() const {
        if (lag != nullptr) { asm volatile("s_waitcnt vmcnt(0)" ::: "memory");
            if ((threadIdx.x & 63) == 0) (void)__hip_atomic_fetch_add(lag, 1u, __ATOMIC_RELAXED, __HIP_MEMORY_SCOPE_AGENT); }
    }
};

__device__ __forceinline__ unsigned cvt_pk_bf16(float lo, float hi) { unsigned r; asm volatile("v_cvt_pk_bf16_f32 %0, %1, %2" : "=v"(r) : "v"(lo), "v"(hi)); return r; }

struct EpiIn {
    static constexpr bool PERM = true, AFTER_DRAIN = false;
    bf16_t* Z; int ldz; const float* ss; const float* rope; int odd; float qscale, ascale;
    int plain;
    const PG8_LAS float* rtab; const PG8_LAS int* rtag;
    __device__ __forceinline__ void operator()(const f32x4 (&acc)[2][2][4][2], const Unit& u, int wr, int wc, int fr, int fq) const {
        const int row0 = u.pm * BM + wr * 64 + fr; const int pn = u.pn;
        const float cs = (pn == 0) ? qscale : ((pn == 4 || pn == 5) ? ascale : 1.0f);
        const bool do_rope = !plain && odd && (pn <= 1 || (pn >= 4 && pn <= 7));
        const bool do_silu = !plain && pn >= 10;
        const int rbase_col = (pn < 2) ? pn * 256 : (pn < 4) ? 512 : (pn < 10) ? 1024 + ((pn - 4) >> 1) * 512 : 2560;
        const int hw_log = (pn >= 10) ? 10 : (pn == 2 || pn == 3) ? 7 : 6; const int nh_log = (pn >= 10) ? 0 : (pn < 4) ? 2 : 3;
        const int col0 = pn * BM + wc * 32 + 8 * fq - rbase_col;
        const size_t zbase = (size_t)rbase_col * 32768;
        const int slot = (u.pm >> 3) & 1; const bool have_tab = rtag[slot] == u.pm;
#pragma unroll
        for (int ai = 0; ai < 2; ++ai)
#pragma unroll
            for (int m = 0; m < 4; ++m) {
                const int row = row0 + ai * HALF + m * 16;
                float sc;
                if (plain) sc = 1.0f;
                else if (have_tab) sc = cs * rtab[slot * 256 + (row & 255)];
                else {
                    const f32x4* sp = (const f32x4*)(ss + (size_t)row * 16);
                    const f32x4 s0 = sp[0], s1 = sp[1], s2 = sp[2], s3 = sp[3];
                    const float tot = ((s0[0] + s0[1]) + (s0[2] + s0[3])) + ((s1[0] + s1[1]) + (s1[2] + s1[3])) + ((s2[0] + s2[1]) + (s2[2] + s2[3])) + ((s3[0] + s3[1]) + (s3[2] + s3[3]));
                    sc = cs / sqrtf(tot * (1.0f / 1024.0f) + 1e-6f);
                }
                const int bidx = row >> 12, tt = row & 4095;
#pragma unroll
                for (int bj = 0; bj < 2; ++bj) {
                    f32x4 v0 = acc[ai][bj][m][0] * sc, v1 = acc[ai][bj][m][1] * sc;
                    if (do_rope) {
                        const int t = row & 4095; const int j0 = ((bj * HALF + wc * 32 + 8 * fq) & 63) >> 1;
                        const f32x4* rp = (const f32x4*)(rope + ((size_t)t * 32 + j0) * 2);
                        const f32x4 c01 = rp[0], c23 = rp[1];
                        f32x4 w0, w1;
                        w0[0] = v0[0] * c01[0] - v0[1] * c01[1]; w0[1] = v0[1] * c01[0] + v0[0] * c01[1];
                        w0[2] = v0[2] * c01[2] - v0[3] * c01[3]; w0[3] = v0[3] * c01[2] + v0[2] * c01[3];
                        w1[0] = v1[0] * c23[0] - v1[1] * c23[1]; w1[1] = v1[1] * c23[0] + v1[0] * c23[1];
                        w1[2] = v1[2] * c23[2] - v1[3] * c23[3]; w1[3] = v1[3] * c23[2] + v1[2] * c23[3];
                        v0 = w0; v1 = w1;
                    }
                    if (do_silu) {
#pragma unroll
                        for (int e = 0; e < 4; ++e) { v0[e] = v0[e] * __builtin_amdgcn_rcpf(1.0f + __builtin_amdgcn_exp2f(-1.4426950408889634f * v0[e])); v1[e] = v1[e] * __builtin_amdgcn_rcpf(1.0f + __builtin_amdgcn_exp2f(-1.4426950408889634f * v1[e])); }
                    }
                    u32x4 w; w.x = cvt_pk_bf16(v0[0], v0[1]); w.y = cvt_pk_bf16(v0[2], v0[3]); w.z = cvt_pk_bf16(v1[0], v1[1]); w.w = cvt_pk_bf16(v1[2], v1[3]);
                    const int c = col0 + bj * HALF;
                    size_t zo = zbase + ((((((size_t)((bidx << nh_log) + (c >> hw_log))) << 12) + (size_t)tt)) << hw_log) + (c & ((1 << hw_log) - 1));
                    if (plain == 5) { const int l16 = fr + 16 * fq; const int rowA = row - fr, cA = c - 8 * fq;
                        zo = zbase + ((((((size_t)(((rowA >> 12) << nh_log) + (cA >> hw_log))) << 12) + (size_t)(rowA & 4095))) << hw_log) + (cA & ((1 << hw_log) - 1)) + (size_t)l16 * 8; }
                    if (plain == 6) { const int l16 = fr + 16 * fq; const int rowA = row - fr + 8 * bj + (l16 >> 3), cA = pn * BM + wc * 64 - rbase_col + 8 * (l16 & 7);
                        zo = zbase + ((((((size_t)(((rowA >> 12) << nh_log) + (cA >> hw_log))) << 12) + (size_t)(rowA & 4095))) << hw_log) + (cA & ((1 << hw_log) - 1)); }
                    if (plain == 7) { const int l16 = fr + 16 * fq; const int rowA = row - fr + (l16 >> 2), cA = c - 8 * fq + 8 * (l16 & 3);
                        zo = zbase + ((((((size_t)(((rowA >> 12) << nh_log) + (cA >> hw_log))) << 12) + (size_t)(rowA & 4095))) << hw_log) + (cA & ((1 << hw_log) - 1)); }
                    if (plain == 4) zo = (zo & 0xFFFFu) + (size_t)blockIdx.x * 65536u;
                    if (plain < 2 || plain >= 4 || (plain == 3 && m == 0) || (w.x == 0x7fc12345u && w.y == 0x7fc12345u))
                        *(u32x4*)(Z + zo) = w;
                }
            }
    }
};

template <class Sched> __device__ __forceinline__ void epi_in_fill(const Sched& S, const float* ss, PG8_LAS float* rtab, PG8_LAS int* rtag) {
    if (threadIdx.x < 2) rtag[threadIdx.x] = -1;
    __syncthreads();
    Unit u;
    for (int i = 0; S.next(i, u); ++i) {
        const int slot = (u.pm >> 3) & 1;
        if (rtag[slot] == -1) {
            __syncthreads();
            if (threadIdx.x < 256) {
                const int row = u.pm * BM + threadIdx.x; const f32x4* sp = (const f32x4*)(ss + (size_t)row * 16);
                const f32x4 s0 = sp[0], s1 = sp[1], s2 = sp[2], s3 = sp[3];
                const float tot = ((s0[0] + s0[1]) + (s0[2] + s0[3])) + ((s1[0] + s1[1]) + (s1[2] + s1[3])) + ((s2[0] + s2[1]) + (s2[2] + s2[3])) + ((s3[0] + s3[1]) + (s3[2] + s3[3]));
                rtab[slot * 256 + threadIdx.x] = 1.0f / sqrtf(tot * (1.0f / 1024.0f) + 1e-6f);
                if (threadIdx.x == 0) rtag[slot] = u.pm;
            }
            __syncthreads();
        }
    }
    __syncthreads();
}

struct EpiOut {
    static constexpr bool PERM = true, AFTER_DRAIN = false;
    bf16_t* hb; float* ss; bf16_t* hbo;
    __device__ __forceinline__ void operator()(const f32x4 (&acc)[2][2][4][2], const Unit& u, int wr, int wc, int fr, int fq) const {
        const int row0 = u.pm * BM + wr * 64 + fr; const int col0 = u.pn * BM + wc * 32 + 8 * fq;
#pragma unroll
        for (int ai = 0; ai < 2; ++ai)
#pragma unroll
            for (int m = 0; m < 4; ++m) {
                const int row = row0 + ai * HALF + m * 16; const size_t off = (size_t)row * 1024 + col0; float q = 0.f;
#pragma unroll
                for (int bj = 0; bj < 2; ++bj) {
                    const u32x4 old = *(const u32x4*)(hb + off + bj * HALF);
                    f32x4 v0 = acc[ai][bj][m][0], v1 = acc[ai][bj][m][1];
                    v0[0] += __uint_as_float(old.x << 16); v0[1] += __uint_as_float(old.x & 0xffff0000u); v0[2] += __uint_as_float(old.y << 16); v0[3] += __uint_as_float(old.y & 0xffff0000u);
                    v1[0] += __uint_as_float(old.z << 16); v1[1] += __uint_as_float(old.z & 0xffff0000u); v1[2] += __uint_as_float(old.w << 16); v1[3] += __uint_as_float(old.w & 0xffff0000u);
                    q += (v0[0] * v0[0] + v0[1] * v0[1]) + (v0[2] * v0[2] + v0[3] * v0[3]) + (v1[0] * v1[0] + v1[1] * v1[1]) + (v1[2] * v1[2] + v1[3] * v1[3]);
                    u32x4 w; w.x = cvt_pk_bf16(v0[0], v0[1]); w.y = cvt_pk_bf16(v0[2], v0[3]); w.z = cvt_pk_bf16(v1[0], v1[1]); w.w = cvt_pk_bf16(v1[2], v1[3]);
                    *(u32x4*)(hbo + off + bj * HALF) = w;
                }
                q += __shfl_xor(q, 16); q += __shfl_xor(q, 32);
                if (fq == 0) ss[(size_t)row * 16 + u.pn * 4 + wc] = q;
            }
    }
};

template <class Epi, class Sched, bool ALIGN_EPI = false, bool SP2 = false>
__device__ __forceinline__ void gemm_phase(PG8_LAS unsigned char* lds, const Gemm g, const Sched& S, const Epi& E) {
    int tid_ = threadIdx.x; asm volatile("" : "+v"(tid_));
    const int tid = tid_, wid = __builtin_amdgcn_readfirstlane(tid >> 6), lane = tid & 63, wr = wid >> 2, wc = wid & 3, fr = lane & 15, fq = lane >> 4;
    const int K = g.K, nt = K / BK;
    unsigned voffA[2], voffB[2];
#pragma unroll
    for (int i = 0; i < 2; ++i) { int R, C; stage_rc(tid * 16 + i * 8192, R, C); const int Rb = Epi::PERM ? ((R & ~31) + perm32(R & 31)) : R;
        voffA[i] = (unsigned)(R * K + C) * 2u; voffB[i] = (unsigned)(Rb * K + C) * 2u; }
    const size_t kstep = (size_t)(BK * 2);
    const size_t hstep = (size_t)HALF * K * 2;
    const size_t tstep = 2 * hstep;
    const unsigned ldsw = (unsigned)wid * 1024u;
    const int aoff = lds_byte(wr * 64 + fr, fq * 8), boff = lds_byte(wc * 32 + fr, fq * 8);
#define PG8_SA(b, h) (((b) * 2 + (h)) * HTB)
#define PG8_SB(b, h) ((4 + (b) * 2 + (h)) * HTB)
#define PG8_STAGE(bufoff, gbase, voff) do { _Pragma("unroll") for (int _i = 0; _i < 2; ++_i) \
        __builtin_amdgcn_global_load_lds((const unsigned*)((const char*)(gbase) + (voff)[_i]), (PG8_LAS unsigned*)(lds + (bufoff) + ldsw + _i * 8192), 16, 0, 0); } while (0)
#define PG8_LDA(dst, b, h) do { _Pragma("unroll") for (int m = 0; m < 4; ++m) _Pragma("unroll") for (int k = 0; k < 2; ++k) dst[m][k] = *(const PG8_LAS bf16x8*)(lds + PG8_SA(b, h) + aoff + m * 2048 + k * 1024); } while (0)
#define PG8_LDB(dst, b, h) do { _Pragma("unroll") for (int n = 0; n < 2; ++n) _Pragma("unroll") for (int k = 0; k < 2; ++k) dst[n][k] = *(const PG8_LAS bf16x8*)(lds + PG8_SB(b, h) + boff + n * 2048 + k * 1024); } while (0)
#define PG8_MMA(ai, bj, At, Bt) do { __builtin_amdgcn_s_setprio(1); _Pragma("unroll") for (int m = 0; m < 4; ++m) _Pragma("unroll") for (int n = 0; n < 2; ++n) _Pragma("unroll") for (int k = 0; k < 2; ++k) \
        acc[ai][bj][m][n] = __builtin_amdgcn_mfma_f32_16x16x32_bf16(Bt[n][k], At[m][k], acc[ai][bj][m][n], 0, 0, 0); __builtin_amdgcn_s_setprio(0); } while (0)
#define PG8_WAIT_V(n) asm volatile("s_waitcnt vmcnt(" #n ")" ::: "memory")
#define PG8_WAIT_L(n) asm volatile("s_waitcnt lgkmcnt(" #n ")" ::: "memory")
#define PG8_BAR __builtin_amdgcn_s_barrier()
#define PG8_SCHED __builtin_amdgcn_sched_barrier(0)
    Unit cur, nxt; int ui = 0;
    if (!S.next(0, cur)) return;
    f32x4 acc[2][2][4][2];
#pragma unroll
    for (int a = 0; a < 2; ++a)
#pragma unroll
        for (int b = 0; b < 2; ++b)
#pragma unroll
            for (int m = 0; m < 4; ++m)
#pragma unroll
                for (int n = 0; n < 2; ++n) acc[a][b][m][n] = (f32x4){0.f, 0.f, 0.f, 0.f};
    bf16x8 At[4][2], B0[2][2], B1[2][2];
    const char* cA = (const char*)g.A + (size_t)cur.pm * tstep; const char* cB = (const char*)g.Bt + (size_t)cur.pn * tstep;
    S.a_ready(cur);
    if constexpr (SP2) {
        PG8_STAGE(PG8_SB(0, 0), cB, voffB); PG8_STAGE(PG8_SB(0, 1), cB + hstep, voffB); PG8_STAGE(PG8_SA(0, 0), cA, voffA); PG8_STAGE(PG8_SA(0, 1), cA + hstep, voffA);
        if (wr == 1) PG8_BAR;
        PG8_WAIT_V(2); PG8_BAR;
        PG8_STAGE(PG8_SB(1, 0), cB + kstep, voffB); PG8_STAGE(PG8_SA(1, 0), cA + kstep, voffA); PG8_STAGE(PG8_SB(1, 1), cB + hstep + kstep, voffB);
        PG8_WAIT_V(6); PG8_BAR;
    } else {
        PG8_STAGE(PG8_SB(0, 0), cB, voffB); PG8_STAGE(PG8_SA(0, 0), cA, voffA); PG8_STAGE(PG8_SB(0, 1), cB + hstep, voffB); PG8_STAGE(PG8_SA(0, 1), cA + hstep, voffA);
        if (wr == 1) PG8_BAR;
        PG8_WAIT_V(4); PG8_BAR;
        PG8_STAGE(PG8_SB(1, 0), cB + kstep, voffB); PG8_STAGE(PG8_SA(1, 0), cA + kstep, voffA); PG8_STAGE(PG8_SB(1, 1), cB + hstep + kstep, voffB);
        PG8_WAIT_V(6); PG8_BAR;
    }
    for (;;) {
        const bool has_next = S.next(ui + 1, nxt);
        const char* nA = has_next ? (const char*)g.A + (size_t)nxt.pm * tstep : cA; const char* nB = has_next ? (const char*)g.Bt + (size_t)nxt.pn * tstep : cB;
        for (int t = 0; t < nt; t += 2) {
            const bool last = (t == nt - 2);
            const char* a1 = cA + (size_t)(t + 1) * kstep;
            const char* a2 = last ? nA : cA + (size_t)(t + 2) * kstep; const char* b2 = last ? nB : cB + (size_t)(t + 2) * kstep;
            const char* a3 = a2 + kstep; const char* b3 = b2 + kstep;
            if (last && has_next) S.a_ready(nxt);
            if constexpr (SP2) {
            PG8_LDB(B0, 0, 0); PG8_LDB(B1, 0, 1); PG8_SCHED; PG8_LDA(At, 0, 0); PG8_STAGE(PG8_SA(1, 1), a1 + hstep, voffA);
            PG8_WAIT_V(8); PG8_WAIT_L(0); PG8_BAR; PG8_MMA(0, 0, At, B0); PG8_MMA(0, 1, At, B1); PG8_BAR; PG8_SCHED;
            PG8_LDA(At, 0, 1); PG8_STAGE(PG8_SB(0, 0), b2, voffB); PG8_STAGE(PG8_SB(0, 1), b2 + hstep, voffB); PG8_STAGE(PG8_SA(0, 0), a2, voffA);
            PG8_WAIT_V(8); PG8_WAIT_L(0); PG8_BAR; PG8_MMA(1, 0, At, B0); PG8_MMA(1, 1, At, B1); PG8_BAR; PG8_SCHED;
            PG8_LDB(B0, 1, 0); PG8_LDB(B1, 1, 1); PG8_SCHED; PG8_LDA(At, 1, 0); PG8_STAGE(PG8_SA(0, 1), a2 + hstep, voffA);
            PG8_WAIT_V(8); PG8_WAIT_L(0); PG8_BAR; PG8_MMA(0, 0, At, B0); PG8_MMA(0, 1, At, B1); PG8_BAR; PG8_SCHED;
            PG8_LDA(At, 1, 1); PG8_STAGE(PG8_SB(1, 0), b3, voffB); PG8_STAGE(PG8_SB(1, 1), b3 + hstep, voffB); PG8_STAGE(PG8_SA(1, 0), a3, voffA);
            PG8_WAIT_V(8); PG8_WAIT_L(0); PG8_BAR; PG8_MMA(1, 0, At, B0); PG8_MMA(1, 1, At, B1); PG8_BAR; PG8_SCHED;
            } else {
            PG8_LDB(B0, 0, 0); PG8_SCHED; PG8_LDA(At, 0, 0); PG8_STAGE(PG8_SA(1, 1), a1 + hstep, voffA);
            PG8_WAIT_L(8); PG8_BAR; PG8_WAIT_L(0); PG8_MMA(0, 0, At, B0); PG8_BAR; PG8_SCHED;
            PG8_LDB(B1, 0, 1); PG8_STAGE(PG8_SB(0, 0), b2, voffB);
            PG8_BAR; PG8_WAIT_L(0); PG8_MMA(0, 1, At, B1); PG8_BAR;
            PG8_LDA(At, 0, 1); PG8_STAGE(PG8_SA(0, 0), a2, voffA);
            PG8_BAR; PG8_WAIT_L(0); PG8_MMA(1, 0, At, B0); PG8_BAR; PG8_SCHED;
            PG8_STAGE(PG8_SB(0, 1), b2 + hstep, voffB);
            PG8_WAIT_V(6); PG8_BAR; PG8_MMA(1, 1, At, B1); PG8_BAR;
            PG8_LDB(B0, 1, 0); PG8_SCHED; PG8_LDA(At, 1, 0); PG8_STAGE(PG8_SA(0, 1), a2 + hstep, voffA);
            PG8_WAIT_L(8); PG8_BAR; PG8_WAIT_L(0); PG8_MMA(0, 0, At, B0); PG8_BAR; PG8_SCHED;
            PG8_LDB(B1, 1, 1); PG8_STAGE(PG8_SB(1, 0), b3, voffB);
            PG8_BAR; PG8_WAIT_L(0); PG8_MMA(0, 1, At, B1); PG8_BAR;
            PG8_LDA(At, 1, 1); PG8_STAGE(PG8_SA(1, 0), a3, voffA);
            PG8_BAR; PG8_WAIT_L(0); PG8_MMA(1, 0, At, B0); PG8_BAR; PG8_SCHED;
            PG8_STAGE(PG8_SB(1, 1), b3 + hstep, voffB);
            PG8_WAIT_V(6); PG8_BAR; PG8_MMA(1, 1, At, B1); PG8_BAR;
            }
        }
        if (!has_next) S.lag_arrive();
        if constexpr (ALIGN_EPI) { if (wr == 0) PG8_BAR; }
        if constexpr (!Epi::AFTER_DRAIN) { E(acc, cur, wr, wc, fr, fq); S.done(cur); }
        if (!has_next) break;
#pragma unroll
        for (int a = 0; a < 2; ++a)
#pragma unroll
            for (int b = 0; b < 2; ++b)
#pragma unroll
                for (int m = 0; m < 4; ++m)
#pragma unroll
                    for (int n = 0; n < 2; ++n) acc[a][b][m][n] = (f32x4){0.f, 0.f, 0.f, 0.f};
        cur = nxt; cA = nA; cB = nB; ++ui;
        if constexpr (ALIGN_EPI) { if (wr == 1) PG8_BAR; }
    }
    PG8_WAIT_V(0);
    if constexpr (!ALIGN_EPI) { if (wr == 0) PG8_BAR; }
    PG8_BAR;
#undef PG8_SA
#undef PG8_SB
#undef PG8_STAGE
#undef PG8_LDA
#undef PG8_LDB
#undef PG8_MMA
#undef PG8_WAIT_V
#undef PG8_WAIT_L
#undef PG8_BAR
#undef PG8_SCHED
}
}
namespace attn_body {
using bf16=__hip_bfloat16;
using bf16x8=__attribute__((ext_vector_type(8)))short;
using s16x4=__attribute__((ext_vector_type(4)))short;
using f32x16=__attribute__((ext_vector_type(16)))float;
using u32x4=__attribute__((ext_vector_type(4)))unsigned;
constexpr int BATCH=8,NHEAD=8,SEQ=4096,D=64,DM=64,OP=1024;
constexpr int NW=8,QBLK=32,QB=QBLK*NW,KVBLK=64,NQB=SEQ/QB;
constexpr int ATTN_PITCH=DM, ATTN_UNIT_ROWS=QB;
__device__ __forceinline__ int crow(int r,int hi){return (r&3)+8*(r>>2)+4*hi;}
#define SBAR() __builtin_amdgcn_sched_barrier(0)
__device__ __forceinline__ void cmask(f32x16&p0,f32x16&p1,int jb,int qrel,int hi){
  const float NEG=-INFINITY; int kb=64*jb+4*hi;
  #pragma unroll
  for(int r=0;r<16;++r){int kv=kb+(r&3)+8*(r>>2); if(kv>qrel)p0[r]=NEG; if(kv+32>qrel)p1[r]=NEG;}
}

constexpr int NSLOT=3, SLOTB=8192;
constexpr int LDS_K=0, LDS_V=NSLOT*SLOTB, LDS_WS=2*NSLOT*SLOTB, LDS_OST=LDS_WS+NW*64*4, LDS_BIAS=LDS_OST+NW*4096, LDS_BYTES=LDS_BIAS+SEQ*4;
constexpr float C2=0.125f*1.4426950408889634f;
__device__ __forceinline__ void glds16(const void*gsrc,unsigned lds_dst){unsigned keep;
  asm volatile("s_mov_b32 %0, m0\n\ts_mov_b32 m0, %2\n\ts_nop 0\n\tglobal_load_lds_dwordx4 %1, off\n\ts_mov_b32 m0, %0":"=&s"(keep):"v"(gsrc),"s"(lds_dst):"memory");}
__device__ __forceinline__ float max3f(float a,float b,float c){float r;asm("v_max3_f32 %0, %1, %2, %3":"=v"(r):"v"(a),"v"(b),"v"(c));return r;}
__device__ __forceinline__ float max2f(float a,float b){float r;asm("v_max_f32_e32 %0, %1, %2":"=v"(r):"v"(a),"v"(b));return r;}
__device__ __forceinline__ float fadd_s(float a,float b){float r;asm("v_add_f32_e32 %0, %1, %2":"=v"(r):"v"(a),"v"(b));return r;}
__device__ __forceinline__ float fsub_s(float a,float b){float r;asm("v_sub_f32_e32 %0, %1, %2":"=v"(r):"v"(a),"v"(b));return r;}
typedef float f32x4v __attribute__((ext_vector_type(4))); typedef float f32x2_t __attribute__((ext_vector_type(2))); typedef __bf16 bf16x2_t __attribute__((ext_vector_type(2)));
__device__ __forceinline__ unsigned cvtpk_s(float lo,float hi){f32x2_t v={lo,hi};bf16x2_t b=__builtin_convertvector(v,bf16x2_t);return __builtin_bit_cast(unsigned,b);}
#define WAIT_BAR(N) asm volatile("s_waitcnt vmcnt(" #N ") lgkmcnt(0)\n\ts_barrier":::"memory")

__device__ __forceinline__ void qkt(f32x16&p0,f32x16&p1,const char*Kslot,const bf16x8*qr,const f32x16&negm,int r32,int hi){
  const char*kb=Kslot+hi*1024+r32*16;
  #pragma unroll
  for(int d0=0;d0<4;++d0){
    const bf16x8 b0=*reinterpret_cast<const bf16x8*>(kb+d0*2048);
    const bf16x8 b1=*reinterpret_cast<const bf16x8*>(kb+d0*2048+512);
    if(d0==0){p0=__builtin_amdgcn_mfma_f32_32x32x16_bf16(b0,qr[0],negm,0,0,0);p1=__builtin_amdgcn_mfma_f32_32x32x16_bf16(b1,qr[0],negm,0,0,0);}
    else{p0=__builtin_amdgcn_mfma_f32_32x32x16_bf16(b0,qr[d0],p0,0,0,0);p1=__builtin_amdgcn_mfma_f32_32x32x16_bf16(b1,qr[d0],p1,0,0,0);}}
}
typedef __attribute__((address_space(3))) const char* lds_cptr;
typedef short v4i16_t __attribute__((ext_vector_type(4)));
__device__ __forceinline__ void kload8(bf16x8*kf,lds_cptr kp){
  kf[0]=*(const __attribute__((address_space(3))) bf16x8*)(kp);      kf[1]=*(const __attribute__((address_space(3))) bf16x8*)(kp+512);
  kf[2]=*(const __attribute__((address_space(3))) bf16x8*)(kp+2048); kf[3]=*(const __attribute__((address_space(3))) bf16x8*)(kp+2560);
  kf[4]=*(const __attribute__((address_space(3))) bf16x8*)(kp+4096); kf[5]=*(const __attribute__((address_space(3))) bf16x8*)(kp+4608);
  kf[6]=*(const __attribute__((address_space(3))) bf16x8*)(kp+6144); kf[7]=*(const __attribute__((address_space(3))) bf16x8*)(kp+6656);
}
__device__ __forceinline__ void kload2(bf16x8*kf,lds_cptr kp,int j){ kf[2*j]=*(const __attribute__((address_space(3))) bf16x8*)(kp+j*2048); kf[2*j+1]=*(const __attribute__((address_space(3))) bf16x8*)(kp+j*2048+512); }
__device__ __forceinline__ s16x4 vtr(lds_cptr p){ return __builtin_bit_cast(s16x4,__builtin_amdgcn_ds_read_tr16_b64_v4i16((__attribute__((address_space(3))) v4i16_t*)p)); }
__device__ __forceinline__ float rowmax(const f32x16&p0,const f32x16&p1){
  float a=max3f(p0[0],p0[1],p1[0]),b=max3f(p0[2],p0[3],p1[1]);a=max3f(a,p1[2],p1[3]);
  #pragma unroll
  for(int r=4;r<16;r+=4){a=max3f(a,p0[r],p0[r+1]);b=max3f(b,p0[r+2],p0[r+3]);a=max3f(a,p1[r],p1[r+1]);b=max3f(b,p1[r+2],p1[r+3]);}
  const float m=max2f(a,b);
  auto rr=__builtin_amdgcn_permlane32_swap(__float_as_uint(m),__float_as_uint(m),false,false);
  return max2f(__uint_as_float(rr[0]),__uint_as_float(rr[1]));
}
__device__ __forceinline__ void pv(f32x16*o,int vb,bf16x8 pa0,bf16x8 pa1,bf16x8 pa2,bf16x8 pa3){
  #pragma unroll
  for(int d0=0;d0<2;++d0){s16x4 lo[4],hi[4];
    #pragma unroll
    for(int ks=0;ks<4;++ks){
      asm volatile("ds_read_b64_tr_b16 %0,%1 offset:%c2":"=&v"(lo[ks]):"v"(vb),"i"(d0*4096+ks*1024):"memory");
      asm volatile("ds_read_b64_tr_b16 %0,%1 offset:%c2":"=&v"(hi[ks]):"v"(vb),"i"(d0*4096+ks*1024+512):"memory");}
    asm volatile("s_waitcnt lgkmcnt(0)":::"memory");SBAR();
    #define PK(k) (bf16x8){lo[k][0],lo[k][1],lo[k][2],lo[k][3],hi[k][0],hi[k][1],hi[k][2],hi[k][3]}
    o[d0]=__builtin_amdgcn_mfma_f32_32x32x16_bf16(pa0,PK(0),o[d0],0,0,0);
    o[d0]=__builtin_amdgcn_mfma_f32_32x32x16_bf16(pa1,PK(1),o[d0],0,0,0);
    o[d0]=__builtin_amdgcn_mfma_f32_32x32x16_bf16(pa2,PK(2),o[d0],0,0,0);
    o[d0]=__builtin_amdgcn_mfma_f32_32x32x16_bf16(pa3,PK(3),o[d0],0,0,0);
    #undef PK
  }
}

#ifndef ATTN_STORE16
#define ATTN_STORE16(p,v) (*(u32x4*)(p)=(v))
#endif
template<int THRL> __device__ __forceinline__ void attn_unit(int b,int h,int qb,const bf16*Q,const bf16*__restrict__ K,const bf16*__restrict__ V,const bf16*__restrict__ GT,const float*__restrict__ CB,const float*__restrict__ KN,const float*__restrict__ QN,bf16*O,char*shm){
  int tid_=threadIdx.x; asm volatile("":"+v"(tid_)); const int tid=tid_,lane=tid&63,r32=lane&31,hi=lane>>5; const int wid=__builtin_amdgcn_readfirstlane(tid>>6);
  const long rowbase=(long)b*SEQ; const long hbase=(long)(b*NHEAD+h)*SEQ; const int q0=qb*QB;
  const bf16*Qw=Q+(hbase+q0+wid*QBLK)*DM;
  int tstart=0;
  { const float*cbh=CB+(long)(b*NHEAD+h)*SEQ; const float*kn=KN+(b*NHEAD+h)*64; const float*qn=QN+(b*NHEAD+h)*32;
    const int NT0=(q0+QB)/KVBLK; const float cref=cbh[q0];
    const float Qn=__builtin_fmaxf(qn[2*qb],qn[2*qb+1]);
    const float Dmin=__builtin_fminf(qn[2048+2*qb],qn[2048+2*qb+1]);
    float kt=(lane<NT0)?kn[lane]:0.f;
    #pragma unroll
    for(int o_=1;o_<64;o_<<=1){ const float y_=__shfl_up(kt,o_); if(lane>=o_)kt=__builtin_fmaxf(kt,y_); }
    const float bmax=(lane<NT0)?(cref-cbh[64*lane+63])*1.4426950408889634f:0.f;
    const bool skip_=(lane<NT0-4)&&(bmax+Qn*kt-Dmin<-44.0f);
    const unsigned long long m_=__ballot(skip_);
    tstart=__builtin_amdgcn_readfirstlane(((int)__builtin_ctzll(~m_))&~1); }
  const bf16*Kh=K+(hbase+(long)tstart*KVBLK)*DM,*Vh=V+(hbase+(long)tstart*KVBLK)*DM;
  const unsigned lds0=(unsigned)(uintptr_t)shm;
  float*wsf=(float*)(shm+LDS_WS)+wid*64;
  const bf16*ksrc=Kh+(long)lane*DM+wid*8;
  const bf16*vsrc=Vh+(long)(16*(wid&3)+(lane>>2))*DM+(wid>>2)*32+(lane&3)*8;
  const unsigned kdst=lds0+LDS_K+wid*1024, vdst=lds0+LDS_V+wid*1024;
  #define DMA_K(t,slot) glds16(ksrc+(long)(t)*KVBLK*DM,(unsigned)__builtin_amdgcn_readfirstlane(kdst+(slot)))
  #define DMA_V(t,slot) glds16(vsrc+(long)(t)*KVBLK*DM,(unsigned)__builtin_amdgcn_readfirstlane(vdst+(slot)))
  const int vb0=(int)(lds0+LDS_V)+((lane>>4)&1)*32+(lane&3)*8+(4*hi+((lane&15)>>2))*64;
  const char*Kbase=shm+LDS_K; bf16x8 kf[8];
  const lds_cptr shm3=(lds_cptr)shm; const lds_cptr kp0=shm3+LDS_K+hi*1024+r32*16; const lds_cptr vp0=shm3+LDS_V+((lane>>4)&1)*32+(lane&3)*8+(4*hi+((lane&15)>>2))*64;
  const int NT=(q0+QB)/KVBLK-tstart;
  DMA_K(0,0);DMA_V(0,0);DMA_K(1,SLOTB);
  { const float*cbh=CB+(long)(b*NHEAD+h)*SEQ; const float cref=cbh[q0]; float*bl=(float*)(shm+LDS_BIAS); const int nk=q0+QB;
    float cv_[8];
    #pragma unroll
    for(int e_=0;e_<8;++e_){ const int i=tid+tstart*KVBLK+e_*NW*64; cv_[e_]=(i<nk)?cbh[i]:0.f; }
    #pragma unroll
    for(int e_=0;e_<8;++e_){ const int i=tid+tstart*KVBLK+e_*NW*64; if(i<nk) bl[i]=(cref-cv_[e_])*1.4426950408889634f; } }
  const __attribute__((address_space(3))) float* biasp=(const __attribute__((address_space(3))) float*)((lds_cptr)shm+LDS_BIAS)+4*hi+tstart*KVBLK;
  #define BIASADD(P0,P1,t) do{ const __attribute__((address_space(3))) float* bp_=biasp+64*(t); \
    _Pragma("unroll") for(int g_=0;g_<4;++g_){ f32x4v x0_=*(const __attribute__((address_space(3))) f32x4v*)(bp_+8*g_); f32x4v x1_=*(const __attribute__((address_space(3))) f32x4v*)(bp_+32+8*g_); \
      x0_=x0_-mhat; x1_=x1_-mhat; \
      P0[4*g_]+=x0_[0];P0[4*g_+1]+=x0_[1];P0[4*g_+2]+=x0_[2];P0[4*g_+3]+=x0_[3]; P1[4*g_]+=x1_[0];P1[4*g_+1]+=x1_[1];P1[4*g_+2]+=x1_[2];P1[4*g_+3]+=x1_[3]; } }while(0)
  #define LDB(P0,P1,t) do{ const __attribute__((address_space(3))) float* bp_=biasp+64*(t); \
    _Pragma("unroll") for(int g_=0;g_<4;++g_){ f32x4v x0_=*(const __attribute__((address_space(3))) f32x4v*)(bp_+8*g_); f32x4v x1_=*(const __attribute__((address_space(3))) f32x4v*)(bp_+32+8*g_); \
      x0_=x0_-mhat; x1_=x1_-mhat; \
      P0[4*g_]=x0_[0];P0[4*g_+1]=x0_[1];P0[4*g_+2]=x0_[2];P0[4*g_+3]=x0_[3]; P1[4*g_]=x1_[0];P1[4*g_+1]=x1_[1];P1[4*g_+2]=x1_[2];P1[4*g_+3]=x1_[3]; } }while(0)
  bf16x8 qr[4];
  #pragma unroll
  for(int d0=0;d0<4;++d0)qr[d0]=*reinterpret_cast<const bf16x8*>(&Qw[(long)r32*DM+d0*16+hi*8]);
  float mhat=0.f,l_reg=0.f;f32x16 o[2];o[0]=f32x16{};o[1]=f32x16{};const f32x16 negm=f32x16{};
  const int qrel=wid*QBLK+r32;
  #define CMASK(P0,P1,t) do{int jb_=(t)-(NT-4); if(jb_>=0)cmask(P0,P1,jb_,qrel,hi);}while(0)
  bool resc=false;
  #define START(P0,P1) do{ const float rm=rowmax(P0,P1); resc=false; \
    { const float dl=rm; mhat=fadd_s(mhat,dl); \
      _Pragma("unroll") for(int r=0;r<16;++r){P0[r]=fsub_s(P0[r],dl);P1[r]=fsub_s(P1[r],dl);} \
      } \
    _Pragma("unroll") for(int r=0;r<16;++r)P0[r]=__builtin_amdgcn_exp2f(P0[r]); }while(0)
  #define RESC() do{ if(resc){ asm volatile("s_waitcnt lgkmcnt(0)":::"memory"); \
      _Pragma("unroll") for(int d_=0;d_<2;++d_) _Pragma("unroll") for(int r=0;r<16;++r)o[d_][r]*=wsf[crow(r,hi)]; } }while(0)
  f32x16 pA0,pA1,pB0,pB1;
  int sl_prev=0,sl_cur=0,sl_next=SLOTB;
  #define ROT() do{sl_prev=sl_cur;sl_cur=sl_next;sl_next=(sl_next==(NSLOT-1)*SLOTB)?0:sl_next+SLOTB;}while(0)
  DMA_K(2,2*SLOTB);
  WAIT_BAR(3);
  qkt(pA0,pA1,Kbase,qr,negm,r32,hi);asm volatile("s_nop 15\n\ts_nop 7":"+v"(pA0),"+v"(pA1));BIASADD(pA0,pA1,0);CMASK(pA0,pA1,0);
  START(pA0,pA1);
  _Pragma("unroll") for(int r=0;r<16;++r)pA1[r]=__builtin_amdgcn_exp2f(pA1[r]);
  WAIT_BAR(0);
  DMA_K(3,0);DMA_V(1,SLOTB);
  ROT();
  kload8(kf,kp0+sl_cur);
  WAIT_BAR(2);
  s16x4 vlo[8],vhi[8]; u32x4 pw0,pw1,pw2,pw3;
  #define PKW(P,B) cvtpk_s(P[B],P[B+1])
  #define PAF(k) __builtin_bit_cast(bf16x8,pw##k)
  #define VFR(i) (bf16x8){vlo[i][0],vlo[i][1],vlo[i][2],vlo[i][3],vhi[i][0],vhi[i][1],vhi[i][2],vhi[i][3]}
  #define PIN(x) asm volatile("":"+v"(x))
  #define MX3(a,b,c) __builtin_fmaxf(__builtin_fmaxf((a),(b)),(c))
  #define GAPA(MF,A0,A1,A2,A3,W0,W1,PW) do{ MF; sacc+=A0; sacc+=A1; sacc+=A2; sacc+=A3; PIN(sacc); W0; W1; PIN(PW); SBAR(); }while(0)
  #define EX(v) __builtin_amdgcn_exp2f(v)
  #define GAPB(MF,X,B) do{ MF; X[B]=EX(X[B]); X[B+1]=EX(X[B+1]); X[B+2]=EX(X[B+2]); X[B+3]=EX(X[B+3]); PIN(X); SBAR(); }while(0)
  #define VRD(i) do{ vlo[i]=vtr(vp_+(((i)>>2)*4096+((i)&3)*1024)); vhi[i]=vtr(vp_+(((i)>>2)*4096+((i)&3)*1024+512)); }while(0)
  #define KRD(G,j) do{ if(G){ kload2(kf,kp0+sl_next,j); SBAR(); } }while(0)
  #define STEP(C0,C1,P0,P1,t,GK,GV,GL) do{ SBAR(); \
    const lds_cptr vp_=vp0+sl_prev; \
    VRD(0); SBAR(); float sacc=(P0[0]+P0[1]); \
    GAPA(C0=__builtin_amdgcn_mfma_f32_32x32x16_bf16(kf[0],qr[0],C0,0,0,0), P0[2],P0[3],P0[4],P0[5],     pw0[0]=PKW(P0,0), pw0[1]=PKW(P0,2), pw0); \
    VRD(4); SBAR(); GAPA(C1=__builtin_amdgcn_mfma_f32_32x32x16_bf16(kf[1],qr[0],C1,0,0,0), P0[6],P0[7],P0[8],P0[9],     pw0[2]=PKW(P0,4), pw0[3]=PKW(P0,6), pw0); \
    VRD(1); SBAR(); GAPA(C0=__builtin_amdgcn_mfma_f32_32x32x16_bf16(kf[2],qr[1],C0,0,0,0),   P0[10],P0[11],P0[12],P0[13], pw1[0]=PKW(P0,8), pw1[1]=PKW(P0,10), pw1); \
    VRD(5); SBAR(); GAPA(C1=__builtin_amdgcn_mfma_f32_32x32x16_bf16(kf[3],qr[1],C1,0,0,0),   P0[14],P0[15],P1[0],P1[1],   pw1[2]=PKW(P0,12),pw1[3]=PKW(P0,14), pw1); \
    VRD(2); SBAR(); GAPA(C0=__builtin_amdgcn_mfma_f32_32x32x16_bf16(kf[4],qr[2],C0,0,0,0),   P1[2],P1[3],P1[4],P1[5],     pw2[0]=PKW(P1,0), pw2[1]=PKW(P1,2), pw2); \
    VRD(6); SBAR(); GAPA(C1=__builtin_amdgcn_mfma_f32_32x32x16_bf16(kf[5],qr[2],C1,0,0,0),   P1[6],P1[7],P1[8],P1[9],     pw2[2]=PKW(P1,4), pw2[3]=PKW(P1,6), pw2); \
    VRD(3); SBAR(); GAPA(C0=__builtin_amdgcn_mfma_f32_32x32x16_bf16(kf[6],qr[3],C0,0,0,0),   P1[10],P1[11],P1[12],P1[13], pw3[0]=PKW(P1,8), pw3[1]=PKW(P1,10), pw3); \
    VRD(7); SBAR(); GAPA(C1=__builtin_amdgcn_mfma_f32_32x32x16_bf16(kf[7],qr[3],C1,0,0,0),   P1[14],P1[15],0.f,0.f,       pw3[2]=PKW(P1,12),pw3[3]=PKW(P1,14), pw3); \
    l_reg+=sacc; \
    if(GK){DMA_K((t)+3,sl_cur);} if(GV){DMA_V((t)+1,sl_next);} \
    CMASK(C0,C1,t); \
    { float a=MX3(C0[0],C0[1],C1[0]),b=MX3(C0[2],C0[3],C1[1]); a=MX3(a,C1[2],C1[3]); \
      _Pragma("unroll") for(int r=4;r<16;r+=4){a=MX3(a,C0[r],C0[r+1]);b=MX3(b,C0[r+2],C0[r+3]);a=MX3(a,C1[r],C1[r+1]);b=MX3(b,C1[r+2],C1[r+3]);} \
      float rm=__builtin_fmaxf(a,b); { auto rr=__builtin_amdgcn_permlane32_swap(__float_as_uint(rm),__float_as_uint(rm),false,false); rm=__builtin_fmaxf(__uint_as_float(rr[0]),__uint_as_float(rr[1])); } \
      resc=false; \
      if(__builtin_expect(__any(rm>(float)THRL),0)){ const float dl=__builtin_fmaxf(rm,0.f); mhat+=dl; \
        _Pragma("unroll") for(int r=0;r<16;++r){C0[r]-=dl;C1[r]-=dl;} \
        const float f=__builtin_amdgcn_exp2f(-dl); l_reg*=f; if(hi==0)wsf[r32]=f; resc=true; } } \
    SBAR(); \
    GAPB(o[0]=__builtin_amdgcn_mfma_f32_32x32x16_bf16(PAF(0),VFR(0),o[0],0,0,0), C0,0); \
    GAPB(o[1]=__builtin_amdgcn_mfma_f32_32x32x16_bf16(PAF(0),VFR(4),o[1],0,0,0), C0,4); \
    KRD(GL,0); GAPB(o[0]=__builtin_amdgcn_mfma_f32_32x32x16_bf16(PAF(1),VFR(1),o[0],0,0,0), C0,8); \
    KRD(GL,1); GAPB(o[1]=__builtin_amdgcn_mfma_f32_32x32x16_bf16(PAF(1),VFR(5),o[1],0,0,0), C0,12); \
    KRD(GL,2); GAPB(o[0]=__builtin_amdgcn_mfma_f32_32x32x16_bf16(PAF(2),VFR(2),o[0],0,0,0), C1,0); \
    KRD(GL,3); GAPB(o[1]=__builtin_amdgcn_mfma_f32_32x32x16_bf16(PAF(2),VFR(6),o[1],0,0,0), C1,4); \
    GAPB(o[0]=__builtin_amdgcn_mfma_f32_32x32x16_bf16(PAF(3),VFR(3),o[0],0,0,0), C1,8); \
    GAPB(o[1]=__builtin_amdgcn_mfma_f32_32x32x16_bf16(PAF(3),VFR(7),o[1],0,0,0), C1,12); \
    LDB(P0,P1,(t)+1);     \
    }while(0)
  LDB(pB0,pB1,1);
  int t=1;
  #undef CMASK
  #define CMASK(P0,P1,t) do{}while(0)
  for(;t+5<NT;t+=2){
    STEP(pB0,pB1,pA0,pA1,t,true,true,true);     WAIT_BAR(2); RESC(); ROT();
    STEP(pA0,pA1,pB0,pB1,t+1,true,true,true);   WAIT_BAR(2); RESC(); ROT();
  }
  #undef CMASK
  #define CMASK(P0,P1,t) do{int jb_=(t)-(NT-4); if(jb_>=0)cmask(P0,P1,jb_,qrel,hi);}while(0)
  #define ENDW(tt) do{ if((tt)+3<NT){WAIT_BAR(2);} else if((tt)+2<NT){WAIT_BAR(1);} else {WAIT_BAR(0);} }while(0)
  for(;t+1<NT;t+=2){
    STEP(pB0,pB1,pA0,pA1,t,(t+3<NT),(t+1<NT),(t+1<NT));       ENDW(t);   RESC(); ROT();
    STEP(pA0,pA1,pB0,pB1,t+1,(t+4<NT),(t+2<NT),(t+2<NT));     ENDW(t+1); RESC(); ROT();
  }
  STEP(pB0,pB1,pA0,pA1,NT-1,false,false,false); RESC();
  { float sacc=pB0[0]+pB0[1]; _Pragma("unroll") for(int r=2;r<16;++r)sacc+=pB0[r]; _Pragma("unroll") for(int r=0;r<16;++r)sacc+=pB1[r]; l_reg+=sacc;
    pw0=(u32x4){PKW(pB0,0),PKW(pB0,2),PKW(pB0,4),PKW(pB0,6)};pw1=(u32x4){PKW(pB0,8),PKW(pB0,10),PKW(pB0,12),PKW(pB0,14)};pw2=(u32x4){PKW(pB1,0),PKW(pB1,2),PKW(pB1,4),PKW(pB1,6)};pw3=(u32x4){PKW(pB1,8),PKW(pB1,10),PKW(pB1,12),PKW(pB1,14)};
    SBAR(); pv(o,vb0+sl_cur,PAF(0),PAF(1),PAF(2),PAF(3)); }
  #undef PKW
  #undef PAF
  #undef VFR
  #undef PIN
  #undef MX3
  #undef GAPA
  #undef GAPB
  #undef EX
  #undef VRD
  #undef KRD
  #undef STEP
  #undef ENDW
  {auto rr=__builtin_amdgcn_permlane32_swap(__float_as_uint(l_reg),__float_as_uint(l_reg),false,false);l_reg=__uint_as_float(rr[0])+__uint_as_float(rr[1]);}
  if(hi==0)wsf[32+r32]=l_reg;asm volatile("s_waitcnt lgkmcnt(0)":::"memory");
  float rli[16];
  #pragma unroll
  for(int r=0;r<16;++r)rli[r]=__builtin_amdgcn_rcpf(wsf[32+crow(r,hi)]);
  bf16*Ow=O+(rowbase+q0+wid*QBLK)*OP+h*D; const bf16*Gw=GT+(rowbase+q0+wid*QBLK)*OP+h*D;
  { bf16*stg=(bf16*)(shm+LDS_OST)+wid*2048;
    #pragma unroll
    for(int r=0;r<16;++r){const int orow=crow(r,hi);
      #pragma unroll
      for(int d0=0;d0<2;++d0)stg[orow*64+d0*32+r32]=__float2bfloat16(o[d0][r]*rli[r]);}
    asm volatile("s_waitcnt lgkmcnt(0)":::"memory");
    #pragma unroll
    for(int i=0;i<4;++i){const int row=i*8+(lane>>3),ch=lane&7; const u32x4 v=*(const u32x4*)(stg+row*64+ch*8); const u32x4 g=*(const u32x4*)(Gw+(long)row*OP+ch*8); u32x4 w;
      _Pragma("unroll") for(int e=0;e<4;++e){ const float a0=__uint_as_float(v[e]<<16)*__uint_as_float(g[e]<<16), a1=__uint_as_float(v[e]&0xffff0000u)*__uint_as_float(g[e]&0xffff0000u); w[e]=cvtpk_s(a0,a1); }
      ATTN_STORE16(Ow+(long)row*OP+ch*8,w);} }
  asm volatile("s_waitcnt lgkmcnt(0)\n\ts_barrier":::"memory");
  #undef BIASADD
  #undef LDB
  #undef DMA_K
  #undef DMA_V
  #undef CMASK
  #undef START
  #undef RESC
  #undef ROT
}
constexpr int ATTN_LDS_BYTES=LDS_BYTES;
struct AttnTensors { const bf16* Q; const bf16* K; const bf16* V; const bf16* GT; const float* CB; const float* KN; const float* QN; bf16* O; };
struct AttnUnit { int bh; int qb; };
struct QueueOrder {
  unsigned* ctr; int xg, limit;
  __device__ __forceinline__ QueueOrder(unsigned* counters,int grid,int block,int limit_):limit(limit_){ const int vcu=(grid%8==0)?(block%8)*(grid/8)+block/8:block; xg=(vcu*8)/grid; ctr=counters+64*xg; }
  __device__ __forceinline__ bool next(int i,volatile __attribute__((address_space(3))) unsigned* slot,AttnUnit&u)const{
    if(i>=limit)return false;
    if(threadIdx.x==0) *slot=__hip_atomic_fetch_add(ctr,1u,__ATOMIC_RELAXED,__HIP_MEMORY_SCOPE_AGENT);
    __syncthreads(); const unsigned idx=*slot; __syncthreads();
    if(idx>=128u)return false;
    u.bh=xg*NHEAD+(int)(idx&7u); u.qb=15-(int)(idx>>3); return true; }
};
template<int THRL=64> __device__ __forceinline__ void attn_phase(char*lds,const AttnTensors&T,const QueueOrder&S,volatile __attribute__((address_space(3))) unsigned* slot){
  AttnUnit u;
  for(int i=0;S.next(i,slot,u);++i){ attn_unit<THRL>(u.bh/NHEAD,u.bh%NHEAD,u.qb,T.Q,T.K,T.V,T.GT,T.CB,T.KN,T.QN,T.O,lds); }
}
#undef SBAR
#undef WAIT_BAR
}
constexpr int NWAVES = 8;
constexpr int BATCH = 8, SEQ = 4096, DMODEL = 1024, M = BATCH * SEQ;
constexpr int NZ = 3584;
constexpr int ZC_LQ = 0, ZC_LK = 256, ZC_LV = 512, ZC_AQ = 1024, ZC_AK = 1536, ZC_AV = 2048, ZC_GATE = 2560;
constexpr size_t ZR_LQ = 0, ZR_LK = (size_t)M * 256, ZR_LV = (size_t)M * 512, ZR_AQ = (size_t)M * 1024, ZR_AK = (size_t)M * 1536, ZR_AV = (size_t)M * 2048, ZR_GATE = (size_t)M * 2560;
constexpr int EVEN_IN = 3608, ODD_IN = 3584;
constexpr float RMS_EPS = 1e-6f;
constexpr float LOG2E = 1.4426950408889634f;
constexpr float C2 = 0.125f * LOG2E;

constexpr size_t MiB = 1u << 20;
constexpr size_t WS_CTL = 0, CTL_ZERO_BYTES = 1 * MiB;
constexpr size_t WS_ROPE = 1 * MiB;
constexpr size_t WS_SS = 2 * MiB;
constexpr size_t WS_FF = 4 * MiB;
constexpr size_t WS_GLR = 5 * MiB;
constexpr size_t WS_CB = 7 * MiB;
constexpr size_t WS_LSE = 8 * MiB;
constexpr size_t WS_DECAY = 9 * MiB;
constexpr size_t WS_KN = 9 * MiB + 512 * 1024;
constexpr size_t WS_QN = WS_KN + 16 * 1024;
constexpr size_t WS_WSK = 10 * MiB;
constexpr size_t WS_W = 11 * MiB;
constexpr size_t WS_Z = 48 * MiB;
constexpr size_t WS_Y = 272 * MiB;
constexpr size_t WS_HB = 336 * MiB;
constexpr size_t WS_KV = 400 * MiB;
constexpr size_t WS_OD = 432 * MiB;
constexpr size_t WS_END = 496 * MiB;
constexpr int CW_TMO = 0, CW_CODE = 1;
constexpr int CW_BAR = 4096;
constexpr int CW_QUEUE = 131072;

constexpr int RING_OFF = 0, RING_BYTES = 131072;
constexpr int LDSCTL_OFF = RING_BYTES, MISC_OFF = LDSCTL_OFF + 320;
constexpr int LDS_BYTES = 147456;
static_assert(MISC_OFF + 128 <= LDS_BYTES, "LDS map");

#define GAS __attribute__((address_space(1)))
#define LAS __attribute__((address_space(3)))
typedef unsigned short bf16;
typedef unsigned v4u __attribute__((ext_vector_type(4)));
typedef float f32x4 __attribute__((ext_vector_type(4)));
typedef short bf16x8 __attribute__((ext_vector_type(8)));
typedef GAS unsigned gu32;
#define RLX_AGENT __ATOMIC_RELAXED, __HIP_MEMORY_SCOPE_AGENT
#define LDS_WAIT() asm volatile("s_waitcnt lgkmcnt(0)" ::: "memory")
#define VM_WAIT() asm volatile("s_waitcnt vmcnt(0)" ::: "memory")
__device__ __forceinline__ unsigned f2bf(float f) { unsigned u = __builtin_bit_cast(unsigned, f); return (u + 0x7fffu + ((u >> 16) & 1u)) >> 16; }
__device__ __forceinline__ unsigned pk2(float lo, float hi) { return f2bf(lo) | (f2bf(hi) << 16); }
__device__ __forceinline__ float bflo(unsigned w) { return __uint_as_float(w << 16); }
__device__ __forceinline__ float bfhi(unsigned w) { return __uint_as_float(w & 0xffff0000u); }
__device__ __forceinline__ float bf1(bf16 h) { return __uint_as_float((unsigned)h << 16); }
__device__ __forceinline__ float logsigmoidf(float x) { return x < 0.f ? x - log1pf(__expf(x)) : -log1pf(__expf(-x)); }
__device__ __forceinline__ float logsigmoid_fast(float x) { return fminf(x, 0.f) - 0.6931471805599453f * __builtin_amdgcn_logf(1.0f + __builtin_amdgcn_exp2f(-fabsf(x) * 1.4426950408889634f)); }

#define XB_TMO      128
#define XB_XCNT(j)  (256  + 64 * (j))
#define XB_XSUB(j)  (1280 + 64 * (j))
#define XB_XGEN(j)  (2304 + 64 * (j))
#define XB_TOP      3328
#define XB_TOPGEN   3392
#define XB_LSUB(j)  (3456 + 64 * (j))
#define XB_LGEN(j)  (4480 + 64 * (j))
#define XB_ARR(s, j) (5504 + 64 * (8 * (s) + (j)))
#define XCD_BAR_WORDS (5504 + 64 * 8 * 12)
#define XB_SPIN_CAP (1u << 18)

__device__ __forceinline__ unsigned xb_ld(unsigned* p)              { return __hip_atomic_load(p, __ATOMIC_RELAXED, __HIP_MEMORY_SCOPE_AGENT); }
__device__ __forceinline__ unsigned xb_add(unsigned* p, unsigned v) { return __hip_atomic_fetch_add(p, v, __ATOMIC_RELAXED, __HIP_MEMORY_SCOPE_AGENT); }
__device__ __forceinline__ unsigned xb_xcc_id() { return (unsigned)__builtin_amdgcn_s_getreg((3 << 11) | 20) & 0xFu; }
#define XB_SPIN(cond, bar) do { unsigned _sp = 0; while (cond) { __builtin_amdgcn_s_sleep(1); \
    if ((++_sp & 255u) == 0u) { if (xb_ld(&(bar)[XB_TMO])) break; if (_sp > XB_SPIN_CAP) { atomicAdd(&(bar)[XB_TMO], 1u); break; } } } } while (0)

struct XcdBarrier { unsigned* bar; unsigned x; volatile LAS unsigned* st; };

__device__ __forceinline__ XcdBarrier xcd_barrier_post(unsigned* bar, volatile LAS unsigned* st) {
    XcdBarrier b; b.bar = bar; b.x = xb_xcc_id(); b.st = st;
    if (threadIdx.x == 0) st[2] = xb_add(&bar[XB_XCNT(b.x)], 1u);
    return b;
}
__device__ __forceinline__ void xcd_barrier_complete(unsigned* bar, unsigned x, unsigned& nloc, unsigned& nx) {
    const unsigned G = gridDim.x * gridDim.y * gridDim.z;
    unsigned sum, cnt, mine, sp = 0u;
    for (;;) {
        sum = 0u; cnt = 0u; mine = 0u;
#pragma unroll
        for (unsigned j = 0; j < 16; ++j) { const unsigned c = xb_ld(&bar[XB_XCNT(j)]); sum += c; cnt += (c > 0u) ? 1u : 0u; mine = (j == x) ? c : mine; }
        if (sum == G) break;
        __builtin_amdgcn_s_sleep(1);
        if ((++sp & 255u) == 0u) { if (xb_ld(&bar[XB_TMO])) break; if (sp > XB_SPIN_CAP) { atomicAdd(&bar[XB_TMO], 1u); break; } }
    }
    nloc = mine > 0u ? mine : 1u; nx = cnt > 0u ? cnt : 1u;
}
__device__ __forceinline__ void xcd_barrier(const XcdBarrier& b) {
    asm volatile("s_waitcnt vmcnt(0)" ::: "memory");
    __syncthreads();
    if (threadIdx.x == 0) {
        unsigned* bar = b.bar;
        __builtin_amdgcn_s_waitcnt(0);
        unsigned nloc = b.st[0], nx = b.st[1];
        if (nloc == 0u) { xcd_barrier_complete(bar, b.x, nloc, nx); b.st[0] = nloc; b.st[1] = nx; }
        const unsigned old = xb_add(&bar[XB_XSUB(b.x)], 1u);
        const unsigned gen = old / nloc;
        if (old + 1u == (gen + 1u) * nloc) {
            __builtin_amdgcn_fence(__ATOMIC_RELEASE, "agent");
            asm volatile("s_waitcnt vmcnt(0)" ::: "memory");
            const unsigned og = xb_add(&bar[XB_TOP], 1u);
            const unsigned tg = og / nx;
            if (og + 1u == (tg + 1u) * nx) xb_add(&bar[XB_TOPGEN], 1u);
            else XB_SPIN(xb_ld(&bar[XB_TOPGEN]) == tg, bar);
            __builtin_amdgcn_fence(__ATOMIC_ACQUIRE, "agent");
            xb_add(&bar[XB_XGEN(b.x)], 1u);
            asm volatile("s_waitcnt vmcnt(0)" ::: "memory");
        } else {
            XB_SPIN(xb_ld(&bar[XB_XGEN(b.x)]) == gen, bar);
            __builtin_amdgcn_fence(__ATOMIC_ACQUIRE, "agent");
            asm volatile("s_waitcnt vmcnt(0)" ::: "memory");
        }
    }
    __syncthreads();
}

__device__ __forceinline__ void xcd_arrive(const XcdBarrier& b, int slot) {
    asm volatile("s_waitcnt vmcnt(0)" ::: "memory");
    __syncthreads();
    if (threadIdx.x == 0) (void)xb_add(&b.bar[XB_ARR(slot, b.x)], 1u);
}
__device__ __forceinline__ void xcd_wait(const XcdBarrier& b, int slot, unsigned need = 32u) {
    if (threadIdx.x == 0) {
        unsigned* bar = b.bar;
        XB_SPIN(xb_ld(&bar[XB_ARR(slot, b.x)]) < need, bar);
        __builtin_amdgcn_fence(__ATOMIC_ACQUIRE, "agent");
        asm volatile("s_waitcnt vmcnt(0)" ::: "memory");
    }
    __syncthreads();
}

__device__ __forceinline__ void xcd_local_barrier(const XcdBarrier& b) {
    asm volatile("s_waitcnt vmcnt(0)" ::: "memory");
    __syncthreads();
    if (threadIdx.x == 0) {
        unsigned* bar = b.bar;
        const unsigned old = xb_add(&bar[XB_LSUB(b.x)], 1u);
        const unsigned gen = old / 32u;
        if (old + 1u == (gen + 1u) * 32u) (void)xb_add(&bar[XB_LGEN(b.x)], 1u);
        else XB_SPIN(xb_ld(&bar[XB_LGEN(b.x)]) == gen, bar);
        __builtin_amdgcn_fence(__ATOMIC_ACQUIRE, "agent");
        asm volatile("s_waitcnt vmcnt(0)" ::: "memory");
    }
    __syncthreads();
}

struct Frame {
    LAS unsigned char* lds;
    volatile LAS unsigned* MISC;
    gu32* ctl;
    int tid, lane, wave;
    int vcu, G;
    unsigned char* ws;
    int cidx, grp;
};

__device__ __forceinline__ float wave_sum(float v) {
#pragma unroll
    for (int o = 1; o < 64; o <<= 1) v += __shfl_xor(v, o);
    return v;
}

__device__ __forceinline__ int wsrc_col(int kind, int n) {
    if (kind == 0) {
        if (n < 256) return 1544 + n;
        if (n < 512) return 1800 + (n - 256);
        if (n < 1024) return 2056 + (n - 512);
        if (n < 1536) return n - 1024;
        if (n < 2048) return 512 + (n - 1536);
        if (n < 2560) return 1024 + (n - 2048);
        return 2584 + (n - 2560);
    } else if (kind == 1) {
        const bool il = (n < 512) || (n >= 1024 && n < 2048);
        if (!il) return n;
        const int p = n & 63; return (n & ~63) + (p >> 1) + 32 * (p & 1);
    } else if (kind == 2) {
        return n;
    } else {
        if (n < 8) return 1536 + n;
        if (n < 24) return 2568 + (n - 8);
        return -1;
    }
}
__device__ __forceinline__ void p0_transpose_item(const float* W, int Nsrc, int kind, const float* gain, bf16* WT, int nblk, LAS float* scr, int item, int lane) {
    const int K = DMODEL; const int kb = item / nblk, nb = item % nblk, k0 = 64 * kb, n0 = 32 * nb;
    const int sc = wsrc_col(kind, n0 + (lane & 31));
    float wv[32];
#pragma unroll
    for (int i = 0; i < 32; ++i) { const int kk = 2 * i + (lane >> 5); wv[i] = (sc >= 0) ? W[(size_t)(k0 + kk) * Nsrc + sc] : 0.f; }
#pragma unroll
    for (int i = 0; i < 32; ++i) { const int kk = 2 * i + (lane >> 5); const float g = gain ? gain[k0 + kk] : 1.0f; scr[kk * 33 + (lane & 31)] = wv[i] * g; }
    LDS_WAIT(); asm volatile("" ::: "memory");
    const int c = lane & 7;
#pragma unroll
    for (int j = 0; j < 4; ++j) { const int n = (lane >> 3) + 8 * j; const LAS float* s = scr + (8 * c) * 33 + n;
        v4u o; o.x = pk2(s[0 * 33], s[1 * 33]); o.y = pk2(s[2 * 33], s[3 * 33]); o.z = pk2(s[4 * 33], s[5 * 33]); o.w = pk2(s[6 * 33], s[7 * 33]);
        *(GAS v4u*)(WT + (size_t)(n0 + n) * K + k0 + 8 * c) = o; }
    LDS_WAIT(); asm volatile("" ::: "memory");
}
typedef float f32x16 __attribute__((ext_vector_type(16)));
typedef float f32x2 __attribute__((ext_vector_type(2)));
typedef unsigned v2u __attribute__((ext_vector_type(2)));
typedef __bf16 bf16x2_t __attribute__((ext_vector_type(2)));
__device__ __forceinline__ unsigned cvtpk(float lo, float hi) { f32x2 v = {lo, hi}; bf16x2_t b = __builtin_convertvector(v, bf16x2_t); return __builtin_bit_cast(unsigned, b); }
__device__ __forceinline__ int crow16(int r, int hi) { return (r & 3) + 8 * (r >> 2) + 4 * hi; }
__device__ __forceinline__ f32x16 mfma32(bf16x8 a, bf16x8 b, f32x16 c) { return __builtin_amdgcn_mfma_f32_32x32x16_bf16(a, b, c, 0, 0, 0); }
__device__ __forceinline__ bf16x8 pack8(const f32x16& p, int s2) {
    v4u w; w.x = cvtpk(p[8 * s2 + 0], p[8 * s2 + 1]); w.y = cvtpk(p[8 * s2 + 2], p[8 * s2 + 3]); w.z = cvtpk(p[8 * s2 + 4], p[8 * s2 + 5]); w.w = cvtpk(p[8 * s2 + 6], p[8 * s2 + 7]);
    return __builtin_bit_cast(bf16x8, w);
}

__device__ __forceinline__ void wave_lds_sync() { asm volatile("s_waitcnt lgkmcnt(0)" ::: "memory"); }

constexpr int LC = 64;
constexpr int LLD = 72;
constexpr int RUNS = 256, RUN_CH = 8;

struct LinArgs {
    bf16* Z; const float* GLR; const float* w_lr; const float* b_lr;
    const float* g1; const float* g2;
    float* TRUN; float* DRUN; float* DEC; bf16* Y;
};

typedef short v4i16_t __attribute__((ext_vector_type(4)));
template <int PITCH> __device__ __forceinline__ bf16x8 ld_tr8p(const LAS bf16* p) {
    const v4i16_t a = __builtin_amdgcn_ds_read_tr16_b64_v4i16((LAS v4i16_t*)p), b = __builtin_amdgcn_ds_read_tr16_b64_v4i16((LAS v4i16_t*)(p + 8 * PITCH));
    return (bf16x8){a[0], a[1], a[2], a[3], b[0], b[1], b[2], b[3]};
}
__device__ __forceinline__ bf16x8 ld_tr8(const LAS bf16* p) { return ld_tr8p<32>(p); }

constexpr int L1_W = 0, L1_BL = 16384;
constexpr int L1R_K = 17408, L1R_Q = L1R_K + 64 * LLD * 2, L1R_V = L1R_Q + 64 * LLD * 2, L1R_VLD = 136, L1R_G = L1R_V + 64 * L1R_VLD * 2, L1R_GLD = 20, L1R_D = L1R_G + 64 * L1R_GLD * 4, L1R_END = L1R_D + 256;
static_assert(L1R_END <= RING_BYTES, "X1 LDS map");
struct LinRaw { v4u kx, qx, vx0, vx1; f32x4 gl; };

template <bool ODD> __device__ __forceinline__ void lin_prep_load(Frame& F, const LinArgs& A, int u, LinRaw& R) {
    const int bh = u >> 6, n = u & 63, b = bh >> 2; const int tok = F.tid >> 3, c = F.tid & 7;
    const size_t hrow = (size_t)bh * SEQ + n * LC + tok;
    R.kx = *(const v4u*)(A.Z + ZR_LK + hrow * 64 + 8 * c); R.qx = (v4u){0u, 0u, 0u, 0u}; if (!ODD) R.qx = *(const v4u*)(A.Z + ZR_LQ + hrow * 64 + 8 * c);
    R.vx0 = *(const v4u*)(A.Z + ZR_LV + hrow * 128 + 16 * c); R.vx1 = *(const v4u*)(A.Z + ZR_LV + hrow * 128 + 16 * c + 8);
    if (!ODD) { R.gl = (f32x4){0.f, 0.f, 0.f, 0.f}; if (F.tid < 256) R.gl = *(const f32x4*)(A.GLR + ((size_t)b * SEQ + n * LC + (F.tid >> 2)) * 16 + 4 * (F.tid & 3)); }
}

__device__ __forceinline__ float wave_scan_incl(float x) {
    int v = __builtin_bit_cast(int, x);
#define LIN_DPP_ADD(ctrl, rmask) v = __builtin_bit_cast(int, __builtin_bit_cast(float, v) + __builtin_bit_cast(float, __builtin_amdgcn_update_dpp(0, v, (ctrl), (rmask), 0xf, true)))
    LIN_DPP_ADD(0x111, 0xf); LIN_DPP_ADD(0x112, 0xf); LIN_DPP_ADD(0x114, 0xf); LIN_DPP_ADD(0x118, 0xf);
    LIN_DPP_ADD(0x142, 0xa);
    LIN_DPP_ADD(0x143, 0xc);
#undef LIN_DPP_ADD
    return __builtin_bit_cast(float, v);
}

template <bool ODD> __device__ __forceinline__ void lin_prep_phase(Frame& F, const LinArgs& A) {
    LAS float* wL = (LAS float*)(F.lds + RING_OFF + L1_W); LAS float* bL = (LAS float*)(F.lds + RING_OFF + L1_BL);
    LAS bf16* KR = (LAS bf16*)(F.lds + RING_OFF + L1R_K); LAS bf16* QR = (LAS bf16*)(F.lds + RING_OFF + L1R_Q); LAS bf16* VR = (LAS bf16*)(F.lds + RING_OFF + L1R_V);
    LAS float* GR = (LAS float*)(F.lds + RING_OFF + L1R_G); LAS float* DL = (LAS float*)(F.lds + RING_OFF + L1R_D);
    if (!ODD) { for (int i = F.tid; i < 4096; i += 512) wL[i] = A.w_lr[i]; if (F.tid < 256) bL[F.tid] = A.b_lr[F.tid]; __syncthreads(); }
    const int r32 = F.lane & 31, hi = F.lane >> 5, w = F.wave, ctok = F.tid >> 3, cc = F.tid & 7, vb = w >> 1, db = w & 1;
    const int trow = 4 * hi + ((F.lane & 15) >> 2), tcol = 16 * ((F.lane >> 4) & 1) + 4 * (F.lane & 3);
    const LAS bf16* vtr = VR + trow * L1R_VLD + vb * 32 + tcol; const LAS bf16* ktr = KR + trow * LLD + db * 32 + tcol;
    LinRaw R;
    int run = F.vcu;
    if (run < RUNS) lin_prep_load<ODD>(F, A, run * RUN_CH, R);
    for (; run < RUNS; run += F.G) {
        const int bh = run >> 3, h = bh & 3;
        f32x16 acc = {}; float drun = 1.0f;
        float wr0 = 0.f, wr1 = 0.f; f32x4 bx0 = {0.f, 0.f, 0.f, 0.f}, bx1 = {0.f, 0.f, 0.f, 0.f};
        if (!ODD) { const LAS float* wq = wL + h * 64 + 8 * w + (F.lane >> 3) * 256 + (F.lane & 7); wr0 = wq[0]; wr1 = wq[8 * 256];
                    bx0 = *(const LAS f32x4*)(bL + h * 64 + 8 * w); bx1 = *(const LAS f32x4*)(bL + h * 64 + 8 * w + 4); }
        for (int i = 0; i < RUN_CH; ++i) {
            const int u = run * RUN_CH + i, n = u & 63;
            __syncthreads();
            *(LAS v4u*)(KR + ctok * LLD + 8 * cc) = R.kx; if (!ODD) *(LAS v4u*)(QR + ctok * LLD + 8 * cc) = R.qx;
            *(LAS v4u*)(VR + ctok * L1R_VLD + 16 * cc) = R.vx0; *(LAS v4u*)(VR + ctok * L1R_VLD + 16 * cc + 8) = R.vx1;
            if (!ODD && F.tid < 256) *(LAS f32x4*)(GR + (F.tid >> 2) * L1R_GLD + 4 * (F.tid & 3)) = R.gl;
            __syncthreads();
            { const int un = (i + 1 < RUN_CH) ? u + 1 : (run + F.G) * RUN_CH; if (i + 1 < RUN_CH || run + F.G < RUNS) lin_prep_load<ODD>(F, A, un, R); }
            const v4u kx = *(const LAS v4u*)(KR + F.lane * LLD + 8 * w); v4u qx = {0u, 0u, 0u, 0u}; if (!ODD) qx = *(const LAS v4u*)(QR + F.lane * LLD + 8 * w);
            float bv[8], blast[8];
            if (ODD) {
                const float lg = __logf(1.0f - exp2f(-5.0f - (float)h));
#pragma unroll
                for (int e = 0; e < 8; ++e) { bv[e] = lg * (float)(F.lane + 1); blast[e] = lg * 64.0f; }
            } else {
                f32x4 gl[4];
#pragma unroll
                for (int q = 0; q < 4; ++q) gl[q] = *(const LAS f32x4*)(GR + F.lane * L1R_GLD + 4 * q);
                f32x4 x0 = bx0, x1 = bx1;
                const int wi0 = __builtin_bit_cast(int, wr0), wi1 = __builtin_bit_cast(int, wr1);
#pragma unroll
                for (int r = 0; r < 16; ++r) { const float g = gl[r >> 2][r & 3]; const int wi = r < 8 ? wi0 : wi1;
#pragma unroll
                    for (int e = 0; e < 8; ++e) { const float wv = __builtin_bit_cast(float, __builtin_amdgcn_readlane(wi, (r & 7) * 8 + e)); if (e < 4) x0[e] += g * wv; else x1[e - 4] += g * wv; } }
#pragma unroll
                for (int e = 0; e < 8; ++e) bv[e] = wave_scan_incl(logsigmoid_fast(e < 4 ? x0[e & 3] : x1[e & 3]) * (1.0f / 16.0f));
#pragma unroll
                for (int e = 0; e < 8; ++e) blast[e] = __builtin_bit_cast(float, __builtin_amdgcn_readlane(__builtin_bit_cast(int, bv[e]), 63));
            }
            {
                v4u qo, ko;
#pragma unroll
                for (int e2 = 0; e2 < 4; ++e2) {
                    const float q0 = bflo(qx[e2]), q1 = bfhi(qx[e2]), k0 = bflo(kx[e2]), k1 = bfhi(kx[e2]);
                    const float e0 = __expf(bv[2 * e2]), e1 = __expf(bv[2 * e2 + 1]);
                    qo[e2] = cvtpk(q0 * e0, q1 * e1);
                    ko[e2] = cvtpk(k0 * __builtin_amdgcn_rcpf(e0), k1 * __builtin_amdgcn_rcpf(e1));
                }
                if (!ODD) *(LAS v4u*)(QR + F.lane * LLD + 8 * w) = qo;
                *(LAS v4u*)(KR + F.lane * LLD + 8 * w) = ko;
                if (F.lane == 63) { float* dp = A.DEC + (size_t)u * 64 + 8 * w;
#pragma unroll
                    for (int e = 0; e < 8; ++e) { const float dv = __expf(blast[e]); dp[e] = dv; DL[8 * w + e] = dv; } }
            }
            __syncthreads();
            {
                const size_t hrow = (size_t)bh * SEQ + n * LC + ctok;
                if (!ODD) { *(v4u*)(A.Z + ZR_LQ + hrow * 64 + 8 * cc) = *(const LAS v4u*)(QR + ctok * LLD + 8 * cc);
                            *(v4u*)(A.Z + ZR_LK + hrow * 64 + 8 * cc) = *(const LAS v4u*)(KR + ctok * LLD + 8 * cc); }
#pragma unroll
                for (int s = 0; s < 4; ++s) acc = mfma32(ld_tr8p<L1R_VLD>(vtr + 16 * s * L1R_VLD), ld_tr8p<LLD>(ktr + 16 * s * LLD), acc);
                const float dv = DL[db * 32 + r32];
#pragma unroll
                for (int r = 0; r < 16; ++r) acc[r] *= dv;
                drun *= dv;
            }
        }
        float* dst = A.TRUN + (size_t)run * (128 * 64) + db * 32 + r32;
#pragma unroll
        for (int r = 0; r < 16; ++r) dst[(size_t)(vb * 32 + crow16(r, hi)) * 64] = acc[r];
        if (vb == 0 && hi == 0) A.DRUN[run * 64 + db * 32 + r32] = drun;
    }
    __syncthreads();
}

constexpr int L3_QT = 0, L3_KT = L3_QT + 64 * LLD * 2, L3_VP = L3_KT + 64 * LLD * 2  , L3_PL = L3_VP + 4 * 64 * 32 * 2,
              L3_GL = L3_PL + 128 * LLD * 2, L3_GLD = 136, L3_OL = L3_GL + 64 * L3_GLD * 2, L3_D = L3_OL + 64 * 132 * 4, L3_END = L3_D + 256;
static_assert(L3_END <= RING_BYTES, "X3 LDS map");
struct LinOutRaw { v4u q, k, vv[2], g[2]; float dec; };
template <bool ODD> __device__ __forceinline__ void lin_out_load(Frame& F, const LinArgs& A, int u, LinOutRaw& R) {
    const int bh = u >> 6, n = u & 63, b = bh >> 2, h = bh & 3; const size_t hrow0 = (size_t)bh * SEQ + n * LC;
    const int tok = F.tid >> 3, c = F.tid & 7;
    R.q = *(const v4u*)(A.Z + ZR_LQ + (hrow0 + tok) * 64 + 8 * c); R.k = *(const v4u*)(A.Z + ZR_LK + (hrow0 + tok) * 64 + 8 * c);
    const bf16* vsrc = A.Z + ZR_LV + (hrow0 + tok) * 128 + 16 * c;
    R.vv[0] = *(const v4u*)vsrc; R.vv[1] = *(const v4u*)(vsrc + 8);
    const bf16* gp = A.Z + ZR_GATE + ((size_t)b * SEQ + n * LC + tok) * 1024 + (ODD ? 0 : 512) + h * 128 + 16 * c;
    R.g[0] = *(const v4u*)gp; R.g[1] = *(const v4u*)(gp + 8);
    R.dec = (F.tid < 64) ? A.DEC[(size_t)u * 64 + F.tid] : 0.f;
}
template <bool ODD> __device__ __forceinline__ void lin_out_phase(Frame& F, const LinArgs& A) {
    LAS bf16* QtL = (LAS bf16*)(F.lds + RING_OFF + L3_QT); LAS bf16* KtL = (LAS bf16*)(F.lds + RING_OFF + L3_KT);
    LAS bf16* VPL = (LAS bf16*)(F.lds + RING_OFF + L3_VP); LAS bf16* PL = (LAS bf16*)(F.lds + RING_OFF + L3_PL);
    LAS bf16* GL = (LAS bf16*)(F.lds + RING_OFF + L3_GL); LAS float* OL = (LAS float*)(F.lds + RING_OFF + L3_OL); LAS float* DL = (LAS float*)(F.lds + RING_OFF + L3_D);
    const int r32 = F.lane & 31, hi = F.lane >> 5, qi = F.wave >> 2, vj = F.wave & 3, vb = F.wave >> 1, db = F.wave & 1;
    const int trow = 4 * hi + ((F.lane & 15) >> 2), tcol = 16 * ((F.lane >> 4) & 1) + 4 * (F.lane & 3);
    int run = F.vcu;
    f32x4 g1v[4], g2v[4]; int hcur = -1;
    LinOutRaw R;
    if (run < RUNS) lin_out_load<ODD>(F, A, run * RUN_CH, R);
    for (; run < RUNS; run += F.G) {
        const int bh = run >> 3, b = bh >> 2, h = bh & 3;
        if (h != hcur) {
            hcur = h; const int c0 = h * 128 + (F.tid & 7) * 16;
#pragma unroll
            for (int e = 0; e < 4; ++e) { g1v[e] = *(const f32x4*)(A.g1 + c0 + 4 * e); g2v[e] = ODD ? *(const f32x4*)(A.g2 + c0 + 4 * e) : (f32x4){0.f, 0.f, 0.f, 0.f}; }
        }
        f32x16 S = {};
        { const int rn = run & (RUN_CH - 1); const float* tp = A.TRUN + (size_t)(run - rn) * (128 * 64) + db * 32 + r32; const float* dp = A.DRUN + (size_t)(run - rn) * 64 + db * 32 + r32;
          for (int p = 0; p < rn; p += 2) {
              const bool two = p + 1 < rn; const int p1 = two ? p + 1 : p;
              const float d0 = dp[p * 64], d1 = two ? dp[p1 * 64] : 1.0f, m1 = two ? 1.0f : 0.0f;
              float t0[16], t1[16];
#pragma unroll
              for (int r = 0; r < 16; ++r) { t0[r] = tp[(size_t)p * 8192 + (vb * 32 + crow16(r, hi)) * 64]; t1[r] = tp[(size_t)p1 * 8192 + (vb * 32 + crow16(r, hi)) * 64]; }
#pragma unroll
              for (int r = 0; r < 16; ++r) S[r] = (S[r] * d0 + t0[r]) * d1 + t1[r] * m1;
          } }
        for (int i = 0; i < RUN_CH; ++i) {
            const int u = run * RUN_CH + i, n = u & 63;
            const v4u gc0 = R.g[0], gc1 = R.g[1];
            { const int tok = F.tid >> 3, c = F.tid & 7;
              if (ODD) {
                  const float eq = __expf(__logf(1.0f - exp2f(-5.0f - (float)h)) * (float)(tok + 1)), ek = __builtin_amdgcn_rcpf(eq); v4u q2, k2;
#pragma unroll
                  for (int e = 0; e < 4; ++e) { q2[e] = cvtpk(bflo(R.q[e]) * eq, bfhi(R.q[e]) * eq); k2[e] = cvtpk(bflo(R.k[e]) * ek, bfhi(R.k[e]) * ek); }
                  *(LAS v4u*)(QtL + tok * LLD + 8 * c) = q2; *(LAS v4u*)(KtL + tok * LLD + 8 * c) = k2;
              } else { *(LAS v4u*)(QtL + tok * LLD + 8 * c) = R.q; *(LAS v4u*)(KtL + tok * LLD + 8 * c) = R.k; }
#pragma unroll
              for (int e = 0; e < 2; ++e) *(LAS v4u*)(VPL + (c >> 1) * 2048 + tok * 32 + (c & 1) * 16 + 8 * e) = R.vv[e];
              if (F.tid < 64) DL[F.tid] = R.dec; }
#pragma unroll
            for (int r = 0; r < 16; ++r) PL[(vb * 32 + crow16(r, hi)) * LLD + db * 32 + r32] = (bf16)f2bf(S[r]);
            __syncthreads();
            { const int un = (i + 1 < RUN_CH) ? u + 1 : (run + F.G) * RUN_CH; if (i + 1 < RUN_CH || run + F.G < RUNS) lin_out_load<ODD>(F, A, un, R); }
            f32x16 st0 = {}, st1 = {};
            bf16x8 qf[4];
#pragma unroll
            for (int s = 0; s < 4; ++s) qf[s] = *(const LAS bf16x8*)(QtL + (qi * 32 + r32) * LLD + 16 * s + 8 * hi);
#pragma unroll
            for (int s = 0; s < 4; ++s) st0 = mfma32(*(const LAS bf16x8*)(KtL + r32 * LLD + 16 * s + 8 * hi), qf[s], st0);
            if (qi == 1) {
#pragma unroll
                for (int s = 0; s < 4; ++s) st1 = mfma32(*(const LAS bf16x8*)(KtL + (32 + r32) * LLD + 16 * s + 8 * hi), qf[s], st1);
            }
#pragma unroll
            for (int r = 0; r < 16; ++r) { const int kl = crow16(r, hi); if (qi == 0) { if (kl > r32) st0[r] = 0.f; } else { if (kl > r32) st1[r] = 0.f; } }
            f32x16 o = {};
            const LAS bf16* vlane = VPL + vj * 2048 + trow * 32 + tcol;
            o = mfma32(pack8(st0, 0), ld_tr8(vlane), o);
            o = mfma32(pack8(st0, 1), ld_tr8(vlane + 16 * 32), o);
            if (qi == 1) { o = mfma32(pack8(st1, 0), ld_tr8(vlane + 32 * 32), o); o = mfma32(pack8(st1, 1), ld_tr8(vlane + 48 * 32), o); }
#pragma unroll
            for (int s = 0; s < 4; ++s) o = mfma32(qf[s], *(const LAS bf16x8*)(PL + (vj * 32 + r32) * LLD + 16 * s + 8 * hi), o);
#pragma unroll
            for (int r = 0; r < 16; ++r) OL[(qi * 32 + crow16(r, hi)) * 132 + vj * 32 + r32] = o[r];
            { const LAS bf16* va = VPL + vb * 2048 + trow * 32 + tcol; const LAS bf16* kb = KtL + trow * LLD + db * 32 + tcol;
#pragma unroll
              for (int s = 0; s < 4; ++s) S = mfma32(ld_tr8(va + 16 * s * 32), ld_tr8p<LLD>(kb + 16 * s * LLD), S);
              const float dv = DL[db * 32 + r32];
#pragma unroll
              for (int r = 0; r < 16; ++r) S[r] *= dv; }
            __syncthreads();
            {
                const int q = F.tid >> 3, part = F.tid & 7; const size_t row = (size_t)b * SEQ + n * LC + q;
                f32x4 x[4];
#pragma unroll
                for (int e = 0; e < 4; ++e) x[e] = *(const LAS f32x4*)(OL + q * 132 + part * 16 + 4 * e);
                if (ODD) {
                    float s = 0.f;
#pragma unroll
                    for (int e = 0; e < 4; ++e) s += (x[e][0] + x[e][1]) + (x[e][2] + x[e][3]);
                    s += __shfl_xor(s, 1); s += __shfl_xor(s, 2); s += __shfl_xor(s, 4);
                    const float mu = s * (1.0f / 128.0f);
#pragma unroll
                    for (int e = 0; e < 4; ++e) x[e] = x[e] - mu;
                }
                float s2 = 0.f;
#pragma unroll
                for (int e = 0; e < 4; ++e) s2 += (x[e][0] * x[e][0] + x[e][1] * x[e][1]) + (x[e][2] * x[e][2] + x[e][3] * x[e][3]);
                s2 += __shfl_xor(s2, 1); s2 += __shfl_xor(s2, 2); s2 += __shfl_xor(s2, 4);
                const float rs = 1.0f / sqrtf(s2 * (1.0f / 128.0f) + RMS_EPS);
                const int c0 = h * 128 + part * 16, yb = ODD ? 0 : 512;
                v4u* yp = (v4u*)(A.Y + row * DMODEL + yb + c0);
#pragma unroll
                for (int e2 = 0; e2 < 2; ++e2) {
                    const v4u gt = e2 ? gc1 : gc0; v4u ov;
                    const f32x4 ya = x[2 * e2] * rs * g1v[2 * e2] + g2v[2 * e2], yb4 = x[2 * e2 + 1] * rs * g1v[2 * e2 + 1] + g2v[2 * e2 + 1];
                    ov[0] = cvtpk(ya[0] * bflo(gt[0]), ya[1] * bfhi(gt[0])); ov[1] = cvtpk(ya[2] * bflo(gt[1]), ya[3] * bfhi(gt[1]));
                    ov[2] = cvtpk(yb4[0] * bflo(gt[2]), yb4[1] * bfhi(gt[2])); ov[3] = cvtpk(yb4[2] * bflo(gt[3]), yb4[3] * bfhi(gt[3]));
                    yp[e2] = ov;
                }
            }
        }
    }
    __syncthreads();
}

constexpr int DK_LD = 72;
constexpr int DV_HALF = 384 * 32;
constexpr int DA_K = 0, DA_VT = DA_K + 384 * DK_LD * 2, DA_WS = DA_VT + 2 * DV_HALF * 2, DA_END = DA_WS + 8 * 512;
constexpr int DA_TLD = 68, DA_TILE = 32 * DA_TLD * 4;
static_assert(DA_END <= RING_BYTES && 8 * DA_TILE <= DA_WS, "dilated-attention LDS map");

struct DilRows { v4u kx[6], vx[6]; };
struct DilDesc { int bh, dil, r, blk, has_old, fin; };
template <int PH> __device__ __forceinline__ bool dil_desc(int first, int G, int i, DilDesc& d, int grp) {
    if (PH == 0) { const int su = first + (i >> 3) * G; if (su >= 256) return false; const int k = i & 7, span = su & 3;
        d.bh = su >> 2; d.has_old = k >> 2; d.fin = 0;
        if (k < 4) { d.dil = 1; d.r = 0; d.blk = 4 * span + k; } else { d.dil = 4; d.r = k & 3; d.blk = span; }
        return true; }
    int u = first + i * G; if (u >= 1024) return false;
    if (grp) { if (i >= 4) return false; u = (first >> 5) * 128 + (first & 31) + 32 * i; }
    d.bh = u >> 4; d.dil = 16; d.r = u & 15; d.blk = 0; d.has_old = 1; d.fin = 1; return true;
}
__device__ __forceinline__ void dil_load_rows(Frame& F, const bf16* Z, const DilDesc& d, DilRows& R) {
    const int i0 = 256 * d.blk; const size_t hb0 = (size_t)d.bh * SEQ;
#pragma unroll
    for (int e = 0; e < 6; ++e) {
        const int pi = F.tid + 512 * e, row = pi >> 3, c = pi & 7, idx = i0 - 128 + row;
        R.kx[e] = (v4u){0u, 0u, 0u, 0u}; R.vx[e] = (v4u){0u, 0u, 0u, 0u};
        if (idx >= 0) { const size_t ro = (hb0 + (size_t)(idx * d.dil + d.r)) * 64 + 8 * c; R.kx[e] = *(const v4u*)(Z + ZR_AK + ro); R.vx[e] = *(const v4u*)(Z + ZR_AV + ro); }
    }
}

template <int PH> __device__ __forceinline__ void dil_phase(Frame& F, const bf16* Z, bf16* Y, bf16* OD, float* LSE) {
    LAS bf16* KI = (LAS bf16*)(F.lds + RING_OFF + DA_K); LAS bf16* VH = (LAS bf16*)(F.lds + RING_OFF + DA_VT);
    LAS float* wsc = (LAS float*)(F.lds + RING_OFF + DA_WS + F.wave * 512); LAS float* T = (LAS float*)(F.lds + RING_OFF + F.wave * DA_TILE);
    const int r32 = F.lane & 31, hi = F.lane >> 5;
    DilDesc d, dn;
    DilRows R;
    bool have = dil_desc<PH>(F.vcu, F.G, 0, d, F.grp);
    if (have) dil_load_rows(F, Z, d, R);
    for (int it = 0; have; ++it) {
        const int b = d.bh >> 3, h = d.bh & 7, r = d.r, DIL = d.dil, i0 = 256 * d.blk;
        const size_t hb0 = (size_t)d.bh * SEQ;
        if (PH == 0 && (it & 7) == 4) asm volatile("s_waitcnt vmcnt(0)" ::: "memory");
        __syncthreads();
#pragma unroll
        for (int e = 0; e < 6; ++e) {
            const int pi = F.tid + 512 * e, row = pi >> 3, c = pi & 7;
            *(LAS v4u*)(KI + row * DK_LD + 8 * c) = R.kx[e];
            *(LAS v4u*)(VH + (c >> 2) * DV_HALF + row * 32 + (c & 3) * 8) = R.vx[e];
        }
        const int qidx = i0 + 32 * F.wave + r32; const size_t qhrow = hb0 + (size_t)qidx * DIL + r;
        bf16x8 qf[4];
#pragma unroll
        for (int s = 0; s < 4; ++s) qf[s] = *(const bf16x8*)(Z + ZR_AQ + qhrow * 64 + 16 * s + 8 * hi);
        float lse_old = 0.f;
        if (d.has_old) lse_old = __builtin_nontemporal_load(LSE + qhrow);
        __syncthreads();
        have = dil_desc<PH>(F.vcu, F.G, it + 1, dn, F.grp);
        if (have) dil_load_rows(F, Z, dn, R);
        const int kb_lo = (i0 + 32 * F.wave - 128 < 0) ? (128 - i0 - 32 * F.wave) / 32 : 0;
        f32x16 st[5];
#pragma unroll
        for (int kb = 0; kb < 5; ++kb) {
            st[kb] = (f32x16){};
            if (kb >= kb_lo) {
#pragma unroll
                for (int s = 0; s < 4; ++s) st[kb] = mfma32(*(const LAS bf16x8*)(KI + (32 * F.wave + 32 * kb + r32) * DK_LD + 16 * s + 8 * hi), qf[s], st[kb]);
            }
        }
        float mx = -INFINITY;
#pragma unroll
        for (int kb = 0; kb < 5; ++kb)
#pragma unroll
            for (int rr = 0; rr < 16; ++rr) {
                const int kl = crow16(rr, hi); bool ok = kb >= kb_lo;
                if (kb == 0) ok = ok && (kl >= r32);
                if (kb == 4) ok = ok && (kl <= r32);
                const float sv = ok ? st[kb][rr] : -INFINITY; st[kb][rr] = sv; mx = fmaxf(mx, sv);
            }
        mx = fmaxf(mx, __shfl_xor(mx, 32));
        float l = 0.f;
#pragma unroll
        for (int kb = 0; kb < 5; ++kb)
#pragma unroll
            for (int rr = 0; rr < 16; ++rr) { const float p = __builtin_amdgcn_exp2f(st[kb][rr] - mx); st[kb][rr] = p; l += p; }
        l += __shfl_xor(l, 32);
        const float lse_cur = mx + __log2f(l);
        float w_old = 0.f, w_cur = 1.0f / l, lse_new = lse_cur;
        if (d.has_old) {
            const float m2 = fmaxf(lse_old, lse_cur); lse_new = m2 + __log2f(exp2f(lse_old - m2) + exp2f(lse_cur - m2));
            w_old = exp2f(lse_old - lse_new); w_cur = exp2f(lse_cur - lse_new) / l;
        }
        if (!d.fin && hi == 0) LSE[qhrow] = lse_new;
        if (hi == 0) { wsc[r32] = w_old; wsc[32 + r32] = w_cur; }
        v4u oldv[4];
#pragma unroll
        for (int e = 0; e < 4; ++e) {
            const int pi = F.lane + 64 * e, ql = pi >> 3, c = pi & 7; const size_t tok = (size_t)(i0 + 32 * F.wave + ql) * DIL + r;
            oldv[e] = (v4u){0u, 0u, 0u, 0u};
            if (d.has_old) oldv[e] = __builtin_nontemporal_load((const v4u*)(OD + (hb0 + tok) * 64 + 8 * c));
        }
        f32x16 o0 = {}, o1 = {};
        const LAS bf16* vlane = VH + (32 * F.wave + 4 * hi + ((F.lane & 15) >> 2)) * 32 + 16 * ((F.lane >> 4) & 1) + 4 * (F.lane & 3);
#pragma unroll
        for (int kb = 0; kb < 5; ++kb) {
            if (kb >= kb_lo) {
#pragma unroll
                for (int s2 = 0; s2 < 2; ++s2) {
                    const bf16x8 pa = pack8(st[kb], s2);
                    const LAS bf16* vp = vlane + (32 * kb + 16 * s2) * 32;
                    o0 = mfma32(pa, ld_tr8(vp), o0);
                    o1 = mfma32(pa, ld_tr8(vp + DV_HALF), o1);
                }
            }
        }
        v4u gatev[4];
        if (PH == 1) {
#pragma unroll
            for (int e = 0; e < 4; ++e) { const int pi = F.lane + 64 * e, ql = pi >> 3, c = pi & 7; const size_t tok = (size_t)(i0 + 32 * F.wave + ql) * DIL + r;
                gatev[e] = *(const v4u*)(Z + ZR_GATE + ((size_t)b * SEQ + tok) * 1024 + 512 + h * 64 + 8 * c); }
        }
        __syncthreads();
#pragma unroll
        for (int rr = 0; rr < 16; ++rr) { const int ql = crow16(rr, hi); T[ql * DA_TLD + r32] = o0[rr]; T[ql * DA_TLD + 32 + r32] = o1[rr]; }
        wave_lds_sync();
#pragma unroll
        for (int e = 0; e < 4; ++e) {
            const int pi = F.lane + 64 * e, ql = pi >> 3, c = pi & 7;
            const f32x4 t0 = *(const LAS f32x4*)(T + ql * DA_TLD + 8 * c), t1 = *(const LAS f32x4*)(T + ql * DA_TLD + 8 * c + 4);
            const float wo = wsc[ql], wc = wsc[32 + ql];
            const size_t tok = (size_t)(i0 + 32 * F.wave + ql) * DIL + r;
            float a[8] = {t0[0] * wc, t0[1] * wc, t0[2] * wc, t0[3] * wc, t1[0] * wc, t1[1] * wc, t1[2] * wc, t1[3] * wc};
#pragma unroll
            for (int q = 0; q < 4; ++q) { a[2 * q] += wo * bflo(oldv[e][q]); a[2 * q + 1] += wo * bfhi(oldv[e][q]); }
            if (PH == 1) {
                v4u w;
#pragma unroll
                for (int q = 0; q < 4; ++q) w[q] = cvtpk(a[2 * q] * bflo(gatev[e][q]), a[2 * q + 1] * bfhi(gatev[e][q]));
                *(v4u*)(Y + ((size_t)b * SEQ + tok) * DMODEL + 512 + h * 64 + 8 * c) = w;
            } else {
                v4u w;
#pragma unroll
                for (int q = 0; q < 4; ++q) w[q] = cvtpk(a[2 * q], a[2 * q + 1]);
                *(v4u*)(OD + (hb0 + tok) * 64 + 8 * c) = w;
            }
        }
        d = dn;
    }
    __syncthreads();
}
struct Args { const float* in[14]; float* out; unsigned char* ws; int ph_lo, ph_hi, li, pad; };

constexpr size_t W_LAYER_BYTES = 9 * MiB;
__device__ __forceinline__ bf16* w_in_ptr(unsigned char* ws, int L) { return (bf16*)(ws + WS_W + (size_t)L * W_LAYER_BYTES); }
__device__ __forceinline__ bf16* w_out_ptr(unsigned char* ws, int L) { return (bf16*)(ws + WS_W + (size_t)L * W_LAYER_BYTES + 7 * MiB); }

__device__ __forceinline__ void p0_prologue(Frame& F, const Args& a) {
    LAS float* scr = (LAS float*)(F.lds + RING_OFF + F.wave * 16384);
    const int gw = F.vcu * NWAVES + F.wave, NGW = F.G * NWAVES;
    constexpr int I_IN = 16 * 112, I_OUT = 16 * 32, I_SK = 16, PER_LAYER = I_IN + I_OUT, NITEMS = 4 * PER_LAYER + 2 * I_SK;
    for (int it = gw; it < NITEMS; it += NGW) {
        if (it < 4 * PER_LAYER) {
            const int L = it / PER_LAYER; int r = it % PER_LAYER; const int j = L >> 1, odd = L & 1;
            if (r < I_IN) {
                const float* W = odd ? a.in[9] + (size_t)j * DMODEL * ODD_IN : a.in[2] + (size_t)j * DMODEL * EVEN_IN;
                const float* gain = (odd ? a.in[8] : a.in[1]) + j * DMODEL;
                p0_transpose_item(W, odd ? ODD_IN : EVEN_IN, odd ? 1 : 0, gain, w_in_ptr(a.ws, L), 112, scr, r, F.lane);
            } else {
                r -= I_IN;
                const float* W = (odd ? a.in[12] : a.in[7]) + (size_t)j * DMODEL * DMODEL;
                p0_transpose_item(W, DMODEL, 2, nullptr, w_out_ptr(a.ws, L), 32, scr, r, F.lane);
            }
        } else {
            const int r = it - 4 * PER_LAYER; const int j = r / I_SK;
            p0_transpose_item(a.in[2] + (size_t)j * DMODEL * EVEN_IN, EVEN_IN, 3, a.in[1] + j * DMODEL, (bf16*)(a.ws + WS_WSK) + (size_t)j * 32 * DMODEL, 1, scr, r % I_SK, F.lane);
        }
    }
    {
        bf16* HB = (bf16*)(a.ws + WS_HB); float* SS = (float*)(a.ws + WS_SS);
        for (int m0 = gw * 4; m0 < M; m0 += NGW * 4) {
            f32x4 v[4][4];
#pragma unroll
            for (int rr = 0; rr < 4; ++rr) { const GAS f32x4* xr = (const GAS f32x4*)(a.in[0] + (size_t)(m0 + rr) * DMODEL) + F.lane;
#pragma unroll
                for (int j = 0; j < 4; ++j) v[rr][j] = xr[64 * j]; }
#pragma unroll
            for (int rr = 0; rr < 4; ++rr) {
                GAS unsigned long long* o8 = (GAS unsigned long long*)(HB + (size_t)(m0 + rr) * DMODEL) + F.lane;
                float s = 0.f;
#pragma unroll
                for (int j = 0; j < 4; ++j) { s += (v[rr][j].x * v[rr][j].x + v[rr][j].y * v[rr][j].y) + (v[rr][j].z * v[rr][j].z + v[rr][j].w * v[rr][j].w);
                    o8[64 * j] = (unsigned long long)pk2(v[rr][j].x, v[rr][j].y) | ((unsigned long long)pk2(v[rr][j].z, v[rr][j].w) << 32); }
                s = wave_sum(s);
                if (F.lane < 16) SS[(size_t)(m0 + rr) * 16 + F.lane] = (F.lane == 0) ? s : 0.f;
            }
        }
    }
    {
        float* RP = (float*)(a.ws + WS_ROPE);
        for (int e = F.vcu * 512 + F.tid; e < SEQ * 32; e += F.G * 512) {
            const int t = e >> 5, j = e & 31;
            const float inv = (float)exp(-(double)j * (9.210340371976184 / 32.0));
            const float ang = (float)t * inv;
            double sn, cs; sincos((double)ang, &sn, &cs);
            RP[2 * e] = (float)cs; RP[2 * e + 1] = (float)sn;
        }
    }
}

__device__ __forceinline__ void skinny_phase(Frame& F, const bf16* HB, const bf16* WSK, const float* SS, const float* b_f, float* FFo, float* GLRo) {
    typedef float f32x4_t __attribute__((ext_vector_type(4)));
    const int lr = F.lane & 15, kq = F.lane >> 4;
    for (int rb = F.grp ? F.vcu : (int)blockIdx.x; rb < M / 128; rb += F.G) {
        const int r0 = rb * 128 + F.wave * 16;
        f32x4_t acc0 = {0.f, 0.f, 0.f, 0.f}, acc1 = {0.f, 0.f, 0.f, 0.f};
        const bf16* ap = HB + (size_t)(r0 + lr) * DMODEL + 8 * kq;
        const bf16* bp0 = WSK + (size_t)lr * DMODEL + 8 * kq;
        const bf16* bp1 = WSK + (size_t)(16 + lr) * DMODEL + 8 * kq;
        for (int k0 = 0; k0 < DMODEL; k0 += 256) {
            bf16x8 av[8], b0[8], b1[8];
#pragma unroll
            for (int i = 0; i < 8; ++i) { av[i] = *(const bf16x8*)(ap + k0 + 32 * i); b0[i] = *(const bf16x8*)(bp0 + k0 + 32 * i); b1[i] = *(const bf16x8*)(bp1 + k0 + 32 * i); }
#pragma unroll
            for (int i = 0; i < 8; ++i) { acc0 = __builtin_amdgcn_mfma_f32_16x16x32_bf16(av[i], b0[i], acc0, 0, 0, 0); acc1 = __builtin_amdgcn_mfma_f32_16x16x32_bf16(av[i], b1[i], acc1, 0, 0, 0); }
        }
#pragma unroll
        for (int reg = 0; reg < 4; ++reg) {
            const int row = r0 + 4 * kq + reg;
            const f32x4* sp = (const f32x4*)(SS + (size_t)row * 16);
            const f32x4 s0 = sp[0], s1 = sp[1], s2 = sp[2], s3 = sp[3];
            const float tot = ((s0[0] + s0[1]) + (s0[2] + s0[3])) + ((s1[0] + s1[1]) + (s1[2] + s1[3])) + ((s2[0] + s2[1]) + (s2[2] + s2[3])) + ((s3[0] + s3[1]) + (s3[2] + s3[3]));
            const float rinv = 1.0f / sqrtf(tot * (1.0f / 1024.0f) + RMS_EPS);
            const float v0 = acc0[reg] * rinv, v1 = acc1[reg] * rinv;
            if (lr < 8) { FFo[(size_t)row * 8 + lr] = logsigmoidf(v0 + b_f[lr]); GLRo[(size_t)row * 16 + 8 + lr] = v1; }
            else GLRo[(size_t)row * 16 + (lr - 8)] = v0;
        }
    }
}

__device__ __forceinline__ void fox_norm_unit(Frame& F, int u, const bf16* Z, float* KN, float* QN) {
    const int bh = u >> 2, qz = u & 3, c = F.lane & 7, rl = F.lane >> 3;
    float q2 = 0.f, dmin = 3.0e38f;
#pragma unroll
    for (int tile = 0; tile < 2; ++tile) {
        v4u kx[8], qx[8];
#pragma unroll
        for (int ps = 0; ps < 8; ++ps) {
            const size_t hrow = (size_t)bh * SEQ + 1024 * qz + 128 * F.wave + 64 * tile + 8 * ps + rl;
            kx[ps] = *(const v4u*)(Z + ZR_AK + hrow * 64 + 8 * c); qx[ps] = *(const v4u*)(Z + ZR_AQ + hrow * 64 + 8 * c);
        }
        float k2 = 0.f;
#pragma unroll
        for (int ps = 0; ps < 8; ++ps) {
            float ks = 0.f, qs = 0.f, dg = 0.f;
#pragma unroll
            for (int e = 0; e < 4; ++e) { const float a = bflo(kx[ps][e]), bb = bfhi(kx[ps][e]), cc = bflo(qx[ps][e]), dd = bfhi(qx[ps][e]); ks += a * a + bb * bb; qs += cc * cc + dd * dd; dg += a * cc + bb * dd; }
#pragma unroll
            for (int o = 1; o < 8; o <<= 1) { ks += __shfl_xor(ks, o); qs += __shfl_xor(qs, o); dg += __shfl_xor(dg, o); }
            k2 = fmaxf(k2, ks); q2 = fmaxf(q2, qs); dmin = fminf(dmin, dg);
        }
#pragma unroll
        for (int o = 8; o < 64; o <<= 1) k2 = fmaxf(k2, __shfl_xor(k2, o));
        if (F.lane == 0) KN[bh * 64 + qz * 16 + 2 * F.wave + tile] = sqrtf(k2) * 1.001f;
    }
#pragma unroll
    for (int o = 8; o < 64; o <<= 1) { q2 = fmaxf(q2, __shfl_xor(q2, o)); dmin = fminf(dmin, __shfl_xor(dmin, o)); }
    if (F.lane == 0) { QN[bh * 32 + qz * 8 + F.wave] = sqrtf(q2) * 1.001f; QN[2048 + bh * 32 + qz * 8 + F.wave] = dmin - 1e-3f * fabsf(dmin) - 1e-3f; }
}

__device__ __forceinline__ void cumsum_unit(Frame& F, int bh, const float* FFp, float* CB) {
    LAS float* wsum = (LAS float*)(F.lds + RING_OFF);
    const int b = bh >> 3, h = bh & 7;
    float v[8]; float run = 0.f;
#pragma unroll
    for (int i = 0; i < 8; ++i) { run += FFp[((size_t)b * SEQ + F.tid * 8 + i) * 8 + h]; v[i] = run; }
    float x = run;
#pragma unroll
    for (int o = 1; o < 64; o <<= 1) { const float y = __shfl_up(x, o); if (F.lane >= o) x += y; }
    if (F.lane == 63) wsum[F.wave] = x;
    __syncthreads();
    float off = x - run;
    for (int w = 0; w < F.wave; ++w) off += wsum[w];
#pragma unroll
    for (int i = 0; i < 8; ++i) CB[(size_t)bh * SEQ + F.tid * 8 + i] = v[i] + off;
    __syncthreads();
}

__device__ __forceinline__ void final_norm_phase(Frame& F, const bf16* HB, const float* SS, float* out, const float* g) {
    const int gw = F.vcu * NWAVES + F.wave, NGW = F.G * NWAVES;
    f32x4 gv[4];
#pragma unroll
    for (int j = 0; j < 4; ++j) gv[j] = ((const f32x4*)g)[F.lane + 64 * j];
    const int mstart = F.grp ? F.vcu * 128 + F.wave * 16 : gw * 4, mstep = F.grp ? 4 : NGW * 4, mend = F.grp ? mstart + 16 : M;
    for (int m0 = mstart; m0 < mend; m0 += mstep) {
        float sv[4]; unsigned long long w[4][4];
#pragma unroll
        for (int rr = 0; rr < 4; ++rr) { sv[rr] = (F.lane < 16) ? SS[(size_t)(m0 + rr) * 16 + F.lane] : 0.f;
            const GAS unsigned long long* hr = (const GAS unsigned long long*)(HB + (size_t)(m0 + rr) * DMODEL) + F.lane;
#pragma unroll
            for (int j = 0; j < 4; ++j) w[rr][j] = hr[64 * j]; }
#pragma unroll
        for (int rr = 0; rr < 4; ++rr) {
            const float r = 1.0f / sqrtf(wave_sum(sv[rr]) * (1.0f / 1024.0f) + RMS_EPS);
            GAS f32x4* xr = (GAS f32x4*)(out + (size_t)(m0 + rr) * DMODEL) + F.lane;
#pragma unroll
            for (int j = 0; j < 4; ++j) { const unsigned lo = (unsigned)w[rr][j], hi2 = (unsigned)(w[rr][j] >> 32);
                f32x4 v; v.x = bflo(lo); v.y = bfhi(lo); v.z = bflo(hi2); v.w = bfhi(hi2); xr[64 * j] = v * r * gv[j]; }
        }
    }
}

constexpr int PH_PER_LAYER = 4, N_PHASES = 2 + 4 * PH_PER_LAYER;
#ifndef MK_N_LAUNCHES
#define MK_N_LAUNCHES 1
#endif

#define SEAM_BAR(k) do { if (F.grp && (k) >= 1) { if (((k) & 3) == 1) xcd_wait(bar, 3 * (((k) - 1) >> 2) + 2, 256u);   else if (((k) & 3) != 2) xcd_local_barrier(bar);   } else xcd_barrier(bar); } while (0)
#define IN(k) (lo <= (k) && (k) < hi)
#if defined(PROBE_TS)
#define SEAM(k) do { if (IN(k) && IN((k) + 1)) { for (int rb_ = 0; rb_ < REP_BAR; ++rb_) SEAM_BAR(k); } \
    { const unsigned long long now_ = __builtin_amdgcn_s_memrealtime(); if (((PROBE_TS >> (k)) & 1) && PROBE_SEGSEL(9)) prof_val += (float)(now_ - prof_t) * 0.01f; prof_t = now_; } } while (0)
#else
#define SEAM(k) do { if (IN(k) && IN((k) + 1)) { for (int rb_ = 0; rb_ < REP_BAR; ++rb_) SEAM_BAR(k); } } while (0)
#endif
__device__ __forceinline__ unsigned char* launder_ptr(unsigned char* p) { asm volatile("" : "+s"(p)); return p; }
__device__ __forceinline__ void refresh(Frame& F) { int t = threadIdx.x; asm volatile("" : "+v"(t)); F.tid = t; F.lane = t & 63; F.wave = __builtin_amdgcn_readfirstlane(t >> 6); }
#ifndef REP_PRO
#define REP_PRO 1
#endif
#ifndef REP_INPROJ
#define REP_INPROJ 1
#endif
#ifndef REP_OUT0
#define REP_OUT0 1
#endif
#ifndef REP_X1
#define REP_X1 1
#endif
#ifndef REP_INPROJ_PLAINMODE
#define REP_INPROJ_PLAINMODE 1
#endif
#ifndef STAG_US
#define STAG_US 8
#endif
#if defined(PHDELAY_NS)
#define PHDELAY(ph) do { if (PHDELAY_WHERE(ph)) { const unsigned long long t0_ = __builtin_amdgcn_s_memrealtime(); const unsigned long long w_ = (unsigned long long)(PHDELAY_GRP) * (PHDELAY_NS) / 10;     \
    while (__builtin_amdgcn_s_memrealtime() - t0_ < w_) __builtin_amdgcn_s_sleep(2); } } while (0)
#else
#define PHDELAY(ph) do {} while (0)
#endif
#ifndef INSTAG_GRP
#define INSTAG_GRP ((blockIdx.x >> 6) & 3)
#endif
#ifndef PG_ALIGN_IN
#define PG_ALIGN_IN true
#endif
#ifndef PG_ALIGN_OUT
#define PG_ALIGN_OUT true
#endif
#ifndef PG_SP2
#define PG_SP2 true
#endif
#ifndef REP_X1_PAR
#define REP_X1_PAR 2
#endif
#ifndef REP_X2
#define REP_X2 1
#endif
#ifndef REP_X3
#define REP_X3 1
#endif
#ifndef REP_FOX
#define REP_FOX 1
#endif
#ifndef REP_DIL0
#define REP_DIL0 1
#endif
#ifndef REP_BAR
#define REP_BAR 1
#endif
template <int L> __device__ __forceinline__ LinArgs make_lin_args(unsigned char* ws, const Args& args) {
    constexpr int j = L >> 1; constexpr bool odd = (L & 1) != 0;
    LinArgs A;
    A.Z = (bf16*)(ws + WS_Z); A.GLR = (const float*)(ws + WS_GLR); A.w_lr = args.in[4] + (size_t)j * 16 * 256; A.b_lr = args.in[5] + j * 256;
    A.g1 = odd ? args.in[10] + j * 512 : args.in[6] + j * 512; A.g2 = odd ? args.in[11] + j * 512 : nullptr;
    A.TRUN = (float*)(ws + WS_KV); A.DRUN = (float*)(ws + WS_DECAY + 768 * 1024); A.DEC = (float*)(ws + WS_DECAY); A.Y = (bf16*)(ws + WS_Y);
    return A;
}
#if defined(PROBE_SEG)
#define PROBE_SEGSEL(s) ((s) == PROBE_SEG)
#else
#define PROBE_SEGSEL(s) true
#endif
#if defined(PROBE_TS) && defined(PROBE_SEG)
#define SUBT(k, seg) do { const unsigned long long n2_ = __builtin_amdgcn_s_memrealtime(); if (((PROBE_TS >> (k)) & 1) && (seg) == PROBE_SEG) prof_val += (float)(n2_ - prof_t) * 0.01f; prof_t = n2_; } while (0)
#else
#define SUBT(k, seg) do {} while (0)
#endif
#if defined(PROBE_TS)
#define PROF_PARAMS , unsigned long long& prof_t, float& prof_val
#define PROF_ARGS , prof_t, prof_val
#else
#define PROF_PARAMS
#define PROF_ARGS
#endif
template <int L> __device__ __forceinline__ void run_layer(Frame& F, const Args& args, const XcdBarrier& bar, const int lo, const int hi, unsigned char* lds PROF_PARAMS) {
    constexpr int pb = 1 + PH_PER_LAYER * L; constexpr int j = L >> 1; constexpr bool odd = (L & 1) != 0;
    if (IN(pb)) {
        unsigned char* ws = launder_ptr(args.ws); refresh(F);
        bf16* Z = (bf16*)(ws + WS_Z); bf16* HB = (bf16*)(ws + WS_HB); float* SS = (float*)(ws + WS_SS);
        pg8::Gemm g{HB, w_in_ptr(ws, L), M, NZ, DMODEL}; pg8::StaticOrder S; S.init(M, NZ, F.G, F.cidx);
        LAS float* rtab = (LAS float*)(F.lds + LDSCTL_OFF + 1024); LAS int* rtag = (LAS int*)(F.lds + LDSCTL_OFF + 1024 + 2048);
        pg8::epi_in_fill(S, SS, rtab, rtag);
        pg8::EpiIn E{Z, NZ, SS, (const float*)(ws + WS_ROPE), odd ? 1 : 0, 0.125f, C2, 0, rtab, rtag};
#if defined(REP_INPROJ_PLAIN)
        { pg8::EpiIn Ep = E; Ep.plain = REP_INPROJ_PLAINMODE; for (int rp_ = 0; rp_ < REP_INPROJ_PLAIN; ++rp_) pg8::gemm_phase<pg8::EpiIn, pg8::StaticOrder, PG_ALIGN_IN, PG_SP2>(F.lds + RING_OFF, g, S, Ep); }
#endif
#if defined(INSTAG_NS)
        { const unsigned long long t0_ = __builtin_amdgcn_s_memrealtime(); const unsigned long long w_ = (unsigned long long)(INSTAG_GRP) * (INSTAG_NS) / 10;
          while (__builtin_amdgcn_s_memrealtime() - t0_ < w_) __builtin_amdgcn_s_sleep(2); }
#endif
        if (!odd) skinny_phase(F, HB, (const bf16*)(ws + WS_WSK) + (size_t)j * 32 * DMODEL, SS, args.in[3] + j * 8, (float*)(ws + WS_FF), (float*)(ws + WS_GLR));
        if (F.grp) S.lag = bar.bar + XB_ARR(3 * L + 2, bar.x);
        pg8::gemm_phase<pg8::EpiIn, pg8::StaticOrder, PG_ALIGN_IN, PG_SP2>(F.lds + RING_OFF, g, S, E);
    }
    SUBT(pb, 1);
    SEAM(pb);
    if (IN(pb + 1)) {
        unsigned char* ws = launder_ptr(args.ws); refresh(F);
        bf16* Z = (bf16*)(ws + WS_Z); bf16* Y = (bf16*)(ws + WS_Y);
        PHDELAY(1);
        { const LinArgs A = make_lin_args<L>(ws, args); lin_prep_phase<odd>(F, A); }
        if (F.grp) xcd_arrive(bar, 3 * L);
        SUBT(pb + 1, 0);
        if (!odd) { if (F.grp) { if ((F.vcu & 31) < 8) cumsum_unit(F, (F.vcu >> 5) * 8 + (F.vcu & 31), (const float*)(ws + WS_FF), (float*)(ws + WS_CB)); }
                    else for (int u = F.vcu; u < 64; u += F.G) cumsum_unit(F, u, (const float*)(ws + WS_FF), (float*)(ws + WS_CB));
                    for (int u = F.vcu; u < 256; u += F.G) fox_norm_unit(F, u, Z, (float*)(ws + WS_KN), (float*)(ws + WS_QN)); }
        else {
            dil_phase<0>(F, Z, Y, (bf16*)(ws + WS_OD), (float*)(ws + WS_LSE));
        }
        if (F.grp) xcd_arrive(bar, 3 * L + 1);
        SUBT(pb + 1, 1);
    }
    SEAM(pb + 1);
    if (IN(pb + 2)) {
        unsigned char* ws = launder_ptr(args.ws); refresh(F);
        PHDELAY(2);
        if (F.grp) xcd_wait(bar, 3 * L);
        SUBT(pb + 2, 0);
        { const LinArgs A = make_lin_args<L>(ws, args); for (int rp_ = 0; rp_ < REP_X3; ++rp_) lin_out_phase<odd>(F, A); }
        if (F.grp) xcd_wait(bar, 3 * L + 1);
        SUBT(pb + 2, 1);
        if (odd) dil_phase<1>(F, (const bf16*)(ws + WS_Z), (bf16*)(ws + WS_Y), (bf16*)(ws + WS_OD), (float*)(ws + WS_LSE));
        if (!odd) {
            bf16* Z = (bf16*)(ws + WS_Z);
            const attn_body::AttnTensors AT{(const attn_body::bf16*)(Z + ZR_AQ), (const attn_body::bf16*)(Z + ZR_AK), (const attn_body::bf16*)(Z + ZR_AV), (const attn_body::bf16*)(Z + ZR_GATE), (const float*)(ws + WS_CB), (const float*)(ws + WS_KN), (const float*)(ws + WS_QN), (attn_body::bf16*)(ws + WS_Y)};
            const attn_body::QueueOrder S((unsigned*)(F.ctl + CW_QUEUE) + j * 512, (int)F.G, F.cidx, 1 << 20);
            __syncthreads();
            attn_body::attn_phase<>((char*)lds + RING_OFF, AT, S, F.MISC + 12);
        }
    }
    SUBT(pb + 2, 2);
    SEAM(pb + 2);
    if (IN(pb + 3)) {
        unsigned char* ws = launder_ptr(args.ws); refresh(F);
        PHDELAY(3);
        pg8::Gemm g{(bf16*)(ws + WS_Y), w_out_ptr(ws, L), M, DMODEL, DMODEL}; pg8::StaticOrder S; S.init(M, DMODEL, F.G, F.cidx);
        pg8::EpiOut E{(bf16*)(ws + WS_HB), (float*)(ws + WS_SS), (bf16*)(ws + WS_HB)};
#if defined(REP_OUT_DRY)
        { pg8::EpiOut Ed = E; Ed.hbo = (bf16*)(ws + WS_KV); for (int rp_ = 0; rp_ < REP_OUT_DRY; ++rp_) pg8::gemm_phase<pg8::EpiOut, pg8::StaticOrder, PG_ALIGN_OUT, PG_SP2>(F.lds + RING_OFF, g, S, Ed); }
#endif
        pg8::gemm_phase<pg8::EpiOut, pg8::StaticOrder, PG_ALIGN_OUT, PG_SP2>(F.lds + RING_OFF, g, S, E);
    }
    SUBT(pb + 3, 1);
    SEAM(pb + 3);
}
#undef IN
#undef SEAM

__global__ void __launch_bounds__(NWAVES * 64, 2) trunk_fwd(Args args) {
    extern __shared__ __attribute__((aligned(16))) unsigned char lds[];
    Frame F;
    F.lds = (LAS unsigned char*)lds;
    F.MISC = (volatile LAS unsigned*)(F.lds + MISC_OFF);
    F.tid = threadIdx.x; F.lane = F.tid & 63; F.wave = __builtin_amdgcn_readfirstlane(F.tid >> 6);
    F.G = gridDim.x; { const int bx = blockIdx.x; F.vcu = (F.G % 8 == 0) ? (bx % 8) * (F.G / 8) + bx / 8 : bx; }
    F.ws = args.ws; F.ctl = (gu32*)(args.ws + WS_CTL); F.cidx = (int)blockIdx.x; F.grp = 0;
    for (int u = F.tid; u < (LDS_BYTES - LDSCTL_OFF) / 4; u += NWAVES * 64) ((LAS unsigned*)(F.lds + LDSCTL_OFF))[u] = 0u;
    __syncthreads();
    XcdBarrier bar = xcd_barrier_post((unsigned*)(F.ctl + CW_BAR) + args.li * XCD_BAR_WORDS, F.MISC + 8);
    const int lo = args.ph_lo, hi = args.ph_hi;
#define IN(k) (lo <= (k) && (k) < hi)
#if defined(PROBE_TS)
#define SEAM(k) do { if (IN(k) && IN((k) + 1)) { for (int rb_ = 0; rb_ < REP_BAR; ++rb_) SEAM_BAR(k); } \
    { const unsigned long long now_ = __builtin_amdgcn_s_memrealtime(); if (((PROBE_TS >> (k)) & 1) && PROBE_SEGSEL(9)) prof_val += (float)(now_ - prof_t) * 0.01f; prof_t = now_; } } while (0)
    unsigned long long prof_t = __builtin_amdgcn_s_memrealtime(); float prof_val = 0.f;
#else
#define SEAM(k) do { if (IN(k) && IN((k) + 1)) { for (int rb_ = 0; rb_ < REP_BAR; ++rb_) SEAM_BAR(k); } } while (0)
#endif

#if defined(REP_ALL)
    for (int ra_ = 0; ra_ < REP_ALL; ++ra_) {
#endif
    if (IN(0)) { for (int rp_ = 0; rp_ < REP_PRO; ++rp_) p0_prologue(F, args); }
    SEAM(0);
#ifndef NO_XCD_GROUPS
    if (lo == 0 && hi == N_PHASES) {
        if (threadIdx.x == 0) { unsigned ok = (F.G == 256) ? 1u : 0u; unsigned* bw = (unsigned*)(F.ctl + CW_BAR) + args.li * XCD_BAR_WORDS;
            for (unsigned j = 0; j < 16; ++j) { const unsigned c = xb_ld(&bw[XB_XCNT(j)]); if (c != (j < 8u ? 32u : 0u)) ok = 0u; }
            if (F.MISC[10] >= 32u) ok = 0u;
            F.MISC[11] = ok; }
        __syncthreads();
        if (F.MISC[11]) { const int rank = (int)F.MISC[10]; F.grp = 1; F.vcu = (int)bar.x * 32 + rank; F.cidx = rank * 8 + (int)bar.x; }
    }
#endif

    run_layer<0>(F, args, bar, lo, hi, lds PROF_ARGS); run_layer<1>(F, args, bar, lo, hi, lds PROF_ARGS); run_layer<2>(F, args, bar, lo, hi, lds PROF_ARGS); run_layer<3>(F, args, bar, lo, hi, lds PROF_ARGS);
#if defined(REP_ALL)
    }
#endif
    if (IN(N_PHASES - 1)) { refresh(F); unsigned char* ws = launder_ptr(args.ws); final_norm_phase(F, (const bf16*)(ws + WS_HB), (const float*)(ws + WS_SS), args.out, args.in[13]);
#if defined(PROBE_TS)
        if ((PROBE_TS >> (N_PHASES - 1)) & 1) prof_val += (float)(__builtin_amdgcn_s_memrealtime() - prof_t) * 0.01f;
        if (blockIdx.x == 0) { const unsigned long long t0_ = __builtin_amdgcn_s_memrealtime(); const unsigned long long wait_ = (unsigned long long)(prof_val * 100.0f * 4.0f);
            while (__builtin_amdgcn_s_memrealtime() - t0_ < wait_) __builtin_amdgcn_s_sleep(8); }
#endif
    }
#undef IN
#undef SEAM
}

extern "C" void kernel_launch(void* const* d_in, const int* in_sizes, int n_in, void* d_out, int out_size, void* d_ws, size_t ws_size, hipStream_t stream) {
    static int grid = 0;
    if (grid == 0) {
        if (n_in != 14 || in_sizes[0] != M * DMODEL || out_size != M * DMODEL || ws_size < WS_END) { fprintf(stderr, "kernel_launch: unexpected shapes: n_in %d in0 %d out %d ws %zu (need %zu)\n", n_in, n_in > 0 ? in_sizes[0] : -1, out_size, ws_size, (size_t)WS_END); grid = -1; return; }
        int dev = 0, cus = 0, per_cu = 0;
        if (hipGetDevice(&dev) != hipSuccess || hipDeviceGetAttribute(&cus, hipDeviceAttributeMultiprocessorCount, dev) != hipSuccess) { fprintf(stderr, "kernel_launch: device query failed\n"); grid = -1; return; }
        if (hipFuncSetAttribute((const void*)trunk_fwd, hipFuncAttributeMaxDynamicSharedMemorySize, LDS_BYTES) != hipSuccess) { fprintf(stderr, "kernel_launch: hipFuncSetAttribute failed\n"); grid = -1; return; }
        if (hipOccupancyMaxActiveBlocksPerMultiprocessor(&per_cu, (const void*)trunk_fwd, NWAVES * 64, LDS_BYTES) != hipSuccess || per_cu < 1) fprintf(stderr, "kernel_launch: note: occupancy query reports %d blocks per CU\n", per_cu);
        (void)hipGetLastError();
        grid = cus;
    }
    if (grid < 0) return;
    if (hipMemsetAsync((char*)d_ws + WS_CTL, 0, CTL_ZERO_BYTES, stream) != hipSuccess) { fprintf(stderr, "kernel_launch: memset failed\n"); return; }
    Args a{};
    for (int i = 0; i < 14; ++i) a.in[i] = (const float*)d_in[i];
    a.out = (float*)d_out; a.ws = (unsigned char*)d_ws;
#if defined(REP_LAUNCH)
    constexpr int NL = REP_LAUNCH;
    for (int li = 0; li < NL; ++li) {
        a.ph_lo = 0; a.ph_hi = N_PHASES; a.li = li;
#else
    constexpr int NL = MK_N_LAUNCHES;
    for (int li = 0; li < NL; ++li) {
        a.ph_lo = (NL == 1) ? 0 : li; a.ph_hi = (NL == 1) ? N_PHASES : li + 1; a.li = li;
#endif
        hipLaunchKernelGGL(trunk_fwd, dim3(grid), dim3(NWAVES * 64), LDS_BYTES, stream, a);
        const hipError_t le = hipPeekAtLastError();
        if (le != hipSuccess) { fprintf(stderr, "kernel_launch: launch %d failed: %s\n", li, hipGetErrorName(le)); break; }
    }
}
```
